# Optimizing an MI355X kernel written in HIP

```python
import math
import jax, jax.numpy as jnp
from jax import lax
import numpy as np

D_MODEL = 2048
BATCH = 8
SEQ = 2048
DEPTH = 2

M_WIDTH = D_MODEL // 4
G_WIDTH = D_MODEL // 4
A_WIDTH = D_MODEL // 2
M_HEADS = 4
M_V = M_WIDTH // M_HEADS
M_QK = M_V // 2
M_CHUNK = 128
CONV_W = 4
G_HEADS = 4
G_V = G_WIDTH // G_HEADS
G_QK = G_V // 2
G_RANK = 16
G_TAU = 16.0
G_CHUNK = 64
A_HD = 64
A_HEADS = A_WIDTH // A_HD
A_KV = A_HEADS // 8
WINDOW = 128
A_BLOCK = WINDOW
N_BUCKETS = 32
MAX_DIST = 128
D_FF = ((8 * D_MODEL // 3 + 255) // 256) * 256
N_EXPERTS = 8
TOP_K = 2
D_FF_E = 7 * D_MODEL // 2
EPS = 1e-6

IN_SPLITS = [
    M_HEADS * M_QK, M_HEADS * M_QK, M_WIDTH, M_WIDTH, 2 * M_HEADS,
    G_HEADS * G_QK, G_HEADS * G_QK, G_WIDTH, G_WIDTH, G_RANK,
    A_HEADS * A_HD, A_KV * A_HD, A_KV * A_HD,
]
N_IN = sum(IN_SPLITS)

kernel_name = "hybrid_mlstm_gla_swa_moe_block"


def _rmsnorm(x, g):
    x32 = x.astype(jnp.float32)
    y = x32 * lax.rsqrt(jnp.mean(x32 * x32, axis=-1, keepdims=True) + EPS)
    return (y * g.astype(jnp.float32)).astype(x.dtype)


def _causal_dwconv(x, w, b):
    ch = x.shape[-1]
    y = lax.conv_general_dilated(x, w[:, None, :].astype(x.dtype), window_strides=(1,),
                                 padding=[(CONV_W - 1, 0)],
                                 dimension_numbers=('NWC', 'WIO', 'NWC'),
                                 feature_group_count=ch)
    return y + b


def _to_chunks(t, L):
    B, S = t.shape[:2]
    t = t.reshape((B, S // L, L) + t.shape[2:])
    return jnp.moveaxis(t, (1, 3), (0, 2))


def _from_chunks(t):
    t = jnp.moveaxis(t, (0, 2), (1, 3))
    return t.reshape((t.shape[0], t.shape[1] * t.shape[2]) + t.shape[3:])


def _mlstm(q, k, v, i_pre, log_f):
    B, S, H, dk = q.shape
    dv = v.shape[-1]
    L = M_CHUNK
    f32 = jnp.float32
    causal = jnp.asarray(np.tril(np.ones((L, L), dtype=bool)))

    def step(carry, inp):
        C, n, m = carry
        qc, kc, vc, ic, lfc = inp
        b = jnp.cumsum(lfc, axis=-1)
        log_d = jnp.where(causal, b[..., :, None] - b[..., None, :] + ic[..., None, :], -jnp.inf)
        log_inter = b + m[..., None]
        m_row = jnp.maximum(log_inter, jnp.max(log_d, axis=-1))
        d_mat = jnp.exp(log_d - m_row[..., None])
        w_inter = jnp.exp(log_inter - m_row)
        s = jnp.einsum('bhjk,bhsk->bhjs', qc, kc) * d_mat
        num = (w_inter[..., None] * jnp.einsum('bhjk,bhvk->bhjv', qc, C)
               + jnp.einsum('bhjs,bhsv->bhjv', s, vc))
        den = w_inter * jnp.einsum('bhjk,bhk->bhj', qc, n) + jnp.sum(s, axis=-1)
        h = num / jnp.maximum(jnp.abs(den), jnp.exp(-m_row))[..., None]
        b_last = b[..., -1]
        log_w = b_last[..., None] - b + ic
        m_new = jnp.maximum(b_last + m, jnp.max(log_w, axis=-1))
        w = jnp.exp(log_w - m_new[..., None])
        decay = jnp.exp(b_last + m - m_new)
        C = decay[..., None, None] * C + jnp.einsum('bhsv,bhsk->bhvk', vc * w[..., None], kc)
        n = decay[..., None] * n + jnp.einsum('bhs,bhsk->bhk', w, kc)
        return (C, n, m_new), h

    init = (jnp.zeros((B, H, dv, dk), f32), jnp.zeros((B, H, dk), f32), jnp.zeros((B, H), f32))
    xs = tuple(_to_chunks(t.astype(f32), L) for t in (q, k, v, i_pre, log_f))
    _, h = lax.scan(step, init, xs)
    return _from_chunks(h)


def _gla(q, k, v, log_a):
    B, S, H, dk = q.shape
    dv = v.shape[-1]
    L = G_CHUNK
    f32 = jnp.float32
    causal = jnp.asarray(np.tril(np.ones((L, L), dtype=bool)))

    def step(state, inp):
        qc, kc, vc, lac = inp
        b = jnp.cumsum(lac, axis=2)
        o_inter = jnp.einsum('bhjk,bhkv->bhjv', qc * jnp.exp(b), state)
        rel = jnp.where(causal[..., None], b[:, :, :, None, :] - b[:, :, None, :, :], -jnp.inf)
        att = jnp.einsum('bhjsk,bhjk->bhjs', kc[:, :, None, :, :] * jnp.exp(rel), qc)
        o_intra = jnp.einsum('bhjs,bhsv->bhjv', att, vc)
        b_last = b[:, :, -1]
        state = (jnp.exp(b_last)[..., None] * state
                 + jnp.einsum('bhsk,bhsv->bhkv', kc * jnp.exp(b_last[:, :, None, :] - b), vc))
        return state, o_inter + o_intra

    init = jnp.zeros((B, H, dk, dv), f32)
    xs = tuple(_to_chunks(t.astype(f32), L) for t in (q, k, v, log_a))
    _, o = lax.scan(step, init, xs)
    return _from_chunks(o)


def _t5_bucket(dist):
    max_exact = N_BUCKETS // 2
    d = np.maximum(dist, 1).astype(np.float32)
    large = max_exact + (np.log(d / max_exact) / math.log(MAX_DIST / max_exact)
                         * (N_BUCKETS - max_exact)).astype(np.int32)
    large = np.minimum(large, N_BUCKETS - 1)
    return np.where(dist < max_exact, dist, large).astype(np.int32)


def _swa_sinks(q, k, v, g_q, g_k, sinks, rel_bias):
    f32 = jnp.float32
    B, S, HQ, d = q.shape
    HKV = k.shape[2]
    G = HQ // HKV
    T = A_BLOCK
    nb = S // T
    q = _rmsnorm(q, g_q).astype(f32)
    k = _rmsnorm(k, g_k).astype(f32)
    v = v.astype(f32)
    qb = q.reshape(B, nb, T, HKV, G, d)

    def band(t):
        tp = jnp.pad(t, ((0, 0), (T, 0), (0, 0), (0, 0)))[:, :S]
        return jnp.concatenate([tp.reshape(B, nb, T, HKV, d), t.reshape(B, nb, T, HKV, d)], axis=2)

    kb, vb = band(k), band(v)
    j = np.arange(T)[:, None]
    s = np.arange(2 * T)[None, :]
    dist = j + T - s
    valid = (dist >= 0) & (dist < WINDOW)
    key_ok = (np.arange(nb)[:, None, None] * T - T + s[None]) >= 0
    mask = jnp.asarray(valid[None] & key_ok)
    buckets = _t5_bucket(np.clip(dist, 0, None))
    bias = jnp.transpose(rel_bias.astype(f32)[buckets], (2, 0, 1)).reshape(HKV, G, T, 2 * T)
    scores = jnp.einsum('bnjhgd,bnshd->bnhgjs', qb, kb) * (d ** -0.5) + bias
    scores = jnp.where(mask[None, :, None, None], scores, -jnp.inf)
    sink = sinks.astype(f32).reshape(HKV, G)[None, None, :, :, None]
    m = jnp.maximum(jnp.max(scores, axis=-1), sink)
    p = jnp.exp(scores - m[..., None])
    denom = jnp.sum(p, axis=-1) + jnp.exp(sink - m)
    out = jnp.einsum('bnhgjs,bnshd->bnjhgd', p, vb) / jnp.transpose(denom, (0, 1, 4, 2, 3))[..., None]
    return out.reshape(B, S, HQ * d)


def _hybrid_mixer(h, w_in, b_gates_m, w_conv_m, b_conv_m, g_out_m, w_gla_decay, b_gla_decay,
                  g_out_g, g_qnorm, g_knorm, sinks, rel_bias, w_out):
    B, S, _ = h.shape
    dt = h.dtype
    proj = h @ w_in
    (mq, mk, mv, mo, mif, gq, gk, gv, gg, ga, aq, ak, av) = jnp.split(
        proj, np.cumsum(IN_SPLITS)[:-1].tolist(), axis=-1)

    qk = jax.nn.silu(_causal_dwconv(jnp.concatenate([mq, mk], axis=-1), w_conv_m, b_conv_m))
    mq, mk = jnp.split(qk, 2, axis=-1)
    mq = mq.reshape(B, S, M_HEADS, M_QK)
    mk = mk.reshape(B, S, M_HEADS, M_QK) * (M_QK ** -0.5)
    mv = mv.reshape(B, S, M_HEADS, M_V)
    mif = mif.astype(jnp.float32)
    i_pre = mif[..., :M_HEADS] + b_gates_m[0].astype(jnp.float32)
    log_f = jax.nn.log_sigmoid(mif[..., M_HEADS:] + b_gates_m[1].astype(jnp.float32))
    hm = _mlstm(mq, mk, mv, i_pre, log_f)
    hm = _rmsnorm(hm, g_out_m.reshape(M_HEADS, M_V)).reshape(B, S, M_WIDTH)
    y_m = (hm * jax.nn.sigmoid(mo.astype(jnp.float32))).astype(dt)

    log_a = jax.nn.log_sigmoid((ga @ w_gla_decay + b_gla_decay).astype(jnp.float32)) / G_TAU
    og = _gla((gq * (G_QK ** -0.5)).reshape(B, S, G_HEADS, G_QK),
              gk.reshape(B, S, G_HEADS, G_QK),
              gv.reshape(B, S, G_HEADS, G_V),
              log_a.reshape(B, S, G_HEADS, G_QK))
    og = _rmsnorm(og, g_out_g.reshape(G_HEADS, G_V)).reshape(B, S, G_WIDTH)
    y_g = (og * jax.nn.silu(gg.astype(jnp.float32))).astype(dt)

    y_a = _swa_sinks(aq.reshape(B, S, A_HEADS, A_HD), ak.reshape(B, S, A_KV, A_HD),
                     av.reshape(B, S, A_KV, A_HD), g_qnorm, g_knorm, sinks, rel_bias).astype(dt)

    return jnp.concatenate([y_m, y_g, y_a], axis=-1) @ w_out


def _swiglu(h, wg, wu, wd):
    return (jax.nn.silu(h @ wg) * (h @ wu)) @ wd


def _moe_swiglu(h, w_router, w_gate, w_up, w_down):
    B, S, D = h.shape
    t = h.reshape(B * S, D)
    logits = (t @ w_router).astype(jnp.float32)
    top_val, top_idx = lax.top_k(logits, TOP_K)
    top_w = jax.nn.softmax(top_val, axis=-1)
    gates = jnp.sum(jax.nn.one_hot(top_idx, N_EXPERTS, dtype=jnp.float32) * top_w[..., None], axis=1)
    gates = gates.astype(t.dtype)
    out = jnp.zeros_like(t)
    for e in range(N_EXPERTS):
        out = out + gates[:, e:e + 1] * _swiglu(t, w_gate[e], w_up[e], w_down[e])
    return out.reshape(B, S, D)


def setup_inputs(seed: int = 0) -> dict:
    key = jax.random.key(seed)
    ks = jax.random.split(key, 32)
    f32 = jnp.float32
    n_even = (DEPTH + 1) // 2
    n_odd = DEPTH // 2

    def nrm(k, shape, scale):
        return jax.random.normal(k, shape, f32) * scale

    return {
        "x": nrm(ks[0], (BATCH, SEQ, D_MODEL), 1.0),
        "c": nrm(ks[1], (BATCH, D_MODEL), 1.0),
        "w_ada": nrm(ks[2], (DEPTH, D_MODEL, 6 * D_MODEL), D_MODEL ** -0.5),
        "b_ada": nrm(ks[3], (DEPTH, 6 * D_MODEL), 0.02),
        "g_mix_norm": 1.0 + nrm(ks[4], (DEPTH, D_MODEL), 0.02),
        "g_ffn_norm": 1.0 + nrm(ks[5], (DEPTH, D_MODEL), 0.02),
        "w_in": nrm(ks[6], (DEPTH, D_MODEL, N_IN), D_MODEL ** -0.5),
        "b_gates_m": jnp.stack([nrm(ks[7], (DEPTH, M_HEADS), 0.1),
                                3.0 + nrm(ks[8], (DEPTH, M_HEADS), 0.1)], axis=1),
        "w_conv_m": nrm(ks[9], (DEPTH, CONV_W, 2 * M_HEADS * M_QK), CONV_W ** -0.5),
        "b_conv_m": nrm(ks[10], (DEPTH, 2 * M_HEADS * M_QK), 0.02),
        "g_out_m": 1.0 + nrm(ks[11], (DEPTH, M_WIDTH), 0.02),
        "w_gla_decay": nrm(ks[12], (DEPTH, G_RANK, G_HEADS * G_QK), G_RANK ** -0.5),
        "b_gla_decay": nrm(ks[13], (DEPTH, G_HEADS * G_QK), 0.1),
        "g_out_g": 1.0 + nrm(ks[14], (DEPTH, G_WIDTH), 0.02),
        "g_qnorm": 1.0 + nrm(ks[15], (DEPTH, A_HD), 0.02),
        "g_knorm": 1.0 + nrm(ks[16], (DEPTH, A_HD), 0.02),
        "sinks": nrm(ks[17], (DEPTH, A_HEADS), 0.5),
        "rel_bias": nrm(ks[18], (N_BUCKETS, A_HEADS), 0.5),
        "w_out": nrm(ks[19], (DEPTH, D_MODEL, D_MODEL), D_MODEL ** -0.5),
        "w_ffn_gate": nrm(ks[20], (n_even, D_MODEL, D_FF), D_MODEL ** -0.5),
        "w_ffn_up": nrm(ks[21], (n_even, D_MODEL, D_FF), D_MODEL ** -0.5),
        "w_ffn_down": nrm(ks[22], (n_even, D_FF, D_MODEL), D_FF ** -0.5),
        "w_router": nrm(ks[23], (n_odd, D_MODEL, N_EXPERTS), D_MODEL ** -0.5),
        "w_moe_gate": nrm(ks[24], (n_odd, N_EXPERTS, D_MODEL, D_FF_E), D_MODEL ** -0.5),
        "w_moe_up": nrm(ks[25], (n_odd, N_EXPERTS, D_MODEL, D_FF_E), D_MODEL ** -0.5),
        "w_moe_down": nrm(ks[26], (n_odd, N_EXPERTS, D_FF_E, D_MODEL), D_FF_E ** -0.5),
    }


def reference(x, c, w_ada, b_ada, g_mix_norm, g_ffn_norm, w_in, b_gates_m, w_conv_m, b_conv_m,
              g_out_m, w_gla_decay, b_gla_decay, g_out_g, g_qnorm, g_knorm, sinks, rel_bias,
              w_out, w_ffn_gate, w_ffn_up, w_ffn_down, w_router, w_moe_gate, w_moe_up, w_moe_down):
    cond = jax.nn.silu(c)
    for l in range(DEPTH):
        mod = cond @ w_ada[l] + b_ada[l]
        sh_a, sc_a, gt_a, sh_f, sc_f, gt_f = jnp.split(mod[:, None, :], 6, axis=-1)
        h = _rmsnorm(x, g_mix_norm[l]) * (1 + sc_a) + sh_a
        x = x + gt_a * _hybrid_mixer(h, w_in[l], b_gates_m[l], w_conv_m[l], b_conv_m[l], g_out_m[l],
                                     w_gla_decay[l], b_gla_decay[l], g_out_g[l], g_qnorm[l],
                                     g_knorm[l], sinks[l], rel_bias, w_out[l])
        h = _rmsnorm(x, g_ffn_norm[l]) * (1 + sc_f) + sh_f
        if l % 2 == 0:
            y = _swiglu(h, w_ffn_gate[l // 2], w_ffn_up[l // 2], w_ffn_down[l // 2])
        else:
            y = _moe_swiglu(h, w_router[l // 2], w_moe_gate[l // 2], w_moe_up[l // 2], w_moe_down[l // 2])
        x = x + gt_f * y
    return x
```

```cpp
#include <hip/hip_runtime.h>
#include <cstdio>
#include <cstdint>
namespace pg8 {
#define PG8_LAS __attribute__((address_space(3)))
typedef unsigned short bf16_t;
typedef short bf16x8 __attribute__((ext_vector_type(8)));
typedef float f32x4 __attribute__((ext_vector_type(4)));
typedef unsigned u32x4 __attribute__((ext_vector_type(4)));
constexpr int BM = 256, BK = 64, HALF = 128, HTB = HALF * BK * 2  , STAGE_BYTES = 8 * HTB, NXCD = 8, WGM = 8;

__host__ __device__ __forceinline__ int lds_byte(int r, int c) { const int st = (r >> 4) * 2 + (c >> 5), rr = r & 15, cc = c & 31, ob = rr * 64 + cc * 2; return st * 1024 + (ob ^ (((ob >> 9) & 1) << 5)); }
__host__ __device__ __forceinline__ void stage_rc(int b, int& R, int& C) { const int st = b / 1024, sb = b % 1024, swz = sb ^ (((sb >> 9) & 1) << 5); R = (st >> 1) * 16 + swz / 64; C = (st & 1) * 32 + (swz % 64) / 2; }
__host__ __device__ __forceinline__ int perm32(int rho) { const int n = rho >> 4, i = rho & 15; return 8 * (i >> 2) + 4 * n + (i & 3); }

struct Unit { int pm, pn; };
struct Gemm { const bf16_t* A; const bf16_t* Bt; int M, N, K; };

struct StaticOrder {
    int nM, nN, nwg, G, c;
    __host__ __device__ void init(int M, int N, int G_, int c_) { nM = M / BM; nN = N / BM; nwg = nM * nN; G = G_; c = c_; }
    __host__ __device__ bool next(int i, Unit& u) const {
        const long L = (long)i * G + c; if (L >= nwg) return false;
        int wgid = (int)L; { const int q = nwg / NXCD, r = nwg % NXCD, xcd = wgid % NXCD, off = wgid / NXCD; wgid = (xcd < r ? xcd * (q + 1) : r * (q + 1) + (xcd - r) * q) + off; }
        const int nig = WGM * nN, gid = wgid / nig, fm = gid * WGM, gsz = (nM - fm) < WGM ? (nM - fm) : WGM;
        u.pm = fm + ((wgid % nig) % gsz); u.pn = (wgid % nig) / gsz; return true;
    }
    __device__ __forceinline__ void a_ready(const Unit&) const {}
    __device__ __forceinline__ void done(const Unit&) const {}
};
__device__ __forceinline__ unsigned cvt_pk_bf16(float lo, float hi) { unsigned r; asm volatile("v_cvt_pk_bf16_f32 %0, %1, %2" : "=v"(r) : "v"(lo), "v"(hi)); return r; }
typedef unsigned u32x2 __attribute__((ext_vector_type(2)));
__device__ __forceinline__ float fast_silu(float g) { return g * __builtin_amdgcn_rcpf(1.0f + __expf(-g)); }
struct EpiProj {
    static constexpr bool PERM = true, AFTER_DRAIN = false;
    bf16_t* O; float* side;
    __device__ __forceinline__ void operator()(const f32x4 (&acc)[2][2][4][2], const Unit& u, int wr, int wc, int fr, int fq) const {
        const int row0 = u.pm * BM + wr * 64 + fr;
        if (u.pn < 17) {
            const int col0 = u.pn * BM + wc * 32 + 8 * fq;
#pragma unroll
            for (int ai = 0; ai < 2; ++ai)
#pragma unroll
                for (int m = 0; m < 4; ++m) { bf16_t* rowp = O + (size_t)(row0 + ai * HALF + m * 16) * 4352 + col0;
#pragma unroll
                    for (int bj = 0; bj < 2; ++bj) { const f32x4 v0 = acc[ai][bj][m][0], v1 = acc[ai][bj][m][1];
                        u32x4 w; w.x = cvt_pk_bf16(v0[0], v0[1]); w.y = cvt_pk_bf16(v0[2], v0[3]); w.z = cvt_pk_bf16(v1[0], v1[1]); w.w = cvt_pk_bf16(v1[2], v1[3]);
                        *(u32x4*)(rowp + bj * HALF) = w; } }
        } else if (wc == 0) {
#pragma unroll
            for (int ai = 0; ai < 2; ++ai)
#pragma unroll
                for (int m = 0; m < 4; ++m) { float* rowp = side + (size_t)(row0 + ai * HALF + m * 16) * 32 + 8 * fq;
                    *(f32x4*)(rowp) = acc[ai][0][m][0]; *(f32x4*)(rowp + 4) = acc[ai][0][m][1]; }
        }
    }
};
struct EpiResid {
    static constexpr bool PERM = false, AFTER_DRAIN = false;
    const float* base; float* out; const float* gate;
    __device__ __forceinline__ void operator()(const f32x4 (&acc)[2][2][4][2], const Unit& u, int wr, int wc, int fr, int fq) const {
        const int row0 = u.pm * BM + wr * 64 + fr, col0 = u.pn * BM + wc * 32 + 4 * fq;
        const float* __restrict__ gp = gate + (size_t)(u.pm >> 3) * 12288 + col0;
        const float* __restrict__ bp = base + (size_t)row0 * 2048 + col0; float* __restrict__ op = out + (size_t)row0 * 2048 + col0;
        f32x4 gv[2][2];
#pragma unroll
        for (int bj = 0; bj < 2; ++bj)
#pragma unroll
            for (int n = 0; n < 2; ++n) gv[bj][n] = *(const f32x4*)(gp + bj * HALF + n * 16);
        f32x4 cur[2][2], nxt[2][2];
#pragma unroll
        for (int bj = 0; bj < 2; ++bj)
#pragma unroll
            for (int n = 0; n < 2; ++n) cur[bj][n] = *(const f32x4*)(bp + bj * HALF + n * 16);
#pragma unroll
        for (int g = 0; g < 8; ++g) { const int ai = g >> 2, m = g & 3; const size_t off = (size_t)(ai * HALF + m * 16) * 2048;
            if (g < 7) { const int ai2 = (g + 1) >> 2, m2 = (g + 1) & 3; const size_t off2 = (size_t)(ai2 * HALF + m2 * 16) * 2048;
#pragma unroll
                for (int bj = 0; bj < 2; ++bj)
#pragma unroll
                    for (int n = 0; n < 2; ++n) nxt[bj][n] = *(const f32x4*)(bp + off2 + bj * HALF + n * 16); }
#pragma unroll
            for (int bj = 0; bj < 2; ++bj)
#pragma unroll
                for (int n = 0; n < 2; ++n) *(f32x4*)(op + off + bj * HALF + n * 16) = cur[bj][n] + gv[bj][n] * acc[ai][bj][m][n];
#pragma unroll
            for (int bj = 0; bj < 2; ++bj)
#pragma unroll
                for (int n = 0; n < 2; ++n) cur[bj][n] = nxt[bj][n];
            asm volatile("" ::: "memory"); }
    }
};
struct EpiSwiglu {
    static constexpr bool PERM = true, AFTER_DRAIN = false;
    bf16_t* O; int ldc; int nN;
    __device__ __forceinline__ void operator()(const f32x4 (&acc)[2][2][4][2], const Unit& u, int wr, int wc, int fr, int fq) const {
        const int row0 = u.pm * BM + wr * 64 + fr, col0 = (u.pn % nN) * HALF + wc * 32 + 8 * fq;
#pragma unroll
        for (int ai = 0; ai < 2; ++ai)
#pragma unroll
            for (int m = 0; m < 4; ++m) { bf16_t* rowp = O + (size_t)(row0 + ai * HALF + m * 16) * ldc + col0;
                const f32x4 g0 = acc[ai][0][m][0], g1 = acc[ai][0][m][1], u0 = acc[ai][1][m][0], u1 = acc[ai][1][m][1];
                u32x4 w; w.x = cvt_pk_bf16(fast_silu(g0[0]) * u0[0], fast_silu(g0[1]) * u0[1]); w.y = cvt_pk_bf16(fast_silu(g0[2]) * u0[2], fast_silu(g0[3]) * u0[3]);
                w.z = cvt_pk_bf16(fast_silu(g1[0]) * u1[0], fast_silu(g1[1]) * u1[1]); w.w = cvt_pk_bf16(fast_silu(g1[2]) * u1[2], fast_silu(g1[3]) * u1[3]);
                *(u32x4*)(rowp) = w; }
    }
};
struct EpiPlainBf16 {
    static constexpr bool PERM = true, AFTER_DRAIN = false;
    bf16_t* O; int ldc; int nN;
    __device__ __forceinline__ void operator()(const f32x4 (&acc)[2][2][4][2], const Unit& u, int wr, int wc, int fr, int fq) const {
        const int row0 = u.pm * BM + wr * 64 + fr, col0 = (u.pn % nN) * BM + wc * 32 + 8 * fq;
#pragma unroll
        for (int ai = 0; ai < 2; ++ai)
#pragma unroll
            for (int m = 0; m < 4; ++m) { bf16_t* rowp = O + (size_t)(row0 + ai * HALF + m * 16) * ldc + col0;
#pragma unroll
                for (int bj = 0; bj < 2; ++bj) { const f32x4 v0 = acc[ai][bj][m][0], v1 = acc[ai][bj][m][1];
                    u32x4 w; w.x = cvt_pk_bf16(v0[0], v0[1]); w.y = cvt_pk_bf16(v0[2], v0[3]); w.z = cvt_pk_bf16(v1[0], v1[1]); w.w = cvt_pk_bf16(v1[2], v1[3]);
                    *(u32x4*)(rowp + bj * HALF) = w; } }
    }
};
struct GroupedOrder {
    int nM, nN, nwg, G, c; const PG8_LAS int* tile_e;
    __device__ void init(int nM_, int nN_, int G_, int c_, const PG8_LAS int* te) { nM = nM_; nN = nN_; nwg = nM * nN; G = G_; c = c_; tile_e = te; }
    __device__ bool next(int i, Unit& u) const {
        const long L = (long)i * G + c; if (L >= nwg) return false;
        int wgid = (int)L; { const int q = nwg / NXCD, r = nwg % NXCD, xcd = wgid % NXCD, off = wgid / NXCD; wgid = (xcd < r ? xcd * (q + 1) : r * (q + 1) + (xcd - r) * q) + off; }
        const int nig = WGM * nN, gid = wgid / nig, fm = gid * WGM, gsz = (nM - fm) < WGM ? (nM - fm) : WGM;
        u.pm = fm + ((wgid % nig) % gsz); u.pn = tile_e[u.pm] * nN + (wgid % nig) / gsz; return true;
    }
    __device__ __forceinline__ void a_ready(const Unit&) const {}
    __device__ __forceinline__ void done(const Unit&) const {}
};
template <class Epi, class Sched, bool ALIGN_EPI = false, bool SP2 = false>
__device__ __forceinline__ void gemm_phase(PG8_LAS unsigned char* lds, const Gemm g, const Sched& S, const Epi& E) {
    const int tid = threadIdx.x, wid = __builtin_amdgcn_readfirstlane(tid >> 6), lane = tid & 63, wr = wid >> 2, wc = wid & 3, fr = lane & 15, fq = lane >> 4;
    const int K = g.K, nt = K / BK;
    unsigned voffA[2], voffB[2];
#pragma unroll
    for (int i = 0; i < 2; ++i) { int R, C; stage_rc(tid * 16 + i * 8192, R, C); const int Rb = Epi::PERM ? ((R & ~31) + perm32(R & 31)) : R;
        voffA[i] = (unsigned)(R * K + C) * 2u; voffB[i] = (unsigned)(Rb * K + C) * 2u; }
    const size_t kstep = (size_t)(BK * 2);
    const size_t hstep = (size_t)HALF * K * 2;
    const size_t tstep = 2 * hstep;
    const unsigned ldsw = (unsigned)wid * 1024u;
    const int aoff = lds_byte(wr * 64 + fr, fq * 8), boff = lds_byte(wc * 32 + fr, fq * 8);
#define PG8_SA(b, h) (((b) * 2 + (h)) * HTB)
#define PG8_SB(b, h) ((4 + (b) * 2 + (h)) * HTB)
#define PG8_STAGE(bufoff, gbase, voff) do { _Pragma("unroll") for (int _i = 0; _i < 2; ++_i) \
        __builtin_amdgcn_global_load_lds((const unsigned*)((const char*)(gbase) + (voff)[_i]), (PG8_LAS unsigned*)(lds + (bufoff) + ldsw + _i * 8192), 16, 0, 0); } while (0)
#define PG8_LDA(dst, b, h) do { _Pragma("unroll") for (int m = 0; m < 4; ++m) _Pragma("unroll") for (int k = 0; k < 2; ++k) dst[m][k] = *(const PG8_LAS bf16x8*)(lds + PG8_SA(b, h) + aoff + m * 2048 + k * 1024); } while (0)
#define PG8_LDB(dst, b, h) do { _Pragma("unroll") for (int n = 0; n < 2; ++n) _Pragma("unroll") for (int k = 0; k < 2; ++k) dst[n][k] = *(const PG8_LAS bf16x8*)(lds + PG8_SB(b, h) + boff + n * 2048 + k * 1024); } while (0)
#define PG8_MMA(ai, bj, At, Bt) do { __builtin_amdgcn_s_setprio(1); _Pragma("unroll") for (int m = 0; m < 4; ++m) _Pragma("unroll") for (int n = 0; n < 2; ++n) _Pragma("unroll") for (int k = 0; k < 2; ++k) \
        acc[ai][bj][m][n] = __builtin_amdgcn_mfma_f32_16x16x32_bf16(Bt[n][k], At[m][k], acc[ai][bj][m][n], 0, 0, 0); __builtin_amdgcn_s_setprio(0); } while (0)
#define PG8_WAIT_V(n) asm volatile("s_waitcnt vmcnt(" #n ")" ::: "memory")
#define PG8_WAIT_L(n) asm volatile("s_waitcnt lgkmcnt(" #n ")" ::: "memory")
#define PG8_BAR __builtin_amdgcn_s_barrier()
#define PG8_SCHED __builtin_amdgcn_sched_barrier(0)
    Unit cur, nxt; int ui = 0;
    if (!S.next(0, cur)) return;
    f32x4 acc[2][2][4][2];
#pragma unroll
    for (int a = 0; a < 2; ++a)
#pragma unroll
        for (int b = 0; b < 2; ++b)
#pragma unroll
            for (int m = 0; m < 4; ++m)
#pragma unroll
                for (int n = 0; n < 2; ++n) acc[a][b][m][n] = (f32x4){0.f, 0.f, 0.f, 0.f};
    bf16x8 At[4][2], B0[2][2], B1[2][2];
    const char* cA = (const char*)g.A + (size_t)cur.pm * tstep; const char* cB = (const char*)g.Bt + (size_t)cur.pn * tstep;
    S.a_ready(cur);
    if constexpr (SP2) {
        PG8_STAGE(PG8_SB(0, 0), cB, voffB); PG8_STAGE(PG8_SB(0, 1), cB + hstep, voffB); PG8_STAGE(PG8_SA(0, 0), cA, voffA); PG8_STAGE(PG8_SA(0, 1), cA + hstep, voffA);
        if (wr == 1) PG8_BAR;
        PG8_WAIT_V(2); PG8_BAR;
        PG8_STAGE(PG8_SB(1, 0), cB + kstep, voffB); PG8_STAGE(PG8_SA(1, 0), cA + kstep, voffA); PG8_STAGE(PG8_SB(1, 1), cB + hstep + kstep, voffB);
        PG8_WAIT_V(6); PG8_BAR;
    } else {
        PG8_STAGE(PG8_SB(0, 0), cB, voffB); PG8_STAGE(PG8_SA(0, 0), cA, voffA); PG8_STAGE(PG8_SB(0, 1), cB + hstep, voffB); PG8_STAGE(PG8_SA(0, 1), cA + hstep, voffA);
        if (wr == 1) PG8_BAR;
        PG8_WAIT_V(4); PG8_BAR;
        PG8_STAGE(PG8_SB(1, 0), cB + kstep, voffB); PG8_STAGE(PG8_SA(1, 0), cA + kstep, voffA); PG8_STAGE(PG8_SB(1, 1), cB + hstep + kstep, voffB);
        PG8_WAIT_V(6); PG8_BAR;
    }
    for (;;) {
        const bool has_next = S.next(ui + 1, nxt);
        const char* nA = has_next ? (const char*)g.A + (size_t)nxt.pm * tstep : cA; const char* nB = has_next ? (const char*)g.Bt + (size_t)nxt.pn * tstep : cB;
        for (int t = 0; t < nt; t += 2) {
            const bool last = (t == nt - 2);
            const char* a1 = cA + (size_t)(t + 1) * kstep;
            const char* a2 = last ? nA : cA + (size_t)(t + 2) * kstep; const char* b2 = last ? nB : cB + (size_t)(t + 2) * kstep;
            const char* a3 = a2 + kstep; const char* b3 = b2 + kstep;
            if (last && has_next) S.a_ready(nxt);
            if constexpr (SP2) {
            PG8_LDB(B0, 0, 0); PG8_LDB(B1, 0, 1); PG8_SCHED; PG8_LDA(At, 0, 0); PG8_STAGE(PG8_SA(1, 1), a1 + hstep, voffA);
            PG8_WAIT_V(8); PG8_WAIT_L(0); PG8_BAR; PG8_MMA(0, 0, At, B0); PG8_MMA(0, 1, At, B1); PG8_BAR; PG8_SCHED;
            PG8_LDA(At, 0, 1); PG8_STAGE(PG8_SB(0, 0), b2, voffB); PG8_STAGE(PG8_SB(0, 1), b2 + hstep, voffB); PG8_STAGE(PG8_SA(0, 0), a2, voffA);
            PG8_WAIT_V(8); PG8_WAIT_L(0); PG8_BAR; PG8_MMA(1, 0, At, B0); PG8_MMA(1, 1, At, B1); PG8_BAR; PG8_SCHED;
            PG8_LDB(B0, 1, 0); PG8_LDB(B1, 1, 1); PG8_SCHED; PG8_LDA(At, 1, 0); PG8_STAGE(PG8_SA(0, 1), a2 + hstep, voffA);
            PG8_WAIT_V(8); PG8_WAIT_L(0); PG8_BAR; PG8_MMA(0, 0, At, B0); PG8_MMA(0, 1, At, B1); PG8_BAR; PG8_SCHED;
            PG8_LDA(At, 1, 1); PG8_STAGE(PG8_SB(1, 0), b3, voffB); PG8_STAGE(PG8_SB(1, 1), b3 + hstep, voffB); PG8_STAGE(PG8_SA(1, 0), a3, voffA);
            PG8_WAIT_V(8); PG8_WAIT_L(0); PG8_BAR; PG8_MMA(1, 0, At, B0); PG8_MMA(1, 1, At, B1); PG8_BAR; PG8_SCHED;
            } else {
            PG8_LDB(B0, 0, 0); PG8_SCHED; PG8_LDA(At, 0, 0); PG8_STAGE(PG8_SA(1, 1), a1 + hstep, voffA);
            PG8_WAIT_L(8); PG8_BAR; PG8_WAIT_L(0); PG8_MMA(0, 0, At, B0); PG8_BAR; PG8_SCHED;
            PG8_LDB(B1, 0, 1); PG8_STAGE(PG8_SB(0, 0), b2, voffB);
            PG8_BAR; PG8_WAIT_L(0); PG8_MMA(0, 1, At, B1); PG8_BAR;
            PG8_LDA(At, 0, 1); PG8_STAGE(PG8_SA(0, 0), a2, voffA);
            PG8_BAR; PG8_WAIT_L(0); PG8_MMA(1, 0, At, B0); PG8_BAR; PG8_SCHED;
            PG8_STAGE(PG8_SB(0, 1), b2 + hstep, voffB);
            PG8_WAIT_V(6); PG8_BAR; PG8_MMA(1, 1, At, B1); PG8_BAR;
            PG8_LDB(B0, 1, 0); PG8_SCHED; PG8_LDA(At, 1, 0); PG8_STAGE(PG8_SA(0, 1), a2 + hstep, voffA);
            PG8_WAIT_L(8); PG8_BAR; PG8_WAIT_L(0); PG8_MMA(0, 0, At, B0); PG8_BAR; PG8_SCHED;
            PG8_LDB(B1, 1, 1); PG8_STAGE(PG8_SB(1, 0), b3, voffB);
            PG8_BAR; PG8_WAIT_L(0); PG8_MMA(0, 1, At, B1); PG8_BAR;
            PG8_LDA(At, 1, 1); PG8_STAGE(PG8_SA(1, 0), a3, voffA);
            PG8_BAR; PG8_WAIT_L(0); PG8_MMA(1, 0, At, B0); PG8_BAR; PG8_SCHED;
            PG8_STAGE(PG8_SB(1, 1), b3 + hstep, voffB);
            PG8_WAIT_V(6); PG8_BAR; PG8_MMA(1, 1, At, B1); PG8_BAR;
            }
        }
        if constexpr (ALIGN_EPI) { if (wr == 0) PG8_BAR; }
        if constexpr (!Epi::AFTER_DRAIN) { E(acc, cur, wr, wc, fr, fq); S.done(cur); }
        if (!has_next) break;
#pragma unroll
        for (int a = 0; a < 2; ++a)
#pragma unroll
            for (int b = 0; b < 2; ++b)
#pragma unroll
                for (int m = 0; m < 4; ++m)
#pragma unroll
                    for (int n = 0; n < 2; ++n) acc[a][b][m][n] = (f32x4){0.f, 0.f, 0.f, 0.f};
        cur = nxt; cA = nA; cB = nB; ++ui;
        if constexpr (ALIGN_EPI) { if (wr == 1) PG8_BAR; }
    }
    PG8_WAIT_V(0);
    if constexpr (!ALIGN_EPI) { if (wr == 0) PG8_BAR; }
    PG8_BAR;
    if constexpr (Epi::AFTER_DRAIN) { E.fused(acc, cur, wr, wc, fr, fq, lds, wid, lane); S.done(cur); }
#undef PG8_SA
#undef PG8_SB
#undef PG8_STAGE
#undef PG8_LDA
#undef PG8_LDB
#undef PG8_MMA
#undef PG8_WAIT_V
#undef PG8_WAIT_L
#undef PG8_BAR
#undef PG8_SCHED
}
}

constexpr int NWAVES = 8;
constexpr int BATCH = 8, SEQ = 2048, DM = 2048, M = BATCH * SEQ;
constexpr int NPROJ = 4608, PROJ_LD = 4352;
constexpr int DFF = 5632, DFFE = 7168, NE = 8;
constexpr int C_MQ = 0, C_MK = 256, C_MV = 512, C_MO = 1024, C_GQ = 1536, C_GK = 1792, C_GV = 2048, C_GG = 2560, C_AQ = 3072, C_AK = 4096, C_AV = 4224;
constexpr float EPS = 1e-6f;
constexpr int MAXROWS_S = M * 2 + NE * 256;

constexpr size_t MiB = 1u << 20;
constexpr size_t WS_CTL = 0, CTL_ZERO_BYTES = 1 * MiB;
constexpr size_t WS_MOD = 1 * MiB;
constexpr size_t WS_WIN = 2 * MiB;
constexpr size_t WS_WOUT = 38 * MiB;
constexpr size_t WS_WGU0 = 54 * MiB;
constexpr size_t WS_WDN0 = 98 * MiB;
constexpr size_t WS_WGU1 = 120 * MiB;
constexpr size_t WS_WDN1 = 568 * MiB;
constexpr size_t WS_XA = 792 * MiB;
constexpr size_t WS_XN = 920 * MiB;
constexpr size_t WS_Y = 984 * MiB;
constexpr size_t WS_SIDE = 1048 * MiB;
constexpr size_t WS_TOK = 1050 * MiB;
constexpr size_t WS_BIG = 1052 * MiB;
constexpr size_t WS_HID = WS_BIG;
constexpr size_t WS_AS = WS_BIG + 476 * MiB;
constexpr size_t WS_PROJ = WS_BIG;
constexpr size_t WS_QKC = WS_BIG + 144 * MiB;
constexpr size_t WS_LA = WS_BIG + 160 * MiB;
constexpr size_t WS_KN = WS_BIG + 176 * MiB;
constexpr size_t WS_UM = WS_BIG + 192 * MiB;
constexpr size_t WS_UG = WS_BIG + 212 * MiB;
constexpr size_t WS_GAUX = WS_BIG + 244 * MiB;
constexpr size_t WS_END = WS_BIG + 612 * MiB;
constexpr int TOK_E = 0, TOK_SLOT = 32768, TOK_W = 65536, TOK_POS = 98304;

constexpr int CW_TMO = 0, CW_CODE = 1, CW_BAR = 4096, CW_CNT = 8192;

constexpr int RING_OFF = 0, RING_BYTES = 131072;
constexpr int MISC_OFF = RING_BYTES;
constexpr int LDS_BYTES = 147456;

#define GAS __attribute__((address_space(1)))
#define LAS __attribute__((address_space(3)))
typedef unsigned short bf16;
typedef unsigned v4u __attribute__((ext_vector_type(4)));
typedef unsigned v2u __attribute__((ext_vector_type(2)));
typedef float f32x4 __attribute__((ext_vector_type(4)));
typedef short bf16x8 __attribute__((ext_vector_type(8)));
typedef GAS unsigned gu32;
#define RLX_AGENT __ATOMIC_RELAXED, __HIP_MEMORY_SCOPE_AGENT
#define LDS_WAIT() asm volatile("s_waitcnt lgkmcnt(0)" ::: "memory")
#define VM_WAIT() asm volatile("s_waitcnt vmcnt(0)" ::: "memory")
__device__ __forceinline__ unsigned f2bf(float f) { unsigned u = __builtin_bit_cast(unsigned, f); return (u + 0x7fffu + ((u >> 16) & 1u)) >> 16; }
__device__ __forceinline__ unsigned pk2(float lo, float hi) { return f2bf(lo) | (f2bf(hi) << 16); }
__device__ __forceinline__ float bflo(unsigned w) { return __builtin_bit_cast(float, w << 16); }
__device__ __forceinline__ float bfhi(unsigned w) { return __builtin_bit_cast(float, w & 0xffff0000u); }
__device__ __forceinline__ float bf1(bf16 b) { return __builtin_bit_cast(float, ((unsigned)b) << 16); }
__device__ __forceinline__ float wave_sum(float v) {
#pragma unroll
    for (int o = 1; o < 64; o <<= 1) v += __shfl_xor(v, o);
    return v;
}
__device__ __forceinline__ float sigmoidf_(float x) { return 1.0f / (1.0f + __expf(-x)); }
__device__ __forceinline__ float siluf_(float x) { return x / (1.0f + __expf(-x)); }
__device__ __forceinline__ float logsigmoidf_(float z) { return fminf(z, 0.f) - log1pf(expf(-fabsf(z))); }
#define XB_TMO      128
#define XB_XCNT(j)  (256  + 64 * (j))
#define XB_XSUB(j)  (1280 + 64 * (j))
#define XB_XGEN(j)  (2304 + 64 * (j))
#define XB_TOP      3328
#define XB_TOPGEN   3392
#define XCD_BAR_WORDS 3456
#define XB_SPIN_CAP (1u << 18)

__device__ __forceinline__ unsigned xb_ld(unsigned* p)              { return __hip_atomic_load(p, __ATOMIC_RELAXED, __HIP_MEMORY_SCOPE_AGENT); }
__device__ __forceinline__ unsigned xb_add(unsigned* p, unsigned v) { return __hip_atomic_fetch_add(p, v, __ATOMIC_RELAXED, __HIP_MEMORY_SCOPE_AGENT); }
__device__ __forceinline__ unsigned xb_xcc_id() { return (unsigned)__builtin_amdgcn_s_getreg((3 << 11) | 20) & 0xFu; }
#define XB_SPIN(cond, bar) do { unsigned _sp = 0; while (cond) { __builtin_amdgcn_s_sleep(1); \
    if ((++_sp & 255u) == 0u) { if (xb_ld(&(bar)[XB_TMO])) break; if (_sp > XB_SPIN_CAP) { atomicAdd(&(bar)[XB_TMO], 1u); break; } } } } while (0)

struct XcdBarrier {
    unsigned* bar; unsigned x;
    volatile LAS unsigned* st;
};

__device__ __forceinline__ XcdBarrier xcd_barrier_post(unsigned* bar, volatile LAS unsigned* st) {
    XcdBarrier b; b.bar = bar; b.x = xb_xcc_id(); b.st = st;
    if (threadIdx.x == 0) (void)xb_add(&bar[XB_XCNT(b.x)], 1u);
    return b;
}
__device__ __forceinline__ void xcd_barrier_complete(unsigned* bar, unsigned x, unsigned& nloc, unsigned& nx) {
    const unsigned G = gridDim.x * gridDim.y * gridDim.z;
    unsigned sum, cnt, mine, sp = 0u;
    for (;;) {
        sum = 0u; cnt = 0u; mine = 0u;
#pragma unroll
        for (unsigned j = 0; j < 16; ++j) { const unsigned c = xb_ld(&bar[XB_XCNT(j)]); sum += c; cnt += (c > 0u) ? 1u : 0u; mine = (j == x) ? c : mine; }
        if (sum == G) break;
        __builtin_amdgcn_s_sleep(1);
        if ((++sp & 255u) == 0u) { if (xb_ld(&bar[XB_TMO])) break; if (sp > XB_SPIN_CAP) { atomicAdd(&bar[XB_TMO], 1u); break; } }
    }
    nloc = mine > 0u ? mine : 1u; nx = cnt > 0u ? cnt : 1u;
}

__device__ __forceinline__ void xcd_barrier(const XcdBarrier& b) {
    asm volatile("s_waitcnt vmcnt(0)" ::: "memory");
    __syncthreads();
    if (threadIdx.x == 0) {
        unsigned* bar = b.bar;
        __builtin_amdgcn_s_waitcnt(0);
        unsigned nloc = b.st[0], nx = b.st[1];
        if (nloc == 0u) { xcd_barrier_complete(bar, b.x, nloc, nx); b.st[0] = nloc; b.st[1] = nx; }
        const unsigned old = xb_add(&bar[XB_XSUB(b.x)], 1u);
        const unsigned gen = old / nloc;
        if (old + 1u == (gen + 1u) * nloc) {
            __builtin_amdgcn_fence(__ATOMIC_RELEASE, "agent");
            asm volatile("s_waitcnt vmcnt(0)" ::: "memory");
            const unsigned og = xb_add(&bar[XB_TOP], 1u);
            const unsigned tg = og / nx;
            if (og + 1u == (tg + 1u) * nx) xb_add(&bar[XB_TOPGEN], 1u);
            else XB_SPIN(xb_ld(&bar[XB_TOPGEN]) == tg, bar);
            __builtin_amdgcn_fence(__ATOMIC_ACQUIRE, "agent");
            xb_add(&bar[XB_XGEN(b.x)], 1u);
            asm volatile("s_waitcnt vmcnt(0)" ::: "memory");
        } else {
            XB_SPIN(xb_ld(&bar[XB_XGEN(b.x)]) == gen, bar);
            __builtin_amdgcn_fence(__ATOMIC_ACQUIRE, "agent");
            asm volatile("s_waitcnt vmcnt(0)" ::: "memory");
        }
    }
    __syncthreads();
}

typedef const float* cfp;
typedef __attribute__((address_space(4))) cfp cfp_k;
struct Frame {
    LAS unsigned char* lds;
    gu32* ctl;
    int tid, lane, wave, vcu, G;
    cfp_k* in;
    float* out; unsigned char* ws;
};
#define IN_X 0
#define IN_C 1
#define IN_WADA 2
#define IN_BADA 3
#define IN_GMIX 4
#define IN_GFFN 5
#define IN_WIN 6
#define IN_BGATES 7
#define IN_WCONV 8
#define IN_BCONV 9
#define IN_GOUTM 10
#define IN_WDEC 11
#define IN_BDEC 12
#define IN_GOUTG 13
#define IN_GQN 14
#define IN_GKN 15
#define IN_SINKS 16
#define IN_RELB 17
#define IN_WOUT 18
#define IN_WFG 19
#define IN_WFU 20
#define IN_WFD 21
#define IN_WROUTER 22
#define IN_WMG 23
#define IN_WMU 24
#define IN_WMD 25

__device__ __forceinline__ int rowmap(int kind, int off, int n) {
    if (kind == 0) return off + n;
    if (kind == 1) return off + ((n >> 7) << 8) + (n & 127);
    if (n < 1536) return n; if (n < 1544) return 4352 + (n - 1536); if (n < 3080) return n - 8; if (n < 3096) return 4360 + (n - 3080); return n - 24;
}
__device__ __forceinline__ void transpose_item(const float* W, int N, bf16* WT, int ldt, int kind, int off, LAS float* scr, int item, int lane) {
    const int nblk = (N + 31) >> 5, kb = item / nblk, nb = item - kb * nblk, k0 = 64 * kb, n0 = 32 * nb;
    const int nn = n0 + (lane & 31); const bool ok = nn < N;
    const float* src = W + (size_t)(k0 + (lane >> 5)) * N + nn;
#pragma unroll 8
    for (int i = 0; i < 32; ++i) { scr[(2 * i + (lane >> 5)) * 33 + (lane & 31)] = ok ? src[(size_t)(2 * i) * N] : 0.f; }
    LDS_WAIT(); asm volatile("" ::: "memory");
    const int c = lane & 7;
#pragma unroll
    for (int j = 0; j < 4; ++j) { const int n = (lane >> 3) + 8 * j; const LAS float* s = scr + (8 * c) * 33 + n;
        v4u o; o.x = pk2(s[0 * 33], s[1 * 33]); o.y = pk2(s[2 * 33], s[3 * 33]); o.z = pk2(s[4 * 33], s[5 * 33]); o.w = pk2(s[6 * 33], s[7 * 33]);
        if (n0 + n < N) *(v4u*)(WT + (size_t)rowmap(kind, off, n0 + n) * ldt + k0 + 8 * c) = o; }
    LDS_WAIT(); asm volatile("" ::: "memory");
}
__device__ __forceinline__ void p0_prologue(Frame& F) {
    {
        LAS float* cond = (LAS float*)(F.lds + RING_OFF);
        LAS float* red = (LAS float*)(F.lds + RING_OFF + 65536);
        float* mod = (float*)(F.ws + WS_MOD);
        bool have = false;
        for (int it = F.vcu; it < 192; it += F.G) {
            if (!have) { for (int i = F.tid; i < 8 * 2048; i += NWAVES * 64) { const float cv = F.in[IN_C][i]; cond[i] = cv / (1.0f + expf(-cv)); } have = true; }
            __syncthreads();
            const int l = it / 96, cg = it % 96, col = cg * 128 + (F.tid & 127), dq = F.tid >> 7;
            float acc[8];
#pragma unroll
            for (int b = 0; b < 8; ++b) acc[b] = 0.f;
            const float* wp = F.in[IN_WADA] + (size_t)l * 2048 * 12288 + (size_t)(dq * 512) * 12288 + col;
            const LAS float* cp = cond + dq * 512;
#pragma unroll 8
            for (int d = 0; d < 512; ++d) { const float w = wp[(size_t)d * 12288];
#pragma unroll
                for (int b = 0; b < 8; ++b) acc[b] += cp[b * 2048 + d] * w; }
#pragma unroll
            for (int b = 0; b < 8; ++b) red[(dq * 8 + b) * 128 + (F.tid & 127)] = acc[b];
            __syncthreads();
            if (F.tid < 128) {
#pragma unroll
                for (int b = 0; b < 8; ++b) { const float s = (red[(0 * 8 + b) * 128 + F.tid] + red[(1 * 8 + b) * 128 + F.tid]) + (red[(2 * 8 + b) * 128 + F.tid] + red[(3 * 8 + b) * 128 + F.tid]);
                    mod[(size_t)(l * 8 + b) * 12288 + cg * 128 + F.tid] = s + F.in[IN_BADA][l * 12288 + cg * 128 + F.tid]; }
            }
        }
        __syncthreads();
    }
    LAS float* scr = (LAS float*)(F.lds + RING_OFF + F.wave * 16384);
    const int gw = F.vcu * NWAVES + F.wave, NGW = F.G * NWAVES;
    constexpr int NITEMS = 201792;
    for (int it = gw; it < NITEMS; it += NGW) {
        int r = it; const float* W; bf16* WT; int N, ldt, kind, off;
        if (r < 8768) { const int l = r / 4384; r -= l * 4384; W = F.in[IN_WIN] + (size_t)l * 2048 * 4376; N = 4376; WT = (bf16*)(F.ws + WS_WIN) + (size_t)l * NPROJ * 2048; ldt = 2048; kind = 2; off = 0; }
        else if ((r -= 8768) < 4096) { const int l = r / 2048; r -= l * 2048; W = F.in[IN_WOUT] + (size_t)l * 2048 * 2048; N = 2048; WT = (bf16*)(F.ws + WS_WOUT) + (size_t)l * 2048 * 2048; ldt = 2048; kind = 0; off = 0; }
        else if ((r -= 4096) < 5632) { W = F.in[IN_WFG]; N = DFF; WT = (bf16*)(F.ws + WS_WGU0); ldt = 2048; kind = 1; off = 0; }
        else if ((r -= 5632) < 5632) { W = F.in[IN_WFU]; N = DFF; WT = (bf16*)(F.ws + WS_WGU0); ldt = 2048; kind = 1; off = 128; }
        else if ((r -= 5632) < 5632) { W = F.in[IN_WFD]; N = 2048; WT = (bf16*)(F.ws + WS_WDN0); ldt = DFF; kind = 0; off = 0; }
        else if ((r -= 5632) < 57344) { const int e = r / 7168; r -= e * 7168; W = F.in[IN_WMG] + (size_t)e * 2048 * DFFE; N = DFFE; WT = (bf16*)(F.ws + WS_WGU1) + (size_t)e * 14336 * 2048; ldt = 2048; kind = 1; off = 0; }
        else if ((r -= 57344) < 57344) { const int e = r / 7168; r -= e * 7168; W = F.in[IN_WMU] + (size_t)e * 2048 * DFFE; N = DFFE; WT = (bf16*)(F.ws + WS_WGU1) + (size_t)e * 14336 * 2048; ldt = 2048; kind = 1; off = 128; }
        else { r -= 57344; const int e = r / 7168; r -= e * 7168; W = F.in[IN_WMD] + (size_t)e * DFFE * 2048; N = 2048; WT = (bf16*)(F.ws + WS_WDN1) + (size_t)e * 2048 * DFFE; ldt = DFFE; kind = 0; off = 0; }
        transpose_item(W, N, WT, ldt, kind, off, scr, r, F.lane);
    }
    for (int i = gw; i < 2 * 232; i += NGW) { const int l = i / 232, rr = 4376 + i % 232; v4u* p = (v4u*)((bf16*)(F.ws + WS_WIN) + ((size_t)l * NPROJ + rr) * 2048);
#pragma unroll
        for (int j = 0; j < 4; ++j) p[F.lane + 64 * j] = (v4u){0u, 0u, 0u, 0u}; }
}

template <bool ROUTER>
__device__ __forceinline__ void norm_phase(Frame& F, const float* xin, const float* g, const float* modl, int sh_off, int sc_off) {
    bf16* XN = (bf16*)(F.ws + WS_XN);
    const int gw = F.vcu * NWAVES + F.wave, NGW = F.G * NWAVES;
    LAS float* wrT = (LAS float*)(F.lds + RING_OFF);
    LAS int* lcnt = (LAS int*)(F.lds + MISC_OFF + 1152);
    LAS int* lbase = (LAS int*)(F.lds + MISC_OFF + 1216);
    LAS int* rtab = (LAS int*)(F.lds + MISC_OFF + 2048);
    int nrow = 0;
    if (ROUTER) {
        for (int i = F.tid; i < 2048 * 8; i += NWAVES * 64) wrT[(i & 7) * 2048 + (i >> 3)] = F.in[IN_WROUTER][i];
        if (F.tid < 8) lcnt[F.tid] = 0;
        __syncthreads();
    }
    for (int m = gw; m < M; m += NGW, ++nrow) {
        const int b = m >> 11;
        const f32x4* xr = (const f32x4*)(xin + (size_t)m * DM) + F.lane;
        f32x4 v[8]; float ss = 0.f;
#pragma unroll
        for (int j = 0; j < 8; ++j) { v[j] = xr[64 * j]; ss += (v[j].x * v[j].x + v[j].y * v[j].y) + (v[j].z * v[j].z + v[j].w * v[j].w); }
        const float rstd = 1.0f / sqrtf(wave_sum(ss) * (1.0f / DM) + EPS);
        const f32x4* gp = (const f32x4*)g + F.lane; const f32x4* scp = (const f32x4*)(modl + (size_t)b * 12288 + sc_off) + F.lane; const f32x4* shp = (const f32x4*)(modl + (size_t)b * 12288 + sh_off) + F.lane;
        v2u* o8 = (v2u*)(XN + (size_t)m * DM) + F.lane;
#pragma unroll
        for (int j = 0; j < 8; ++j) { const f32x4 gg = gp[64 * j], sc = scp[64 * j], sh = shp[64 * j];
            v[j] = v[j] * rstd * gg * (sc + 1.0f) + sh;
            v2u w; w.x = pk2(v[j].x, v[j].y); w.y = pk2(v[j].z, v[j].w); o8[64 * j] = w; }
        if (ROUTER) {
            float lg[8];
#pragma unroll
            for (int e = 0; e < 8; ++e) { float p = 0.f; const LAS f32x4* wp = (const LAS f32x4*)(wrT + e * 2048) + F.lane;
#pragma unroll
                for (int j = 0; j < 8; ++j) { const f32x4 w = wp[64 * j]; p += (v[j].x * w.x + v[j].y * w.y) + (v[j].z * w.z + v[j].w * w.w); }
                lg[e] = wave_sum(p); }
            int e1 = 0; float v1 = lg[0];
#pragma unroll
            for (int e = 1; e < 8; ++e) if (lg[e] > v1) { v1 = lg[e]; e1 = e; }
            int e2 = -1; float v2 = -3.0e38f;
#pragma unroll
            for (int e = 0; e < 8; ++e) if (e != e1 && lg[e] > v2) { v2 = lg[e]; e2 = e; }
            const float w1 = 1.0f / (1.0f + expf(v2 - v1)), w2 = 1.0f - w1;
            if (F.lane == 0) {
                const int r1 = atomicAdd((int*)(lcnt + e1), 1), r2 = atomicAdd((int*)(lcnt + e2), 1);
                LAS int* en = rtab + (F.wave * 16 + nrow) * 8;
                en[0] = m; en[1] = e1; en[2] = r1; en[3] = __builtin_bit_cast(int, w1); en[4] = m; en[5] = e2; en[6] = r2; en[7] = __builtin_bit_cast(int, w2);
            }
        }
    }
    if (ROUTER) {
        __syncthreads();
        if (F.tid < 8) lbase[F.tid] = (int)__hip_atomic_fetch_add((unsigned*)(F.ctl + CW_CNT + 64 * F.tid), (unsigned)lcnt[F.tid], RLX_AGENT);
        __syncthreads();
        int* tk = (int*)(F.ws + WS_TOK);
        const int per = (M + NGW - 1) / NGW;
        for (int i = F.tid; i < NWAVES * per * 2; i += NWAVES * 64) { const int w = i / (per * 2), rr = (i % (per * 2)) >> 1, k = i & 1;
            const int mrow = F.vcu * NWAVES + w + rr * NGW; if (mrow >= M) continue;
            const LAS int* en = rtab + (w * 16 + rr) * 8 + 4 * k;
            const int t = en[0], e = en[1];
            tk[TOK_E + t * 2 + k] = e; tk[TOK_SLOT + t * 2 + k] = lbase[e] + en[2]; tk[TOK_W + t * 2 + k] = en[3]; }
    }
}

__device__ const unsigned char T5_BUCKET[128] = {0, 1, 2, 3, 4, 5, 6, 7, 8, 9, 10, 11, 12, 13, 14, 15, 16, 16, 16, 17, 17, 18, 18, 18, 19, 19, 19, 20, 20, 20, 20, 21, 21, 21, 21, 22, 22, 22, 22, 22, 23, 23, 23, 23, 23, 23, 24, 24, 24, 24, 24, 24, 25, 25, 25, 25, 25, 25, 25, 26, 26, 26, 26, 26, 26, 26, 26, 27, 27, 27, 27, 27, 27, 27, 27, 27, 27, 28, 28, 28, 28, 28, 28, 28, 28, 28, 28, 29, 29, 29, 29, 29, 29, 29, 29, 29, 29, 29, 29, 30, 30, 30, 30, 30, 30, 30, 30, 30, 30, 30, 30, 30, 30, 31, 31, 31, 31, 31, 31, 31, 31, 31, 31, 31, 31, 31, 31, 31};

__device__ __forceinline__ void mix_prep(Frame& F, int l) {
    const bf16* proj = (const bf16*)(F.ws + WS_PROJ); const float* side = (const float*)(F.ws + WS_SIDE);
    bf16* qkc = (bf16*)(F.ws + WS_QKC); float* la = (float*)(F.ws + WS_LA); bf16* kn = (bf16*)(F.ws + WS_KN);
    const int gw = F.vcu * NWAVES + F.wave, NGW = F.G * NWAVES, lane = F.lane;
    const float* wc = F.in[IN_WCONV] + l * 4 * 512; const float* bc = F.in[IN_BCONV] + l * 512;
    const float* wd = F.in[IN_WDEC] + l * 16 * 256; const float* bd = F.in[IN_BDEC] + l * 256; const float* gk = F.in[IN_GKN] + l * 64;
    for (int m = gw; m < M; m += NGW) {
        const int pos = m & (SEQ - 1);
        {
            float y[8]; const int ch = lane * 8;
            { const f32x4 b0 = *(const f32x4*)(bc + ch), b1 = *(const f32x4*)(bc + ch + 4); y[0] = b0.x; y[1] = b0.y; y[2] = b0.z; y[3] = b0.w; y[4] = b1.x; y[5] = b1.y; y[6] = b1.z; y[7] = b1.w; }
#pragma unroll
            for (int i = 0; i < 4; ++i) { if (pos - 3 + i >= 0) {
                const v4u xv = *(const v4u*)(proj + (size_t)(m - 3 + i) * PROJ_LD + ch);
                const f32x4 w0 = *(const f32x4*)(wc + i * 512 + ch), w1 = *(const f32x4*)(wc + i * 512 + ch + 4);
                y[0] += w0.x * bflo(xv.x); y[1] += w0.y * bfhi(xv.x); y[2] += w0.z * bflo(xv.y); y[3] += w0.w * bfhi(xv.y);
                y[4] += w1.x * bflo(xv.z); y[5] += w1.y * bfhi(xv.z); y[6] += w1.z * bflo(xv.w); y[7] += w1.w * bfhi(xv.w); } }
            const float sc = ch >= 256 ? 0.125f : 1.0f;
#pragma unroll
            for (int i = 0; i < 8; ++i) y[i] = siluf_(y[i]) * sc;
            v4u o; o.x = pk2(y[0], y[1]); o.y = pk2(y[2], y[3]); o.z = pk2(y[4], y[5]); o.w = pk2(y[6], y[7]);
            *(v4u*)(qkc + (size_t)m * 512 + ch) = o;
        }
        {
            const int c = lane * 4; f32x4 z = *(const f32x4*)(bd + c);
            const f32x4* gp = (const f32x4*)(side + (size_t)m * 32 + 8);
            const f32x4 g0 = gp[0], g1 = gp[1], g2 = gp[2], g3 = gp[3];
            const float ga[16] = {g0.x, g0.y, g0.z, g0.w, g1.x, g1.y, g1.z, g1.w, g2.x, g2.y, g2.z, g2.w, g3.x, g3.y, g3.z, g3.w};
#pragma unroll
            for (int r = 0; r < 16; ++r) { const f32x4 w = *(const f32x4*)(wd + r * 256 + c); z += w * ga[r]; }
            f32x4 o; o.x = logsigmoidf_(z.x) * 0.0625f; o.y = logsigmoidf_(z.y) * 0.0625f; o.z = logsigmoidf_(z.z) * 0.0625f; o.w = logsigmoidf_(z.w) * 0.0625f;
            *(f32x4*)(la + (size_t)m * 256 + c) = o;
        }
        {
            const unsigned kv = *(const unsigned*)(proj + (size_t)m * PROJ_LD + C_AK + 2 * lane);
            const float k0 = bflo(kv), k1 = bfhi(kv); float ss = k0 * k0 + k1 * k1;
#pragma unroll
            for (int o = 1; o < 32; o <<= 1) ss += __shfl_xor(ss, o);
            const float rstd = 1.0f / sqrtf(ss * (1.0f / 64.0f) + EPS);
            *(unsigned*)(kn + (size_t)m * 128 + 2 * lane) = pk2(k0 * rstd * gk[(2 * lane) & 63], k1 * rstd * gk[(2 * lane + 1) & 63]);
        }
    }
}

__device__ __forceinline__ void naive_mlstm(Frame& F, int l, int bh) {
    const int b = bh >> 2, h = bh & 3, tid = F.tid, v = tid >> 2, kq = tid & 3;
    const bf16* proj = (const bf16*)(F.ws + WS_PROJ); const float* side = (const float*)(F.ws + WS_SIDE); const bf16* qkc = (const bf16*)(F.ws + WS_QKC);
    bf16* Y = (bf16*)(F.ws + WS_Y);
    LAS float* red = (LAS float*)(F.lds + RING_OFF);
    const float bi = F.in[IN_BGATES][l * 8 + h], bfg = F.in[IN_BGATES][l * 8 + 4 + h];
    const float gout = F.in[IN_GOUTM][l * 512 + h * 128 + v];
    float C[16], n[16]; float mst = 0.f;
#pragma unroll
    for (int i = 0; i < 16; ++i) { C[i] = 0.f; n[i] = 0.f; }
    for (int t = 0; t < SEQ; ++t) {
        const size_t row = (size_t)b * SEQ + t;
        const v4u q0 = *(const v4u*)(qkc + row * 512 + h * 64 + kq * 16), q1 = *(const v4u*)(qkc + row * 512 + h * 64 + kq * 16 + 8);
        const v4u k0 = *(const v4u*)(qkc + row * 512 + 256 + h * 64 + kq * 16), k1 = *(const v4u*)(qkc + row * 512 + 256 + h * 64 + kq * 16 + 8);
        const float q[16] = {bflo(q0.x), bfhi(q0.x), bflo(q0.y), bfhi(q0.y), bflo(q0.z), bfhi(q0.z), bflo(q0.w), bfhi(q0.w), bflo(q1.x), bfhi(q1.x), bflo(q1.y), bfhi(q1.y), bflo(q1.z), bfhi(q1.z), bflo(q1.w), bfhi(q1.w)};
        const float k[16] = {bflo(k0.x), bfhi(k0.x), bflo(k0.y), bfhi(k0.y), bflo(k0.z), bfhi(k0.z), bflo(k0.w), bfhi(k0.w), bflo(k1.x), bfhi(k1.x), bflo(k1.y), bfhi(k1.y), bflo(k1.z), bfhi(k1.z), bflo(k1.w), bfhi(k1.w)};
        const float vv = bf1(proj[row * PROJ_LD + C_MV + h * 128 + v]);
        const float ip = side[row * 32 + h] + bi, lf = logsigmoidf_(side[row * 32 + 4 + h] + bfg);
        const float mn = fmaxf(lf + mst, ip), fd = expf(lf + mst - mn), iw = expf(ip - mn); mst = mn;
        float num = 0.f, den = 0.f;
#pragma unroll
        for (int i = 0; i < 16; ++i) { C[i] = fd * C[i] + (iw * vv) * k[i]; n[i] = fd * n[i] + iw * k[i]; num += C[i] * q[i]; den += n[i] * q[i]; }
        num += __shfl_xor(num, 1); num += __shfl_xor(num, 2); den += __shfl_xor(den, 1); den += __shfl_xor(den, 2);
        const float hv = num / fmaxf(fabsf(den), expf(-mst));
        const float s2 = wave_sum(kq == 0 ? hv * hv : 0.f);
        if (F.lane == 0) red[(t & 1) * 8 + F.wave] = s2;
        __syncthreads();
        float tot = 0.f;
#pragma unroll
        for (int w = 0; w < 8; ++w) tot += red[(t & 1) * 8 + w];
        const float rstd = 1.0f / sqrtf(tot * (1.0f / 128.0f) + EPS);
        if (kq == 0) { const float mo = bf1(proj[row * PROJ_LD + C_MO + h * 128 + v]);
            Y[row * DM + h * 128 + v] = (bf16)f2bf(hv * rstd * gout * sigmoidf_(mo)); }
    }
    __syncthreads();
}
__device__ __forceinline__ void naive_gla(Frame& F, int l, int bh) {
    const int b = bh >> 2, h = bh & 3, tid = F.tid, v = tid >> 2, kq = tid & 3;
    const bf16* proj = (const bf16*)(F.ws + WS_PROJ); const float* la = (const float*)(F.ws + WS_LA);
    bf16* Y = (bf16*)(F.ws + WS_Y);
    LAS float* red = (LAS float*)(F.lds + RING_OFF);
    const float gout = F.in[IN_GOUTG][l * 512 + h * 128 + v];
    float S[16];
#pragma unroll
    for (int i = 0; i < 16; ++i) S[i] = 0.f;
    for (int t = 0; t < SEQ; ++t) {
        const size_t row = (size_t)b * SEQ + t;
        const v4u q0 = *(const v4u*)(proj + row * PROJ_LD + C_GQ + h * 64 + kq * 16), q1 = *(const v4u*)(proj + row * PROJ_LD + C_GQ + h * 64 + kq * 16 + 8);
        const v4u k0 = *(const v4u*)(proj + row * PROJ_LD + C_GK + h * 64 + kq * 16), k1 = *(const v4u*)(proj + row * PROJ_LD + C_GK + h * 64 + kq * 16 + 8);
        const float q[16] = {bflo(q0.x), bfhi(q0.x), bflo(q0.y), bfhi(q0.y), bflo(q0.z), bfhi(q0.z), bflo(q0.w), bfhi(q0.w), bflo(q1.x), bfhi(q1.x), bflo(q1.y), bfhi(q1.y), bflo(q1.z), bfhi(q1.z), bflo(q1.w), bfhi(q1.w)};
        const float k[16] = {bflo(k0.x), bfhi(k0.x), bflo(k0.y), bfhi(k0.y), bflo(k0.z), bfhi(k0.z), bflo(k0.w), bfhi(k0.w), bflo(k1.x), bfhi(k1.x), bflo(k1.y), bfhi(k1.y), bflo(k1.z), bfhi(k1.z), bflo(k1.w), bfhi(k1.w)};
        const f32x4* lp = (const f32x4*)(la + row * 256 + h * 64 + kq * 16);
        const f32x4 a0 = lp[0], a1 = lp[1], a2 = lp[2], a3 = lp[3];
        const float a[16] = {a0.x, a0.y, a0.z, a0.w, a1.x, a1.y, a1.z, a1.w, a2.x, a2.y, a2.z, a2.w, a3.x, a3.y, a3.z, a3.w};
        const float vv = bf1(proj[row * PROJ_LD + C_GV + h * 128 + v]);
        float o = 0.f;
#pragma unroll
        for (int i = 0; i < 16; ++i) { S[i] = expf(a[i]) * S[i] + k[i] * vv; o += (q[i] * 0.125f) * S[i]; }
        o += __shfl_xor(o, 1); o += __shfl_xor(o, 2);
        const float s2 = wave_sum(kq == 0 ? o * o : 0.f);
        if (F.lane == 0) red[(t & 1) * 8 + F.wave] = s2;
        __syncthreads();
        float tot = 0.f;
#pragma unroll
        for (int w = 0; w < 8; ++w) tot += red[(t & 1) * 8 + w];
        const float rstd = 1.0f / sqrtf(tot * (1.0f / 128.0f) + EPS);
        if (kq == 0) { const float gg = bf1(proj[row * PROJ_LD + C_GG + h * 128 + v]);
            Y[row * DM + 512 + h * 128 + v] = (bf16)f2bf(o * rstd * gout * siluf_(gg)); }
    }
    __syncthreads();
}
__device__ __forceinline__ void naive_swa(Frame& F, int l, int blk) {
    const int tid = F.tid, hq = tid & 15, row = blk * 32 + (tid >> 4), kvh = hq >> 3, pos = row & (SEQ - 1);
    const bf16* proj = (const bf16*)(F.ws + WS_PROJ); const bf16* kn = (const bf16*)(F.ws + WS_KN); bf16* Y = (bf16*)(F.ws + WS_Y);
    const float* gq = F.in[IN_GQN] + l * 64; const float* relb = F.in[IN_RELB];
    float q[64], o[64];
    { float ss = 0.f;
#pragma unroll
      for (int c = 0; c < 8; ++c) { const v4u x = *(const v4u*)(proj + (size_t)row * PROJ_LD + C_AQ + hq * 64 + 8 * c);
          q[8 * c + 0] = bflo(x.x); q[8 * c + 1] = bfhi(x.x); q[8 * c + 2] = bflo(x.y); q[8 * c + 3] = bfhi(x.y); q[8 * c + 4] = bflo(x.z); q[8 * c + 5] = bfhi(x.z); q[8 * c + 6] = bflo(x.w); q[8 * c + 7] = bfhi(x.w); }
#pragma unroll
      for (int d = 0; d < 64; ++d) ss += q[d] * q[d];
      const float rstd = 1.0f / sqrtf(ss * (1.0f / 64.0f) + EPS);
#pragma unroll
      for (int d = 0; d < 64; ++d) { q[d] = q[d] * rstd * gq[d] * 0.125f; o[d] = 0.f; } }
    float mx = F.in[IN_SINKS][l * 16 + hq], den = 1.0f;
    const int s0 = pos - 127 < 0 ? 0 : pos - 127;
    for (int s = s0; s <= pos; ++s) {
        const size_t kr = (size_t)(row - pos + s);
        float dot = 0.f;
#pragma unroll
        for (int c = 0; c < 8; ++c) { const v4u x = *(const v4u*)(kn + kr * 128 + kvh * 64 + 8 * c);
            dot += q[8 * c + 0] * bflo(x.x) + q[8 * c + 1] * bfhi(x.x) + q[8 * c + 2] * bflo(x.y) + q[8 * c + 3] * bfhi(x.y) + q[8 * c + 4] * bflo(x.z) + q[8 * c + 5] * bfhi(x.z) + q[8 * c + 6] * bflo(x.w) + q[8 * c + 7] * bfhi(x.w); }
        const float sc = dot + relb[T5_BUCKET[pos - s] * 16 + hq];
        const float mn = fmaxf(mx, sc), corr = expf(mx - mn), p = expf(sc - mn); mx = mn; den = den * corr + p;
#pragma unroll
        for (int c = 0; c < 8; ++c) { const v4u x = *(const v4u*)(proj + kr * PROJ_LD + C_AV + kvh * 64 + 8 * c);
            o[8 * c + 0] = o[8 * c + 0] * corr + p * bflo(x.x); o[8 * c + 1] = o[8 * c + 1] * corr + p * bfhi(x.x); o[8 * c + 2] = o[8 * c + 2] * corr + p * bflo(x.y); o[8 * c + 3] = o[8 * c + 3] * corr + p * bfhi(x.y);
            o[8 * c + 4] = o[8 * c + 4] * corr + p * bflo(x.z); o[8 * c + 5] = o[8 * c + 5] * corr + p * bfhi(x.z); o[8 * c + 6] = o[8 * c + 6] * corr + p * bflo(x.w); o[8 * c + 7] = o[8 * c + 7] * corr + p * bfhi(x.w); }
    }
    const float inv = 1.0f / den;
#pragma unroll
    for (int c = 0; c < 8; ++c) { v4u w; w.x = pk2(o[8 * c] * inv, o[8 * c + 1] * inv); w.y = pk2(o[8 * c + 2] * inv, o[8 * c + 3] * inv); w.z = pk2(o[8 * c + 4] * inv, o[8 * c + 5] * inv); w.w = pk2(o[8 * c + 6] * inv, o[8 * c + 7] * inv);
        *(v4u*)(Y + (size_t)row * DM + 1024 + hq * 64 + 8 * c) = w; }
}
__device__ __forceinline__ void mix_naive(Frame& F, int l) {
    for (int u = F.vcu; u < 64 + 512; u += F.G) {
        if (u < 32) naive_mlstm(F, l, u);
        else if (u < 64) naive_gla(F, l, u - 32);
        else naive_swa(F, l, u - 64);
    }
}

__device__ __forceinline__ int moe_tables(Frame& F) {
    LAS int* seg = (LAS int*)(F.lds + MISC_OFF + 1024); LAS int* tile_e = (LAS int*)(F.lds + MISC_OFF + 64);
    if (F.tid == 0) { int s = 0;
        for (int e = 0; e < 8; ++e) { seg[e] = s; const int c = (int)__hip_atomic_load(F.ctl + CW_CNT + 64 * e, RLX_AGENT); const int nt = (c + 255) >> 8; for (int i = 0; i < nt; ++i) tile_e[(s >> 8) + i] = e; s += nt << 8; }
        seg[8] = s; }
    __syncthreads();
    return seg[8] >> 8;
}
__device__ __forceinline__ void moe_gather(Frame& F) {
    (void)moe_tables(F);
    const LAS int* seg = (const LAS int*)(F.lds + MISC_OFF + 1024);
    const int gw = F.vcu * NWAVES + F.wave, NGW = F.G * NWAVES;
    int* tk = (int*)(F.ws + WS_TOK); const bf16* XN = (const bf16*)(F.ws + WS_XN); bf16* AS = (bf16*)(F.ws + WS_AS);
    for (int m = gw; m < M; m += NGW) {
        const v4u* src = (const v4u*)(XN + (size_t)m * DM) + F.lane; v4u r[4];
#pragma unroll
        for (int j = 0; j < 4; ++j) r[j] = src[64 * j];
#pragma unroll
        for (int k = 0; k < 2; ++k) { const int e = tk[TOK_E + m * 2 + k], dest = seg[e] + tk[TOK_SLOT + m * 2 + k];
            v4u* dst = (v4u*)(AS + (size_t)dest * DM) + F.lane;
#pragma unroll
            for (int j = 0; j < 4; ++j) dst[64 * j] = r[j];
            if (F.lane == 0) tk[TOK_POS + m * 2 + k] = dest; }
    }
    for (int e = 0; e < 8; ++e) { const int c = (int)__hip_atomic_load(F.ctl + CW_CNT + 64 * e, RLX_AGENT);
        for (int r = seg[e] + c + gw; r < seg[e + 1]; r += NGW) { v4u* dst = (v4u*)(AS + (size_t)r * DM) + F.lane;
#pragma unroll
            for (int j = 0; j < 4; ++j) dst[64 * j] = (v4u){0u, 0u, 0u, 0u}; } }
}
__device__ __forceinline__ void moe_combine(Frame& F, const float* gtf) {
    const int gw = F.vcu * NWAVES + F.wave, NGW = F.G * NWAVES;
    const int* tk = (const int*)(F.ws + WS_TOK); const float* xa = (const float*)(F.ws + WS_XA); const bf16* YS = (const bf16*)(F.ws + WS_AS);
    for (int m = gw; m < M; m += NGW) {
        const int b = m >> 11, p1 = tk[TOK_POS + 2 * m], p2 = tk[TOK_POS + 2 * m + 1];
        const float w1 = __builtin_bit_cast(float, tk[TOK_W + 2 * m]), w2 = __builtin_bit_cast(float, tk[TOK_W + 2 * m + 1]);
        const f32x4* xr = (const f32x4*)(xa + (size_t)m * DM) + F.lane; const f32x4* gp = (const f32x4*)(gtf + (size_t)b * 12288) + F.lane;
        const v2u* y1 = (const v2u*)(YS + (size_t)p1 * DM) + F.lane; const v2u* y2 = (const v2u*)(YS + (size_t)p2 * DM) + F.lane;
        f32x4* op = (f32x4*)(F.out + (size_t)m * DM) + F.lane;
#pragma unroll
        for (int j = 0; j < 8; ++j) { const f32x4 x = xr[64 * j], g = gp[64 * j]; const v2u a = y1[64 * j], c = y2[64 * j];
            f32x4 y; y.x = w1 * bflo(a.x) + w2 * bflo(c.x); y.y = w1 * bfhi(a.x) + w2 * bfhi(c.x); y.z = w1 * bflo(a.y) + w2 * bflo(c.y); y.w = w1 * bfhi(a.y) + w2 * bfhi(c.y);
            op[64 * j] = x + g * y; }
    }
}

#ifndef MK_ONE_LAUNCH
#define MK_ONE_LAUNCH 1
#endif
constexpr int NPH = 19;
struct Args { const float* in[26]; float* out; unsigned char* ws; int ph_lo, ph_hi; };
__global__ void __launch_bounds__(NWAVES * 64, 2) hybrid_fwd(Args args) {
    extern __shared__ __attribute__((aligned(16))) unsigned char lds[];
    Frame F;
    F.lds = (LAS unsigned char*)lds;
    F.tid = threadIdx.x; F.lane = F.tid & 63; F.wave = __builtin_amdgcn_readfirstlane(F.tid >> 6);
    F.G = gridDim.x; { const int bx = blockIdx.x; F.vcu = (F.G % 8 == 0) ? (bx % 8) * (F.G / 8) + bx / 8 : bx; }
    F.ws = args.ws; F.out = args.out; F.ctl = (gu32*)(args.ws + WS_CTL);
    F.in = (cfp_k*)__builtin_amdgcn_kernarg_segment_ptr();
    for (int u = F.tid; u < (LDS_BYTES - MISC_OFF) / 4; u += NWAVES * 64) ((LAS unsigned*)(F.lds + MISC_OFF))[u] = 0u;
    __syncthreads();
    const int lo = args.ph_lo, hi = args.ph_hi;
    XcdBarrier bar; bar.bar = (unsigned*)(F.ctl + CW_BAR); bar.x = 0; bar.st = nullptr;
    if (hi - lo > 1) bar = xcd_barrier_post((unsigned*)(F.ctl + CW_BAR), (volatile LAS unsigned*)(F.lds + MISC_OFF));
#define IN(k) (lo <= (k) && (k) < hi)
#define SEAM(k) do { if (IN(k) && IN((k) + 1)) xcd_barrier(bar); } while (0)
    bf16* const XN = (bf16*)(F.ws + WS_XN); bf16* const Yb = (bf16*)(F.ws + WS_Y); float* const XA = (float*)(F.ws + WS_XA);
    bf16* const PROJ = (bf16*)(F.ws + WS_PROJ); float* const SIDE = (float*)(F.ws + WS_SIDE); bf16* const HID = (bf16*)(F.ws + WS_HID); bf16* const AS = (bf16*)(F.ws + WS_AS);
    const float* const MOD = (const float*)(F.ws + WS_MOD);

    if (IN(0)) p0_prologue(F);
    SEAM(0);
#define LAYER_MIX(l) do { \
        const int pb = 1 + 8 * (l); \
        const float* modl = MOD + (size_t)(l) * 8 * 12288; \
        const float* xin = (l) == 0 ? F.in[IN_X] : (const float*)F.out; \
        if (IN(pb)) norm_phase<false>(F, xin, F.in[IN_GMIX] + (l) * DM, modl, 0, 2048); \
        SEAM(pb); \
        if (IN(pb + 1)) { \
            pg8::Gemm g{XN, (const bf16*)(F.ws + WS_WIN) + (size_t)(l) * NPROJ * DM, M, NPROJ, DM}; pg8::StaticOrder S; S.init(M, NPROJ, F.G, (int)blockIdx.x); \
            pg8::EpiProj E{PROJ, SIDE}; \
            pg8::gemm_phase<pg8::EpiProj, pg8::StaticOrder, true, true>(F.lds + RING_OFF, g, S, E); \
        } \
        SEAM(pb + 1); \
        if (IN(pb + 2)) mix_prep(F, (l)); \
        SEAM(pb + 2); \
        if (IN(pb + 3)) mix_naive(F, (l)); \
        SEAM(pb + 3); \
        if (IN(pb + 4)) { \
            pg8::Gemm g{Yb, (const bf16*)(F.ws + WS_WOUT) + (size_t)(l) * DM * DM, M, DM, DM}; pg8::StaticOrder S; S.init(M, DM, F.G, (int)blockIdx.x); \
            pg8::EpiResid E{xin, XA, modl + 4096}; \
            pg8::gemm_phase<pg8::EpiResid, pg8::StaticOrder, true, true>(F.lds + RING_OFF, g, S, E); \
        } \
        SEAM(pb + 4); \
    } while (0)
    LAYER_MIX(0);
    {
        const float* modl = MOD;
        if (IN(6)) norm_phase<false>(F, XA, F.in[IN_GFFN], modl, 6144, 8192);
        SEAM(6);
        if (IN(7)) {
            pg8::Gemm g{XN, (const bf16*)(F.ws + WS_WGU0), M, 2 * DFF, DM}; pg8::StaticOrder S; S.init(M, 2 * DFF, F.G, (int)blockIdx.x);
            pg8::EpiSwiglu E{HID, DFF, 44};
            pg8::gemm_phase<pg8::EpiSwiglu, pg8::StaticOrder, true, true>(F.lds + RING_OFF, g, S, E);
        }
        SEAM(7);
        if (IN(8)) {
            pg8::Gemm g{HID, (const bf16*)(F.ws + WS_WDN0), M, DM, DFF}; pg8::StaticOrder S; S.init(M, DM, F.G, (int)blockIdx.x);
            pg8::EpiResid E{XA, F.out, modl + 10240};
            pg8::gemm_phase<pg8::EpiResid, pg8::StaticOrder, true, true>(F.lds + RING_OFF, g, S, E);
        }
        SEAM(8);
    }
    LAYER_MIX(1);
    const float* mod1 = MOD + (size_t)8 * 12288;
    if (IN(14)) norm_phase<true>(F, XA, F.in[IN_GFFN] + DM, mod1, 6144, 8192);
    SEAM(14);
    if (IN(15)) moe_gather(F);
    SEAM(15);
    if (IN(16)) {
        const int T = moe_tables(F);
        pg8::Gemm g{AS, (const bf16*)(F.ws + WS_WGU1), T * 256, 2 * DFFE, DM}; pg8::GroupedOrder S; S.init(T, 56, F.G, (int)blockIdx.x, (const LAS int*)(F.lds + MISC_OFF + 64));
        pg8::EpiSwiglu E{HID, DFFE, 56};
        pg8::gemm_phase<pg8::EpiSwiglu, pg8::GroupedOrder, true, true>(F.lds + RING_OFF, g, S, E);
    }
    SEAM(16);
    if (IN(17)) {
        const int T = moe_tables(F);
        pg8::Gemm g{HID, (const bf16*)(F.ws + WS_WDN1), T * 256, DM, DFFE}; pg8::GroupedOrder S; S.init(T, 8, F.G, (int)blockIdx.x, (const LAS int*)(F.lds + MISC_OFF + 64));
        pg8::EpiPlainBf16 E{AS, DM, 8};
        pg8::gemm_phase<pg8::EpiPlainBf16, pg8::GroupedOrder, true, true>(F.lds + RING_OFF, g, S, E);
    }
    SEAM(17);
    if (IN(18)) moe_combine(F, mod1 + 10240);
#undef IN
#undef SEAM
}

extern "C" void kernel_launch(void* const* d_in, const int* in_sizes, int n_in, void* d_out, int out_size, void* d_ws, size_t ws_size, hipStream_t stream) {
    static int grid = 0;
    if (grid == 0) {
        if (n_in != 26 || in_sizes[0] != M * DM || out_size != M * DM || ws_size < WS_END) { fprintf(stderr, "kernel_launch: unexpected shapes (n_in %d, in0 %d, out %d, ws %zu < %zu)\n", n_in, n_in > 0 ? in_sizes[0] : -1, out_size, ws_size, (size_t)WS_END); grid = -1; return; }
        int dev = 0, cus = 0, per_cu = 0;
        if (hipGetDevice(&dev) != hipSuccess || hipDeviceGetAttribute(&cus, hipDeviceAttributeMultiprocessorCount, dev) != hipSuccess) { grid = -1; return; }
        if (hipFuncSetAttribute((const void*)hybrid_fwd, hipFuncAttributeMaxDynamicSharedMemorySize, LDS_BYTES) != hipSuccess) { fprintf(stderr, "kernel_launch: hipFuncSetAttribute failed\n"); grid = -1; return; }
        if (hipOccupancyMaxActiveBlocksPerMultiprocessor(&per_cu, (const void*)hybrid_fwd, NWAVES * 64, LDS_BYTES) != hipSuccess || per_cu < 1) fprintf(stderr, "kernel_launch: occupancy query says %d\n", per_cu);
        (void)hipGetLastError();
        grid = cus < 256 ? cus : 256;
    }
    if (grid < 0) return;
    if (hipMemsetAsync((char*)d_ws + WS_CTL, 0, CTL_ZERO_BYTES, stream) != hipSuccess) return;
    Args a{};
    for (int i = 0; i < 26; ++i) a.in[i] = (const float*)d_in[i];
    a.out = (float*)d_out; a.ws = (unsigned char*)d_ws;
#if MK_ONE_LAUNCH
    a.ph_lo = 0; a.ph_hi = NPH;
    hipLaunchKernelGGL(hybrid_fwd, dim3(grid), dim3(NWAVES * 64), LDS_BYTES, stream, a);
#else
    for (int p = 0; p < NPH; ++p) { a.ph_lo = p; a.ph_hi = p + 1; hipLaunchKernelGGL(hybrid_fwd, dim3(grid), dim3(NWAVES * 64), LDS_BYTES, stream, a); }
#endif
}
```

```cpp
#include <hip/hip_runtime.h>
#include <cstdio>
#include <cstdint>
namespace pg8 {
#define PG8_LAS __attribute__((address_space(3)))
typedef unsigned short bf16_t;
typedef short bf16x8 __attribute__((ext_vector_type(8)));
typedef float f32x4 __attribute__((ext_vector_type(4)));
typedef unsigned u32x4 __attribute__((ext_vector_type(4)));
constexpr int BM = 256, BK = 64, HALF = 128, HTB = HALF * BK * 2  , STAGE_BYTES = 8 * HTB, NXCD = 8, WGM = 8;

__host__ __device__ __forceinline__ int lds_byte(int r, int c) { const int st = (r >> 4) * 2 + (c >> 5), rr = r & 15, cc = c & 31, ob = rr * 64 + cc * 2; return st * 1024 + (ob ^ (((ob >> 9) & 1) << 5)); }
__host__ __device__ __forceinline__ void stage_rc(int b, int& R, int& C) { const int st = b / 1024, sb = b % 1024, swz = sb ^ (((sb >> 9) & 1) << 5); R = (st >> 1) * 16 + swz / 64; C = (st & 1) * 32 + (swz % 64) / 2; }
__host__ __device__ __forceinline__ int perm32(int rho) { const int n = rho >> 4, i = rho & 15; return 8 * (i >> 2) + 4 * n + (i & 3); }

struct Unit { int pm, pn; };
struct Gemm { const bf16_t* A; const bf16_t* Bt; int M, N, K; };

struct StaticOrder {
    int nM, nN, nwg, G, c;
    __host__ __device__ void init(int M, int N, int G_, int c_) { nM = M / BM; nN = N / BM; nwg = nM * nN; G = G_; c = c_; }
    __host__ __device__ bool next(int i, Unit& u) const {
        const long L = (long)i * G + c; if (L >= nwg) return false;
        int wgid = (int)L; { const int q = nwg / NXCD, r = nwg % NXCD, xcd = wgid % NXCD, off = wgid / NXCD; wgid = (xcd < r ? xcd * (q + 1) : r * (q + 1) + (xcd - r) * q) + off; }
        const int nig = WGM * nN, gid = wgid / nig, fm = gid * WGM, gsz = (nM - fm) < WGM ? (nM - fm) : WGM;
        u.pm = fm + ((wgid % nig) % gsz); u.pn = (wgid % nig) / gsz; return true;
    }
    __device__ __forceinline__ void a_ready(const Unit&) const {}
    __device__ __forceinline__ void done(const Unit&) const {}
};
__device__ __forceinline__ unsigned cvt_pk_bf16(float lo, float hi) { unsigned r; asm volatile("v_cvt_pk_bf16_f32 %0, %1, %2" : "=v"(r) : "v"(lo), "v"(hi)); return r; }
typedef unsigned u32x2 __attribute__((ext_vector_type(2)));
__device__ __forceinline__ float fast_silu(float g) { return g * __builtin_amdgcn_rcpf(1.0f + __expf(-g)); }
struct EpiProj {
    static constexpr bool PERM = true, AFTER_DRAIN = false;
    bf16_t* O; float* side;
    __device__ __forceinline__ void operator()(const f32x4 (&acc)[2][2][4][2], const Unit& u, int wr, int wc, int fr, int fq) const {
        const int row0 = u.pm * BM + wr * 64 + fr;
        if (u.pn < 17) {
            const int col0 = u.pn * BM + wc * 32 + 8 * fq;
#pragma unroll
            for (int ai = 0; ai < 2; ++ai)
#pragma unroll
                for (int m = 0; m < 4; ++m) { bf16_t* rowp = O + (size_t)(row0 + ai * HALF + m * 16) * 4352 + col0;
#pragma unroll
                    for (int bj = 0; bj < 2; ++bj) { const f32x4 v0 = acc[ai][bj][m][0], v1 = acc[ai][bj][m][1];
                        u32x4 w; w.x = cvt_pk_bf16(v0[0], v0[1]); w.y = cvt_pk_bf16(v0[2], v0[3]); w.z = cvt_pk_bf16(v1[0], v1[1]); w.w = cvt_pk_bf16(v1[2], v1[3]);
                        *(u32x4*)(rowp + bj * HALF) = w; } }
        } else if (wc == 0) {
#pragma unroll
            for (int ai = 0; ai < 2; ++ai)
#pragma unroll
                for (int m = 0; m < 4; ++m) { float* rowp = side + (size_t)(row0 + ai * HALF + m * 16) * 32 + 8 * fq;
                    *(f32x4*)(rowp) = acc[ai][0][m][0]; *(f32x4*)(rowp + 4) = acc[ai][0][m][1]; }
        }
    }
};
struct EpiResid {
    static constexpr bool PERM = false, AFTER_DRAIN = false;
    const float* base; float* out; const float* gate;
    __device__ __forceinline__ void operator()(const f32x4 (&acc)[2][2][4][2], const Unit& u, int wr, int wc, int fr, int fq) const {
        const int row0 = u.pm * BM + wr * 64 + fr, col0 = u.pn * BM + wc * 32 + 4 * fq;
        const float* __restrict__ gp = gate + (size_t)(u.pm >> 3) * 12288 + col0;
        const float* __restrict__ bp = base + (size_t)row0 * 2048 + col0; float* __restrict__ op = out + (size_t)row0 * 2048 + col0;
        f32x4 gv[2][2];
#pragma unroll
        for (int bj = 0; bj < 2; ++bj)
#pragma unroll
            for (int n = 0; n < 2; ++n) gv[bj][n] = *(const f32x4*)(gp + bj * HALF + n * 16);
        f32x4 cur[2][2], nxt[2][2];
#pragma unroll
        for (int bj = 0; bj < 2; ++bj)
#pragma unroll
            for (int n = 0; n < 2; ++n) cur[bj][n] = *(const f32x4*)(bp + bj * HALF + n * 16);
#pragma unroll
        for (int g = 0; g < 8; ++g) { const int ai = g >> 2, m = g & 3; const size_t off = (size_t)(ai * HALF + m * 16) * 2048;
            if (g < 7) { const int ai2 = (g + 1) >> 2, m2 = (g + 1) & 3; const size_t off2 = (size_t)(ai2 * HALF + m2 * 16) * 2048;
#pragma unroll
                for (int bj = 0; bj < 2; ++bj)
#pragma unroll
                    for (int n = 0; n < 2; ++n) nxt[bj][n] = *(const f32x4*)(bp + off2 + bj * HALF + n * 16); }
#pragma unroll
            for (int bj = 0; bj < 2; ++bj)
#pragma unroll
                for (int n = 0; n < 2; ++n) *(f32x4*)(op + off + bj * HALF + n * 16) = cur[bj][n] + gv[bj][n] * acc[ai][bj][m][n];
#pragma unroll
            for (int bj = 0; bj < 2; ++bj)
#pragma unroll
                for (int n = 0; n < 2; ++n) cur[bj][n] = nxt[bj][n];
            asm volatile("" ::: "memory"); }
    }
};
struct EpiSwiglu {
    static constexpr bool PERM = true, AFTER_DRAIN = false;
    bf16_t* O; int ldc; int nN;
    __device__ __forceinline__ void operator()(const f32x4 (&acc)[2][2][4][2], const Unit& u, int wr, int wc, int fr, int fq) const {
        const int row0 = u.pm * BM + wr * 64 + fr, col0 = (u.pn % nN) * HALF + wc * 32 + 8 * fq;
#pragma unroll
        for (int ai = 0; ai < 2; ++ai)
#pragma unroll
            for (int m = 0; m < 4; ++m) { bf16_t* rowp = O + (size_t)(row0 + ai * HALF + m * 16) * ldc + col0;
                const f32x4 g0 = acc[ai][0][m][0], g1 = acc[ai][0][m][1], u0 = acc[ai][1][m][0], u1 = acc[ai][1][m][1];
                u32x4 w; w.x = cvt_pk_bf16(fast_silu(g0[0]) * u0[0], fast_silu(g0[1]) * u0[1]); w.y = cvt_pk_bf16(fast_silu(g0[2]) * u0[2], fast_silu(g0[3]) * u0[3]);
                w.z = cvt_pk_bf16(fast_silu(g1[0]) * u1[0], fast_silu(g1[1]) * u1[1]); w.w = cvt_pk_bf16(fast_silu(g1[2]) * u1[2], fast_silu(g1[3]) * u1[3]);
                *(u32x4*)(rowp) = w; }
    }
};
struct EpiPlainBf16 {
    static constexpr bool PERM = true, AFTER_DRAIN = false;
    bf16_t* O; int ldc; int nN;
    __device__ __forceinline__ void operator()(const f32x4 (&acc)[2][2][4][2], const Unit& u, int wr, int wc, int fr, int fq) const {
        const int row0 = u.pm * BM + wr * 64 + fr, col0 = (u.pn % nN) * BM + wc * 32 + 8 * fq;
#pragma unroll
        for (int ai = 0; ai < 2; ++ai)
#pragma unroll
            for (int m = 0; m < 4; ++m) { bf16_t* rowp = O + (size_t)(row0 + ai * HALF + m * 16) * ldc + col0;
#pragma unroll
                for (int bj = 0; bj < 2; ++bj) { const f32x4 v0 = acc[ai][bj][m][0], v1 = acc[ai][bj][m][1];
                    u32x4 w; w.x = cvt_pk_bf16(v0[0], v0[1]); w.y = cvt_pk_bf16(v0[2], v0[3]); w.z = cvt_pk_bf16(v1[0], v1[1]); w.w = cvt_pk_bf16(v1[2], v1[3]);
                    *(u32x4*)(rowp + bj * HALF) = w; } }
    }
};
struct GroupedOrder {
    int nM, nN, nwg, G, c; const PG8_LAS int* tile_e;
    __device__ void init(int nM_, int nN_, int G_, int c_, const PG8_LAS int* te) { nM = nM_; nN = nN_; nwg = nM * nN; G = G_; c = c_; tile_e = te; }
    __device__ bool next(int i, Unit& u) const {
        const long L = (long)i * G + c; if (L >= nwg) return false;
        int wgid = (int)L; { const int q = nwg / NXCD, r = nwg % NXCD, xcd = wgid % NXCD, off = wgid / NXCD; wgid = (xcd < r ? xcd * (q + 1) : r * (q + 1) + (xcd - r) * q) + off; }
        const int nig = WGM * nN, gid = wgid / nig, fm = gid * WGM, gsz = (nM - fm) < WGM ? (nM - fm) : WGM;
        u.pm = fm + ((wgid % nig) % gsz); u.pn = tile_e[u.pm] * nN + (wgid % nig) / gsz; return true;
    }
    __device__ __forceinline__ void a_ready(const Unit&) const {}
    __device__ __forceinline__ void done(const Unit&) const {}
};
template <class Epi, class Sched, bool ALIGN_EPI = false, bool SP2 = false>
__device__ __forceinline__ void gemm_phase(PG8_LAS unsigned char* lds, const Gemm g, const Sched& S, const Epi& E) {
    const int tid = threadIdx.x, wid = __builtin_amdgcn_readfirstlane(tid >> 6), lane = tid & 63, wr = wid >> 2, wc = wid & 3, fr = lane & 15, fq = lane >> 4;
    const int K = g.K, nt = K / BK;
    unsigned voffA[2], voffB[2];
#pragma unroll
    for (int i = 0; i < 2; ++i) { int R, C; stage_rc(tid * 16 + i * 8192, R, C); const int Rb = Epi::PERM ? ((R & ~31) + perm32(R & 31)) : R;
        voffA[i] = (unsigned)(R * K + C) * 2u; voffB[i] = (unsigned)(Rb * K + C) * 2u; }
    const size_t kstep = (size_t)(BK * 2);
    const size_t hstep = (size_t)HALF * K * 2;
    const size_t tstep = 2 * hstep;
    const unsigned ldsw = (unsigned)wid * 1024u;
    const int aoff = lds_byte(wr * 64 + fr, fq * 8), boff = lds_byte(wc * 32 + fr, fq * 8);
#define PG8_SA(b, h) (((b) * 2 + (h)) * HTB)
#define PG8_SB(b, h) ((4 + (b) * 2 + (h)) * HTB)
#define PG8_STAGE(bufoff, gbase, voff) do { _Pragma("unroll") for (int _i = 0; _i < 2; ++_i) \
        __builtin_amdgcn_global_load_lds((const unsigned*)((const char*)(gbase) + (voff)[_i]), (PG8_LAS unsigned*)(lds + (bufoff) + ldsw + _i * 8192), 16, 0, 0); } while (0)
#define PG8_LDA(dst, b, h) do { _Pragma("unroll") for (int m = 0; m < 4; ++m) _Pragma("unroll") for (int k = 0; k < 2; ++k) dst[m][k] = *(const PG8_LAS bf16x8*)(lds + PG8_SA(b, h) + aoff + m * 2048 + k * 1024); } while (0)
#define PG8_LDB(dst, b, h) do { _Pragma("unroll") for (int n = 0; n < 2; ++n) _Pragma("unroll") for (int k = 0; k < 2; ++k) dst[n][k] = *(const PG8_LAS bf16x8*)(lds + PG8_SB(b, h) + boff + n * 2048 + k * 1024); } while (0)
#define PG8_MMA(ai, bj, At, Bt) do { __builtin_amdgcn_s_setprio(1); _Pragma("unroll") for (int m = 0; m < 4; ++m) _Pragma("unroll") for (int n = 0; n < 2; ++n) _Pragma("unroll") for (int k = 0; k < 2; ++k) \
        acc[ai][bj][m][n] = __builtin_amdgcn_mfma_f32_16x16x32_bf16(Bt[n][k], At[m][k], acc[ai][bj][m][n], 0, 0, 0); __builtin_amdgcn_s_setprio(0); } while (0)
#define PG8_WAIT_V(n) asm volatile("s_waitcnt vmcnt(" #n ")" ::: "memory")
#define PG8_WAIT_L(n) asm volatile("s_waitcnt lgkmcnt(" #n ")" ::: "memory")
#define PG8_BAR __builtin_amdgcn_s_barrier()
#define PG8_SCHED __builtin_amdgcn_sched_barrier(0)
    Unit cur, nxt; int ui = 0;
    if (!S.next(0, cur)) return;
    f32x4 acc[2][2][4][2];
#pragma unroll
    for (int a = 0; a < 2; ++a)
#pragma unroll
        for (int b = 0; b < 2; ++b)
#pragma unroll
            for (int m = 0; m < 4; ++m)
#pragma unroll
                for (int n = 0; n < 2; ++n) acc[a][b][m][n] = (f32x4){0.f, 0.f, 0.f, 0.f};
    bf16x8 At[4][2], B0[2][2], B1[2][2];
    const char* cA = (const char*)g.A + (size_t)cur.pm * tstep; const char* cB = (const char*)g.Bt + (size_t)cur.pn * tstep;
    S.a_ready(cur);
    if constexpr (SP2) {
        PG8_STAGE(PG8_SB(0, 0), cB, voffB); PG8_STAGE(PG8_SB(0, 1), cB + hstep, voffB); PG8_STAGE(PG8_SA(0, 0), cA, voffA); PG8_STAGE(PG8_SA(0, 1), cA + hstep, voffA);
        if (wr == 1) PG8_BAR;
        PG8_WAIT_V(2); PG8_BAR;
        PG8_STAGE(PG8_SB(1, 0), cB + kstep, voffB); PG8_STAGE(PG8_SA(1, 0), cA + kstep, voffA); PG8_STAGE(PG8_SB(1, 1), cB + hstep + kstep, voffB);
        PG8_WAIT_V(6); PG8_BAR;
    } else {
        PG8_STAGE(PG8_SB(0, 0), cB, voffB); PG8_STAGE(PG8_SA(0, 0), cA, voffA); PG8_STAGE(PG8_SB(0, 1), cB + hstep, voffB); PG8_STAGE(PG8_SA(0, 1), cA + hstep, voffA);
        if (wr == 1) PG8_BAR;
        PG8_WAIT_V(4); PG8_BAR;
        PG8_STAGE(PG8_SB(1, 0), cB + kstep, voffB); PG8_STAGE(PG8_SA(1, 0), cA + kstep, voffA); PG8_STAGE(PG8_SB(1, 1), cB + hstep + kstep, voffB);
        PG8_WAIT_V(6); PG8_BAR;
    }
    for (;;) {
        const bool has_next = S.next(ui + 1, nxt);
        const char* nA = has_next ? (const char*)g.A + (size_t)nxt.pm * tstep : cA; const char* nB = has_next ? (const char*)g.Bt + (size_t)nxt.pn * tstep : cB;
        for (int t = 0; t < nt; t += 2) {
            const bool last = (t == nt - 2);
            const char* a1 = cA + (size_t)(t + 1) * kstep;
            const char* a2 = last ? nA : cA + (size_t)(t + 2) * kstep; const char* b2 = last ? nB : cB + (size_t)(t + 2) * kstep;
            const char* a3 = a2 + kstep; const char* b3 = b2 + kstep;
            if (last && has_next) S.a_ready(nxt);
            if constexpr (SP2) {
            PG8_LDB(B0, 0, 0); PG8_LDB(B1, 0, 1); PG8_SCHED; PG8_LDA(At, 0, 0); PG8_STAGE(PG8_SA(1, 1), a1 + hstep, voffA);
            PG8_WAIT_V(8); PG8_WAIT_L(0); PG8_BAR; PG8_MMA(0, 0, At, B0); PG8_MMA(0, 1, At, B1); PG8_BAR; PG8_SCHED;
            PG8_LDA(At, 0, 1); PG8_STAGE(PG8_SB(0, 0), b2, voffB); PG8_STAGE(PG8_SB(0, 1), b2 + hstep, voffB); PG8_STAGE(PG8_SA(0, 0), a2, voffA);
            PG8_WAIT_V(8); PG8_WAIT_L(0); PG8_BAR; PG8_MMA(1, 0, At, B0); PG8_MMA(1, 1, At, B1); PG8_BAR; PG8_SCHED;
            PG8_LDB(B0, 1, 0); PG8_LDB(B1, 1, 1); PG8_SCHED; PG8_LDA(At, 1, 0); PG8_STAGE(PG8_SA(0, 1), a2 + hstep, voffA);
            PG8_WAIT_V(8); PG8_WAIT_L(0); PG8_BAR; PG8_MMA(0, 0, At, B0); PG8_MMA(0, 1, At, B1); PG8_BAR; PG8_SCHED;
            PG8_LDA(At, 1, 1); PG8_STAGE(PG8_SB(1, 0), b3, voffB); PG8_STAGE(PG8_SB(1, 1), b3 + hstep, voffB); PG8_STAGE(PG8_SA(1, 0), a3, voffA);
            PG8_WAIT_V(8); PG8_WAIT_L(0); PG8_BAR; PG8_MMA(1, 0, At, B0); PG8_MMA(1, 1, At, B1); PG8_BAR; PG8_SCHED;
            } else {
            PG8_LDB(B0, 0, 0); PG8_SCHED; PG8_LDA(At, 0, 0); PG8_STAGE(PG8_SA(1, 1), a1 + hstep, voffA);
            PG8_WAIT_L(8); PG8_BAR; PG8_WAIT_L(0); PG8_MMA(0, 0, At, B0); PG8_BAR; PG8_SCHED;
            PG8_LDB(B1, 0, 1); PG8_STAGE(PG8_SB(0, 0), b2, voffB);
            PG8_BAR; PG8_WAIT_L(0); PG8_MMA(0, 1, At, B1); PG8_BAR;
            PG8_LDA(At, 0, 1); PG8_STAGE(PG8_SA(0, 0), a2, voffA);
            PG8_BAR; PG8_WAIT_L(0); PG8_MMA(1, 0, At, B0); PG8_BAR; PG8_SCHED;
            PG8_STAGE(PG8_SB(0, 1), b2 + hstep, voffB);
            PG8_WAIT_V(6); PG8_BAR; PG8_MMA(1, 1, At, B1); PG8_BAR;
            PG8_LDB(B0, 1, 0); PG8_SCHED; PG8_LDA(At, 1, 0); PG8_STAGE(PG8_SA(0, 1), a2 + hstep, voffA);
            PG8_WAIT_L(8); PG8_BAR; PG8_WAIT_L(0); PG8_MMA(0, 0, At, B0); PG8_BAR; PG8_SCHED;
            PG8_LDB(B1, 1, 1); PG8_STAGE(PG8_SB(1, 0), b3, voffB);
            PG8_BAR; PG8_WAIT_L(0); PG8_MMA(0, 1, At, B1); PG8_BAR;
            PG8_LDA(At, 1, 1); PG8_STAGE(PG8_SA(1, 0), a3, voffA);
            PG8_BAR; PG8_WAIT_L(0); PG8_MMA(1, 0, At, B0); PG8_BAR; PG8_SCHED;
            PG8_STAGE(PG8_SB(1, 1), b3 + hstep, voffB);
            PG8_WAIT_V(6); PG8_BAR; PG8_MMA(1, 1, At, B1); PG8_BAR;
            }
        }
        if constexpr (ALIGN_EPI) { if (wr == 0) PG8_BAR; }
        if constexpr (!Epi::AFTER_DRAIN) { E(acc, cur, wr, wc, fr, fq); S.done(cur); }
        if (!has_next) break;
#pragma unroll
        for (int a = 0; a < 2; ++a)
#pragma unroll
            for (int b = 0; b < 2; ++b)
#pragma unroll
                for (int m = 0; m < 4; ++m)
#pragma unroll
                    for (int n = 0; n < 2; ++n) acc[a][b][m][n] = (f32x4){0.f, 0.f, 0.f, 0.f};
        cur = nxt; cA = nA; cB = nB; ++ui;
        if constexpr (ALIGN_EPI) { if (wr == 1) PG8_BAR; }
    }
    PG8_WAIT_V(0);
    if constexpr (!ALIGN_EPI) { if (wr == 0) PG8_BAR; }
    PG8_BAR;
    if constexpr (Epi::AFTER_DRAIN) { E.fused(acc, cur, wr, wc, fr, fq, lds, wid, lane); S.done(cur); }
#undef PG8_SA
#undef PG8_SB
#undef PG8_STAGE
#undef PG8_LDA
#undef PG8_LDB
#undef PG8_MMA
#undef PG8_WAIT_V
#undef PG8_WAIT_L
#undef PG8_BAR
#undef PG8_SCHED
}
}

constexpr int NWAVES = 8;
constexpr int BATCH = 8, SEQ = 2048, DM = 2048, M = BATCH * SEQ;
constexpr int NPROJ = 4608, PROJ_LD = 4352;
constexpr int DFF = 5632, DFFE = 7168, NE = 8;
constexpr int C_MQ = 0, C_MK = 256, C_MV = 512, C_MO = 1024, C_GQ = 1536, C_GK = 1792, C_GV = 2048, C_GG = 2560, C_AQ = 3072, C_AK = 4096, C_AV = 4224;
constexpr float EPS = 1e-6f;
constexpr int MAXROWS_S = M * 2 + NE * 256;

constexpr size_t MiB = 1u << 20;
constexpr size_t WS_CTL = 0, CTL_ZERO_BYTES = 1 * MiB;
constexpr size_t WS_MOD = 1 * MiB;
constexpr size_t WS_WIN = 2 * MiB;
constexpr size_t WS_WOUT = 38 * MiB;
constexpr size_t WS_WGU0 = 54 * MiB;
constexpr size_t WS_WDN0 = 98 * MiB;
constexpr size_t WS_WGU1 = 120 * MiB;
constexpr size_t WS_WDN1 = 568 * MiB;
constexpr size_t WS_XA = 792 * MiB;
constexpr size_t WS_XN = 920 * MiB;
constexpr size_t WS_Y = 984 * MiB;
constexpr size_t WS_SIDE = 1048 * MiB;
constexpr size_t WS_TOK = 1050 * MiB;
constexpr size_t WS_BIG = 1052 * MiB;
constexpr size_t WS_HID = WS_BIG;
constexpr size_t WS_AS = WS_BIG + 476 * MiB;
constexpr size_t WS_PROJ = WS_BIG;
constexpr size_t WS_QKC = WS_BIG + 144 * MiB;
constexpr size_t WS_LA = WS_BIG + 160 * MiB;
constexpr size_t WS_KN = WS_BIG + 176 * MiB;
constexpr size_t WS_UM = WS_BIG + 192 * MiB;
constexpr size_t WS_UG = WS_BIG + 212 * MiB;
constexpr size_t WS_GAUX = WS_BIG + 244 * MiB;
constexpr size_t WS_END = WS_BIG + 612 * MiB;
constexpr int TOK_E = 0, TOK_SLOT = 32768, TOK_W = 65536, TOK_POS = 98304;

constexpr int CW_TMO = 0, CW_CODE = 1, CW_BAR = 4096, CW_CNT = 8192;

constexpr int RING_OFF = 0, RING_BYTES = 131072;
constexpr int MISC_OFF = RING_BYTES;
constexpr int LDS_BYTES = 147456;

#define GAS __attribute__((address_space(1)))
#define LAS __attribute__((address_space(3)))
typedef unsigned short bf16;
typedef unsigned v4u __attribute__((ext_vector_type(4)));
typedef unsigned v2u __attribute__((ext_vector_type(2)));
typedef float f32x4 __attribute__((ext_vector_type(4)));
typedef short bf16x8 __attribute__((ext_vector_type(8)));
typedef GAS unsigned gu32;
#define RLX_AGENT __ATOMIC_RELAXED, __HIP_MEMORY_SCOPE_AGENT
#define LDS_WAIT() asm volatile("s_waitcnt lgkmcnt(0)" ::: "memory")
#define VM_WAIT() asm volatile("s_waitcnt vmcnt(0)" ::: "memory")
__device__ __forceinline__ unsigned f2bf(float f) { unsigned u = __builtin_bit_cast(unsigned, f); return (u + 0x7fffu + ((u >> 16) & 1u)) >> 16; }
__device__ __forceinline__ unsigned pk2(float lo, float hi) { return f2bf(lo) | (f2bf(hi) << 16); }
__device__ __forceinline__ float bflo(unsigned w) { return __builtin_bit_cast(float, w << 16); }
__device__ __forceinline__ float bfhi(unsigned w) { return __builtin_bit_cast(float, w & 0xffff0000u); }
__device__ __forceinline__ float bf1(bf16 b) { return __builtin_bit_cast(float, ((unsigned)b) << 16); }
__device__ __forceinline__ float wave_sum(float v) {
#pragma unroll
    for (int o = 1; o < 64; o <<= 1) v += __shfl_xor(v, o);
    return v;
}
__device__ __forceinline__ float sigmoidf_(float x) { return 1.0f / (1.0f + __expf(-x)); }
__device__ __forceinline__ float siluf_(float x) { return x / (1.0f + __expf(-x)); }
__device__ __forceinline__ float logsigmoidf_(float z) { return fminf(z, 0.f) - log1pf(expf(-fabsf(z))); }

#ifndef FAST_SWA
#define FAST_SWA 1
#endif
#ifndef FAST_GLA
#define FAST_GLA 1
#endif
#ifndef FAST_MLSTM
#define FAST_MLSTM 1
#endif
#define XB_TMO      128
#define XB_XCNT(j)  (256  + 64 * (j))
#define XB_XSUB(j)  (1280 + 64 * (j))
#define XB_XGEN(j)  (2304 + 64 * (j))
#define XB_TOP      3328
#define XB_TOPGEN   3392
#define XCD_BAR_WORDS 3456
#define XB_SPIN_CAP (1u << 18)

__device__ __forceinline__ unsigned xb_ld(unsigned* p)              { return __hip_atomic_load(p, __ATOMIC_RELAXED, __HIP_MEMORY_SCOPE_AGENT); }
__device__ __forceinline__ unsigned xb_add(unsigned* p, unsigned v) { return __hip_atomic_fetch_add(p, v, __ATOMIC_RELAXED, __HIP_MEMORY_SCOPE_AGENT); }
__device__ __forceinline__ unsigned xb_xcc_id() { return (unsigned)__builtin_amdgcn_s_getreg((3 << 11) | 20) & 0xFu; }
#define XB_SPIN(cond, bar) do { unsigned _sp = 0; while (cond) { __builtin_amdgcn_s_sleep(1); \
    if ((++_sp & 255u) == 0u) { if (xb_ld(&(bar)[XB_TMO])) break; if (_sp > XB_SPIN_CAP) { atomicAdd(&(bar)[XB_TMO], 1u); break; } } } } while (0)

struct XcdBarrier {
    unsigned* bar; unsigned x;
    volatile LAS unsigned* st;
};

__device__ __forceinline__ XcdBarrier xcd_barrier_post(unsigned* bar, volatile LAS unsigned* st) {
    XcdBarrier b; b.bar = bar; b.x = xb_xcc_id(); b.st = st;
    if (threadIdx.x == 0) (void)xb_add(&bar[XB_XCNT(b.x)], 1u);
    return b;
}
__device__ __forceinline__ void xcd_barrier_complete(unsigned* bar, unsigned x, unsigned& nloc, unsigned& nx) {
    const unsigned G = gridDim.x * gridDim.y * gridDim.z;
    unsigned sum, cnt, mine, sp = 0u;
    for (;;) {
        sum = 0u; cnt = 0u; mine = 0u;
#pragma unroll
        for (unsigned j = 0; j < 16; ++j) { const unsigned c = xb_ld(&bar[XB_XCNT(j)]); sum += c; cnt += (c > 0u) ? 1u : 0u; mine = (j == x) ? c : mine; }
        if (sum == G) break;
        __builtin_amdgcn_s_sleep(1);
        if ((++sp & 255u) == 0u) { if (xb_ld(&bar[XB_TMO])) break; if (sp > XB_SPIN_CAP) { atomicAdd(&bar[XB_TMO], 1u); break; } }
    }
    nloc = mine > 0u ? mine : 1u; nx = cnt > 0u ? cnt : 1u;
}

__device__ __forceinline__ void xcd_barrier(const XcdBarrier& b) {
    asm volatile("s_waitcnt vmcnt(0)" ::: "memory");
    __syncthreads();
    if (threadIdx.x == 0) {
        unsigned* bar = b.bar;
        __builtin_amdgcn_s_waitcnt(0);
        unsigned nloc = b.st[0], nx = b.st[1];
        if (nloc == 0u) { xcd_barrier_complete(bar, b.x, nloc, nx); b.st[0] = nloc; b.st[1] = nx; }
        const unsigned old = xb_add(&bar[XB_XSUB(b.x)], 1u);
        const unsigned gen = old / nloc;
        if (old + 1u == (gen + 1u) * nloc) {
            __builtin_amdgcn_fence(__ATOMIC_RELEASE, "agent");
            asm volatile("s_waitcnt vmcnt(0)" ::: "memory");
            const unsigned og = xb_add(&bar[XB_TOP], 1u);
            const unsigned tg = og / nx;
            if (og + 1u == (tg + 1u) * nx) xb_add(&bar[XB_TOPGEN], 1u);
            else XB_SPIN(xb_ld(&bar[XB_TOPGEN]) == tg, bar);
            __builtin_amdgcn_fence(__ATOMIC_ACQUIRE, "agent");
            xb_add(&bar[XB_XGEN(b.x)], 1u);
            asm volatile("s_waitcnt vmcnt(0)" ::: "memory");
        } else {
            XB_SPIN(xb_ld(&bar[XB_XGEN(b.x)]) == gen, bar);
            __builtin_amdgcn_fence(__ATOMIC_ACQUIRE, "agent");
            asm volatile("s_waitcnt vmcnt(0)" ::: "memory");
        }
    }
    __syncthreads();
}

typedef const float* cfp;
typedef __attribute__((address_space(4))) cfp cfp_k;
struct Frame {
    LAS unsigned char* lds;
    gu32* ctl;
    int tid, lane, wave, vcu, G;
    cfp_k* in;
    float* out; unsigned char* ws;
};
#define IN_X 0
#define IN_C 1
#define IN_WADA 2
#define IN_BADA 3
#define IN_GMIX 4
#define IN_GFFN 5
#define IN_WIN 6
#define IN_BGATES 7
#define IN_WCONV 8
#define IN_BCONV 9
#define IN_GOUTM 10
#define IN_WDEC 11
#define IN_BDEC 12
#define IN_GOUTG 13
#define IN_GQN 14
#define IN_GKN 15
#define IN_SINKS 16
#define IN_RELB 17
#define IN_WOUT 18
#define IN_WFG 19
#define IN_WFU 20
#define IN_WFD 21
#define IN_WROUTER 22
#define IN_WMG 23
#define IN_WMU 24
#define IN_WMD 25

__device__ __forceinline__ int rowmap(int kind, int off, int n) {
    if (kind == 0) return off + n;
    if (kind == 1) return off + ((n >> 7) << 8) + (n & 127);
    if (n < 1536) return n; if (n < 1544) return 4352 + (n - 1536); if (n < 3080) return n - 8; if (n < 3096) return 4360 + (n - 3080); return n - 24;
}
__device__ __forceinline__ void transpose_item(const float* W, int N, bf16* WT, int ldt, int kind, int off, LAS float* scr, int item, int lane) {
    const int nblk = (N + 31) >> 5, kb = item / nblk, nb = item - kb * nblk, k0 = 64 * kb, n0 = 32 * nb;
    const int nn = n0 + (lane & 31); const bool ok = nn < N;
    const float* src = W + (size_t)(k0 + (lane >> 5)) * N + nn;
#pragma unroll 8
    for (int i = 0; i < 32; ++i) { scr[(2 * i + (lane >> 5)) * 33 + (lane & 31)] = ok ? src[(size_t)(2 * i) * N] : 0.f; }
    LDS_WAIT(); asm volatile("" ::: "memory");
    const int c = lane & 7;
#pragma unroll
    for (int j = 0; j < 4; ++j) { const int n = (lane >> 3) + 8 * j; const LAS float* s = scr + (8 * c) * 33 + n;
        v4u o; o.x = pk2(s[0 * 33], s[1 * 33]); o.y = pk2(s[2 * 33], s[3 * 33]); o.z = pk2(s[4 * 33], s[5 * 33]); o.w = pk2(s[6 * 33], s[7 * 33]);
        if (n0 + n < N) *(v4u*)(WT + (size_t)rowmap(kind, off, n0 + n) * ldt + k0 + 8 * c) = o; }
    LDS_WAIT(); asm volatile("" ::: "memory");
}
__device__ __forceinline__ void p0_prologue(Frame& F) {
    {
        LAS float* cond = (LAS float*)(F.lds + RING_OFF);
        LAS float* red = (LAS float*)(F.lds + RING_OFF + 65536);
        float* mod = (float*)(F.ws + WS_MOD);
        bool have = false;
        for (int it = F.vcu; it < 192; it += F.G) {
            if (!have) { for (int i = F.tid; i < 8 * 2048; i += NWAVES * 64) { const float cv = F.in[IN_C][i]; cond[i] = cv / (1.0f + expf(-cv)); } have = true; }
            __syncthreads();
            const int l = it / 96, cg = it % 96, col = cg * 128 + (F.tid & 127), dq = F.tid >> 7;
            float acc[8];
#pragma unroll
            for (int b = 0; b < 8; ++b) acc[b] = 0.f;
            const float* wp = F.in[IN_WADA] + (size_t)l * 2048 * 12288 + (size_t)(dq * 512) * 12288 + col;
            const LAS float* cp = cond + dq * 512;
#pragma unroll 8
            for (int d = 0; d < 512; ++d) { const float w = wp[(size_t)d * 12288];
#pragma unroll
                for (int b = 0; b < 8; ++b) acc[b] += cp[b * 2048 + d] * w; }
#pragma unroll
            for (int b = 0; b < 8; ++b) red[(dq * 8 + b) * 128 + (F.tid & 127)] = acc[b];
            __syncthreads();
            if (F.tid < 128) {
#pragma unroll
                for (int b = 0; b < 8; ++b) { const float s = (red[(0 * 8 + b) * 128 + F.tid] + red[(1 * 8 + b) * 128 + F.tid]) + (red[(2 * 8 + b) * 128 + F.tid] + red[(3 * 8 + b) * 128 + F.tid]);
                    mod[(size_t)(l * 8 + b) * 12288 + cg * 128 + F.tid] = s + F.in[IN_BADA][l * 12288 + cg * 128 + F.tid]; }
            }
        }
        __syncthreads();
    }
    LAS float* scr = (LAS float*)(F.lds + RING_OFF + F.wave * 16384);
    const int gw = F.vcu * NWAVES + F.wave, NGW = F.G * NWAVES;
    constexpr int NITEMS = 201792;
    for (int it = gw; it < NITEMS; it += NGW) {
        int r = it; const float* W; bf16* WT; int N, ldt, kind, off;
        if (r < 8768) { const int l = r / 4384; r -= l * 4384; W = F.in[IN_WIN] + (size_t)l * 2048 * 4376; N = 4376; WT = (bf16*)(F.ws + WS_WIN) + (size_t)l * NPROJ * 2048; ldt = 2048; kind = 2; off = 0; }
        else if ((r -= 8768) < 4096) { const int l = r / 2048; r -= l * 2048; W = F.in[IN_WOUT] + (size_t)l * 2048 * 2048; N = 2048; WT = (bf16*)(F.ws + WS_WOUT) + (size_t)l * 2048 * 2048; ldt = 2048; kind = 0; off = 0; }
        else if ((r -= 4096) < 5632) { W = F.in[IN_WFG]; N = DFF; WT = (bf16*)(F.ws + WS_WGU0); ldt = 2048; kind = 1; off = 0; }
        else if ((r -= 5632) < 5632) { W = F.in[IN_WFU]; N = DFF; WT = (bf16*)(F.ws + WS_WGU0); ldt = 2048; kind = 1; off = 128; }
        else if ((r -= 5632) < 5632) { W = F.in[IN_WFD]; N = 2048; WT = (bf16*)(F.ws + WS_WDN0); ldt = DFF; kind = 0; off = 0; }
        else if ((r -= 5632) < 57344) { const int e = r / 7168; r -= e * 7168; W = F.in[IN_WMG] + (size_t)e * 2048 * DFFE; N = DFFE; WT = (bf16*)(F.ws + WS_WGU1) + (size_t)e * 14336 * 2048; ldt = 2048; kind = 1; off = 0; }
        else if ((r -= 57344) < 57344) { const int e = r / 7168; r -= e * 7168; W = F.in[IN_WMU] + (size_t)e * 2048 * DFFE; N = DFFE; WT = (bf16*)(F.ws + WS_WGU1) + (size_t)e * 14336 * 2048; ldt = 2048; kind = 1; off = 128; }
        else { r -= 57344; const int e = r / 7168; r -= e * 7168; W = F.in[IN_WMD] + (size_t)e * DFFE * 2048; N = 2048; WT = (bf16*)(F.ws + WS_WDN1) + (size_t)e * 2048 * DFFE; ldt = DFFE; kind = 0; off = 0; }
        transpose_item(W, N, WT, ldt, kind, off, scr, r, F.lane);
    }
    for (int i = gw; i < 2 * 232; i += NGW) { const int l = i / 232, rr = 4376 + i % 232; v4u* p = (v4u*)((bf16*)(F.ws + WS_WIN) + ((size_t)l * NPROJ + rr) * 2048);
#pragma unroll
        for (int j = 0; j < 4; ++j) p[F.lane + 64 * j] = (v4u){0u, 0u, 0u, 0u}; }
}

template <bool ROUTER>
__device__ __forceinline__ void norm_phase(Frame& F, const float* xin, const float* g, const float* modl, int sh_off, int sc_off) {
    bf16* XN = (bf16*)(F.ws + WS_XN);
    const int gw = F.vcu * NWAVES + F.wave, NGW = F.G * NWAVES;
    LAS float* wrT = (LAS float*)(F.lds + RING_OFF);
    LAS int* lcnt = (LAS int*)(F.lds + MISC_OFF + 1152);
    LAS int* lbase = (LAS int*)(F.lds + MISC_OFF + 1216);
    LAS int* rtab = (LAS int*)(F.lds + MISC_OFF + 2048);
    int nrow = 0;
    if (ROUTER) {
        for (int i = F.tid; i < 2048 * 8; i += NWAVES * 64) wrT[(i & 7) * 2048 + (i >> 3)] = F.in[IN_WROUTER][i];
        if (F.tid < 8) lcnt[F.tid] = 0;
        __syncthreads();
    }
    for (int m = gw; m < M; m += NGW, ++nrow) {
        const int b = m >> 11;
        const f32x4* xr = (const f32x4*)(xin + (size_t)m * DM) + F.lane;
        f32x4 v[8]; float ss = 0.f;
#pragma unroll
        for (int j = 0; j < 8; ++j) { v[j] = xr[64 * j]; ss += (v[j].x * v[j].x + v[j].y * v[j].y) + (v[j].z * v[j].z + v[j].w * v[j].w); }
        const float rstd = 1.0f / sqrtf(wave_sum(ss) * (1.0f / DM) + EPS);
        const f32x4* gp = (const f32x4*)g + F.lane; const f32x4* scp = (const f32x4*)(modl + (size_t)b * 12288 + sc_off) + F.lane; const f32x4* shp = (const f32x4*)(modl + (size_t)b * 12288 + sh_off) + F.lane;
        v2u* o8 = (v2u*)(XN + (size_t)m * DM) + F.lane;
#pragma unroll
        for (int j = 0; j < 8; ++j) { const f32x4 gg = gp[64 * j], sc = scp[64 * j], sh = shp[64 * j];
            v[j] = v[j] * rstd * gg * (sc + 1.0f) + sh;
            v2u w; w.x = pk2(v[j].x, v[j].y); w.y = pk2(v[j].z, v[j].w); o8[64 * j] = w; }
        if (ROUTER) {
            float lg[8];
#pragma unroll
            for (int e = 0; e < 8; ++e) { float p = 0.f; const LAS f32x4* wp = (const LAS f32x4*)(wrT + e * 2048) + F.lane;
#pragma unroll
                for (int j = 0; j < 8; ++j) { const f32x4 w = wp[64 * j]; p += (v[j].x * w.x + v[j].y * w.y) + (v[j].z * w.z + v[j].w * w.w); }
                lg[e] = wave_sum(p); }
            int e1 = 0; float v1 = lg[0];
#pragma unroll
            for (int e = 1; e < 8; ++e) if (lg[e] > v1) { v1 = lg[e]; e1 = e; }
            int e2 = -1; float v2 = -3.0e38f;
#pragma unroll
            for (int e = 0; e < 8; ++e) if (e != e1 && lg[e] > v2) { v2 = lg[e]; e2 = e; }
            const float w1 = 1.0f / (1.0f + expf(v2 - v1)), w2 = 1.0f - w1;
            if (F.lane == 0) {
                const int r1 = atomicAdd((int*)(lcnt + e1), 1), r2 = atomicAdd((int*)(lcnt + e2), 1);
                LAS int* en = rtab + (F.wave * 16 + nrow) * 8;
                en[0] = m; en[1] = e1; en[2] = r1; en[3] = __builtin_bit_cast(int, w1); en[4] = m; en[5] = e2; en[6] = r2; en[7] = __builtin_bit_cast(int, w2);
            }
        }
    }
    if (ROUTER) {
        __syncthreads();
        if (F.tid < 8) lbase[F.tid] = (int)__hip_atomic_fetch_add((unsigned*)(F.ctl + CW_CNT + 64 * F.tid), (unsigned)lcnt[F.tid], RLX_AGENT);
        __syncthreads();
        int* tk = (int*)(F.ws + WS_TOK);
        const int per = (M + NGW - 1) / NGW;
        for (int i = F.tid; i < NWAVES * per * 2; i += NWAVES * 64) { const int w = i / (per * 2), rr = (i % (per * 2)) >> 1, k = i & 1;
            const int mrow = F.vcu * NWAVES + w + rr * NGW; if (mrow >= M) continue;
            const LAS int* en = rtab + (w * 16 + rr) * 8 + 4 * k;
            const int t = en[0], e = en[1];
            tk[TOK_E + t * 2 + k] = e; tk[TOK_SLOT + t * 2 + k] = lbase[e] + en[2]; tk[TOK_W + t * 2 + k] = en[3]; }
    }
}

__device__ const unsigned char T5_BUCKET[128] = {0, 1, 2, 3, 4, 5, 6, 7, 8, 9, 10, 11, 12, 13, 14, 15, 16, 16, 16, 17, 17, 18, 18, 18, 19, 19, 19, 20, 20, 20, 20, 21, 21, 21, 21, 22, 22, 22, 22, 22, 23, 23, 23, 23, 23, 23, 24, 24, 24, 24, 24, 24, 25, 25, 25, 25, 25, 25, 25, 26, 26, 26, 26, 26, 26, 26, 26, 27, 27, 27, 27, 27, 27, 27, 27, 27, 27, 28, 28, 28, 28, 28, 28, 28, 28, 28, 28, 29, 29, 29, 29, 29, 29, 29, 29, 29, 29, 29, 29, 30, 30, 30, 30, 30, 30, 30, 30, 30, 30, 30, 30, 30, 30, 31, 31, 31, 31, 31, 31, 31, 31, 31, 31, 31, 31, 31, 31, 31};

__device__ __forceinline__ void mix_prep(Frame& F, int l) {
    const bf16* proj = (const bf16*)(F.ws + WS_PROJ); const float* side = (const float*)(F.ws + WS_SIDE);
    bf16* qkc = (bf16*)(F.ws + WS_QKC); float* la = (float*)(F.ws + WS_LA); bf16* kn = (bf16*)(F.ws + WS_KN);
    const int gw = F.vcu * NWAVES + F.wave, NGW = F.G * NWAVES, lane = F.lane;
    const float* wc = F.in[IN_WCONV] + l * 4 * 512; const float* bc = F.in[IN_BCONV] + l * 512;
    const float* wd = F.in[IN_WDEC] + l * 16 * 256; const float* bd = F.in[IN_BDEC] + l * 256; const float* gk = F.in[IN_GKN] + l * 64;
    for (int m = gw; m < M; m += NGW) {
        const int pos = m & (SEQ - 1);
        {
            float y[8]; const int ch = lane * 8;
            { const f32x4 b0 = *(const f32x4*)(bc + ch), b1 = *(const f32x4*)(bc + ch + 4); y[0] = b0.x; y[1] = b0.y; y[2] = b0.z; y[3] = b0.w; y[4] = b1.x; y[5] = b1.y; y[6] = b1.z; y[7] = b1.w; }
#pragma unroll
            for (int i = 0; i < 4; ++i) { if (pos - 3 + i >= 0) {
                const v4u xv = *(const v4u*)(proj + (size_t)(m - 3 + i) * PROJ_LD + ch);
                const f32x4 w0 = *(const f32x4*)(wc + i * 512 + ch), w1 = *(const f32x4*)(wc + i * 512 + ch + 4);
                y[0] += w0.x * bflo(xv.x); y[1] += w0.y * bfhi(xv.x); y[2] += w0.z * bflo(xv.y); y[3] += w0.w * bfhi(xv.y);
                y[4] += w1.x * bflo(xv.z); y[5] += w1.y * bfhi(xv.z); y[6] += w1.z * bflo(xv.w); y[7] += w1.w * bfhi(xv.w); } }
            const float sc = ch >= 256 ? 0.125f : 1.0f;
#pragma unroll
            for (int i = 0; i < 8; ++i) y[i] = siluf_(y[i]) * sc;
            v4u o; o.x = pk2(y[0], y[1]); o.y = pk2(y[2], y[3]); o.z = pk2(y[4], y[5]); o.w = pk2(y[6], y[7]);
            *(v4u*)(qkc + (size_t)m * 512 + ch) = o;
        }
        {
            const int c = lane * 4; f32x4 z = *(const f32x4*)(bd + c);
            const f32x4* gp = (const f32x4*)(side + (size_t)m * 32 + 8);
            const f32x4 g0 = gp[0], g1 = gp[1], g2 = gp[2], g3 = gp[3];
            const float ga[16] = {g0.x, g0.y, g0.z, g0.w, g1.x, g1.y, g1.z, g1.w, g2.x, g2.y, g2.z, g2.w, g3.x, g3.y, g3.z, g3.w};
#pragma unroll
            for (int r = 0; r < 16; ++r) { const f32x4 w = *(const f32x4*)(wd + r * 256 + c); z += w * ga[r]; }
            f32x4 o; o.x = logsigmoidf_(z.x) * 0.0625f; o.y = logsigmoidf_(z.y) * 0.0625f; o.z = logsigmoidf_(z.z) * 0.0625f; o.w = logsigmoidf_(z.w) * 0.0625f;
            *(f32x4*)(la + (size_t)m * 256 + c) = o;
        }
        {
            const unsigned kv = *(const unsigned*)(proj + (size_t)m * PROJ_LD + C_AK + 2 * lane);
            const float k0 = bflo(kv), k1 = bfhi(kv); float ss = k0 * k0 + k1 * k1;
#pragma unroll
            for (int o = 1; o < 32; o <<= 1) ss += __shfl_xor(ss, o);
            const float rstd = 1.0f / sqrtf(ss * (1.0f / 64.0f) + EPS);
            *(unsigned*)(kn + (size_t)m * 128 + 2 * lane) = pk2(k0 * rstd * gk[(2 * lane) & 63], k1 * rstd * gk[(2 * lane + 1) & 63]);
        }
    }
}

__device__ __forceinline__ void naive_mlstm(Frame& F, int l, int bh) {
    const int b = bh >> 2, h = bh & 3, tid = F.tid, v = tid >> 2, kq = tid & 3;
    const bf16* proj = (const bf16*)(F.ws + WS_PROJ); const float* side = (const float*)(F.ws + WS_SIDE); const bf16* qkc = (const bf16*)(F.ws + WS_QKC);
    bf16* Y = (bf16*)(F.ws + WS_Y);
    LAS float* red = (LAS float*)(F.lds + RING_OFF);
    const float bi = F.in[IN_BGATES][l * 8 + h], bfg = F.in[IN_BGATES][l * 8 + 4 + h];
    const float gout = F.in[IN_GOUTM][l * 512 + h * 128 + v];
    float C[16], n[16]; float mst = 0.f;
#pragma unroll
    for (int i = 0; i < 16; ++i) { C[i] = 0.f; n[i] = 0.f; }
    for (int t = 0; t < SEQ; ++t) {
        const size_t row = (size_t)b * SEQ + t;
        const v4u q0 = *(const v4u*)(qkc + row * 512 + h * 64 + kq * 16), q1 = *(const v4u*)(qkc + row * 512 + h * 64 + kq * 16 + 8);
        const v4u k0 = *(const v4u*)(qkc + row * 512 + 256 + h * 64 + kq * 16), k1 = *(const v4u*)(qkc + row * 512 + 256 + h * 64 + kq * 16 + 8);
        const float q[16] = {bflo(q0.x), bfhi(q0.x), bflo(q0.y), bfhi(q0.y), bflo(q0.z), bfhi(q0.z), bflo(q0.w), bfhi(q0.w), bflo(q1.x), bfhi(q1.x), bflo(q1.y), bfhi(q1.y), bflo(q1.z), bfhi(q1.z), bflo(q1.w), bfhi(q1.w)};
        const float k[16] = {bflo(k0.x), bfhi(k0.x), bflo(k0.y), bfhi(k0.y), bflo(k0.z), bfhi(k0.z), bflo(k0.w), bfhi(k0.w), bflo(k1.x), bfhi(k1.x), bflo(k1.y), bfhi(k1.y), bflo(k1.z), bfhi(k1.z), bflo(k1.w), bfhi(k1.w)};
        const float vv = bf1(proj[row * PROJ_LD + C_MV + h * 128 + v]);
        const float ip = side[row * 32 + h] + bi, lf = logsigmoidf_(side[row * 32 + 4 + h] + bfg);
        const float mn = fmaxf(lf + mst, ip), fd = expf(lf + mst - mn), iw = expf(ip - mn); mst = mn;
        float num = 0.f, den = 0.f;
#pragma unroll
        for (int i = 0; i < 16; ++i) { C[i] = fd * C[i] + (iw * vv) * k[i]; n[i] = fd * n[i] + iw * k[i]; num += C[i] * q[i]; den += n[i] * q[i]; }
        num += __shfl_xor(num, 1); num += __shfl_xor(num, 2); den += __shfl_xor(den, 1); den += __shfl_xor(den, 2);
        const float hv = num / fmaxf(fabsf(den), expf(-mst));
        const float s2 = wave_sum(kq == 0 ? hv * hv : 0.f);
        if (F.lane == 0) red[(t & 1) * 8 + F.wave] = s2;
        __syncthreads();
        float tot = 0.f;
#pragma unroll
        for (int w = 0; w < 8; ++w) tot += red[(t & 1) * 8 + w];
        const float rstd = 1.0f / sqrtf(tot * (1.0f / 128.0f) + EPS);
        if (kq == 0) { const float mo = bf1(proj[row * PROJ_LD + C_MO + h * 128 + v]);
            Y[row * DM + h * 128 + v] = (bf16)f2bf(hv * rstd * gout * sigmoidf_(mo)); }
    }
    __syncthreads();
}
__device__ __forceinline__ void naive_gla(Frame& F, int l, int bh) {
    const int b = bh >> 2, h = bh & 3, tid = F.tid, v = tid >> 2, kq = tid & 3;
    const bf16* proj = (const bf16*)(F.ws + WS_PROJ); const float* la = (const float*)(F.ws + WS_LA);
    bf16* Y = (bf16*)(F.ws + WS_Y);
    LAS float* red = (LAS float*)(F.lds + RING_OFF);
    const float gout = F.in[IN_GOUTG][l * 512 + h * 128 + v];
    float S[16];
#pragma unroll
    for (int i = 0; i < 16; ++i) S[i] = 0.f;
    for (int t = 0; t < SEQ; ++t) {
        const size_t row = (size_t)b * SEQ + t;
        const v4u q0 = *(const v4u*)(proj + row * PROJ_LD + C_GQ + h * 64 + kq * 16), q1 = *(const v4u*)(proj + row * PROJ_LD + C_GQ + h * 64 + kq * 16 + 8);
        const v4u k0 = *(const v4u*)(proj + row * PROJ_LD + C_GK + h * 64 + kq * 16), k1 = *(const v4u*)(proj + row * PROJ_LD + C_GK + h * 64 + kq * 16 + 8);
        const float q[16] = {bflo(q0.x), bfhi(q0.x), bflo(q0.y), bfhi(q0.y), bflo(q0.z), bfhi(q0.z), bflo(q0.w), bfhi(q0.w), bflo(q1.x), bfhi(q1.x), bflo(q1.y), bfhi(q1.y), bflo(q1.z), bfhi(q1.z), bflo(q1.w), bfhi(q1.w)};
        const float k[16] = {bflo(k0.x), bfhi(k0.x), bflo(k0.y), bfhi(k0.y), bflo(k0.z), bfhi(k0.z), bflo(k0.w), bfhi(k0.w), bflo(k1.x), bfhi(k1.x), bflo(k1.y), bfhi(k1.y), bflo(k1.z), bfhi(k1.z), bflo(k1.w), bfhi(k1.w)};
        const f32x4* lp = (const f32x4*)(la + row * 256 + h * 64 + kq * 16);
        const f32x4 a0 = lp[0], a1 = lp[1], a2 = lp[2], a3 = lp[3];
        const float a[16] = {a0.x, a0.y, a0.z, a0.w, a1.x, a1.y, a1.z, a1.w, a2.x, a2.y, a2.z, a2.w, a3.x, a3.y, a3.z, a3.w};
        const float vv = bf1(proj[row * PROJ_LD + C_GV + h * 128 + v]);
        float o = 0.f;
#pragma unroll
        for (int i = 0; i < 16; ++i) { S[i] = expf(a[i]) * S[i] + k[i] * vv; o += (q[i] * 0.125f) * S[i]; }
        o += __shfl_xor(o, 1); o += __shfl_xor(o, 2);
        const float s2 = wave_sum(kq == 0 ? o * o : 0.f);
        if (F.lane == 0) red[(t & 1) * 8 + F.wave] = s2;
        __syncthreads();
        float tot = 0.f;
#pragma unroll
        for (int w = 0; w < 8; ++w) tot += red[(t & 1) * 8 + w];
        const float rstd = 1.0f / sqrtf(tot * (1.0f / 128.0f) + EPS);
        if (kq == 0) { const float gg = bf1(proj[row * PROJ_LD + C_GG + h * 128 + v]);
            Y[row * DM + 512 + h * 128 + v] = (bf16)f2bf(o * rstd * gout * siluf_(gg)); }
    }
    __syncthreads();
}
__device__ __forceinline__ void naive_swa(Frame& F, int l, int blk) {
    const int tid = F.tid, hq = tid & 15, row = blk * 32 + (tid >> 4), kvh = hq >> 3, pos = row & (SEQ - 1);
    const bf16* proj = (const bf16*)(F.ws + WS_PROJ); const bf16* kn = (const bf16*)(F.ws + WS_KN); bf16* Y = (bf16*)(F.ws + WS_Y);
    const float* gq = F.in[IN_GQN] + l * 64; const float* relb = F.in[IN_RELB];
    float q[64], o[64];
    { float ss = 0.f;
#pragma unroll
      for (int c = 0; c < 8; ++c) { const v4u x = *(const v4u*)(proj + (size_t)row * PROJ_LD + C_AQ + hq * 64 + 8 * c);
          q[8 * c + 0] = bflo(x.x); q[8 * c + 1] = bfhi(x.x); q[8 * c + 2] = bflo(x.y); q[8 * c + 3] = bfhi(x.y); q[8 * c + 4] = bflo(x.z); q[8 * c + 5] = bfhi(x.z); q[8 * c + 6] = bflo(x.w); q[8 * c + 7] = bfhi(x.w); }
#pragma unroll
      for (int d = 0; d < 64; ++d) ss += q[d] * q[d];
      const float rstd = 1.0f / sqrtf(ss * (1.0f / 64.0f) + EPS);
#pragma unroll
      for (int d = 0; d < 64; ++d) { q[d] = q[d] * rstd * gq[d] * 0.125f; o[d] = 0.f; } }
    float mx = F.in[IN_SINKS][l * 16 + hq], den = 1.0f;
    const int s0 = pos - 127 < 0 ? 0 : pos - 127;
    for (int s = s0; s <= pos; ++s) {
        const size_t kr = (size_t)(row - pos + s);
        float dot = 0.f;
#pragma unroll
        for (int c = 0; c < 8; ++c) { const v4u x = *(const v4u*)(kn + kr * 128 + kvh * 64 + 8 * c);
            dot += q[8 * c + 0] * bflo(x.x) + q[8 * c + 1] * bfhi(x.x) + q[8 * c + 2] * bflo(x.y) + q[8 * c + 3] * bfhi(x.y) + q[8 * c + 4] * bflo(x.z) + q[8 * c + 5] * bfhi(x.z) + q[8 * c + 6] * bflo(x.w) + q[8 * c + 7] * bfhi(x.w); }
        const float sc = dot + relb[T5_BUCKET[pos - s] * 16 + hq];
        const float mn = fmaxf(mx, sc), corr = expf(mx - mn), p = expf(sc - mn); mx = mn; den = den * corr + p;
#pragma unroll
        for (int c = 0; c < 8; ++c) { const v4u x = *(const v4u*)(proj + kr * PROJ_LD + C_AV + kvh * 64 + 8 * c);
            o[8 * c + 0] = o[8 * c + 0] * corr + p * bflo(x.x); o[8 * c + 1] = o[8 * c + 1] * corr + p * bfhi(x.x); o[8 * c + 2] = o[8 * c + 2] * corr + p * bflo(x.y); o[8 * c + 3] = o[8 * c + 3] * corr + p * bfhi(x.y);
            o[8 * c + 4] = o[8 * c + 4] * corr + p * bflo(x.z); o[8 * c + 5] = o[8 * c + 5] * corr + p * bfhi(x.z); o[8 * c + 6] = o[8 * c + 6] * corr + p * bflo(x.w); o[8 * c + 7] = o[8 * c + 7] * corr + p * bfhi(x.w); }
    }
    const float inv = 1.0f / den;
#pragma unroll
    for (int c = 0; c < 8; ++c) { v4u w; w.x = pk2(o[8 * c] * inv, o[8 * c + 1] * inv); w.y = pk2(o[8 * c + 2] * inv, o[8 * c + 3] * inv); w.z = pk2(o[8 * c + 4] * inv, o[8 * c + 5] * inv); w.w = pk2(o[8 * c + 6] * inv, o[8 * c + 7] * inv);
        *(v4u*)(Y + (size_t)row * DM + 1024 + hq * 64 + 8 * c) = w; }
}
__device__ __forceinline__ void mix_naive(Frame& F, int l) {
    for (int u = F.vcu; u < 64 + 512; u += F.G) {
        if (u < 32) { if (!FAST_MLSTM) naive_mlstm(F, l, u); }
        else if (u < 64) { if (!FAST_GLA) naive_gla(F, l, u - 32); }
        else { if (!FAST_SWA) naive_swa(F, l, u - 64); }
    }
}

__device__ __forceinline__ int moe_tables(Frame& F) {
    LAS int* seg = (LAS int*)(F.lds + MISC_OFF + 1024); LAS int* tile_e = (LAS int*)(F.lds + MISC_OFF + 64);
    if (F.tid == 0) { int s = 0;
        for (int e = 0; e < 8; ++e) { seg[e] = s; const int c = (int)__hip_atomic_load(F.ctl + CW_CNT + 64 * e, RLX_AGENT); const int nt = (c + 255) >> 8; for (int i = 0; i < nt; ++i) tile_e[(s >> 8) + i] = e; s += nt << 8; }
        seg[8] = s; }
    __syncthreads();
    return seg[8] >> 8;
}
__device__ __forceinline__ void moe_gather(Frame& F) {
    (void)moe_tables(F);
    const LAS int* seg = (const LAS int*)(F.lds + MISC_OFF + 1024);
    const int gw = F.vcu * NWAVES + F.wave, NGW = F.G * NWAVES;
    int* tk = (int*)(F.ws + WS_TOK); const bf16* XN = (const bf16*)(F.ws + WS_XN); bf16* AS = (bf16*)(F.ws + WS_AS);
    for (int m = gw; m < M; m += NGW) {
        const v4u* src = (const v4u*)(XN + (size_t)m * DM) + F.lane; v4u r[4];
#pragma unroll
        for (int j = 0; j < 4; ++j) r[j] = src[64 * j];
#pragma unroll
        for (int k = 0; k < 2; ++k) { const int e = tk[TOK_E + m * 2 + k], dest = seg[e] + tk[TOK_SLOT + m * 2 + k];
            v4u* dst = (v4u*)(AS + (size_t)dest * DM) + F.lane;
#pragma unroll
            for (int j = 0; j < 4; ++j) dst[64 * j] = r[j];
            if (F.lane == 0) tk[TOK_POS + m * 2 + k] = dest; }
    }
    for (int e = 0; e < 8; ++e) { const int c = (int)__hip_atomic_load(F.ctl + CW_CNT + 64 * e, RLX_AGENT);
        for (int r = seg[e] + c + gw; r < seg[e + 1]; r += NGW) { v4u* dst = (v4u*)(AS + (size_t)r * DM) + F.lane;
#pragma unroll
            for (int j = 0; j < 4; ++j) dst[64 * j] = (v4u){0u, 0u, 0u, 0u}; } }
}
__device__ __forceinline__ void moe_combine(Frame& F, const float* gtf) {
    const int gw = F.vcu * NWAVES + F.wave, NGW = F.G * NWAVES;
    const int* tk = (const int*)(F.ws + WS_TOK); const float* xa = (const float*)(F.ws + WS_XA); const bf16* YS = (const bf16*)(F.ws + WS_AS);
    for (int m = gw; m < M; m += NGW) {
        const int b = m >> 11, p1 = tk[TOK_POS + 2 * m], p2 = tk[TOK_POS + 2 * m + 1];
        const float w1 = __builtin_bit_cast(float, tk[TOK_W + 2 * m]), w2 = __builtin_bit_cast(float, tk[TOK_W + 2 * m + 1]);
        const f32x4* xr = (const f32x4*)(xa + (size_t)m * DM) + F.lane; const f32x4* gp = (const f32x4*)(gtf + (size_t)b * 12288) + F.lane;
        const v2u* y1 = (const v2u*)(YS + (size_t)p1 * DM) + F.lane; const v2u* y2 = (const v2u*)(YS + (size_t)p2 * DM) + F.lane;
        f32x4* op = (f32x4*)(F.out + (size_t)m * DM) + F.lane;
#pragma unroll
        for (int j = 0; j < 8; ++j) { const f32x4 x = xr[64 * j], g = gp[64 * j]; const v2u a = y1[64 * j], c = y2[64 * j];
            f32x4 y; y.x = w1 * bflo(a.x) + w2 * bflo(c.x); y.y = w1 * bfhi(a.x) + w2 * bfhi(c.x); y.z = w1 * bflo(a.y) + w2 * bflo(c.y); y.w = w1 * bfhi(a.y) + w2 * bfhi(c.y);
            op[64 * j] = x + g * y; }
    }
}

typedef short v4i16_t __attribute__((ext_vector_type(4)));
#define MFMA16(a, b, c) __builtin_amdgcn_mfma_f32_16x16x32_bf16((a), (b), (c), 0, 0, 0)
__device__ __forceinline__ bf16x8 frag_row(const LAS unsigned char* base, int ldb, int r0, int k0, int lane) {
    return *(const LAS bf16x8*)(base + (r0 + (lane & 15)) * ldb + (k0 + 8 * (lane >> 4)) * 2);
}
__device__ __forceinline__ bf16x8 frag_tr2(const LAS unsigned char* base, int ldb, int ra, int rb, int c0, int lane) {
    const int g = lane >> 4, q = (lane & 15) >> 2, p = lane & 3;
    const LAS unsigned char* a0 = base + (ra + 4 * g + q) * ldb + (c0 + 4 * p) * 2;
    const LAS unsigned char* a1 = base + (rb + 4 * g + q) * ldb + (c0 + 4 * p) * 2;
    const v4i16_t lo = __builtin_amdgcn_ds_read_tr16_b64_v4i16((LAS v4i16_t*)a0), hi = __builtin_amdgcn_ds_read_tr16_b64_v4i16((LAS v4i16_t*)a1);
    bf16x8 r; r[0] = lo[0]; r[1] = lo[1]; r[2] = lo[2]; r[3] = lo[3]; r[4] = hi[0]; r[5] = hi[1]; r[6] = hi[2]; r[7] = hi[3]; return r;
}
__device__ __forceinline__ bf16x8 frag_tr(const LAS unsigned char* base, int ldb, int k0, int c0, int lane) {
    const int g = lane >> 4;
    return frag_tr2(base, ldb, k0 + 4 * g, k0 + 4 * g + 4, c0, lane);
}
__device__ __forceinline__ bf16x8 pack8(float a, float b, float c, float d, float e, float f, float g, float h) {
    v4u w; w.x = pk2(a, b); w.y = pk2(c, d); w.z = pk2(e, f); w.w = pk2(g, h); return __builtin_bit_cast(bf16x8, w);
}
__device__ __forceinline__ float scan_add(float v, int lane) {
#pragma unroll
    for (int d = 1; d < 64; d <<= 1) { const float t = __shfl_up(v, d); if (lane >= d) v += t; }
    return v;
}
__device__ __forceinline__ float scan_max(float v, int lane) {
#pragma unroll
    for (int d = 1; d < 64; d <<= 1) { const float t = __shfl_up(v, d); if (lane >= d) v = fmaxf(v, t); }
    return v;
}

__device__ __forceinline__ void swa_unit(Frame& F, int l, int unit) {
    const int b = unit >> 5, kvh = (unit >> 4) & 1, nb = unit & 15;
    const int tid = F.tid, lane = F.lane, w = F.wave, g = lane >> 4, n = lane & 15;
    const bf16* proj = (const bf16*)(F.ws + WS_PROJ); bf16* Y = (bf16*)(F.ws + WS_Y);
    LAS unsigned char* Kt = F.lds + RING_OFF; LAS unsigned char* Vt = Kt + 36864; LAS float* bias = (LAS float*)(Kt + 73728);
    constexpr int LDB = 144;
    __syncthreads();
    {
        const int r = tid >> 1, hf = tid & 1, pos = nb * 128 - 128 + r;
        v4u kx[4], vx[4];
        if (pos >= 0) { const bf16* kp = proj + (size_t)(b * SEQ + pos) * PROJ_LD + C_AK + kvh * 64 + hf * 32; const bf16* vp = proj + (size_t)(b * SEQ + pos) * PROJ_LD + C_AV + kvh * 64 + hf * 32;
#pragma unroll
            for (int j = 0; j < 4; ++j) { kx[j] = *(const v4u*)(kp + 8 * j); vx[j] = *(const v4u*)(vp + 8 * j); } }
        else {
#pragma unroll
            for (int j = 0; j < 4; ++j) { kx[j] = (v4u){0u, 0u, 0u, 0u}; vx[j] = (v4u){0u, 0u, 0u, 0u}; } }
        float kf[32]; float ss = 0.f;
#pragma unroll
        for (int j = 0; j < 4; ++j) { kf[8 * j + 0] = bflo(kx[j].x); kf[8 * j + 1] = bfhi(kx[j].x); kf[8 * j + 2] = bflo(kx[j].y); kf[8 * j + 3] = bfhi(kx[j].y); kf[8 * j + 4] = bflo(kx[j].z); kf[8 * j + 5] = bfhi(kx[j].z); kf[8 * j + 6] = bflo(kx[j].w); kf[8 * j + 7] = bfhi(kx[j].w); }
#pragma unroll
        for (int i = 0; i < 32; ++i) ss += kf[i] * kf[i];
        ss += __shfl_xor(ss, 1);
        const float rstd = 1.0f / sqrtf(ss * (1.0f / 64.0f) + EPS);
        const float* gk = F.in[IN_GKN] + l * 64 + hf * 32;
#pragma unroll
        for (int j = 0; j < 4; ++j) { const f32x4 g0 = *(const f32x4*)(gk + 8 * j), g1 = *(const f32x4*)(gk + 8 * j + 4);
            v4u o; o.x = pk2(kf[8 * j] * rstd * g0.x, kf[8 * j + 1] * rstd * g0.y); o.y = pk2(kf[8 * j + 2] * rstd * g0.z, kf[8 * j + 3] * rstd * g0.w);
            o.z = pk2(kf[8 * j + 4] * rstd * g1.x, kf[8 * j + 5] * rstd * g1.y); o.w = pk2(kf[8 * j + 6] * rstd * g1.z, kf[8 * j + 7] * rstd * g1.w);
            *(LAS v4u*)(Kt + r * LDB + hf * 64 + 16 * j) = o; *(LAS v4u*)(Vt + r * LDB + hf * 64 + 16 * j) = vx[j]; }
    }
    for (int i = tid; i < 1024; i += NWAVES * 64) bias[i] = F.in[IN_RELB][T5_BUCKET[i & 127] * 16 + kvh * 8 + (i >> 7)];
    __syncthreads();
    const int hq = kvh * 8 + w;
    const float sink = F.in[IN_SINKS][l * 16 + hq];
    const float* gq = F.in[IN_GQN] + l * 64;
    const f32x4 gq0 = *(const f32x4*)(gq + 8 * g), gq1 = *(const f32x4*)(gq + 8 * g + 4), gq2 = *(const f32x4*)(gq + 32 + 8 * g), gq3 = *(const f32x4*)(gq + 32 + 8 * g + 4);
    const LAS float* bw = bias + w * 128;
    for (int qb = 0; qb < 4; ++qb) {
        const int j0 = qb * 32;
        bf16x8 qf[2][2];
#pragma unroll
        for (int jt = 0; jt < 2; ++jt) {
            const bf16* qp = proj + (size_t)(b * SEQ + nb * 128 + j0 + jt * 16 + n) * PROJ_LD + C_AQ + hq * 64;
            const v4u x0 = *(const v4u*)(qp + 8 * g), x1 = *(const v4u*)(qp + 32 + 8 * g);
            float f[16] = {bflo(x0.x), bfhi(x0.x), bflo(x0.y), bfhi(x0.y), bflo(x0.z), bfhi(x0.z), bflo(x0.w), bfhi(x0.w), bflo(x1.x), bfhi(x1.x), bflo(x1.y), bfhi(x1.y), bflo(x1.z), bfhi(x1.z), bflo(x1.w), bfhi(x1.w)};
            float ss = 0.f;
#pragma unroll
            for (int i = 0; i < 16; ++i) ss += f[i] * f[i];
            ss += __shfl_xor(ss, 16); ss += __shfl_xor(ss, 32);
            const float rs = 0.125f / sqrtf(ss * (1.0f / 64.0f) + EPS);
            qf[jt][0] = pack8(f[0] * rs * gq0.x, f[1] * rs * gq0.y, f[2] * rs * gq0.z, f[3] * rs * gq0.w, f[4] * rs * gq1.x, f[5] * rs * gq1.y, f[6] * rs * gq1.z, f[7] * rs * gq1.w);
            qf[jt][1] = pack8(f[8] * rs * gq2.x, f[9] * rs * gq2.y, f[10] * rs * gq2.z, f[11] * rs * gq2.w, f[12] * rs * gq3.x, f[13] * rs * gq3.y, f[14] * rs * gq3.z, f[15] * rs * gq3.w);
        }
        f32x4 sc[2][10];
#pragma unroll
        for (int i = 0; i < 10; ++i) { const int kt = 2 * qb + i;
            const bf16x8 k0 = frag_row(Kt, LDB, 16 * kt, 0, lane), k1 = frag_row(Kt, LDB, 16 * kt, 32, lane);
#pragma unroll
            for (int jt = 0; jt < 2; ++jt) { f32x4 a = (f32x4){0.f, 0.f, 0.f, 0.f}; a = MFMA16(k0, qf[jt][0], a); a = MFMA16(k1, qf[jt][1], a); sc[jt][i] = a; } }
        float inv[2];
#pragma unroll
        for (int jt = 0; jt < 2; ++jt) { const int j = j0 + 16 * jt + n; float mx = sink;
#pragma unroll
            for (int i = 0; i < 10; ++i)
#pragma unroll
                for (int r = 0; r < 4; ++r) { const int s = 16 * (2 * qb + i) + 4 * g + r, dist = j + 128 - s; const bool ok = (dist >= 0) && (dist < 128) && (nb > 0 || s >= 128);
                    const float v = ok ? sc[jt][i][r] + bw[dist & 127] : -INFINITY; sc[jt][i][r] = v; mx = fmaxf(mx, v); }
            mx = fmaxf(mx, __shfl_xor(mx, 16)); mx = fmaxf(mx, __shfl_xor(mx, 32));
            float sum = 0.f;
#pragma unroll
            for (int i = 0; i < 10; ++i)
#pragma unroll
                for (int r = 0; r < 4; ++r) { const float p = __expf(sc[jt][i][r] - mx); sc[jt][i][r] = p; sum += p; }
            sum += __shfl_xor(sum, 16); sum += __shfl_xor(sum, 32);
            inv[jt] = 1.0f / (sum + __expf(sink - mx)); }
        f32x4 o[4][2];
#pragma unroll
        for (int dt = 0; dt < 4; ++dt) { o[dt][0] = (f32x4){0.f, 0.f, 0.f, 0.f}; o[dt][1] = (f32x4){0.f, 0.f, 0.f, 0.f}; }
#pragma unroll
        for (int kk = 0; kk < 5; ++kk) { bf16x8 pf[2];
#pragma unroll
            for (int jt = 0; jt < 2; ++jt) pf[jt] = pack8(sc[jt][2 * kk][0], sc[jt][2 * kk][1], sc[jt][2 * kk][2], sc[jt][2 * kk][3], sc[jt][2 * kk + 1][0], sc[jt][2 * kk + 1][1], sc[jt][2 * kk + 1][2], sc[jt][2 * kk + 1][3]);
            const int ra = 16 * (2 * qb + 2 * kk);
#pragma unroll
            for (int dt = 0; dt < 4; ++dt) { const bf16x8 a = frag_tr2(Vt, LDB, ra, ra + 16, 16 * dt, lane);
                o[dt][0] = MFMA16(a, pf[0], o[dt][0]); o[dt][1] = MFMA16(a, pf[1], o[dt][1]); } }
#pragma unroll
        for (int jt = 0; jt < 2; ++jt) { bf16* yp = Y + (size_t)(b * SEQ + nb * 128 + j0 + 16 * jt + n) * DM + 1024 + hq * 64 + 4 * g;
#pragma unroll
            for (int dt = 0; dt < 4; ++dt) { v2u wv; wv.x = pk2(o[dt][jt][0] * inv[jt], o[dt][jt][1] * inv[jt]); wv.y = pk2(o[dt][jt][2] * inv[jt], o[dt][jt][3] * inv[jt]); *(v2u*)(yp + 16 * dt) = wv; } }
    }
}

__device__ __forceinline__ void gla_u_unit(Frame& F, int l, int u) {
    const int b = u >> 7, h = (u >> 5) & 3, c = u & 31, t0 = b * SEQ + 64 * c;
    const int tid = F.tid, lane = F.lane, w = F.wave, g = lane >> 4, n = lane & 15;
    const bf16* proj = (const bf16*)(F.ws + WS_PROJ); const float* side = (const float*)(F.ws + WS_SIDE);
    bf16* QT = (bf16*)(F.ws + WS_GAUX); bf16* QP = QT + (size_t)M * 256; bf16* KT = QP + (size_t)M * 256; float* BL = (float*)(KT + (size_t)M * 256); float* UG = (float*)(F.ws + WS_UG);
    LAS float* LAm = (LAS float*)(F.lds + RING_OFF);
    LAS unsigned char* KP = F.lds + RING_OFF + 16640;
    LAS unsigned char* VT = F.lds + RING_OFF + 25856;
    __syncthreads();
    const int s = tid >> 3, kg = tid & 7;
    {
        const float* wd = F.in[IN_WDEC] + l * 16 * 256 + h * 64 + 8 * kg; const float* bd = F.in[IN_BDEC] + l * 256 + h * 64 + 8 * kg;
        f32x4 z0 = *(const f32x4*)(bd), z1 = *(const f32x4*)(bd + 4);
        const f32x4* gp = (const f32x4*)(side + (size_t)(t0 + s) * 32 + 8);
        const f32x4 g0 = gp[0], g1 = gp[1], g2 = gp[2], g3 = gp[3];
        const float ga[16] = {g0.x, g0.y, g0.z, g0.w, g1.x, g1.y, g1.z, g1.w, g2.x, g2.y, g2.z, g2.w, g3.x, g3.y, g3.z, g3.w};
#pragma unroll
        for (int r = 0; r < 16; ++r) { z0 += *(const f32x4*)(wd + r * 256) * ga[r]; z1 += *(const f32x4*)(wd + r * 256 + 4) * ga[r]; }
        LAS float* lp = LAm + s * 65 + 8 * kg;
        lp[0] = logsigmoidf_(z0.x) * 0.0625f; lp[1] = logsigmoidf_(z0.y) * 0.0625f; lp[2] = logsigmoidf_(z0.z) * 0.0625f; lp[3] = logsigmoidf_(z0.w) * 0.0625f;
        lp[4] = logsigmoidf_(z1.x) * 0.0625f; lp[5] = logsigmoidf_(z1.y) * 0.0625f; lp[6] = logsigmoidf_(z1.z) * 0.0625f; lp[7] = logsigmoidf_(z1.w) * 0.0625f;
        const bf16* vp = proj + (size_t)(t0 + s) * PROJ_LD + C_GV + h * 128 + 16 * kg;
        *(LAS v4u*)(VT + s * 272 + 32 * kg) = *(const v4u*)(vp); *(LAS v4u*)(VT + s * 272 + 32 * kg + 16) = *(const v4u*)(vp + 8);
    }
    __syncthreads();
#pragma unroll
    for (int ci = 0; ci < 8; ++ci) { const int k = 8 * w + ci; const float v = scan_add(LAm[lane * 65 + k], lane); LAm[lane * 65 + k] = v; }
    __syncthreads();
    {
        const bf16* kp = proj + (size_t)(t0 + s) * PROJ_LD + C_GK + h * 64 + 8 * kg; const bf16* qp = proj + (size_t)(t0 + s) * PROJ_LD + C_GQ + h * 64 + 8 * kg;
        const v4u kx = *(const v4u*)kp, qx = *(const v4u*)qp;
        const float kf[8] = {bflo(kx.x), bfhi(kx.x), bflo(kx.y), bfhi(kx.y), bflo(kx.z), bfhi(kx.z), bflo(kx.w), bfhi(kx.w)};
        const float qf[8] = {bflo(qx.x), bfhi(qx.x), bflo(qx.y), bfhi(qx.y), bflo(qx.z), bfhi(qx.z), bflo(qx.w), bfhi(qx.w)};
        float o1[8], o2[8], o3[8], o4[8];
#pragma unroll
        for (int i = 0; i < 8; ++i) { const float bb = LAm[s * 65 + 8 * kg + i], bl = LAm[63 * 65 + 8 * kg + i], br = LAm[31 * 65 + 8 * kg + i];
            o1[i] = kf[i] * __expf(bl - bb); o2[i] = qf[i] * 0.125f * __expf(bb - br); o3[i] = qf[i] * 0.125f * __expf(bb); o4[i] = kf[i] * __expf(br - bb);
            if (s == 63) BL[(size_t)u * 64 + 8 * kg + i] = bl; }
        v4u o; o.x = pk2(o1[0], o1[1]); o.y = pk2(o1[2], o1[3]); o.z = pk2(o1[4], o1[5]); o.w = pk2(o1[6], o1[7]); *(LAS v4u*)(KP + s * 144 + 16 * kg) = o;
        const size_t go = (size_t)(t0 + s) * 256 + h * 64 + 8 * kg;
        o.x = pk2(o2[0], o2[1]); o.y = pk2(o2[2], o2[3]); o.z = pk2(o2[4], o2[5]); o.w = pk2(o2[6], o2[7]); *(v4u*)(QT + go) = o;
        o.x = pk2(o3[0], o3[1]); o.y = pk2(o3[2], o3[3]); o.z = pk2(o3[4], o3[5]); o.w = pk2(o3[6], o3[7]); *(v4u*)(QP + go) = o;
        o.x = pk2(o4[0], o4[1]); o.y = pk2(o4[2], o4[3]); o.z = pk2(o4[4], o4[5]); o.w = pk2(o4[6], o4[7]); *(v4u*)(KT + go) = o;
    }
    __syncthreads();
    {
        f32x4 acc[4];
#pragma unroll
        for (int mt = 0; mt < 4; ++mt) acc[mt] = (f32x4){0.f, 0.f, 0.f, 0.f};
#pragma unroll
        for (int ks = 0; ks < 2; ++ks) { const bf16x8 bv = frag_tr(VT, 272, 32 * ks, 16 * w, lane);
#pragma unroll
            for (int mt = 0; mt < 4; ++mt) { const bf16x8 a = frag_tr(KP, 144, 32 * ks, 16 * mt, lane); acc[mt] = MFMA16(a, bv, acc[mt]); } }
        float* up = UG + (size_t)u * 64 * 128 + 16 * w + n;
#pragma unroll
        for (int mt = 0; mt < 4; ++mt)
#pragma unroll
            for (int r = 0; r < 4; ++r) up[(size_t)(16 * mt + 4 * g + r) * 128] = acc[mt][r];
    }
}
__device__ __forceinline__ void gla_out_group(Frame& F, int l, int ug) {
    const int bh = ug >> 3, jj = ug & 7, b = bh >> 2, h = bh & 3;
    const int tid = F.tid, lane = F.lane, w = F.wave, g = lane >> 4, n = lane & 15;
    const bf16* proj = (const bf16*)(F.ws + WS_PROJ); bf16* Y = (bf16*)(F.ws + WS_Y);
    const bf16* QT = (const bf16*)(F.ws + WS_GAUX); const bf16* QP = QT + (size_t)M * 256; const bf16* KT = QP + (size_t)M * 256; const float* BL = (const float*)(KT + (size_t)M * 256); const float* UG = (const float*)(F.ws + WS_UG);
    LAS unsigned char* LQT = F.lds + RING_OFF; LAS unsigned char* LQP = LQT + 9216; LAS unsigned char* LKT = LQT + 18432; LAS unsigned char* VT = LQT + 27648; LAS unsigned char* ST = LQT + 45056;
    LAS float* SS = (LAS float*)(LQT + 62464);
    float S[16];
#pragma unroll
    for (int i = 0; i < 16; ++i) S[i] = 0.f;
    const int sk = tid >> 3, sv = (tid & 7) * 16;
    int cdone = 0;
    const float* gout = F.in[IN_GOUTG] + l * 512 + h * 128;
    for (int oi = 0; oi < 4; ++oi) {
        const int c = oi == 0 ? jj : (oi == 1 ? 15 - jj : (oi == 2 ? 16 + jj : 31 - jj));
        for (; cdone < c; ++cdone) { const int uu = bh * 32 + cdone; const float dec = __expf(BL[(size_t)uu * 64 + sk]);
            const f32x4* up = (const f32x4*)(UG + (size_t)uu * 64 * 128 + sk * 128 + sv);
#pragma unroll
            for (int q = 0; q < 4; ++q) { const f32x4 x = up[q]; S[4 * q] = dec * S[4 * q] + x.x; S[4 * q + 1] = dec * S[4 * q + 1] + x.y; S[4 * q + 2] = dec * S[4 * q + 2] + x.z; S[4 * q + 3] = dec * S[4 * q + 3] + x.w; } }
        const int t0 = b * SEQ + 64 * c;
        __syncthreads();
        {
            v4u o; o.x = pk2(S[0], S[1]); o.y = pk2(S[2], S[3]); o.z = pk2(S[4], S[5]); o.w = pk2(S[6], S[7]); *(LAS v4u*)(ST + sk * 272 + sv * 2) = o;
            o.x = pk2(S[8], S[9]); o.y = pk2(S[10], S[11]); o.z = pk2(S[12], S[13]); o.w = pk2(S[14], S[15]); *(LAS v4u*)(ST + sk * 272 + sv * 2 + 16) = o;
            const int s = tid >> 3, kg = tid & 7; const size_t go = (size_t)(t0 + s) * 256 + h * 64 + 8 * kg;
            *(LAS v4u*)(LQT + s * 144 + 16 * kg) = *(const v4u*)(QT + go); *(LAS v4u*)(LQP + s * 144 + 16 * kg) = *(const v4u*)(QP + go); *(LAS v4u*)(LKT + s * 144 + 16 * kg) = *(const v4u*)(KT + go);
            const bf16* vp = proj + (size_t)(t0 + s) * PROJ_LD + C_GV + h * 128 + 16 * kg;
            *(LAS v4u*)(VT + s * 272 + 32 * kg) = *(const v4u*)(vp); *(LAS v4u*)(VT + s * 272 + 32 * kg + 16) = *(const v4u*)(vp + 8);
        }
        __syncthreads();
        const int jt = w & 3, vh = w >> 2;
        bf16x8 qf[2], qpf[2];
#pragma unroll
        for (int ks = 0; ks < 2; ++ks) { qf[ks] = frag_row(LQT, 144, 16 * jt, 32 * ks, lane); qpf[ks] = frag_row(LQP, 144, 16 * jt, 32 * ks, lane); }
        f32x4 at[4];
#pragma unroll
        for (int st = 0; st < 4; ++st) { at[st] = (f32x4){0.f, 0.f, 0.f, 0.f};
            if (st <= jt) {
#pragma unroll
                for (int ks = 0; ks < 2; ++ks) at[st] = MFMA16(frag_row(LKT, 144, 16 * st, 32 * ks, lane), qf[ks], at[st]);
                if (st == jt) {
#pragma unroll
                    for (int r = 0; r < 4; ++r) if (4 * g + r > n) at[st][r] = 0.f; } } }
        f32x4 o[4];
#pragma unroll
        for (int mt = 0; mt < 4; ++mt) { o[mt] = (f32x4){0.f, 0.f, 0.f, 0.f};
#pragma unroll
            for (int ks = 0; ks < 2; ++ks) o[mt] = MFMA16(frag_tr(ST, 272, 32 * ks, 64 * vh + 16 * mt, lane), qpf[ks], o[mt]); }
#pragma unroll
        for (int kk = 0; kk < 2; ++kk) { if (2 * kk <= jt) {
            const bf16x8 pf = pack8(at[2 * kk][0], at[2 * kk][1], at[2 * kk][2], at[2 * kk][3], at[2 * kk + 1][0], at[2 * kk + 1][1], at[2 * kk + 1][2], at[2 * kk + 1][3]);
#pragma unroll
            for (int mt = 0; mt < 4; ++mt) o[mt] = MFMA16(frag_tr2(VT, 272, 32 * kk, 32 * kk + 16, 64 * vh + 16 * mt, lane), pf, o[mt]); } }
        float ss = 0.f;
#pragma unroll
        for (int mt = 0; mt < 4; ++mt)
#pragma unroll
            for (int r = 0; r < 4; ++r) ss += o[mt][r] * o[mt][r];
        ss += __shfl_xor(ss, 16); ss += __shfl_xor(ss, 32);
        if (g == 0) SS[w * 16 + n] = ss;
        __syncthreads();
        const float rstd = 1.0f / sqrtf((SS[w * 16 + n] + SS[(w ^ 4) * 16 + n]) * (1.0f / 128.0f) + EPS);
        const size_t row = (size_t)(t0 + 16 * jt + n);
#pragma unroll
        for (int mt = 0; mt < 4; ++mt) { const int v = 64 * vh + 16 * mt + 4 * g;
            const f32x4 go4 = *(const f32x4*)(gout + v); const v2u gx = *(const v2u*)(proj + row * PROJ_LD + C_GG + h * 128 + v);
            v2u wv; wv.x = pk2(o[mt][0] * rstd * go4.x * siluf_(bflo(gx.x)), o[mt][1] * rstd * go4.y * siluf_(bfhi(gx.x))); wv.y = pk2(o[mt][2] * rstd * go4.z * siluf_(bflo(gx.y)), o[mt][3] * rstd * go4.w * siluf_(bfhi(gx.y)));
            *(v2u*)(Y + row * DM + 512 + h * 128 + v) = wv; }
    }
}

__device__ __forceinline__ void mlstm_u_unit(Frame& F, int l, int u) {
    const int b = u >> 6, h = (u >> 4) & 3, c = u & 15, t0 = b * SEQ + 128 * c;
    const int tid = F.tid, lane = F.lane, w = F.wave, g = lane >> 4, n = lane & 15;
    const bf16* proj = (const bf16*)(F.ws + WS_PROJ); const float* side = (const float*)(F.ws + WS_SIDE); bf16* qkc = (bf16*)(F.ws + WS_QKC);
    float* UM = (float*)(F.ws + WS_UM); float* MS = UM + (size_t)512 * 136 * 64;
    LAS unsigned char* KP = F.lds + RING_OFF;
    LAS unsigned char* VT = F.lds + RING_OFF + 18432;
    LAS float* GF = (LAS float*)(F.lds + RING_OFF + 53248);
    __syncthreads();
    const int s = tid >> 2, qd = tid & 3;
    float kc[16];
    {
        const float* wc = F.in[IN_WCONV] + l * 4 * 512; const float* bc = F.in[IN_BCONV] + l * 512;
        const int pos = 128 * c + s;
#pragma unroll
        for (int part = 0; part < 2; ++part) { const int ch = part * 256 + h * 64 + 16 * qd; float y[16];
#pragma unroll
            for (int q4 = 0; q4 < 4; ++q4) { const f32x4 bb = *(const f32x4*)(bc + ch + 4 * q4); y[4 * q4] = bb.x; y[4 * q4 + 1] = bb.y; y[4 * q4 + 2] = bb.z; y[4 * q4 + 3] = bb.w; }
#pragma unroll
            for (int i = 0; i < 4; ++i) { if (pos - 3 + i >= 0) { const bf16* xp = proj + (size_t)(t0 + s - 3 + i) * PROJ_LD + ch; const v4u x0 = *(const v4u*)xp, x1 = *(const v4u*)(xp + 8);
                const float xf[16] = {bflo(x0.x), bfhi(x0.x), bflo(x0.y), bfhi(x0.y), bflo(x0.z), bfhi(x0.z), bflo(x0.w), bfhi(x0.w), bflo(x1.x), bfhi(x1.x), bflo(x1.y), bfhi(x1.y), bflo(x1.z), bfhi(x1.z), bflo(x1.w), bfhi(x1.w)};
#pragma unroll
                for (int q4 = 0; q4 < 4; ++q4) { const f32x4 ww = *(const f32x4*)(wc + i * 512 + ch + 4 * q4); y[4 * q4] += ww.x * xf[4 * q4]; y[4 * q4 + 1] += ww.y * xf[4 * q4 + 1]; y[4 * q4 + 2] += ww.z * xf[4 * q4 + 2]; y[4 * q4 + 3] += ww.w * xf[4 * q4 + 3]; } } }
            const float scl = part ? 0.125f : 1.0f;
#pragma unroll
            for (int i = 0; i < 16; ++i) y[i] = siluf_(y[i]) * scl;
            v4u o0, o1; o0.x = pk2(y[0], y[1]); o0.y = pk2(y[2], y[3]); o0.z = pk2(y[4], y[5]); o0.w = pk2(y[6], y[7]); o1.x = pk2(y[8], y[9]); o1.y = pk2(y[10], y[11]); o1.z = pk2(y[12], y[13]); o1.w = pk2(y[14], y[15]);
            *(v4u*)(qkc + (size_t)(t0 + s) * 512 + ch) = o0; *(v4u*)(qkc + (size_t)(t0 + s) * 512 + ch + 8) = o1;
            if (part) {
#pragma unroll
                for (int i = 0; i < 16; ++i) kc[i] = y[i]; } }
        const bf16* vp = proj + (size_t)(t0 + s) * PROJ_LD + C_MV + h * 128 + 32 * qd;
#pragma unroll
        for (int j = 0; j < 4; ++j) *(LAS v4u*)(VT + s * 272 + 64 * qd + 16 * j) = *(const v4u*)(vp + 8 * j);
        if (tid < 128) { GF[tid] = logsigmoidf_(side[(size_t)(t0 + tid) * 32 + 4 + h] + F.in[IN_BGATES][l * 8 + 4 + h]); GF[128 + tid] = side[(size_t)(t0 + tid) * 32 + h] + F.in[IN_BGATES][l * 8 + h]; }
    }
    __syncthreads();
    if (w == 0) {
        const float a0 = GF[2 * lane], a1 = GF[2 * lane + 1]; const float P = scan_add(a0 + a1, lane);
        const float blast = __shfl(P, 63);
        const float lw0 = blast - (P - a1) + GF[128 + 2 * lane], lw1 = blast - P + GF[128 + 2 * lane + 1];
        float mx = fmaxf(lw0, lw1);
#pragma unroll
        for (int o = 1; o < 64; o <<= 1) mx = fmaxf(mx, __shfl_xor(mx, o));
        GF[256 + 2 * lane] = expf(lw0 - mx); GF[256 + 2 * lane + 1] = expf(lw1 - mx);
        if (lane == 0) { MS[(size_t)u * 2] = blast; MS[(size_t)u * 2 + 1] = mx; }
    }
    __syncthreads();
    {   const float wg = GF[256 + s];
        v4u o0, o1; o0.x = pk2(kc[0] * wg, kc[1] * wg); o0.y = pk2(kc[2] * wg, kc[3] * wg); o0.z = pk2(kc[4] * wg, kc[5] * wg); o0.w = pk2(kc[6] * wg, kc[7] * wg);
        o1.x = pk2(kc[8] * wg, kc[9] * wg); o1.y = pk2(kc[10] * wg, kc[11] * wg); o1.z = pk2(kc[12] * wg, kc[13] * wg); o1.w = pk2(kc[14] * wg, kc[15] * wg);
        *(LAS v4u*)(KP + s * 144 + 32 * qd) = o0; *(LAS v4u*)(KP + s * 144 + 32 * qd + 16) = o1; }
    __syncthreads();
    {
        const int nt = w & 3, m0 = w >> 2;
        f32x4 acc[5];
#pragma unroll
        for (int i = 0; i < 5; ++i) acc[i] = (f32x4){0.f, 0.f, 0.f, 0.f};
        const bf16x8 ones = (n == 0) ? pack8(1.f, 1.f, 1.f, 1.f, 1.f, 1.f, 1.f, 1.f) : pack8(0.f, 0.f, 0.f, 0.f, 0.f, 0.f, 0.f, 0.f);
#pragma unroll
        for (int ks = 0; ks < 4; ++ks) { const bf16x8 bv = frag_tr(KP, 144, 32 * ks, 16 * nt, lane);
#pragma unroll
            for (int i = 0; i < 4; ++i) acc[i] = MFMA16(frag_tr(VT, 272, 32 * ks, 16 * (m0 + 2 * i), lane), bv, acc[i]);
            if (m0 == 0) acc[4] = MFMA16(ones, bv, acc[4]); }
        float* up = UM + (size_t)u * 136 * 64 + 16 * nt + n;
#pragma unroll
        for (int i = 0; i < 4; ++i)
#pragma unroll
            for (int r = 0; r < 4; ++r) up[(size_t)(16 * (m0 + 2 * i) + 4 * g + r) * 64] = acc[i][r];
        if (m0 == 0 && g == 0) up[(size_t)128 * 64] = acc[4][0];
    }
}
__device__ __forceinline__ void mlstm_out_group(Frame& F, int l, int ug) {
    const int bh = ug >> 3, jj = ug & 7, b = bh >> 2, h = bh & 3;
    const int tid = F.tid, lane = F.lane, w = F.wave, g = lane >> 4, n = lane & 15;
    const bf16* proj = (const bf16*)(F.ws + WS_PROJ); const float* side = (const float*)(F.ws + WS_SIDE); const bf16* qkc = (const bf16*)(F.ws + WS_QKC); bf16* Y = (bf16*)(F.ws + WS_Y);
    const float* UM = (const float*)(F.ws + WS_UM); const float* MS = UM + (size_t)512 * 136 * 64;
    LAS unsigned char* QC = F.lds + RING_OFF; LAS unsigned char* KC = QC + 18432; LAS unsigned char* VT = QC + 36864; LAS unsigned char* CS = QC + 71680;
    LAS float* GF = (LAS float*)(QC + 92416);
    float C[16], nn = 0.f, mst = 0.f;
#pragma unroll
    for (int i = 0; i < 16; ++i) C[i] = 0.f;
    const int cv = tid >> 2, ck = (tid & 3) * 16;
    int cdone = 0;
    const float* gout = F.in[IN_GOUTM] + l * 512 + h * 128;
    for (int oi = 0; oi < 2; ++oi) {
        const int c = oi == 0 ? jj : 15 - jj;
        for (; cdone < c; ++cdone) { const int uu = bh * 16 + cdone; const float Bc = MS[(size_t)uu * 2], ml = MS[(size_t)uu * 2 + 1];
            const float mn = fmaxf(Bc + mst, ml), d1 = expf(Bc + mst - mn), d2 = expf(ml - mn); mst = mn;
            const f32x4* up = (const f32x4*)(UM + (size_t)uu * 136 * 64 + cv * 64 + ck);
#pragma unroll
            for (int q = 0; q < 4; ++q) { const f32x4 x = up[q]; C[4 * q] = d1 * C[4 * q] + d2 * x.x; C[4 * q + 1] = d1 * C[4 * q + 1] + d2 * x.y; C[4 * q + 2] = d1 * C[4 * q + 2] + d2 * x.z; C[4 * q + 3] = d1 * C[4 * q + 3] + d2 * x.w; }
            if (tid < 64) nn = d1 * nn + d2 * UM[(size_t)uu * 136 * 64 + 128 * 64 + tid]; }
        const int t0 = b * SEQ + 128 * c;
        __syncthreads();
        {
            v4u o; o.x = pk2(C[0], C[1]); o.y = pk2(C[2], C[3]); o.z = pk2(C[4], C[5]); o.w = pk2(C[6], C[7]); *(LAS v4u*)(CS + cv * 144 + ck * 2) = o;
            o.x = pk2(C[8], C[9]); o.y = pk2(C[10], C[11]); o.z = pk2(C[12], C[13]); o.w = pk2(C[14], C[15]); *(LAS v4u*)(CS + cv * 144 + ck * 2 + 16) = o;
            if (tid < 64) *(LAS bf16*)(CS + 128 * 144 + tid * 2) = (bf16)f2bf(nn);
            for (int i = tid; i < 15 * 72; i += NWAVES * 64) *(LAS bf16*)(CS + 129 * 144 + i * 2) = (bf16)0;
            const int s = tid >> 2, qd = tid & 3;
            const bf16* qp = qkc + (size_t)(t0 + s) * 512 + h * 64 + 16 * qd;
            *(LAS v4u*)(QC + s * 144 + 32 * qd) = *(const v4u*)qp; *(LAS v4u*)(QC + s * 144 + 32 * qd + 16) = *(const v4u*)(qp + 8);
            *(LAS v4u*)(KC + s * 144 + 32 * qd) = *(const v4u*)(qp + 256); *(LAS v4u*)(KC + s * 144 + 32 * qd + 16) = *(const v4u*)(qp + 256 + 8);
            const bf16* vp = proj + (size_t)(t0 + s) * PROJ_LD + C_MV + h * 128 + 32 * qd;
#pragma unroll
            for (int j = 0; j < 4; ++j) *(LAS v4u*)(VT + s * 272 + 64 * qd + 16 * j) = *(const v4u*)(vp + 8 * j);
            if (tid < 128) { GF[tid] = logsigmoidf_(side[(size_t)(t0 + tid) * 32 + 4 + h] + F.in[IN_BGATES][l * 8 + 4 + h]); GF[128 + tid] = side[(size_t)(t0 + tid) * 32 + h] + F.in[IN_BGATES][l * 8 + h]; }
        }
        __syncthreads();
        if (w == 0) {
            const float a0 = GF[2 * lane], a1 = GF[2 * lane + 1]; const float P = scan_add(a0 + a1, lane);
            const float b0 = P - a1, b1 = P; const float x0 = GF[128 + 2 * lane] - b0, x1 = GF[128 + 2 * lane + 1] - b1;
            const float cm = scan_max(fmaxf(x0, x1), lane);
            float prev = __shfl_up(cm, 1); if (lane == 0) prev = -INFINITY;
            const float M0 = fmaxf(mst, fmaxf(prev, x0)), M1 = fmaxf(mst, cm);
            GF[2 * lane] = x0; GF[2 * lane + 1] = x1; GF[128 + 2 * lane] = M0; GF[128 + 2 * lane + 1] = M1; GF[256 + 2 * lane] = b0; GF[256 + 2 * lane + 1] = b1;
        }
        __syncthreads();
        {
            const int j = 16 * w + n; const float Mj = GF[128 + j], bj = GF[256 + j];
            bf16x8 qf[2];
#pragma unroll
            for (int ks = 0; ks < 2; ++ks) qf[ks] = frag_row(QC, 144, 16 * w, 32 * ks, lane);
            f32x4 p[8];
#pragma unroll
            for (int st = 0; st < 8; ++st) { p[st] = (f32x4){0.f, 0.f, 0.f, 0.f};
                if (st <= w) {
#pragma unroll
                    for (int ks = 0; ks < 2; ++ks) p[st] = MFMA16(frag_row(KC, 144, 16 * st, 32 * ks, lane), qf[ks], p[st]);
                    const f32x4 as = *(const LAS f32x4*)(GF + 16 * st + 4 * g);
#pragma unroll
                    for (int r = 0; r < 4; ++r) { const float e = __expf(as[r] - Mj); p[st][r] = (st < w || 4 * g + r <= n) ? p[st][r] * e : 0.f; } } }
            f32x4 o[9];
            const float wi = __expf(mst - Mj);
#pragma unroll
            for (int mt = 0; mt < 9; ++mt) { o[mt] = (f32x4){0.f, 0.f, 0.f, 0.f};
#pragma unroll
                for (int ks = 0; ks < 2; ++ks) o[mt] = MFMA16(frag_row(CS, 144, 16 * mt, 32 * ks, lane), qf[ks], o[mt]);
                o[mt] = o[mt] * wi; }
            const bf16x8 ones = (n == 0) ? pack8(1.f, 1.f, 1.f, 1.f, 1.f, 1.f, 1.f, 1.f) : pack8(0.f, 0.f, 0.f, 0.f, 0.f, 0.f, 0.f, 0.f);
#pragma unroll
            for (int kk = 0; kk < 4; ++kk) { if (2 * kk <= w) {
                const bf16x8 pf = pack8(p[2 * kk][0], p[2 * kk][1], p[2 * kk][2], p[2 * kk][3], p[2 * kk + 1][0], p[2 * kk + 1][1], p[2 * kk + 1][2], p[2 * kk + 1][3]);
#pragma unroll
                for (int mt = 0; mt < 8; ++mt) o[mt] = MFMA16(frag_tr2(VT, 272, 32 * kk, 32 * kk + 16, 16 * mt, lane), pf, o[mt]);
                o[8] = MFMA16(ones, pf, o[8]); } }
            const float den = __shfl(o[8][0], n);
            const float dn = 1.0f / fmaxf(fabsf(den), __expf(-(bj + Mj)));
            float ss = 0.f;
#pragma unroll
            for (int mt = 0; mt < 8; ++mt)
#pragma unroll
                for (int r = 0; r < 4; ++r) { o[mt][r] *= dn; ss += o[mt][r] * o[mt][r]; }
            ss += __shfl_xor(ss, 16); ss += __shfl_xor(ss, 32);
            const float rstd = 1.0f / sqrtf(ss * (1.0f / 128.0f) + EPS);
            const size_t row = (size_t)(t0 + j);
#pragma unroll
            for (int mt = 0; mt < 8; ++mt) { const int v = 16 * mt + 4 * g;
                const f32x4 go4 = *(const f32x4*)(gout + v); const v2u mx = *(const v2u*)(proj + row * PROJ_LD + C_MO + h * 128 + v);
                v2u wv; wv.x = pk2(o[mt][0] * rstd * go4.x * sigmoidf_(bflo(mx.x)), o[mt][1] * rstd * go4.y * sigmoidf_(bfhi(mx.x))); wv.y = pk2(o[mt][2] * rstd * go4.z * sigmoidf_(bflo(mx.y)), o[mt][3] * rstd * go4.w * sigmoidf_(bfhi(mx.y)));
                *(v2u*)(Y + row * DM + h * 128 + v) = wv; }
        }
    }
}

__device__ __forceinline__ void mix_a(Frame& F, int l) {
    if (!(FAST_GLA && FAST_MLSTM && FAST_SWA)) mix_prep(F, l);
    if (FAST_SWA) for (int u = F.vcu; u < 256; u += F.G) swa_unit(F, l, u);
    if (FAST_MLSTM) for (int u = F.vcu; u < 512; u += F.G) mlstm_u_unit(F, l, u);
    if (FAST_GLA) for (int u = F.vcu; u < 1024; u += F.G) gla_u_unit(F, l, u);
}
__device__ __forceinline__ void mix_b(Frame& F, int l) {
    if (!(FAST_GLA && FAST_MLSTM && FAST_SWA)) mix_naive(F, l);
    if (FAST_MLSTM) for (int ug = F.vcu; ug < 256; ug += F.G) mlstm_out_group(F, l, ug);
    if (FAST_GLA) for (int ug = F.vcu; ug < 256; ug += F.G) gla_out_group(F, l, ug);
}

#ifndef MK_ONE_LAUNCH
#define MK_ONE_LAUNCH 1
#endif
constexpr int NPH = 19;
struct Args { const float* in[26]; float* out; unsigned char* ws; int ph_lo, ph_hi; };
__global__ void __launch_bounds__(NWAVES * 64, 2) hybrid_fwd(Args args) {
    extern __shared__ __attribute__((aligned(16))) unsigned char lds[];
    Frame F;
    F.lds = (LAS unsigned char*)lds;
    F.tid = threadIdx.x; F.lane = F.tid & 63; F.wave = __builtin_amdgcn_readfirstlane(F.tid >> 6);
    F.G = gridDim.x; { const int bx = blockIdx.x; F.vcu = (F.G % 8 == 0) ? (bx % 8) * (F.G / 8) + bx / 8 : bx; }
    F.ws = args.ws; F.out = args.out; F.ctl = (gu32*)(args.ws + WS_CTL);
    F.in = (cfp_k*)__builtin_amdgcn_kernarg_segment_ptr();
    for (int u = F.tid; u < (LDS_BYTES - MISC_OFF) / 4; u += NWAVES * 64) ((LAS unsigned*)(F.lds + MISC_OFF))[u] = 0u;
    __syncthreads();
    const int lo = args.ph_lo, hi = args.ph_hi;
    XcdBarrier bar; bar.bar = (unsigned*)(F.ctl + CW_BAR); bar.x = 0; bar.st = nullptr;
    if (hi - lo > 1) bar = xcd_barrier_post((unsigned*)(F.ctl + CW_BAR), (volatile LAS unsigned*)(F.lds + MISC_OFF));
#define IN(k) (lo <= (k) && (k) < hi)
#define SEAM(k) do { if (IN(k) && IN((k) + 1)) xcd_barrier(bar); } while (0)
    bf16* const XN = (bf16*)(F.ws + WS_XN); bf16* const Yb = (bf16*)(F.ws + WS_Y); float* const XA = (float*)(F.ws + WS_XA);
    bf16* const PROJ = (bf16*)(F.ws + WS_PROJ); float* const SIDE = (float*)(F.ws + WS_SIDE); bf16* const HID = (bf16*)(F.ws + WS_HID); bf16* const AS = (bf16*)(F.ws + WS_AS);
    const float* const MOD = (const float*)(F.ws + WS_MOD);

    if (IN(0)) p0_prologue(F);
    SEAM(0);
#define LAYER_MIX(l) do { \
        const int pb = 1 + 8 * (l); \
        const float* modl = MOD + (size_t)(l) * 8 * 12288; \
        const float* xin = (l) == 0 ? F.in[IN_X] : (const float*)F.out; \
        if (IN(pb)) norm_phase<false>(F, xin, F.in[IN_GMIX] + (l) * DM, modl, 0, 2048); \
        SEAM(pb); \
        if (IN(pb + 1)) { \
            pg8::Gemm g{XN, (const bf16*)(F.ws + WS_WIN) + (size_t)(l) * NPROJ * DM, M, NPROJ, DM}; pg8::StaticOrder S; S.init(M, NPROJ, F.G, (int)blockIdx.x); \
            pg8::EpiProj E{PROJ, SIDE}; \
            pg8::gemm_phase<pg8::EpiProj, pg8::StaticOrder, true, true>(F.lds + RING_OFF, g, S, E); \
        } \
        SEAM(pb + 1); \
        if (IN(pb + 2)) mix_a(F, (l)); \
        SEAM(pb + 2); \
        if (IN(pb + 3)) mix_b(F, (l)); \
        SEAM(pb + 3); \
        if (IN(pb + 4)) { \
            pg8::Gemm g{Yb, (const bf16*)(F.ws + WS_WOUT) + (size_t)(l) * DM * DM, M, DM, DM}; pg8::StaticOrder S; S.init(M, DM, F.G, (int)blockIdx.x); \
            pg8::EpiResid E{xin, XA, modl + 4096}; \
            pg8::gemm_phase<pg8::EpiResid, pg8::StaticOrder, true, true>(F.lds + RING_OFF, g, S, E); \
        } \
        SEAM(pb + 4); \
    } while (0)
    LAYER_MIX(0);
    {
        const float* modl = MOD;
        if (IN(6)) norm_phase<false>(F, XA, F.in[IN_GFFN], modl, 6144, 8192);
        SEAM(6);
        if (IN(7)) {
            pg8::Gemm g{XN, (const bf16*)(F.ws + WS_WGU0), M, 2 * DFF, DM}; pg8::StaticOrder S; S.init(M, 2 * DFF, F.G, (int)blockIdx.x);
            pg8::EpiSwiglu E{HID, DFF, 44};
            pg8::gemm_phase<pg8::EpiSwiglu, pg8::StaticOrder, true, true>(F.lds + RING_OFF, g, S, E);
        }
        SEAM(7);
        if (IN(8)) {
            pg8::Gemm g{HID, (const bf16*)(F.ws + WS_WDN0), M, DM, DFF}; pg8::StaticOrder S; S.init(M, DM, F.G, (int)blockIdx.x);
            pg8::EpiResid E{XA, F.out, modl + 10240};
            pg8::gemm_phase<pg8::EpiResid, pg8::StaticOrder, true, true>(F.lds + RING_OFF, g, S, E);
        }
        SEAM(8);
    }
    LAYER_MIX(1);
    const float* mod1 = MOD + (size_t)8 * 12288;
    if (IN(14)) norm_phase<true>(F, XA, F.in[IN_GFFN] + DM, mod1, 6144, 8192);
    SEAM(14);
    if (IN(15)) moe_gather(F);
    SEAM(15);
    if (IN(16)) {
        const int T = moe_tables(F);
        pg8::Gemm g{AS, (const bf16*)(F.ws + WS_WGU1), T * 256, 2 * DFFE, DM}; pg8::GroupedOrder S; S.init(T, 56, F.G, (int)blockIdx.x, (const LAS int*)(F.lds + MISC_OFF + 64));
        pg8::EpiSwiglu E{HID, DFFE, 56};
        pg8::gemm_phase<pg8::EpiSwiglu, pg8::GroupedOrder, true, true>(F.lds + RING_OFF, g, S, E);
    }
    SEAM(16);
    if (IN(17)) {
        const int T = moe_tables(F);
        pg8::Gemm g{HID, (const bf16*)(F.ws + WS_WDN1), T * 256, DM, DFFE}; pg8::GroupedOrder S; S.init(T, 8, F.G, (int)blockIdx.x, (const LAS int*)(F.lds + MISC_OFF + 64));
        pg8::EpiPlainBf16 E{AS, DM, 8};
        pg8::gemm_phase<pg8::EpiPlainBf16, pg8::GroupedOrder, true, true>(F.lds + RING_OFF, g, S, E);
    }
    SEAM(17);
    if (IN(18)) moe_combine(F, mod1 + 10240);
#undef IN
#undef SEAM
}

extern "C" void kernel_launch(void* const* d_in, const int* in_sizes, int n_in, void* d_out, int out_size, void* d_ws, size_t ws_size, hipStream_t stream) {
    static int grid = 0;
    if (grid == 0) {
        if (n_in != 26 || in_sizes[0] != M * DM || out_size != M * DM || ws_size < WS_END) { fprintf(stderr, "kernel_launch: unexpected shapes (n_in %d, in0 %d, out %d, ws %zu < %zu)\n", n_in, n_in > 0 ? in_sizes[0] : -1, out_size, ws_size, (size_t)WS_END); grid = -1; return; }
        int dev = 0, cus = 0, per_cu = 0;
        if (hipGetDevice(&dev) != hipSuccess || hipDeviceGetAttribute(&cus, hipDeviceAttributeMultiprocessorCount, dev) != hipSuccess) { grid = -1; return; }
        if (hipFuncSetAttribute((const void*)hybrid_fwd, hipFuncAttributeMaxDynamicSharedMemorySize, LDS_BYTES) != hipSuccess) { fprintf(stderr, "kernel_launch: hipFuncSetAttribute failed\n"); grid = -1; return; }
        if (hipOccupancyMaxActiveBlocksPerMultiprocessor(&per_cu, (const void*)hybrid_fwd, NWAVES * 64, LDS_BYTES) != hipSuccess || per_cu < 1) fprintf(stderr, "kernel_launch: occupancy query says %d\n", per_cu);
        (void)hipGetLastError();
        grid = cus < 256 ? cus : 256;
    }
    if (grid < 0) return;
    if (hipMemsetAsync((char*)d_ws + WS_CTL, 0, CTL_ZERO_BYTES, stream) != hipSuccess) return;
    Args a{};
    for (int i = 0; i < 26; ++i) a.in[i] = (const float*)d_in[i];
    a.out = (float*)d_out; a.ws = (unsigned char*)d_ws;
#if MK_ONE_LAUNCH
    a.ph_lo = 0; a.ph_hi = NPH;
    hipLaunchKernelGGL(hybrid_fwd, dim3(grid), dim3(NWAVES * 64), LDS_BYTES, stream, a);
#else
    for (int p = 0; p < NPH; ++p) { a.ph_lo = p; a.ph_hi = p + 1; hipLaunchKernelGGL(hybrid_fwd, dim3(grid), dim3(NWAVES * 64), LDS_BYTES, stream, a); }
#endif
}
```

```cpp
#include <hip/hip_runtime.h>
#include <cstdio>
#include <cstdint>
namespace pg8 {
#define PG8_LAS __attribute__((address_space(3)))
typedef unsigned short bf16_t;
typedef short bf16x8 __attribute__((ext_vector_type(8)));
typedef float f32x4 __attribute__((ext_vector_type(4)));
typedef unsigned u32x4 __attribute__((ext_vector_type(4)));
constexpr int BM = 256, BK = 64, HALF = 128, HTB = HALF * BK * 2  , STAGE_BYTES = 8 * HTB, NXCD = 8, WGM = 8;

__host__ __device__ __forceinline__ int lds_byte(int r, int c) { const int st = (r >> 4) * 2 + (c >> 5), rr = r & 15, cc = c & 31, ob = rr * 64 + cc * 2; return st * 1024 + (ob ^ (((ob >> 9) & 1) << 5)); }
__host__ __device__ __forceinline__ void stage_rc(int b, int& R, int& C) { const int st = b / 1024, sb = b % 1024, swz = sb ^ (((sb >> 9) & 1) << 5); R = (st >> 1) * 16 + swz / 64; C = (st & 1) * 32 + (swz % 64) / 2; }
__host__ __device__ __forceinline__ int perm32(int rho) { const int n = rho >> 4, i = rho & 15; return 8 * (i >> 2) + 4 * n + (i & 3); }

struct Unit { int pm, pn; };
struct Gemm { const bf16_t* A; const bf16_t* Bt; int M, N, K; };

struct StaticOrder {
    int nM, nN, nwg, G, c;
    __host__ __device__ void init(int M, int N, int G_, int c_) { nM = M / BM; nN = N / BM; nwg = nM * nN; G = G_; c = c_; }
    __host__ __device__ bool next(int i, Unit& u) const {
        const long L = (long)i * G + c; if (L >= nwg) return false;
        int wgid = (int)L; { const int q = nwg / NXCD, r = nwg % NXCD, xcd = wgid % NXCD, off = wgid / NXCD; wgid = (xcd < r ? xcd * (q + 1) : r * (q + 1) + (xcd - r) * q) + off; }
        const int nig = WGM * nN, gid = wgid / nig, fm = gid * WGM, gsz = (nM - fm) < WGM ? (nM - fm) : WGM;
        u.pm = fm + ((wgid % nig) % gsz); u.pn = (wgid % nig) / gsz; return true;
    }
    __device__ __forceinline__ void a_ready(const Unit&) const {}
    __device__ __forceinline__ void done(const Unit&) const {}
};
__device__ __forceinline__ unsigned cvt_pk_bf16(float lo, float hi) { unsigned r; asm volatile("v_cvt_pk_bf16_f32 %0, %1, %2" : "=v"(r) : "v"(lo), "v"(hi)); return r; }
typedef unsigned u32x2 __attribute__((ext_vector_type(2)));
__device__ __forceinline__ float fast_silu(float g) { return g * __builtin_amdgcn_rcpf(1.0f + __expf(-g)); }
struct EpiProj {
    static constexpr bool PERM = true, AFTER_DRAIN = false;
    bf16_t* O; float* side;
    __device__ __forceinline__ void operator()(const f32x4 (&acc)[2][2][4][2], const Unit& u, int wr, int wc, int fr, int fq) const {
        const int row0 = u.pm * BM + wr * 64 + fr;
        if (u.pn < 17) {
            const int col0 = u.pn * BM + wc * 32 + 8 * fq;
#pragma unroll
            for (int ai = 0; ai < 2; ++ai)
#pragma unroll
                for (int m = 0; m < 4; ++m) { bf16_t* rowp = O + (size_t)(row0 + ai * HALF + m * 16) * 4352 + col0;
#pragma unroll
                    for (int bj = 0; bj < 2; ++bj) { const f32x4 v0 = acc[ai][bj][m][0], v1 = acc[ai][bj][m][1];
                        u32x4 w; w.x = cvt_pk_bf16(v0[0], v0[1]); w.y = cvt_pk_bf16(v0[2], v0[3]); w.z = cvt_pk_bf16(v1[0], v1[1]); w.w = cvt_pk_bf16(v1[2], v1[3]);
                        *(u32x4*)(rowp + bj * HALF) = w; } }
        } else if (wc == 0) {
#pragma unroll
            for (int ai = 0; ai < 2; ++ai)
#pragma unroll
                for (int m = 0; m < 4; ++m) { float* rowp = side + (size_t)(row0 + ai * HALF + m * 16) * 32 + 8 * fq;
                    *(f32x4*)(rowp) = acc[ai][0][m][0]; *(f32x4*)(rowp + 4) = acc[ai][0][m][1]; }
        }
    }
};
struct EpiResid {
    static constexpr bool PERM = false, AFTER_DRAIN = false;
    const float* base; float* out; const float* gate;
    __device__ __forceinline__ void operator()(const f32x4 (&acc)[2][2][4][2], const Unit& u, int wr, int wc, int fr, int fq) const {
        const int row0 = u.pm * BM + wr * 64 + fr, col0 = u.pn * BM + wc * 32 + 4 * fq;
        const float* __restrict__ gp = gate + (size_t)(u.pm >> 3) * 12288 + col0;
        const float* __restrict__ bp = base + (size_t)row0 * 2048 + col0; float* __restrict__ op = out + (size_t)row0 * 2048 + col0;
        f32x4 gv[2][2];
#pragma unroll
        for (int bj = 0; bj < 2; ++bj)
#pragma unroll
            for (int n = 0; n < 2; ++n) gv[bj][n] = *(const f32x4*)(gp + bj * HALF + n * 16);
        f32x4 cur[2][2], nxt[2][2];
#pragma unroll
        for (int bj = 0; bj < 2; ++bj)
#pragma unroll
            for (int n = 0; n < 2; ++n) cur[bj][n] = *(const f32x4*)(bp + bj * HALF + n * 16);
#pragma unroll
        for (int g = 0; g < 8; ++g) { const int ai = g >> 2, m = g & 3; const size_t off = (size_t)(ai * HALF + m * 16) * 2048;
            if (g < 7) { const int ai2 = (g + 1) >> 2, m2 = (g + 1) & 3; const size_t off2 = (size_t)(ai2 * HALF + m2 * 16) * 2048;
#pragma unroll
                for (int bj = 0; bj < 2; ++bj)
#pragma unroll
                    for (int n = 0; n < 2; ++n) nxt[bj][n] = *(const f32x4*)(bp + off2 + bj * HALF + n * 16); }
#pragma unroll
            for (int bj = 0; bj < 2; ++bj)
#pragma unroll
                for (int n = 0; n < 2; ++n) *(f32x4*)(op + off + bj * HALF + n * 16) = cur[bj][n] + gv[bj][n] * acc[ai][bj][m][n];
#pragma unroll
            for (int bj = 0; bj < 2; ++bj)
#pragma unroll
                for (int n = 0; n < 2; ++n) cur[bj][n] = nxt[bj][n];
            asm volatile("" ::: "memory"); }
    }
};
struct EpiSwiglu {
    static constexpr bool PERM = true, AFTER_DRAIN = false;
    bf16_t* O; int ldc; int nN;
    __device__ __forceinline__ void operator()(const f32x4 (&acc)[2][2][4][2], const Unit& u, int wr, int wc, int fr, int fq) const {
        const int row0 = u.pm * BM + wr * 64 + fr, col0 = (u.pn % nN) * HALF + wc * 32 + 8 * fq;
#pragma unroll
        for (int ai = 0; ai < 2; ++ai)
#pragma unroll
            for (int m = 0; m < 4; ++m) { bf16_t* rowp = O + (size_t)(row0 + ai * HALF + m * 16) * ldc + col0;
                const f32x4 g0 = acc[ai][0][m][0], g1 = acc[ai][0][m][1], u0 = acc[ai][1][m][0], u1 = acc[ai][1][m][1];
                u32x4 w; w.x = cvt_pk_bf16(fast_silu(g0[0]) * u0[0], fast_silu(g0[1]) * u0[1]); w.y = cvt_pk_bf16(fast_silu(g0[2]) * u0[2], fast_silu(g0[3]) * u0[3]);
                w.z = cvt_pk_bf16(fast_silu(g1[0]) * u1[0], fast_silu(g1[1]) * u1[1]); w.w = cvt_pk_bf16(fast_silu(g1[2]) * u1[2], fast_silu(g1[3]) * u1[3]);
                *(u32x4*)(rowp) = w; }
    }
};
struct EpiPlainBf16 {
    static constexpr bool PERM = true, AFTER_DRAIN = false;
    bf16_t* O; int ldc; int nN;
    __device__ __forceinline__ void operator()(const f32x4 (&acc)[2][2][4][2], const Unit& u, int wr, int wc, int fr, int fq) const {
        const int row0 = u.pm * BM + wr * 64 + fr, col0 = (u.pn % nN) * BM + wc * 32 + 8 * fq;
#pragma unroll
        for (int ai = 0; ai < 2; ++ai)
#pragma unroll
            for (int m = 0; m < 4; ++m) { bf16_t* rowp = O + (size_t)(row0 + ai * HALF + m * 16) * ldc + col0;
#pragma unroll
                for (int bj = 0; bj < 2; ++bj) { const f32x4 v0 = acc[ai][bj][m][0], v1 = acc[ai][bj][m][1];
                    u32x4 w; w.x = cvt_pk_bf16(v0[0], v0[1]); w.y = cvt_pk_bf16(v0[2], v0[3]); w.z = cvt_pk_bf16(v1[0], v1[1]); w.w = cvt_pk_bf16(v1[2], v1[3]);
                    *(u32x4*)(rowp + bj * HALF) = w; } }
    }
};
struct GroupedOrder {
    int nM, nN, nwg, G, c; const PG8_LAS int* tile_e;
    __device__ void init(int nM_, int nN_, int G_, int c_, const PG8_LAS int* te) { nM = nM_; nN = nN_; nwg = nM * nN; G = G_; c = c_; tile_e = te; }
    __device__ bool next(int i, Unit& u) const {
        const long L = (long)i * G + c; if (L >= nwg) return false;
        int wgid = (int)L; { const int q = nwg / NXCD, r = nwg % NXCD, xcd = wgid % NXCD, off = wgid / NXCD; wgid = (xcd < r ? xcd * (q + 1) : r * (q + 1) + (xcd - r) * q) + off; }
        const int nig = WGM * nN, gid = wgid / nig, fm = gid * WGM, gsz = (nM - fm) < WGM ? (nM - fm) : WGM;
        u.pm = fm + ((wgid % nig) % gsz); u.pn = tile_e[u.pm] * nN + (wgid % nig) / gsz; return true;
    }
    __device__ __forceinline__ void a_ready(const Unit&) const {}
    __device__ __forceinline__ void done(const Unit&) const {}
};
template <class Epi, class Sched, bool ALIGN_EPI = false, bool SP2 = false>
__device__ __forceinline__ void gemm_phase(PG8_LAS unsigned char* lds, const Gemm g, const Sched& S, const Epi& E) {
    const int tid = threadIdx.x, wid = __builtin_amdgcn_readfirstlane(tid >> 6), lane = tid & 63, wr = wid >> 2, wc = wid & 3, fr = lane & 15, fq = lane >> 4;
    const int K = g.K, nt = K / BK;
    unsigned voffA[2], voffB[2];
#pragma unroll
    for (int i = 0; i < 2; ++i) { int R, C; stage_rc(tid * 16 + i * 8192, R, C); const int Rb = Epi::PERM ? ((R & ~31) + perm32(R & 31)) : R;
        voffA[i] = (unsigned)(R * K + C) * 2u; voffB[i] = (unsigned)(Rb * K + C) * 2u; }
    const size_t kstep = (size_t)(BK * 2);
    const size_t hstep = (size_t)HALF * K * 2;
    const size_t tstep = 2 * hstep;
    const unsigned ldsw = (unsigned)wid * 1024u;
    const int aoff = lds_byte(wr * 64 + fr, fq * 8), boff = lds_byte(wc * 32 + fr, fq * 8);
#define PG8_SA(b, h) (((b) * 2 + (h)) * HTB)
#define PG8_SB(b, h) ((4 + (b) * 2 + (h)) * HTB)
#define PG8_STAGE(bufoff, gbase, voff) do { _Pragma("unroll") for (int _i = 0; _i < 2; ++_i) \
        __builtin_amdgcn_global_load_lds((const unsigned*)((const char*)(gbase) + (voff)[_i]), (PG8_LAS unsigned*)(lds + (bufoff) + ldsw + _i * 8192), 16, 0, 0); } while (0)
#define PG8_LDA(dst, b, h) do { _Pragma("unroll") for (int m = 0; m < 4; ++m) _Pragma("unroll") for (int k = 0; k < 2; ++k) dst[m][k] = *(const PG8_LAS bf16x8*)(lds + PG8_SA(b, h) + aoff + m * 2048 + k * 1024); } while (0)
#define PG8_LDB(dst, b, h) do { _Pragma("unroll") for (int n = 0; n < 2; ++n) _Pragma("unroll") for (int k = 0; k < 2; ++k) dst[n][k] = *(const PG8_LAS bf16x8*)(lds + PG8_SB(b, h) + boff + n * 2048 + k * 1024); } while (0)
#define PG8_MMA(ai, bj, At, Bt) do { __builtin_amdgcn_s_setprio(1); _Pragma("unroll") for (int m = 0; m < 4; ++m) _Pragma("unroll") for (int n = 0; n < 2; ++n) _Pragma("unroll") for (int k = 0; k < 2; ++k) \
        acc[ai][bj][m][n] = __builtin_amdgcn_mfma_f32_16x16x32_bf16(Bt[n][k], At[m][k], acc[ai][bj][m][n], 0, 0, 0); __builtin_amdgcn_s_setprio(0); } while (0)
#define PG8_WAIT_V(n) asm volatile("s_waitcnt vmcnt(" #n ")" ::: "memory")
#define PG8_WAIT_L(n) asm volatile("s_waitcnt lgkmcnt(" #n ")" ::: "memory")
#define PG8_BAR __builtin_amdgcn_s_barrier()
#define PG8_SCHED __builtin_amdgcn_sched_barrier(0)
    Unit cur, nxt; int ui = 0;
    if (!S.next(0, cur)) return;
    f32x4 acc[2][2][4][2];
#pragma unroll
    for (int a = 0; a < 2; ++a)
#pragma unroll
        for (int b = 0; b < 2; ++b)
#pragma unroll
            for (int m = 0; m < 4; ++m)
#pragma unroll
                for (int n = 0; n < 2; ++n) acc[a][b][m][n] = (f32x4){0.f, 0.f, 0.f, 0.f};
    bf16x8 At[4][2], B0[2][2], B1[2][2];
    const char* cA = (const char*)g.A + (size_t)cur.pm * tstep; const char* cB = (const char*)g.Bt + (size_t)cur.pn * tstep;
    S.a_ready(cur);
    if constexpr (SP2) {
        PG8_STAGE(PG8_SB(0, 0), cB, voffB); PG8_STAGE(PG8_SB(0, 1), cB + hstep, voffB); PG8_STAGE(PG8_SA(0, 0), cA, voffA); PG8_STAGE(PG8_SA(0, 1), cA + hstep, voffA);
        if (wr == 1) PG8_BAR;
        PG8_WAIT_V(2); PG8_BAR;
        PG8_STAGE(PG8_SB(1, 0), cB + kstep, voffB); PG8_STAGE(PG8_SA(1, 0), cA + kstep, voffA); PG8_STAGE(PG8_SB(1, 1), cB + hstep + kstep, voffB);
        PG8_WAIT_V(6); PG8_BAR;
    } else {
        PG8_STAGE(PG8_SB(0, 0), cB, voffB); PG8_STAGE(PG8_SA(0, 0), cA, voffA); PG8_STAGE(PG8_SB(0, 1), cB + hstep, voffB); PG8_STAGE(PG8_SA(0, 1), cA + hstep, voffA);
        if (wr == 1) PG8_BAR;
        PG8_WAIT_V(4); PG8_BAR;
        PG8_STAGE(PG8_SB(1, 0), cB + kstep, voffB); PG8_STAGE(PG8_SA(1, 0), cA + kstep, voffA); PG8_STAGE(PG8_SB(1, 1), cB + hstep + kstep, voffB);
        PG8_WAIT_V(6); PG8_BAR;
    }
    for (;;) {
        const bool has_next = S.next(ui + 1, nxt);
        const char* nA = has_next ? (const char*)g.A + (size_t)nxt.pm * tstep : cA; const char* nB = has_next ? (const char*)g.Bt + (size_t)nxt.pn * tstep : cB;
        for (int t = 0; t < nt; t += 2) {
            const bool last = (t == nt - 2);
            const char* a1 = cA + (size_t)(t + 1) * kstep;
            const char* a2 = last ? nA : cA + (size_t)(t + 2) * kstep; const char* b2 = last ? nB : cB + (size_t)(t + 2) * kstep;
            const char* a3 = a2 + kstep; const char* b3 = b2 + kstep;
            if (last && has_next) S.a_ready(nxt);
            if constexpr (SP2) {
            PG8_LDB(B0, 0, 0); PG8_LDB(B1, 0, 1); PG8_SCHED; PG8_LDA(At, 0, 0); PG8_STAGE(PG8_SA(1, 1), a1 + hstep, voffA);
            PG8_WAIT_V(8); PG8_WAIT_L(0); PG8_BAR; PG8_MMA(0, 0, At, B0); PG8_MMA(0, 1, At, B1); PG8_BAR; PG8_SCHED;
            PG8_LDA(At, 0, 1); PG8_STAGE(PG8_SB(0, 0), b2, voffB); PG8_STAGE(PG8_SB(0, 1), b2 + hstep, voffB); PG8_STAGE(PG8_SA(0, 0), a2, voffA);
            PG8_WAIT_V(8); PG8_WAIT_L(0); PG8_BAR; PG8_MMA(1, 0, At, B0); PG8_MMA(1, 1, At, B1); PG8_BAR; PG8_SCHED;
            PG8_LDB(B0, 1, 0); PG8_LDB(B1, 1, 1); PG8_SCHED; PG8_LDA(At, 1, 0); PG8_STAGE(PG8_SA(0, 1), a2 + hstep, voffA);
            PG8_WAIT_V(8); PG8_WAIT_L(0); PG8_BAR; PG8_MMA(0, 0, At, B0); PG8_MMA(0, 1, At, B1); PG8_BAR; PG8_SCHED;
            PG8_LDA(At, 1, 1); PG8_STAGE(PG8_SB(1, 0), b3, voffB); PG8_STAGE(PG8_SB(1, 1), b3 + hstep, voffB); PG8_STAGE(PG8_SA(1, 0), a3, voffA);
            PG8_WAIT_V(8); PG8_WAIT_L(0); PG8_BAR; PG8_MMA(1, 0, At, B0); PG8_MMA(1, 1, At, B1); PG8_BAR; PG8_SCHED;
            } else {
            PG8_LDB(B0, 0, 0); PG8_SCHED; PG8_LDA(At, 0, 0); PG8_STAGE(PG8_SA(1, 1), a1 + hstep, voffA);
            PG8_WAIT_L(8); PG8_BAR; PG8_WAIT_L(0); PG8_MMA(0, 0, At, B0); PG8_BAR; PG8_SCHED;
            PG8_LDB(B1, 0, 1); PG8_STAGE(PG8_SB(0, 0), b2, voffB);
            PG8_BAR; PG8_WAIT_L(0); PG8_MMA(0, 1, At, B1); PG8_BAR;
            PG8_LDA(At, 0, 1); PG8_STAGE(PG8_SA(0, 0), a2, voffA);
            PG8_BAR; PG8_WAIT_L(0); PG8_MMA(1, 0, At, B0); PG8_BAR; PG8_SCHED;
            PG8_STAGE(PG8_SB(0, 1), b2 + hstep, voffB);
            PG8_WAIT_V(6); PG8_BAR; PG8_MMA(1, 1, At, B1); PG8_BAR;
            PG8_LDB(B0, 1, 0); PG8_SCHED; PG8_LDA(At, 1, 0); PG8_STAGE(PG8_SA(0, 1), a2 + hstep, voffA);
            PG8_WAIT_L(8); PG8_BAR; PG8_WAIT_L(0); PG8_MMA(0, 0, At, B0); PG8_BAR; PG8_SCHED;
            PG8_LDB(B1, 1, 1); PG8_STAGE(PG8_SB(1, 0), b3, voffB);
            PG8_BAR; PG8_WAIT_L(0); PG8_MMA(0, 1, At, B1); PG8_BAR;
            PG8_LDA(At, 1, 1); PG8_STAGE(PG8_SA(1, 0), a3, voffA);
            PG8_BAR; PG8_WAIT_L(0); PG8_MMA(1, 0, At, B0); PG8_BAR; PG8_SCHED;
            PG8_STAGE(PG8_SB(1, 1), b3 + hstep, voffB);
            PG8_WAIT_V(6); PG8_BAR; PG8_MMA(1, 1, At, B1); PG8_BAR;
            }
        }
        if constexpr (ALIGN_EPI) { if (wr == 0) PG8_BAR; }
        if constexpr (!Epi::AFTER_DRAIN) { E(acc, cur, wr, wc, fr, fq); S.done(cur); }
        if (!has_next) break;
#pragma unroll
        for (int a = 0; a < 2; ++a)
#pragma unroll
            for (int b = 0; b < 2; ++b)
#pragma unroll
                for (int m = 0; m < 4; ++m)
#pragma unroll
                    for (int n = 0; n < 2; ++n) acc[a][b][m][n] = (f32x4){0.f, 0.f, 0.f, 0.f};
        cur = nxt; cA = nA; cB = nB; ++ui;
        if constexpr (ALIGN_EPI) { if (wr == 1) PG8_BAR; }
    }
    PG8_WAIT_V(0);
    if constexpr (!ALIGN_EPI) { if (wr == 0) PG8_BAR; }
    PG8_BAR;
    if constexpr (Epi::AFTER_DRAIN) { E.fused(acc, cur, wr, wc, fr, fq, lds, wid, lane); S.done(cur); }
#undef PG8_SA
#undef PG8_SB
#undef PG8_STAGE
#undef PG8_LDA
#undef PG8_LDB
#undef PG8_MMA
#undef PG8_WAIT_V
#undef PG8_WAIT_L
#undef PG8_BAR
#undef PG8_SCHED
}
}

constexpr int NWAVES = 8;
constexpr int BATCH = 8, SEQ = 2048, DM = 2048, M = BATCH * SEQ;
constexpr int NPROJ = 4608, PROJ_LD = 4352;
constexpr int DFF = 5632, DFFE = 7168, NE = 8;
constexpr int C_MQ = 0, C_MK = 256, C_MV = 512, C_MO = 1024, C_GQ = 1536, C_GK = 1792, C_GV = 2048, C_GG = 2560, C_AQ = 3072, C_AK = 4096, C_AV = 4224;
constexpr float EPS = 1e-6f;
constexpr int MAXROWS_S = M * 2 + NE * 256;

constexpr size_t MiB = 1u << 20;
constexpr size_t WS_CTL = 0, CTL_ZERO_BYTES = 1 * MiB;
constexpr size_t WS_MOD = 1 * MiB;
constexpr size_t WS_WIN = 2 * MiB;
constexpr size_t WS_WOUT = 38 * MiB;
constexpr size_t WS_WGU0 = 54 * MiB;
constexpr size_t WS_WDN0 = 98 * MiB;
constexpr size_t WS_WGU1 = 120 * MiB;
constexpr size_t WS_WDN1 = 568 * MiB;
constexpr size_t WS_XA = 792 * MiB;
constexpr size_t WS_XN = 920 * MiB;
constexpr size_t WS_Y = 984 * MiB;
constexpr size_t WS_SIDE = 1048 * MiB;
constexpr size_t WS_TOK = 1050 * MiB;
constexpr size_t WS_BIG = 1052 * MiB;
constexpr size_t WS_HID = WS_BIG;
constexpr size_t WS_AS = WS_BIG + 476 * MiB;
constexpr size_t WS_PROJ = WS_BIG;
constexpr size_t WS_QKC = WS_BIG + 144 * MiB;
constexpr size_t WS_LA = WS_BIG + 160 * MiB;
constexpr size_t WS_KN = WS_BIG + 176 * MiB;
constexpr size_t WS_UM = WS_BIG + 192 * MiB;
constexpr size_t WS_UG = WS_BIG + 212 * MiB;
constexpr size_t WS_GAUX = WS_BIG + 244 * MiB;
constexpr size_t WS_END = WS_BIG + 612 * MiB;
constexpr int TOK_E = 0, TOK_SLOT = 32768, TOK_W = 65536, TOK_POS = 98304;

constexpr int CW_TMO = 0, CW_CODE = 1, CW_BAR = 4096, CW_CNT = 8192;

constexpr int RING_OFF = 0, RING_BYTES = 131072;
constexpr int MISC_OFF = RING_BYTES;
constexpr int LDS_BYTES = 147456;

#define GAS __attribute__((address_space(1)))
#define LAS __attribute__((address_space(3)))
typedef unsigned short bf16;
typedef unsigned v4u __attribute__((ext_vector_type(4)));
typedef unsigned v2u __attribute__((ext_vector_type(2)));
typedef float f32x4 __attribute__((ext_vector_type(4)));
typedef short bf16x8 __attribute__((ext_vector_type(8)));
typedef GAS unsigned gu32;
#define RLX_AGENT __ATOMIC_RELAXED, __HIP_MEMORY_SCOPE_AGENT
#define LDS_WAIT() asm volatile("s_waitcnt lgkmcnt(0)" ::: "memory")
#define VM_WAIT() asm volatile("s_waitcnt vmcnt(0)" ::: "memory")
__device__ __forceinline__ unsigned f2bf(float f) { unsigned u = __builtin_bit_cast(unsigned, f); return (u + 0x7fffu + ((u >> 16) & 1u)) >> 16; }
__device__ __forceinline__ unsigned pk2(float lo, float hi) { return f2bf(lo) | (f2bf(hi) << 16); }
__device__ __forceinline__ float bflo(unsigned w) { return __builtin_bit_cast(float, w << 16); }
__device__ __forceinline__ float bfhi(unsigned w) { return __builtin_bit_cast(float, w & 0xffff0000u); }
__device__ __forceinline__ float bf1(bf16 b) { return __builtin_bit_cast(float, ((unsigned)b) << 16); }
__device__ __forceinline__ float wave_sum(float v) {
#pragma unroll
    for (int o = 1; o < 64; o <<= 1) v += __shfl_xor(v, o);
    return v;
}
__device__ __forceinline__ float sigmoidf_(float x) { return 1.0f / (1.0f + __expf(-x)); }
__device__ __forceinline__ float siluf_(float x) { return x / (1.0f + __expf(-x)); }
__device__ __forceinline__ float logsigmoidf_(float z) { return fminf(z, 0.f) - log1pf(expf(-fabsf(z))); }

#ifndef FAST_SWA
#define FAST_SWA 1
#endif
#ifndef FAST_GLA
#define FAST_GLA 1
#endif
#ifndef FAST_MLSTM
#define FAST_MLSTM 1
#endif
#define XB_TMO      128
#define XB_XCNT(j)  (256  + 64 * (j))
#define XB_XSUB(j)  (1280 + 64 * (j))
#define XB_XGEN(j)  (2304 + 64 * (j))
#define XB_TOP      3328
#define XB_TOPGEN   3392
#define XCD_BAR_WORDS 3456
#define XB_SPIN_CAP (1u << 18)

__device__ __forceinline__ unsigned xb_ld(unsigned* p)              { return __hip_atomic_load(p, __ATOMIC_RELAXED, __HIP_MEMORY_SCOPE_AGENT); }
__device__ __forceinline__ unsigned xb_add(unsigned* p, unsigned v) { return __hip_atomic_fetch_add(p, v, __ATOMIC_RELAXED, __HIP_MEMORY_SCOPE_AGENT); }
__device__ __forceinline__ unsigned xb_xcc_id() { return (unsigned)__builtin_amdgcn_s_getreg((3 << 11) | 20) & 0xFu; }
#define XB_SPIN(cond, bar) do { unsigned _sp = 0; while (cond) { __builtin_amdgcn_s_sleep(1); \
    if ((++_sp & 255u) == 0u) { if (xb_ld(&(bar)[XB_TMO])) break; if (_sp > XB_SPIN_CAP) { atomicAdd(&(bar)[XB_TMO], 1u); break; } } } } while (0)

struct XcdBarrier {
    unsigned* bar; unsigned x;
    volatile LAS unsigned* st;
};

__device__ __forceinline__ XcdBarrier xcd_barrier_post(unsigned* bar, volatile LAS unsigned* st) {
    XcdBarrier b; b.bar = bar; b.x = xb_xcc_id(); b.st = st;
    if (threadIdx.x == 0) (void)xb_add(&bar[XB_XCNT(b.x)], 1u);
    return b;
}
__device__ __forceinline__ void xcd_barrier_complete(unsigned* bar, unsigned x, unsigned& nloc, unsigned& nx) {
    const unsigned G = gridDim.x * gridDim.y * gridDim.z;
    unsigned sum, cnt, mine, sp = 0u;
    for (;;) {
        sum = 0u; cnt = 0u; mine = 0u;
#pragma unroll
        for (unsigned j = 0; j < 16; ++j) { const unsigned c = xb_ld(&bar[XB_XCNT(j)]); sum += c; cnt += (c > 0u) ? 1u : 0u; mine = (j == x) ? c : mine; }
        if (sum == G) break;
        __builtin_amdgcn_s_sleep(1);
        if ((++sp & 255u) == 0u) { if (xb_ld(&bar[XB_TMO])) break; if (sp > XB_SPIN_CAP) { atomicAdd(&bar[XB_TMO], 1u); break; } }
    }
    nloc = mine > 0u ? mine : 1u; nx = cnt > 0u ? cnt : 1u;
}

__device__ __forceinline__ void xcd_barrier(const XcdBarrier& b) {
    asm volatile("s_waitcnt vmcnt(0)" ::: "memory");
    __syncthreads();
    if (threadIdx.x == 0) {
        unsigned* bar = b.bar;
        __builtin_amdgcn_s_waitcnt(0);
        unsigned nloc = b.st[0], nx = b.st[1];
        if (nloc == 0u) { xcd_barrier_complete(bar, b.x, nloc, nx); b.st[0] = nloc; b.st[1] = nx; }
        const unsigned old = xb_add(&bar[XB_XSUB(b.x)], 1u);
        const unsigned gen = old / nloc;
        if (old + 1u == (gen + 1u) * nloc) {
            __builtin_amdgcn_fence(__ATOMIC_RELEASE, "agent");
            asm volatile("s_waitcnt vmcnt(0)" ::: "memory");
            const unsigned og = xb_add(&bar[XB_TOP], 1u);
            const unsigned tg = og / nx;
            if (og + 1u == (tg + 1u) * nx) xb_add(&bar[XB_TOPGEN], 1u);
            else XB_SPIN(xb_ld(&bar[XB_TOPGEN]) == tg, bar);
            __builtin_amdgcn_fence(__ATOMIC_ACQUIRE, "agent");
            xb_add(&bar[XB_XGEN(b.x)], 1u);
            asm volatile("s_waitcnt vmcnt(0)" ::: "memory");
        } else {
            XB_SPIN(xb_ld(&bar[XB_XGEN(b.x)]) == gen, bar);
            __builtin_amdgcn_fence(__ATOMIC_ACQUIRE, "agent");
            asm volatile("s_waitcnt vmcnt(0)" ::: "memory");
        }
    }
    __syncthreads();
}

typedef const float* cfp;
typedef __attribute__((address_space(4))) cfp cfp_k;
struct Frame {
    LAS unsigned char* lds;
    gu32* ctl;
    int tid, lane, wave, vcu, G;
    cfp_k* in;
    float* out; unsigned char* ws;
};
#define IN_X 0
#define IN_C 1
#define IN_WADA 2
#define IN_BADA 3
#define IN_GMIX 4
#define IN_GFFN 5
#define IN_WIN 6
#define IN_BGATES 7
#define IN_WCONV 8
#define IN_BCONV 9
#define IN_GOUTM 10
#define IN_WDEC 11
#define IN_BDEC 12
#define IN_GOUTG 13
#define IN_GQN 14
#define IN_GKN 15
#define IN_SINKS 16
#define IN_RELB 17
#define IN_WOUT 18
#define IN_WFG 19
#define IN_WFU 20
#define IN_WFD 21
#define IN_WROUTER 22
#define IN_WMG 23
#define IN_WMU 24
#define IN_WMD 25

__device__ __forceinline__ int rowmap(int kind, int off, int n) {
    if (kind == 0) return off + n;
    if (kind == 1) return off + ((n >> 7) << 8) + (n & 127);
    if (n < 1536) return n; if (n < 1544) return 4352 + (n - 1536); if (n < 3080) return n - 8; if (n < 3096) return 4360 + (n - 3080); return n - 24;
}
__device__ __forceinline__ void transpose_item(const float* W, int N, bf16* WT, int ldt, int kind, int off, int item, int lane) {
    const int nblk = (N + 63) >> 6, kb = item / nblk, nb = item - kb * nblk, k0 = 64 * kb + 16 * (lane >> 4), n = 64 * nb + 4 * (lane & 15);
    if (n >= N) return;
    const f32x4* src = (const f32x4*)(W + (size_t)k0 * N + n);
    f32x4 v[16];
#pragma unroll
    for (int j = 0; j < 16; ++j) v[j] = __builtin_nontemporal_load(src + (size_t)j * (N >> 2));
#pragma unroll
    for (int i = 0; i < 4; ++i) { bf16* dst = WT + (size_t)rowmap(kind, off, n + i) * ldt + k0;
        v4u o0, o1; o0.x = pk2(v[0][i], v[1][i]); o0.y = pk2(v[2][i], v[3][i]); o0.z = pk2(v[4][i], v[5][i]); o0.w = pk2(v[6][i], v[7][i]);
        o1.x = pk2(v[8][i], v[9][i]); o1.y = pk2(v[10][i], v[11][i]); o1.z = pk2(v[12][i], v[13][i]); o1.w = pk2(v[14][i], v[15][i]);
        *(v4u*)dst = o0; *(v4u*)(dst + 8) = o1; }
}
__device__ __forceinline__ void p0_prologue(Frame& F) {
    __syncthreads();
    {
        LAS float* cond = (LAS float*)(F.lds + RING_OFF);
        LAS float* red = (LAS float*)(F.lds + RING_OFF + 65536);
        float* mod = (float*)(F.ws + WS_MOD);
        bool have = false;
        for (int it = F.vcu; it < 192; it += F.G) {
            if (!have) { for (int i = F.tid; i < 8 * 2048; i += NWAVES * 64) { const float cv = F.in[IN_C][i]; cond[i] = cv / (1.0f + expf(-cv)); } have = true; }
            __syncthreads();
            const int l = it / 96, cg = it % 96, c4 = F.tid & 31, dp = F.tid >> 5;
            f32x4 acc[8];
#pragma unroll
            for (int b = 0; b < 8; ++b) acc[b] = (f32x4){0.f, 0.f, 0.f, 0.f};
            const f32x4* wp = (const f32x4*)(F.in[IN_WADA] + (size_t)l * 2048 * 12288 + (size_t)(dp * 128) * 12288 + cg * 128 + 4 * c4);
            const LAS float* cp = cond + dp * 128;
#pragma unroll 8
            for (int d = 0; d < 128; ++d) { const f32x4 w = __builtin_nontemporal_load(wp + (size_t)d * 3072);
#pragma unroll
                for (int b = 0; b < 8; ++b) acc[b] += w * cp[b * 2048 + d]; }
#pragma unroll
            for (int b = 0; b < 8; ++b) *(LAS f32x4*)(red + (dp * 8 + b) * 128 + 4 * c4) = acc[b];
            __syncthreads();
            for (int i = F.tid; i < 8 * 128; i += NWAVES * 64) { const int b = i >> 7, cc = i & 127; float s = 0.f;
#pragma unroll
                for (int q = 0; q < 16; ++q) s += red[(q * 8 + b) * 128 + cc];
                mod[(size_t)(l * 8 + b) * 12288 + cg * 128 + cc] = s + F.in[IN_BADA][l * 12288 + cg * 128 + cc]; }
        }
        __syncthreads();
    }
    const int gw = F.vcu * NWAVES + F.wave, NGW = F.G * NWAVES;
    constexpr int NITEMS = 100928;
    for (int it = gw; it < NITEMS; it += NGW) {
        int r = it; const float* W; bf16* WT; int N, ldt, kind, off;
        if (r < 4416) { const int l = r / 2208; r -= l * 2208; W = F.in[IN_WIN] + (size_t)l * 2048 * 4376; N = 4376; WT = (bf16*)(F.ws + WS_WIN) + (size_t)l * NPROJ * 2048; ldt = 2048; kind = 2; off = 0; }
        else if ((r -= 4416) < 2048) { const int l = r / 1024; r -= l * 1024; W = F.in[IN_WOUT] + (size_t)l * 2048 * 2048; N = 2048; WT = (bf16*)(F.ws + WS_WOUT) + (size_t)l * 2048 * 2048; ldt = 2048; kind = 0; off = 0; }
        else if ((r -= 2048) < 2816) { W = F.in[IN_WFG]; N = DFF; WT = (bf16*)(F.ws + WS_WGU0); ldt = 2048; kind = 1; off = 0; }
        else if ((r -= 2816) < 2816) { W = F.in[IN_WFU]; N = DFF; WT = (bf16*)(F.ws + WS_WGU0); ldt = 2048; kind = 1; off = 128; }
        else if ((r -= 2816) < 2816) { W = F.in[IN_WFD]; N = 2048; WT = (bf16*)(F.ws + WS_WDN0); ldt = DFF; kind = 0; off = 0; }
        else if ((r -= 2816) < 28672) { const int e = r / 3584; r -= e * 3584; W = F.in[IN_WMG] + (size_t)e * 2048 * DFFE; N = DFFE; WT = (bf16*)(F.ws + WS_WGU1) + (size_t)e * 14336 * 2048; ldt = 2048; kind = 1; off = 0; }
        else if ((r -= 28672) < 28672) { const int e = r / 3584; r -= e * 3584; W = F.in[IN_WMU] + (size_t)e * 2048 * DFFE; N = DFFE; WT = (bf16*)(F.ws + WS_WGU1) + (size_t)e * 14336 * 2048; ldt = 2048; kind = 1; off = 128; }
        else { r -= 28672; const int e = r / 3584; r -= e * 3584; W = F.in[IN_WMD] + (size_t)e * DFFE * 2048; N = 2048; WT = (bf16*)(F.ws + WS_WDN1) + (size_t)e * 2048 * DFFE; ldt = DFFE; kind = 0; off = 0; }
        transpose_item(W, N, WT, ldt, kind, off, r, F.lane);
    }
    for (int i = gw; i < 2 * 232; i += NGW) { const int l = i / 232, rr = 4376 + i % 232; v4u* p = (v4u*)((bf16*)(F.ws + WS_WIN) + ((size_t)l * NPROJ + rr) * 2048);
#pragma unroll
        for (int j = 0; j < 4; ++j) p[F.lane + 64 * j] = (v4u){0u, 0u, 0u, 0u}; }
}

template <bool ROUTER>
__device__ __forceinline__ void norm_phase(Frame& F, const float* xin, const float* g, const float* modl, int sh_off, int sc_off) {
    bf16* XN = (bf16*)(F.ws + WS_XN);
    const int gw = F.vcu * NWAVES + F.wave, NGW = F.G * NWAVES;
    LAS float* wrT = (LAS float*)(F.lds + RING_OFF);
    LAS int* lcnt = (LAS int*)(F.lds + MISC_OFF + 1152);
    LAS int* lbase = (LAS int*)(F.lds + MISC_OFF + 1216);
    LAS int* rtab = (LAS int*)(F.lds + MISC_OFF + 2048);
    int nrow = 0;
    if (ROUTER) {
        for (int i = F.tid; i < 2048 * 8; i += NWAVES * 64) wrT[(i & 7) * 2048 + (i >> 3)] = F.in[IN_WROUTER][i];
        if (F.tid < 8) lcnt[F.tid] = 0;
        __syncthreads();
    }
    for (int m = gw; m < M; m += NGW, ++nrow) {
        const int b = m >> 11;
        const f32x4* xr = (const f32x4*)(xin + (size_t)m * DM) + F.lane;
        f32x4 v[8]; float ss = 0.f;
#pragma unroll
        for (int j = 0; j < 8; ++j) { v[j] = xr[64 * j]; ss += (v[j].x * v[j].x + v[j].y * v[j].y) + (v[j].z * v[j].z + v[j].w * v[j].w); }
        const float rstd = 1.0f / sqrtf(wave_sum(ss) * (1.0f / DM) + EPS);
        const f32x4* gp = (const f32x4*)g + F.lane; const f32x4* scp = (const f32x4*)(modl + (size_t)b * 12288 + sc_off) + F.lane; const f32x4* shp = (const f32x4*)(modl + (size_t)b * 12288 + sh_off) + F.lane;
        v2u* o8 = (v2u*)(XN + (size_t)m * DM) + F.lane;
#pragma unroll
        for (int j = 0; j < 8; ++j) { const f32x4 gg = gp[64 * j], sc = scp[64 * j], sh = shp[64 * j];
            v[j] = v[j] * rstd * gg * (sc + 1.0f) + sh;
            v2u w; w.x = pk2(v[j].x, v[j].y); w.y = pk2(v[j].z, v[j].w); o8[64 * j] = w; }
        if (ROUTER) {
            float lg[8];
#pragma unroll
            for (int e = 0; e < 8; ++e) { float p = 0.f; const LAS f32x4* wp = (const LAS f32x4*)(wrT + e * 2048) + F.lane;
#pragma unroll
                for (int j = 0; j < 8; ++j) { const f32x4 w = wp[64 * j]; p += (v[j].x * w.x + v[j].y * w.y) + (v[j].z * w.z + v[j].w * w.w); }
                lg[e] = wave_sum(p); }
            int e1 = 0; float v1 = lg[0];
#pragma unroll
            for (int e = 1; e < 8; ++e) if (lg[e] > v1) { v1 = lg[e]; e1 = e; }
            int e2 = -1; float v2 = -3.0e38f;
#pragma unroll
            for (int e = 0; e < 8; ++e) if (e != e1 && lg[e] > v2) { v2 = lg[e]; e2 = e; }
            const float w1 = 1.0f / (1.0f + expf(v2 - v1)), w2 = 1.0f - w1;
            if (F.lane == 0) {
                const int r1 = atomicAdd((int*)(lcnt + e1), 1), r2 = atomicAdd((int*)(lcnt + e2), 1);
                LAS int* en = rtab + (F.wave * 16 + nrow) * 8;
                en[0] = m; en[1] = e1; en[2] = r1; en[3] = __builtin_bit_cast(int, w1); en[4] = m; en[5] = e2; en[6] = r2; en[7] = __builtin_bit_cast(int, w2);
            }
        }
    }
    if (ROUTER) {
        __syncthreads();
        if (F.tid < 8) lbase[F.tid] = (int)__hip_atomic_fetch_add((unsigned*)(F.ctl + CW_CNT + 64 * F.tid), (unsigned)lcnt[F.tid], RLX_AGENT);
        __syncthreads();
        int* tk = (int*)(F.ws + WS_TOK);
        const int per = (M + NGW - 1) / NGW;
        for (int i = F.tid; i < NWAVES * per * 2; i += NWAVES * 64) { const int w = i / (per * 2), rr = (i % (per * 2)) >> 1, k = i & 1;
            const int mrow = F.vcu * NWAVES + w + rr * NGW; if (mrow >= M) continue;
            const LAS int* en = rtab + (w * 16 + rr) * 8 + 4 * k;
            const int t = en[0], e = en[1];
            tk[TOK_E + t * 2 + k] = e; tk[TOK_SLOT + t * 2 + k] = lbase[e] + en[2]; tk[TOK_W + t * 2 + k] = en[3]; }
    }
}

__device__ const unsigned char T5_BUCKET[128] = {0, 1, 2, 3, 4, 5, 6, 7, 8, 9, 10, 11, 12, 13, 14, 15, 16, 16, 16, 17, 17, 18, 18, 18, 19, 19, 19, 20, 20, 20, 20, 21, 21, 21, 21, 22, 22, 22, 22, 22, 23, 23, 23, 23, 23, 23, 24, 24, 24, 24, 24, 24, 25, 25, 25, 25, 25, 25, 25, 26, 26, 26, 26, 26, 26, 26, 26, 27, 27, 27, 27, 27, 27, 27, 27, 27, 27, 28, 28, 28, 28, 28, 28, 28, 28, 28, 28, 29, 29, 29, 29, 29, 29, 29, 29, 29, 29, 29, 29, 30, 30, 30, 30, 30, 30, 30, 30, 30, 30, 30, 30, 30, 30, 31, 31, 31, 31, 31, 31, 31, 31, 31, 31, 31, 31, 31, 31, 31};

__device__ __forceinline__ void mix_prep(Frame& F, int l) {
    const bf16* proj = (const bf16*)(F.ws + WS_PROJ); const float* side = (const float*)(F.ws + WS_SIDE);
    bf16* qkc = (bf16*)(F.ws + WS_QKC); float* la = (float*)(F.ws + WS_LA); bf16* kn = (bf16*)(F.ws + WS_KN);
    const int gw = F.vcu * NWAVES + F.wave, NGW = F.G * NWAVES, lane = F.lane;
    const float* wc = F.in[IN_WCONV] + l * 4 * 512; const float* bc = F.in[IN_BCONV] + l * 512;
    const float* wd = F.in[IN_WDEC] + l * 16 * 256; const float* bd = F.in[IN_BDEC] + l * 256; const float* gk = F.in[IN_GKN] + l * 64;
    for (int m = gw; m < M; m += NGW) {
        const int pos = m & (SEQ - 1);
        {
            float y[8]; const int ch = lane * 8;
            { const f32x4 b0 = *(const f32x4*)(bc + ch), b1 = *(const f32x4*)(bc + ch + 4); y[0] = b0.x; y[1] = b0.y; y[2] = b0.z; y[3] = b0.w; y[4] = b1.x; y[5] = b1.y; y[6] = b1.z; y[7] = b1.w; }
#pragma unroll
            for (int i = 0; i < 4; ++i) { if (pos - 3 + i >= 0) {
                const v4u xv = *(const v4u*)(proj + (size_t)(m - 3 + i) * PROJ_LD + ch);
                const f32x4 w0 = *(const f32x4*)(wc + i * 512 + ch), w1 = *(const f32x4*)(wc + i * 512 + ch + 4);
                y[0] += w0.x * bflo(xv.x); y[1] += w0.y * bfhi(xv.x); y[2] += w0.z * bflo(xv.y); y[3] += w0.w * bfhi(xv.y);
                y[4] += w1.x * bflo(xv.z); y[5] += w1.y * bfhi(xv.z); y[6] += w1.z * bflo(xv.w); y[7] += w1.w * bfhi(xv.w); } }
            const float sc = ch >= 256 ? 0.125f : 1.0f;
#pragma unroll
            for (int i = 0; i < 8; ++i) y[i] = siluf_(y[i]) * sc;
            v4u o; o.x = pk2(y[0], y[1]); o.y = pk2(y[2], y[3]); o.z = pk2(y[4], y[5]); o.w = pk2(y[6], y[7]);
            *(v4u*)(qkc + (size_t)m * 512 + ch) = o;
        }
        {
            const int c = lane * 4; f32x4 z = *(const f32x4*)(bd + c);
            const f32x4* gp = (const f32x4*)(side + (size_t)m * 32 + 8);
            const f32x4 g0 = gp[0], g1 = gp[1], g2 = gp[2], g3 = gp[3];
            const float ga[16] = {g0.x, g0.y, g0.z, g0.w, g1.x, g1.y, g1.z, g1.w, g2.x, g2.y, g2.z, g2.w, g3.x, g3.y, g3.z, g3.w};
#pragma unroll
            for (int r = 0; r < 16; ++r) { const f32x4 w = *(const f32x4*)(wd + r * 256 + c); z += w * ga[r]; }
            f32x4 o; o.x = logsigmoidf_(z.x) * 0.0625f; o.y = logsigmoidf_(z.y) * 0.0625f; o.z = logsigmoidf_(z.z) * 0.0625f; o.w = logsigmoidf_(z.w) * 0.0625f;
            *(f32x4*)(la + (size_t)m * 256 + c) = o;
        }
        {
            const unsigned kv = *(const unsigned*)(proj + (size_t)m * PROJ_LD + C_AK + 2 * lane);
            const float k0 = bflo(kv), k1 = bfhi(kv); float ss = k0 * k0 + k1 * k1;
#pragma unroll
            for (int o = 1; o < 32; o <<= 1) ss += __shfl_xor(ss, o);
            const float rstd = 1.0f / sqrtf(ss * (1.0f / 64.0f) + EPS);
            *(unsigned*)(kn + (size_t)m * 128 + 2 * lane) = pk2(k0 * rstd * gk[(2 * lane) & 63], k1 * rstd * gk[(2 * lane + 1) & 63]);
        }
    }
}

__device__ __forceinline__ void naive_mlstm(Frame& F, int l, int bh) {
    const int b = bh >> 2, h = bh & 3, tid = F.tid, v = tid >> 2, kq = tid & 3;
    const bf16* proj = (const bf16*)(F.ws + WS_PROJ); const float* side = (const float*)(F.ws + WS_SIDE); const bf16* qkc = (const bf16*)(F.ws + WS_QKC);
    bf16* Y = (bf16*)(F.ws + WS_Y);
    LAS float* red = (LAS float*)(F.lds + RING_OFF);
    const float bi = F.in[IN_BGATES][l * 8 + h], bfg = F.in[IN_BGATES][l * 8 + 4 + h];
    const float gout = F.in[IN_GOUTM][l * 512 + h * 128 + v];
    float C[16], n[16]; float mst = 0.f;
#pragma unroll
    for (int i = 0; i < 16; ++i) { C[i] = 0.f; n[i] = 0.f; }
    for (int t = 0; t < SEQ; ++t) {
        const size_t row = (size_t)b * SEQ + t;
        const v4u q0 = *(const v4u*)(qkc + row * 512 + h * 64 + kq * 16), q1 = *(const v4u*)(qkc + row * 512 + h * 64 + kq * 16 + 8);
        const v4u k0 = *(const v4u*)(qkc + row * 512 + 256 + h * 64 + kq * 16), k1 = *(const v4u*)(qkc + row * 512 + 256 + h * 64 + kq * 16 + 8);
        const float q[16] = {bflo(q0.x), bfhi(q0.x), bflo(q0.y), bfhi(q0.y), bflo(q0.z), bfhi(q0.z), bflo(q0.w), bfhi(q0.w), bflo(q1.x), bfhi(q1.x), bflo(q1.y), bfhi(q1.y), bflo(q1.z), bfhi(q1.z), bflo(q1.w), bfhi(q1.w)};
        const float k[16] = {bflo(k0.x), bfhi(k0.x), bflo(k0.y), bfhi(k0.y), bflo(k0.z), bfhi(k0.z), bflo(k0.w), bfhi(k0.w), bflo(k1.x), bfhi(k1.x), bflo(k1.y), bfhi(k1.y), bflo(k1.z), bfhi(k1.z), bflo(k1.w), bfhi(k1.w)};
        const float vv = bf1(proj[row * PROJ_LD + C_MV + h * 128 + v]);
        const float ip = side[row * 32 + h] + bi, lf = logsigmoidf_(side[row * 32 + 4 + h] + bfg);
        const float mn = fmaxf(lf + mst, ip), fd = expf(lf + mst - mn), iw = expf(ip - mn); mst = mn;
        float num = 0.f, den = 0.f;
#pragma unroll
        for (int i = 0; i < 16; ++i) { C[i] = fd * C[i] + (iw * vv) * k[i]; n[i] = fd * n[i] + iw * k[i]; num += C[i] * q[i]; den += n[i] * q[i]; }
        num += __shfl_xor(num, 1); num += __shfl_xor(num, 2); den += __shfl_xor(den, 1); den += __shfl_xor(den, 2);
        const float hv = num / fmaxf(fabsf(den), expf(-mst));
        const float s2 = wave_sum(kq == 0 ? hv * hv : 0.f);
        if (F.lane == 0) red[(t & 1) * 8 + F.wave] = s2;
        __syncthreads();
        float tot = 0.f;
#pragma unroll
        for (int w = 0; w < 8; ++w) tot += red[(t & 1) * 8 + w];
        const float rstd = 1.0f / sqrtf(tot * (1.0f / 128.0f) + EPS);
        if (kq == 0) { const float mo = bf1(proj[row * PROJ_LD + C_MO + h * 128 + v]);
            Y[row * DM + h * 128 + v] = (bf16)f2bf(hv * rstd * gout * sigmoidf_(mo)); }
    }
    __syncthreads();
}
__device__ __forceinline__ void naive_gla(Frame& F, int l, int bh) {
    const int b = bh >> 2, h = bh & 3, tid = F.tid, v = tid >> 2, kq = tid & 3;
    const bf16* proj = (const bf16*)(F.ws + WS_PROJ); const float* la = (const float*)(F.ws + WS_LA);
    bf16* Y = (bf16*)(F.ws + WS_Y);
    LAS float* red = (LAS float*)(F.lds + RING_OFF);
    const float gout = F.in[IN_GOUTG][l * 512 + h * 128 + v];
    float S[16];
#pragma unroll
    for (int i = 0; i < 16; ++i) S[i] = 0.f;
    for (int t = 0; t < SEQ; ++t) {
        const size_t row = (size_t)b * SEQ + t;
        const v4u q0 = *(const v4u*)(proj + row * PROJ_LD + C_GQ + h * 64 + kq * 16), q1 = *(const v4u*)(proj + row * PROJ_LD + C_GQ + h * 64 + kq * 16 + 8);
        const v4u k0 = *(const v4u*)(proj + row * PROJ_LD + C_GK + h * 64 + kq * 16), k1 = *(const v4u*)(proj + row * PROJ_LD + C_GK + h * 64 + kq * 16 + 8);
        const float q[16] = {bflo(q0.x), bfhi(q0.x), bflo(q0.y), bfhi(q0.y), bflo(q0.z), bfhi(q0.z), bflo(q0.w), bfhi(q0.w), bflo(q1.x), bfhi(q1.x), bflo(q1.y), bfhi(q1.y), bflo(q1.z), bfhi(q1.z), bflo(q1.w), bfhi(q1.w)};
        const float k[16] = {bflo(k0.x), bfhi(k0.x), bflo(k0.y), bfhi(k0.y), bflo(k0.z), bfhi(k0.z), bflo(k0.w), bfhi(k0.w), bflo(k1.x), bfhi(k1.x), bflo(k1.y), bfhi(k1.y), bflo(k1.z), bfhi(k1.z), bflo(k1.w), bfhi(k1.w)};
        const f32x4* lp = (const f32x4*)(la + row * 256 + h * 64 + kq * 16);
        const f32x4 a0 = lp[0], a1 = lp[1], a2 = lp[2], a3 = lp[3];
        const float a[16] = {a0.x, a0.y, a0.z, a0.w, a1.x, a1.y, a1.z, a1.w, a2.x, a2.y, a2.z, a2.w, a3.x, a3.y, a3.z, a3.w};
        const float vv = bf1(proj[row * PROJ_LD + C_GV + h * 128 + v]);
        float o = 0.f;
#pragma unroll
        for (int i = 0; i < 16; ++i) { S[i] = expf(a[i]) * S[i] + k[i] * vv; o += (q[i] * 0.125f) * S[i]; }
        o += __shfl_xor(o, 1); o += __shfl_xor(o, 2);
        const float s2 = wave_sum(kq == 0 ? o * o : 0.f);
        if (F.lane == 0) red[(t & 1) * 8 + F.wave] = s2;
        __syncthreads();
        float tot = 0.f;
#pragma unroll
        for (int w = 0; w < 8; ++w) tot += red[(t & 1) * 8 + w];
        const float rstd = 1.0f / sqrtf(tot * (1.0f / 128.0f) + EPS);
        if (kq == 0) { const float gg = bf1(proj[row * PROJ_LD + C_GG + h * 128 + v]);
            Y[row * DM + 512 + h * 128 + v] = (bf16)f2bf(o * rstd * gout * siluf_(gg)); }
    }
    __syncthreads();
}
__device__ __forceinline__ void naive_swa(Frame& F, int l, int blk) {
    const int tid = F.tid, hq = tid & 15, row = blk * 32 + (tid >> 4), kvh = hq >> 3, pos = row & (SEQ - 1);
    const bf16* proj = (const bf16*)(F.ws + WS_PROJ); const bf16* kn = (const bf16*)(F.ws + WS_KN); bf16* Y = (bf16*)(F.ws + WS_Y);
    const float* gq = F.in[IN_GQN] + l * 64; const float* relb = F.in[IN_RELB];
    float q[64], o[64];
    { float ss = 0.f;
#pragma unroll
      for (int c = 0; c < 8; ++c) { const v4u x = *(const v4u*)(proj + (size_t)row * PROJ_LD + C_AQ + hq * 64 + 8 * c);
          q[8 * c + 0] = bflo(x.x); q[8 * c + 1] = bfhi(x.x); q[8 * c + 2] = bflo(x.y); q[8 * c + 3] = bfhi(x.y); q[8 * c + 4] = bflo(x.z); q[8 * c + 5] = bfhi(x.z); q[8 * c + 6] = bflo(x.w); q[8 * c + 7] = bfhi(x.w); }
#pragma unroll
      for (int d = 0; d < 64; ++d) ss += q[d] * q[d];
      const float rstd = 1.0f / sqrtf(ss * (1.0f / 64.0f) + EPS);
#pragma unroll
      for (int d = 0; d < 64; ++d) { q[d] = q[d] * rstd * gq[d] * 0.125f; o[d] = 0.f; } }
    float mx = F.in[IN_SINKS][l * 16 + hq], den = 1.0f;
    const int s0 = pos - 127 < 0 ? 0 : pos - 127;
    for (int s = s0; s <= pos; ++s) {
        const size_t kr = (size_t)(row - pos + s);
        float dot = 0.f;
#pragma unroll
        for (int c = 0; c < 8; ++c) { const v4u x = *(const v4u*)(kn + kr * 128 + kvh * 64 + 8 * c);
            dot += q[8 * c + 0] * bflo(x.x) + q[8 * c + 1] * bfhi(x.x) + q[8 * c + 2] * bflo(x.y) + q[8 * c + 3] * bfhi(x.y) + q[8 * c + 4] * bflo(x.z) + q[8 * c + 5] * bfhi(x.z) + q[8 * c + 6] * bflo(x.w) + q[8 * c + 7] * bfhi(x.w); }
        const float sc = dot + relb[T5_BUCKET[pos - s] * 16 + hq];
        const float mn = fmaxf(mx, sc), corr = expf(mx - mn), p = expf(sc - mn); mx = mn; den = den * corr + p;
#pragma unroll
        for (int c = 0; c < 8; ++c) { const v4u x = *(const v4u*)(proj + kr * PROJ_LD + C_AV + kvh * 64 + 8 * c);
            o[8 * c + 0] = o[8 * c + 0] * corr + p * bflo(x.x); o[8 * c + 1] = o[8 * c + 1] * corr + p * bfhi(x.x); o[8 * c + 2] = o[8 * c + 2] * corr + p * bflo(x.y); o[8 * c + 3] = o[8 * c + 3] * corr + p * bfhi(x.y);
            o[8 * c + 4] = o[8 * c + 4] * corr + p * bflo(x.z); o[8 * c + 5] = o[8 * c + 5] * corr + p * bfhi(x.z); o[8 * c + 6] = o[8 * c + 6] * corr + p * bflo(x.w); o[8 * c + 7] = o[8 * c + 7] * corr + p * bfhi(x.w); }
    }
    const float inv = 1.0f / den;
#pragma unroll
    for (int c = 0; c < 8; ++c) { v4u w; w.x = pk2(o[8 * c] * inv, o[8 * c + 1] * inv); w.y = pk2(o[8 * c + 2] * inv, o[8 * c + 3] * inv); w.z = pk2(o[8 * c + 4] * inv, o[8 * c + 5] * inv); w.w = pk2(o[8 * c + 6] * inv, o[8 * c + 7] * inv);
        *(v4u*)(Y + (size_t)row * DM + 1024 + hq * 64 + 8 * c) = w; }
}
__device__ __forceinline__ void mix_naive(Frame& F, int l) {
    for (int u = F.vcu; u < 64 + 512; u += F.G) {
        if (u < 32) { if (!FAST_MLSTM) naive_mlstm(F, l, u); }
        else if (u < 64) { if (!FAST_GLA) naive_gla(F, l, u - 32); }
        else { if (!FAST_SWA) naive_swa(F, l, u - 64); }
    }
}

__device__ __forceinline__ int moe_tables(Frame& F) {
    LAS int* seg = (LAS int*)(F.lds + MISC_OFF + 1024); LAS int* tile_e = (LAS int*)(F.lds + MISC_OFF + 64);
    if (F.tid == 0) { int s = 0;
        for (int e = 0; e < 8; ++e) { seg[e] = s; const int c = (int)__hip_atomic_load(F.ctl + CW_CNT + 64 * e, RLX_AGENT); const int nt = (c + 255) >> 8; for (int i = 0; i < nt; ++i) tile_e[(s >> 8) + i] = e; s += nt << 8; }
        seg[8] = s; }
    __syncthreads();
    return seg[8] >> 8;
}
__device__ __forceinline__ void moe_gather(Frame& F) {
    (void)moe_tables(F);
    const LAS int* seg = (const LAS int*)(F.lds + MISC_OFF + 1024);
    const int gw = F.vcu * NWAVES + F.wave, NGW = F.G * NWAVES;
    int* tk = (int*)(F.ws + WS_TOK); const bf16* XN = (const bf16*)(F.ws + WS_XN); bf16* AS = (bf16*)(F.ws + WS_AS);
    for (int m = gw; m < M; m += NGW) {
        const v4u* src = (const v4u*)(XN + (size_t)m * DM) + F.lane; v4u r[4];
#pragma unroll
        for (int j = 0; j < 4; ++j) r[j] = src[64 * j];
#pragma unroll
        for (int k = 0; k < 2; ++k) { const int e = tk[TOK_E + m * 2 + k], dest = seg[e] + tk[TOK_SLOT + m * 2 + k];
            v4u* dst = (v4u*)(AS + (size_t)dest * DM) + F.lane;
#pragma unroll
            for (int j = 0; j < 4; ++j) dst[64 * j] = r[j];
            if (F.lane == 0) tk[TOK_POS + m * 2 + k] = dest; }
    }
    for (int e = 0; e < 8; ++e) { const int c = (int)__hip_atomic_load(F.ctl + CW_CNT + 64 * e, RLX_AGENT);
        for (int r = seg[e] + c + gw; r < seg[e + 1]; r += NGW) { v4u* dst = (v4u*)(AS + (size_t)r * DM) + F.lane;
#pragma unroll
            for (int j = 0; j < 4; ++j) dst[64 * j] = (v4u){0u, 0u, 0u, 0u}; } }
}
__device__ __forceinline__ void moe_combine(Frame& F, const float* gtf) {
    const int gw = F.vcu * NWAVES + F.wave, NGW = F.G * NWAVES;
    const int* tk = (const int*)(F.ws + WS_TOK); const float* xa = (const float*)(F.ws + WS_XA); const bf16* YS = (const bf16*)(F.ws + WS_AS);
    for (int m = gw; m < M; m += NGW) {
        const int b = m >> 11, p1 = tk[TOK_POS + 2 * m], p2 = tk[TOK_POS + 2 * m + 1];
        const float w1 = __builtin_bit_cast(float, tk[TOK_W + 2 * m]), w2 = __builtin_bit_cast(float, tk[TOK_W + 2 * m + 1]);
        const f32x4* xr = (const f32x4*)(xa + (size_t)m * DM) + F.lane; const f32x4* gp = (const f32x4*)(gtf + (size_t)b * 12288) + F.lane;
        const v2u* y1 = (const v2u*)(YS + (size_t)p1 * DM) + F.lane; const v2u* y2 = (const v2u*)(YS + (size_t)p2 * DM) + F.lane;
        f32x4* op = (f32x4*)(F.out + (size_t)m * DM) + F.lane;
#pragma unroll
        for (int j = 0; j < 8; ++j) { const f32x4 x = xr[64 * j], g = gp[64 * j]; const v2u a = y1[64 * j], c = y2[64 * j];
            f32x4 y; y.x = w1 * bflo(a.x) + w2 * bflo(c.x); y.y = w1 * bfhi(a.x) + w2 * bfhi(c.x); y.z = w1 * bflo(a.y) + w2 * bflo(c.y); y.w = w1 * bfhi(a.y) + w2 * bfhi(c.y);
            op[64 * j] = x + g * y; }
    }
}

typedef short v4i16_t __attribute__((ext_vector_type(4)));
#define MFMA16(a, b, c) __builtin_amdgcn_mfma_f32_16x16x32_bf16((a), (b), (c), 0, 0, 0)
__device__ __forceinline__ bf16x8 frag_row(const LAS unsigned char* base, int ldb, int r0, int k0, int lane) {
    return *(const LAS bf16x8*)(base + (r0 + (lane & 15)) * ldb + (k0 + 8 * (lane >> 4)) * 2);
}
__device__ __forceinline__ bf16x8 frag_tr2(const LAS unsigned char* base, int ldb, int ra, int rb, int c0, int lane) {
    const int g = lane >> 4, q = (lane & 15) >> 2, p = lane & 3;
    const LAS unsigned char* a0 = base + (ra + 4 * g + q) * ldb + (c0 + 4 * p) * 2;
    const LAS unsigned char* a1 = base + (rb + 4 * g + q) * ldb + (c0 + 4 * p) * 2;
    const v4i16_t lo = __builtin_amdgcn_ds_read_tr16_b64_v4i16((LAS v4i16_t*)a0), hi = __builtin_amdgcn_ds_read_tr16_b64_v4i16((LAS v4i16_t*)a1);
    bf16x8 r; r[0] = lo[0]; r[1] = lo[1]; r[2] = lo[2]; r[3] = lo[3]; r[4] = hi[0]; r[5] = hi[1]; r[6] = hi[2]; r[7] = hi[3]; return r;
}
__device__ __forceinline__ bf16x8 frag_tr(const LAS unsigned char* base, int ldb, int k0, int c0, int lane) {
    const int g = lane >> 4;
    return frag_tr2(base, ldb, k0 + 4 * g, k0 + 4 * g + 4, c0, lane);
}
__device__ __forceinline__ bf16x8 pack8(float a, float b, float c, float d, float e, float f, float g, float h) {
    v4u w; w.x = pk2(a, b); w.y = pk2(c, d); w.z = pk2(e, f); w.w = pk2(g, h); return __builtin_bit_cast(bf16x8, w);
}
__device__ __forceinline__ float scan_add(float v, int lane) {
#pragma unroll
    for (int d = 1; d < 64; d <<= 1) { const float t = __shfl_up(v, d); if (lane >= d) v += t; }
    return v;
}
__device__ __forceinline__ float scan_max(float v, int lane) {
#pragma unroll
    for (int d = 1; d < 64; d <<= 1) { const float t = __shfl_up(v, d); if (lane >= d) v = fmaxf(v, t); }
    return v;
}

__device__ __forceinline__ void swa_unit(Frame& F, int l, int unit) {
    const int b = unit >> 5, kvh = (unit >> 4) & 1, nb = unit & 15;
    const int tid = F.tid, lane = F.lane, w = F.wave, g = lane >> 4, n = lane & 15;
    const bf16* proj = (const bf16*)(F.ws + WS_PROJ); bf16* Y = (bf16*)(F.ws + WS_Y);
    LAS unsigned char* Kt = F.lds + RING_OFF; LAS unsigned char* Vt = Kt + 36864; LAS float* bias = (LAS float*)(Kt + 73728);
    constexpr int LDB = 144;
    __syncthreads();
    {
        const int r = tid >> 1, hf = tid & 1, pos = nb * 128 - 128 + r;
        v4u kx[4], vx[4];
        if (pos >= 0) { const bf16* kp = proj + (size_t)(b * SEQ + pos) * PROJ_LD + C_AK + kvh * 64 + hf * 32; const bf16* vp = proj + (size_t)(b * SEQ + pos) * PROJ_LD + C_AV + kvh * 64 + hf * 32;
#pragma unroll
            for (int j = 0; j < 4; ++j) { kx[j] = *(const v4u*)(kp + 8 * j); vx[j] = *(const v4u*)(vp + 8 * j); } }
        else {
#pragma unroll
            for (int j = 0; j < 4; ++j) { kx[j] = (v4u){0u, 0u, 0u, 0u}; vx[j] = (v4u){0u, 0u, 0u, 0u}; } }
        float kf[32]; float ss = 0.f;
#pragma unroll
        for (int j = 0; j < 4; ++j) { kf[8 * j + 0] = bflo(kx[j].x); kf[8 * j + 1] = bfhi(kx[j].x); kf[8 * j + 2] = bflo(kx[j].y); kf[8 * j + 3] = bfhi(kx[j].y); kf[8 * j + 4] = bflo(kx[j].z); kf[8 * j + 5] = bfhi(kx[j].z); kf[8 * j + 6] = bflo(kx[j].w); kf[8 * j + 7] = bfhi(kx[j].w); }
#pragma unroll
        for (int i = 0; i < 32; ++i) ss += kf[i] * kf[i];
        ss += __shfl_xor(ss, 1);
        const float rstd = 1.0f / sqrtf(ss * (1.0f / 64.0f) + EPS);
        const float* gk = F.in[IN_GKN] + l * 64 + hf * 32;
#pragma unroll
        for (int j = 0; j < 4; ++j) { const f32x4 g0 = *(const f32x4*)(gk + 8 * j), g1 = *(const f32x4*)(gk + 8 * j + 4);
            v4u o; o.x = pk2(kf[8 * j] * rstd * g0.x, kf[8 * j + 1] * rstd * g0.y); o.y = pk2(kf[8 * j + 2] * rstd * g0.z, kf[8 * j + 3] * rstd * g0.w);
            o.z = pk2(kf[8 * j + 4] * rstd * g1.x, kf[8 * j + 5] * rstd * g1.y); o.w = pk2(kf[8 * j + 6] * rstd * g1.z, kf[8 * j + 7] * rstd * g1.w);
            *(LAS v4u*)(Kt + r * LDB + hf * 64 + 16 * j) = o; *(LAS v4u*)(Vt + r * LDB + hf * 64 + 16 * j) = vx[j]; }
    }
    for (int i = tid; i < 1024; i += NWAVES * 64) bias[i] = F.in[IN_RELB][T5_BUCKET[i & 127] * 16 + kvh * 8 + (i >> 7)];
    __syncthreads();
    const int hq = kvh * 8 + w;
    const float sink = F.in[IN_SINKS][l * 16 + hq];
    const float* gq = F.in[IN_GQN] + l * 64;
    const f32x4 gq0 = *(const f32x4*)(gq + 8 * g), gq1 = *(const f32x4*)(gq + 8 * g + 4), gq2 = *(const f32x4*)(gq + 32 + 8 * g), gq3 = *(const f32x4*)(gq + 32 + 8 * g + 4);
    const LAS float* bw = bias + w * 128;
    for (int qb = 0; qb < 4; ++qb) {
        const int j0 = qb * 32;
        bf16x8 qf[2][2];
#pragma unroll
        for (int jt = 0; jt < 2; ++jt) {
            const bf16* qp = proj + (size_t)(b * SEQ + nb * 128 + j0 + jt * 16 + n) * PROJ_LD + C_AQ + hq * 64;
            const v4u x0 = *(const v4u*)(qp + 8 * g), x1 = *(const v4u*)(qp + 32 + 8 * g);
            float f[16] = {bflo(x0.x), bfhi(x0.x), bflo(x0.y), bfhi(x0.y), bflo(x0.z), bfhi(x0.z), bflo(x0.w), bfhi(x0.w), bflo(x1.x), bfhi(x1.x), bflo(x1.y), bfhi(x1.y), bflo(x1.z), bfhi(x1.z), bflo(x1.w), bfhi(x1.w)};
            float ss = 0.f;
#pragma unroll
            for (int i = 0; i < 16; ++i) ss += f[i] * f[i];
            ss += __shfl_xor(ss, 16); ss += __shfl_xor(ss, 32);
            const float rs = 0.125f / sqrtf(ss * (1.0f / 64.0f) + EPS);
            qf[jt][0] = pack8(f[0] * rs * gq0.x, f[1] * rs * gq0.y, f[2] * rs * gq0.z, f[3] * rs * gq0.w, f[4] * rs * gq1.x, f[5] * rs * gq1.y, f[6] * rs * gq1.z, f[7] * rs * gq1.w);
            qf[jt][1] = pack8(f[8] * rs * gq2.x, f[9] * rs * gq2.y, f[10] * rs * gq2.z, f[11] * rs * gq2.w, f[12] * rs * gq3.x, f[13] * rs * gq3.y, f[14] * rs * gq3.z, f[15] * rs * gq3.w);
        }
        f32x4 sc[2][10];
#pragma unroll
        for (int i = 0; i < 10; ++i) { const int kt = 2 * qb + i;
            const bf16x8 k0 = frag_row(Kt, LDB, 16 * kt, 0, lane), k1 = frag_row(Kt, LDB, 16 * kt, 32, lane);
#pragma unroll
            for (int jt = 0; jt < 2; ++jt) { f32x4 a = (f32x4){0.f, 0.f, 0.f, 0.f}; a = MFMA16(k0, qf[jt][0], a); a = MFMA16(k1, qf[jt][1], a); sc[jt][i] = a; } }
        float inv[2];
#pragma unroll
        for (int jt = 0; jt < 2; ++jt) { const int j = j0 + 16 * jt + n; float mx = sink;
#pragma unroll
            for (int i = 0; i < 10; ++i)
#pragma unroll
                for (int r = 0; r < 4; ++r) { const int s = 16 * (2 * qb + i) + 4 * g + r, dist = j + 128 - s; const bool ok = (dist >= 0) && (dist < 128) && (nb > 0 || s >= 128);
                    const float v = ok ? sc[jt][i][r] + bw[dist & 127] : -INFINITY; sc[jt][i][r] = v; mx = fmaxf(mx, v); }
            mx = fmaxf(mx, __shfl_xor(mx, 16)); mx = fmaxf(mx, __shfl_xor(mx, 32));
            float sum = 0.f;
#pragma unroll
            for (int i = 0; i < 10; ++i)
#pragma unroll
                for (int r = 0; r < 4; ++r) { const float p = __expf(sc[jt][i][r] - mx); sc[jt][i][r] = p; sum += p; }
            sum += __shfl_xor(sum, 16); sum += __shfl_xor(sum, 32);
            inv[jt] = 1.0f / (sum + __expf(sink - mx)); }
        f32x4 o[4][2];
#pragma unroll
        for (int dt = 0; dt < 4; ++dt) { o[dt][0] = (f32x4){0.f, 0.f, 0.f, 0.f}; o[dt][1] = (f32x4){0.f, 0.f, 0.f, 0.f}; }
#pragma unroll
        for (int kk = 0; kk < 5; ++kk) { bf16x8 pf[2];
#pragma unroll
            for (int jt = 0; jt < 2; ++jt) pf[jt] = pack8(sc[jt][2 * kk][0], sc[jt][2 * kk][1], sc[jt][2 * kk][2], sc[jt][2 * kk][3], sc[jt][2 * kk + 1][0], sc[jt][2 * kk + 1][1], sc[jt][2 * kk + 1][2], sc[jt][2 * kk + 1][3]);
            const int ra = 16 * (2 * qb + 2 * kk);
#pragma unroll
            for (int dt = 0; dt < 4; ++dt) { const bf16x8 a = frag_tr2(Vt, LDB, ra, ra + 16, 16 * dt, lane);
                o[dt][0] = MFMA16(a, pf[0], o[dt][0]); o[dt][1] = MFMA16(a, pf[1], o[dt][1]); } }
#pragma unroll
        for (int jt = 0; jt < 2; ++jt) { bf16* yp = Y + (size_t)(b * SEQ + nb * 128 + j0 + 16 * jt + n) * DM + 1024 + hq * 64 + 4 * g;
#pragma unroll
            for (int dt = 0; dt < 4; ++dt) { v2u wv; wv.x = pk2(o[dt][jt][0] * inv[jt], o[dt][jt][1] * inv[jt]); wv.y = pk2(o[dt][jt][2] * inv[jt], o[dt][jt][3] * inv[jt]); *(v2u*)(yp + 16 * dt) = wv; } }
    }
}

__device__ __forceinline__ void gla_u_unit(Frame& F, int l, int u) {
    const int b = u >> 7, h = (u >> 5) & 3, c = u & 31, t0 = b * SEQ + 64 * c;
    const int tid = F.tid, lane = F.lane, w = F.wave, g = lane >> 4, n = lane & 15;
    const bf16* proj = (const bf16*)(F.ws + WS_PROJ); const float* side = (const float*)(F.ws + WS_SIDE);
    bf16* QT = (bf16*)(F.ws + WS_GAUX); bf16* QP = QT + (size_t)M * 256; bf16* KT = QP + (size_t)M * 256; float* BL = (float*)(KT + (size_t)M * 256); float* UG = (float*)(F.ws + WS_UG);
    LAS float* LAm = (LAS float*)(F.lds + RING_OFF);
    LAS unsigned char* KP = F.lds + RING_OFF + 16640;
    LAS unsigned char* VT = F.lds + RING_OFF + 25856;
    __syncthreads();
    const int s = tid >> 3, kg = tid & 7;
    {
        const float* wd = F.in[IN_WDEC] + l * 16 * 256 + h * 64 + 8 * kg; const float* bd = F.in[IN_BDEC] + l * 256 + h * 64 + 8 * kg;
        f32x4 z0 = *(const f32x4*)(bd), z1 = *(const f32x4*)(bd + 4);
        const f32x4* gp = (const f32x4*)(side + (size_t)(t0 + s) * 32 + 8);
        const f32x4 g0 = gp[0], g1 = gp[1], g2 = gp[2], g3 = gp[3];
        const float ga[16] = {g0.x, g0.y, g0.z, g0.w, g1.x, g1.y, g1.z, g1.w, g2.x, g2.y, g2.z, g2.w, g3.x, g3.y, g3.z, g3.w};
#pragma unroll
        for (int r = 0; r < 16; ++r) { z0 += *(const f32x4*)(wd + r * 256) * ga[r]; z1 += *(const f32x4*)(wd + r * 256 + 4) * ga[r]; }
        LAS float* lp = LAm + s * 65 + 8 * kg;
        lp[0] = logsigmoidf_(z0.x) * 0.0625f; lp[1] = logsigmoidf_(z0.y) * 0.0625f; lp[2] = logsigmoidf_(z0.z) * 0.0625f; lp[3] = logsigmoidf_(z0.w) * 0.0625f;
        lp[4] = logsigmoidf_(z1.x) * 0.0625f; lp[5] = logsigmoidf_(z1.y) * 0.0625f; lp[6] = logsigmoidf_(z1.z) * 0.0625f; lp[7] = logsigmoidf_(z1.w) * 0.0625f;
        const bf16* vp = proj + (size_t)(t0 + s) * PROJ_LD + C_GV + h * 128 + 16 * kg;
        *(LAS v4u*)(VT + s * 272 + 32 * kg) = *(const v4u*)(vp); *(LAS v4u*)(VT + s * 272 + 32 * kg + 16) = *(const v4u*)(vp + 8);
    }
    __syncthreads();
#pragma unroll
    for (int ci = 0; ci < 8; ++ci) { const int k = 8 * w + ci; const float v = scan_add(LAm[lane * 65 + k], lane); LAm[lane * 65 + k] = v; }
    __syncthreads();
    {
        const bf16* kp = proj + (size_t)(t0 + s) * PROJ_LD + C_GK + h * 64 + 8 * kg; const bf16* qp = proj + (size_t)(t0 + s) * PROJ_LD + C_GQ + h * 64 + 8 * kg;
        const v4u kx = *(const v4u*)kp, qx = *(const v4u*)qp;
        const float kf[8] = {bflo(kx.x), bfhi(kx.x), bflo(kx.y), bfhi(kx.y), bflo(kx.z), bfhi(kx.z), bflo(kx.w), bfhi(kx.w)};
        const float qf[8] = {bflo(qx.x), bfhi(qx.x), bflo(qx.y), bfhi(qx.y), bflo(qx.z), bfhi(qx.z), bflo(qx.w), bfhi(qx.w)};
        float o1[8], o2[8], o3[8], o4[8];
#pragma unroll
        for (int i = 0; i < 8; ++i) { const float bb = LAm[s * 65 + 8 * kg + i], bl = LAm[63 * 65 + 8 * kg + i], br = LAm[31 * 65 + 8 * kg + i];
            o1[i] = kf[i] * __expf(bl - bb); o2[i] = qf[i] * 0.125f * __expf(bb - br); o3[i] = qf[i] * 0.125f * __expf(bb); o4[i] = kf[i] * __expf(br - bb);
            if (s == 63) BL[(size_t)u * 64 + 8 * kg + i] = bl; }
        v4u o; o.x = pk2(o1[0], o1[1]); o.y = pk2(o1[2], o1[3]); o.z = pk2(o1[4], o1[5]); o.w = pk2(o1[6], o1[7]); *(LAS v4u*)(KP + s * 144 + 16 * kg) = o;
        const size_t go = (size_t)(t0 + s) * 256 + h * 64 + 8 * kg;
        o.x = pk2(o2[0], o2[1]); o.y = pk2(o2[2], o2[3]); o.z = pk2(o2[4], o2[5]); o.w = pk2(o2[6], o2[7]); *(v4u*)(QT + go) = o;
        o.x = pk2(o3[0], o3[1]); o.y = pk2(o3[2], o3[3]); o.z = pk2(o3[4], o3[5]); o.w = pk2(o3[6], o3[7]); *(v4u*)(QP + go) = o;
        o.x = pk2(o4[0], o4[1]); o.y = pk2(o4[2], o4[3]); o.z = pk2(o4[4], o4[5]); o.w = pk2(o4[6], o4[7]); *(v4u*)(KT + go) = o;
    }
    __syncthreads();
    {
        f32x4 acc[4];
#pragma unroll
        for (int mt = 0; mt < 4; ++mt) acc[mt] = (f32x4){0.f, 0.f, 0.f, 0.f};
#pragma unroll
        for (int ks = 0; ks < 2; ++ks) { const bf16x8 bv = frag_tr(VT, 272, 32 * ks, 16 * w, lane);
#pragma unroll
            for (int mt = 0; mt < 4; ++mt) { const bf16x8 a = frag_tr(KP, 144, 32 * ks, 16 * mt, lane); acc[mt] = MFMA16(a, bv, acc[mt]); } }
        float* up = UG + (size_t)u * 64 * 128 + 16 * w + n;
#pragma unroll
        for (int mt = 0; mt < 4; ++mt)
#pragma unroll
            for (int r = 0; r < 4; ++r) up[(size_t)(16 * mt + 4 * g + r) * 128] = acc[mt][r];
    }
}
__device__ __forceinline__ void gla_out_group(Frame& F, int l, int ug) {
    const int bh = ug >> 3, jj = ug & 7, b = bh >> 2, h = bh & 3;
    const int tid = F.tid, lane = F.lane, w = F.wave, g = lane >> 4, n = lane & 15;
    const bf16* proj = (const bf16*)(F.ws + WS_PROJ); bf16* Y = (bf16*)(F.ws + WS_Y);
    const bf16* QT = (const bf16*)(F.ws + WS_GAUX); const bf16* QP = QT + (size_t)M * 256; const bf16* KT = QP + (size_t)M * 256; const float* BL = (const float*)(KT + (size_t)M * 256); const float* UG = (const float*)(F.ws + WS_UG);
    LAS unsigned char* LQT = F.lds + RING_OFF; LAS unsigned char* LQP = LQT + 9216; LAS unsigned char* LKT = LQT + 18432; LAS unsigned char* VT = LQT + 27648; LAS unsigned char* ST = LQT + 45056;
    LAS float* SS = (LAS float*)(LQT + 62464);
    float S[16];
#pragma unroll
    for (int i = 0; i < 16; ++i) S[i] = 0.f;
    const int sk = tid >> 3, sv = (tid & 7) * 16;
    int cdone = 0;
    const float* gout = F.in[IN_GOUTG] + l * 512 + h * 128;
    for (int oi = 0; oi < 4; ++oi) {
        const int c = oi == 0 ? jj : (oi == 1 ? 15 - jj : (oi == 2 ? 16 + jj : 31 - jj));
        for (; cdone < c; ++cdone) { const int uu = bh * 32 + cdone; const float dec = __expf(BL[(size_t)uu * 64 + sk]);
            const f32x4* up = (const f32x4*)(UG + (size_t)uu * 64 * 128 + sk * 128 + sv);
#pragma unroll
            for (int q = 0; q < 4; ++q) { const f32x4 x = up[q]; S[4 * q] = dec * S[4 * q] + x.x; S[4 * q + 1] = dec * S[4 * q + 1] + x.y; S[4 * q + 2] = dec * S[4 * q + 2] + x.z; S[4 * q + 3] = dec * S[4 * q + 3] + x.w; } }
        const int t0 = b * SEQ + 64 * c;
        __syncthreads();
        {
            v4u o; o.x = pk2(S[0], S[1]); o.y = pk2(S[2], S[3]); o.z = pk2(S[4], S[5]); o.w = pk2(S[6], S[7]); *(LAS v4u*)(ST + sk * 272 + sv * 2) = o;
            o.x = pk2(S[8], S[9]); o.y = pk2(S[10], S[11]); o.z = pk2(S[12], S[13]); o.w = pk2(S[14], S[15]); *(LAS v4u*)(ST + sk * 272 + sv * 2 + 16) = o;
            const int s = tid >> 3, kg = tid & 7; const size_t go = (size_t)(t0 + s) * 256 + h * 64 + 8 * kg;
            *(LAS v4u*)(LQT + s * 144 + 16 * kg) = *(const v4u*)(QT + go); *(LAS v4u*)(LQP + s * 144 + 16 * kg) = *(const v4u*)(QP + go); *(LAS v4u*)(LKT + s * 144 + 16 * kg) = *(const v4u*)(KT + go);
            const bf16* vp = proj + (size_t)(t0 + s) * PROJ_LD + C_GV + h * 128 + 16 * kg;
            *(LAS v4u*)(VT + s * 272 + 32 * kg) = *(const v4u*)(vp); *(LAS v4u*)(VT + s * 272 + 32 * kg + 16) = *(const v4u*)(vp + 8);
        }
        __syncthreads();
        const int jt = w & 3, vh = w >> 2;
        bf16x8 qf[2], qpf[2];
#pragma unroll
        for (int ks = 0; ks < 2; ++ks) { qf[ks] = frag_row(LQT, 144, 16 * jt, 32 * ks, lane); qpf[ks] = frag_row(LQP, 144, 16 * jt, 32 * ks, lane); }
        f32x4 at[4];
#pragma unroll
        for (int st = 0; st < 4; ++st) { at[st] = (f32x4){0.f, 0.f, 0.f, 0.f};
            if (st <= jt) {
#pragma unroll
                for (int ks = 0; ks < 2; ++ks) at[st] = MFMA16(frag_row(LKT, 144, 16 * st, 32 * ks, lane), qf[ks], at[st]);
                if (st == jt) {
#pragma unroll
                    for (int r = 0; r < 4; ++r) if (4 * g + r > n) at[st][r] = 0.f; } } }
        f32x4 o[4];
#pragma unroll
        for (int mt = 0; mt < 4; ++mt) { o[mt] = (f32x4){0.f, 0.f, 0.f, 0.f};
#pragma unroll
            for (int ks = 0; ks < 2; ++ks) o[mt] = MFMA16(frag_tr(ST, 272, 32 * ks, 64 * vh + 16 * mt, lane), qpf[ks], o[mt]); }
#pragma unroll
        for (int kk = 0; kk < 2; ++kk) { if (2 * kk <= jt) {
            const bf16x8 pf = pack8(at[2 * kk][0], at[2 * kk][1], at[2 * kk][2], at[2 * kk][3], at[2 * kk + 1][0], at[2 * kk + 1][1], at[2 * kk + 1][2], at[2 * kk + 1][3]);
#pragma unroll
            for (int mt = 0; mt < 4; ++mt) o[mt] = MFMA16(frag_tr2(VT, 272, 32 * kk, 32 * kk + 16, 64 * vh + 16 * mt, lane), pf, o[mt]); } }
        float ss = 0.f;
#pragma unroll
        for (int mt = 0; mt < 4; ++mt)
#pragma unroll
            for (int r = 0; r < 4; ++r) ss += o[mt][r] * o[mt][r];
        ss += __shfl_xor(ss, 16); ss += __shfl_xor(ss, 32);
        if (g == 0) SS[w * 16 + n] = ss;
        __syncthreads();
        const float rstd = 1.0f / sqrtf((SS[w * 16 + n] + SS[(w ^ 4) * 16 + n]) * (1.0f / 128.0f) + EPS);
        const size_t row = (size_t)(t0 + 16 * jt + n);
#pragma unroll
        for (int mt = 0; mt < 4; ++mt) { const int v = 64 * vh + 16 * mt + 4 * g;
            const f32x4 go4 = *(const f32x4*)(gout + v); const v2u gx = *(const v2u*)(proj + row * PROJ_LD + C_GG + h * 128 + v);
            v2u wv; wv.x = pk2(o[mt][0] * rstd * go4.x * siluf_(bflo(gx.x)), o[mt][1] * rstd * go4.y * siluf_(bfhi(gx.x))); wv.y = pk2(o[mt][2] * rstd * go4.z * siluf_(bflo(gx.y)), o[mt][3] * rstd * go4.w * siluf_(bfhi(gx.y)));
            *(v2u*)(Y + row * DM + 512 + h * 128 + v) = wv; }
    }
}

__device__ __forceinline__ void mlstm_u_unit(Frame& F, int l, int u) {
    const int b = u >> 6, h = (u >> 4) & 3, c = u & 15, t0 = b * SEQ + 128 * c;
    const int tid = F.tid, lane = F.lane, w = F.wave, g = lane >> 4, n = lane & 15;
    const bf16* proj = (const bf16*)(F.ws + WS_PROJ); const float* side = (const float*)(F.ws + WS_SIDE); bf16* qkc = (bf16*)(F.ws + WS_QKC);
    float* UM = (float*)(F.ws + WS_UM); float* MS = UM + (size_t)512 * 136 * 64;
    LAS unsigned char* KP = F.lds + RING_OFF;
    LAS unsigned char* VT = F.lds + RING_OFF + 18432;
    LAS float* GF = (LAS float*)(F.lds + RING_OFF + 53248);
    __syncthreads();
    const int s = tid >> 2, qd = tid & 3;
    float kc[16];
    {
        const float* wc = F.in[IN_WCONV] + l * 4 * 512; const float* bc = F.in[IN_BCONV] + l * 512;
        const int pos = 128 * c + s;
#pragma unroll
        for (int part = 0; part < 2; ++part) { const int ch = part * 256 + h * 64 + 16 * qd; float y[16];
#pragma unroll
            for (int q4 = 0; q4 < 4; ++q4) { const f32x4 bb = *(const f32x4*)(bc + ch + 4 * q4); y[4 * q4] = bb.x; y[4 * q4 + 1] = bb.y; y[4 * q4 + 2] = bb.z; y[4 * q4 + 3] = bb.w; }
#pragma unroll
            for (int i = 0; i < 4; ++i) { if (pos - 3 + i >= 0) { const bf16* xp = proj + (size_t)(t0 + s - 3 + i) * PROJ_LD + ch; const v4u x0 = *(const v4u*)xp, x1 = *(const v4u*)(xp + 8);
                const float xf[16] = {bflo(x0.x), bfhi(x0.x), bflo(x0.y), bfhi(x0.y), bflo(x0.z), bfhi(x0.z), bflo(x0.w), bfhi(x0.w), bflo(x1.x), bfhi(x1.x), bflo(x1.y), bfhi(x1.y), bflo(x1.z), bfhi(x1.z), bflo(x1.w), bfhi(x1.w)};
#pragma unroll
                for (int q4 = 0; q4 < 4; ++q4) { const f32x4 ww = *(const f32x4*)(wc + i * 512 + ch + 4 * q4); y[4 * q4] += ww.x * xf[4 * q4]; y[4 * q4 + 1] += ww.y * xf[4 * q4 + 1]; y[4 * q4 + 2] += ww.z * xf[4 * q4 + 2]; y[4 * q4 + 3] += ww.w * xf[4 * q4 + 3]; } } }
            const float scl = part ? 0.125f : 1.0f;
#pragma unroll
            for (int i = 0; i < 16; ++i) y[i] = siluf_(y[i]) * scl;
            v4u o0, o1; o0.x = pk2(y[0], y[1]); o0.y = pk2(y[2], y[3]); o0.z = pk2(y[4], y[5]); o0.w = pk2(y[6], y[7]); o1.x = pk2(y[8], y[9]); o1.y = pk2(y[10], y[11]); o1.z = pk2(y[12], y[13]); o1.w = pk2(y[14], y[15]);
            *(v4u*)(qkc + (size_t)(t0 + s) * 512 + ch) = o0; *(v4u*)(qkc + (size_t)(t0 + s) * 512 + ch + 8) = o1;
            if (part) {
#pragma unroll
                for (int i = 0; i < 16; ++i) kc[i] = y[i]; } }
        const bf16* vp = proj + (size_t)(t0 + s) * PROJ_LD + C_MV + h * 128 + 32 * qd;
#pragma unroll
        for (int j = 0; j < 4; ++j) *(LAS v4u*)(VT + s * 272 + 64 * qd + 16 * j) = *(const v4u*)(vp + 8 * j);
        if (tid < 128) { GF[tid] = logsigmoidf_(side[(size_t)(t0 + tid) * 32 + 4 + h] + F.in[IN_BGATES][l * 8 + 4 + h]); GF[128 + tid] = side[(size_t)(t0 + tid) * 32 + h] + F.in[IN_BGATES][l * 8 + h]; }
    }
    __syncthreads();
    if (w == 0) {
        const float a0 = GF[2 * lane], a1 = GF[2 * lane + 1]; const float P = scan_add(a0 + a1, lane);
        const float blast = __shfl(P, 63);
        const float lw0 = blast - (P - a1) + GF[128 + 2 * lane], lw1 = blast - P + GF[128 + 2 * lane + 1];
        float mx = fmaxf(lw0, lw1);
#pragma unroll
        for (int o = 1; o < 64; o <<= 1) mx = fmaxf(mx, __shfl_xor(mx, o));
        GF[256 + 2 * lane] = expf(lw0 - mx); GF[256 + 2 * lane + 1] = expf(lw1 - mx);
        if (lane == 0) { MS[(size_t)u * 2] = blast; MS[(size_t)u * 2 + 1] = mx; }
    }
    __syncthreads();
    {   const float wg = GF[256 + s];
        v4u o0, o1; o0.x = pk2(kc[0] * wg, kc[1] * wg); o0.y = pk2(kc[2] * wg, kc[3] * wg); o0.z = pk2(kc[4] * wg, kc[5] * wg); o0.w = pk2(kc[6] * wg, kc[7] * wg);
        o1.x = pk2(kc[8] * wg, kc[9] * wg); o1.y = pk2(kc[10] * wg, kc[11] * wg); o1.z = pk2(kc[12] * wg, kc[13] * wg); o1.w = pk2(kc[14] * wg, kc[15] * wg);
        *(LAS v4u*)(KP + s * 144 + 32 * qd) = o0; *(LAS v4u*)(KP + s * 144 + 32 * qd + 16) = o1; }
    __syncthreads();
    {
        const int nt = w & 3, m0 = w >> 2;
        f32x4 acc[5];
#pragma unroll
        for (int i = 0; i < 5; ++i) acc[i] = (f32x4){0.f, 0.f, 0.f, 0.f};
        const bf16x8 ones = (n == 0) ? pack8(1.f, 1.f, 1.f, 1.f, 1.f, 1.f, 1.f, 1.f) : pack8(0.f, 0.f, 0.f, 0.f, 0.f, 0.f, 0.f, 0.f);
#pragma unroll
        for (int ks = 0; ks < 4; ++ks) { const bf16x8 bv = frag_tr(KP, 144, 32 * ks, 16 * nt, lane);
#pragma unroll
            for (int i = 0; i < 4; ++i) acc[i] = MFMA16(frag_tr(VT, 272, 32 * ks, 16 * (m0 + 2 * i), lane), bv, acc[i]);
            if (m0 == 0) acc[4] = MFMA16(ones, bv, acc[4]); }
        float* up = UM + (size_t)u * 136 * 64 + 16 * nt + n;
#pragma unroll
        for (int i = 0; i < 4; ++i)
#pragma unroll
            for (int r = 0; r < 4; ++r) up[(size_t)(16 * (m0 + 2 * i) + 4 * g + r) * 64] = acc[i][r];
        if (m0 == 0 && g == 0) up[(size_t)128 * 64] = acc[4][0];
    }
}
__device__ __forceinline__ void mlstm_out_group(Frame& F, int l, int ug) {
    const int bh = ug >> 3, jj = ug & 7, b = bh >> 2, h = bh & 3;
    const int tid = F.tid, lane = F.lane, w = F.wave, g = lane >> 4, n = lane & 15;
    const bf16* proj = (const bf16*)(F.ws + WS_PROJ); const float* side = (const float*)(F.ws + WS_SIDE); const bf16* qkc = (const bf16*)(F.ws + WS_QKC); bf16* Y = (bf16*)(F.ws + WS_Y);
    const float* UM = (const float*)(F.ws + WS_UM); const float* MS = UM + (size_t)512 * 136 * 64;
    LAS unsigned char* QC = F.lds + RING_OFF; LAS unsigned char* KC = QC + 18432; LAS unsigned char* VT = QC + 36864; LAS unsigned char* CS = QC + 71680;
    LAS float* GF = (LAS float*)(QC + 92416);
    float C[16], nn = 0.f, mst = 0.f;
#pragma unroll
    for (int i = 0; i < 16; ++i) C[i] = 0.f;
    const int cv = tid >> 2, ck = (tid & 3) * 16;
    int cdone = 0;
    const float* gout = F.in[IN_GOUTM] + l * 512 + h * 128;
    for (int oi = 0; oi < 2; ++oi) {
        const int c = oi == 0 ? jj : 15 - jj;
        for (; cdone < c; ++cdone) { const int uu = bh * 16 + cdone; const float Bc = MS[(size_t)uu * 2], ml = MS[(size_t)uu * 2 + 1];
            const float mn = fmaxf(Bc + mst, ml), d1 = expf(Bc + mst - mn), d2 = expf(ml - mn); mst = mn;
            const f32x4* up = (const f32x4*)(UM + (size_t)uu * 136 * 64 + cv * 64 + ck);
#pragma unroll
            for (int q = 0; q < 4; ++q) { const f32x4 x = up[q]; C[4 * q] = d1 * C[4 * q] + d2 * x.x; C[4 * q + 1] = d1 * C[4 * q + 1] + d2 * x.y; C[4 * q + 2] = d1 * C[4 * q + 2] + d2 * x.z; C[4 * q + 3] = d1 * C[4 * q + 3] + d2 * x.w; }
            if (tid < 64) nn = d1 * nn + d2 * UM[(size_t)uu * 136 * 64 + 128 * 64 + tid]; }
        const int t0 = b * SEQ + 128 * c;
        __syncthreads();
        {
            v4u o; o.x = pk2(C[0], C[1]); o.y = pk2(C[2], C[3]); o.z = pk2(C[4], C[5]); o.w = pk2(C[6], C[7]); *(LAS v4u*)(CS + cv * 144 + ck * 2) = o;
            o.x = pk2(C[8], C[9]); o.y = pk2(C[10], C[11]); o.z = pk2(C[12], C[13]); o.w = pk2(C[14], C[15]); *(LAS v4u*)(CS + cv * 144 + ck * 2 + 16) = o;
            if (tid < 64) *(LAS bf16*)(CS + 128 * 144 + tid * 2) = (bf16)f2bf(nn);
            for (int i = tid; i < 15 * 72; i += NWAVES * 64) *(LAS bf16*)(CS + 129 * 144 + i * 2) = (bf16)0;
            const int s = tid >> 2, qd = tid & 3;
            const bf16* qp = qkc + (size_t)(t0 + s) * 512 + h * 64 + 16 * qd;
            *(LAS v4u*)(QC + s * 144 + 32 * qd) = *(const v4u*)qp; *(LAS v4u*)(QC + s * 144 + 32 * qd + 16) = *(const v4u*)(qp + 8);
            *(LAS v4u*)(KC + s * 144 + 32 * qd) = *(const v4u*)(qp + 256); *(LAS v4u*)(KC + s * 144 + 32 * qd + 16) = *(const v4u*)(qp + 256 + 8);
            const bf16* vp = proj + (size_t)(t0 + s) * PROJ_LD + C_MV + h * 128 + 32 * qd;
#pragma unroll
            for (int j = 0; j < 4; ++j) *(LAS v4u*)(VT + s * 272 + 64 * qd + 16 * j) = *(const v4u*)(vp + 8 * j);
            if (tid < 128) { GF[tid] = logsigmoidf_(side[(size_t)(t0 + tid) * 32 + 4 + h] + F.in[IN_BGATES][l * 8 + 4 + h]); GF[128 + tid] = side[(size_t)(t0 + tid) * 32 + h] + F.in[IN_BGATES][l * 8 + h]; }
        }
        __syncthreads();
        if (w == 0) {
            const float a0 = GF[2 * lane], a1 = GF[2 * lane + 1]; const float P = scan_add(a0 + a1, lane);
            const float b0 = P - a1, b1 = P; const float x0 = GF[128 + 2 * lane] - b0, x1 = GF[128 + 2 * lane + 1] - b1;
            const float cm = scan_max(fmaxf(x0, x1), lane);
            float prev = __shfl_up(cm, 1); if (lane == 0) prev = -INFINITY;
            const float M0 = fmaxf(mst, fmaxf(prev, x0)), M1 = fmaxf(mst, cm);
            GF[2 * lane] = x0; GF[2 * lane + 1] = x1; GF[128 + 2 * lane] = M0; GF[128 + 2 * lane + 1] = M1; GF[256 + 2 * lane] = b0; GF[256 + 2 * lane + 1] = b1;
        }
        __syncthreads();
        {
            const int j = 16 * w + n; const float Mj = GF[128 + j], bj = GF[256 + j];
            bf16x8 qf[2];
#pragma unroll
            for (int ks = 0; ks < 2; ++ks) qf[ks] = frag_row(QC, 144, 16 * w, 32 * ks, lane);
            f32x4 p[8];
#pragma unroll
            for (int st = 0; st < 8; ++st) { p[st] = (f32x4){0.f, 0.f, 0.f, 0.f};
                if (st <= w) {
#pragma unroll
                    for (int ks = 0; ks < 2; ++ks) p[st] = MFMA16(frag_row(KC, 144, 16 * st, 32 * ks, lane), qf[ks], p[st]);
                    const f32x4 as = *(const LAS f32x4*)(GF + 16 * st + 4 * g);
#pragma unroll
                    for (int r = 0; r < 4; ++r) { const float e = __expf(as[r] - Mj); p[st][r] = (st < w || 4 * g + r <= n) ? p[st][r] * e : 0.f; } } }
            f32x4 o[9];
            const float wi = __expf(mst - Mj);
#pragma unroll
            for (int mt = 0; mt < 9; ++mt) { o[mt] = (f32x4){0.f, 0.f, 0.f, 0.f};
#pragma unroll
                for (int ks = 0; ks < 2; ++ks) o[mt] = MFMA16(frag_row(CS, 144, 16 * mt, 32 * ks, lane), qf[ks], o[mt]);
                o[mt] = o[mt] * wi; }
            const bf16x8 ones = (n == 0) ? pack8(1.f, 1.f, 1.f, 1.f, 1.f, 1.f, 1.f, 1.f) : pack8(0.f, 0.f, 0.f, 0.f, 0.f, 0.f, 0.f, 0.f);
#pragma unroll
            for (int kk = 0; kk < 4; ++kk) { if (2 * kk <= w) {
                const bf16x8 pf = pack8(p[2 * kk][0], p[2 * kk][1], p[2 * kk][2], p[2 * kk][3], p[2 * kk + 1][0], p[2 * kk + 1][1], p[2 * kk + 1][2], p[2 * kk + 1][3]);
#pragma unroll
                for (int mt = 0; mt < 8; ++mt) o[mt] = MFMA16(frag_tr2(VT, 272, 32 * kk, 32 * kk + 16, 16 * mt, lane), pf, o[mt]);
                o[8] = MFMA16(ones, pf, o[8]); } }
            const float den = __shfl(o[8][0], n);
            const float dn = 1.0f / fmaxf(fabsf(den), __expf(-(bj + Mj)));
            float ss = 0.f;
#pragma unroll
            for (int mt = 0; mt < 8; ++mt)
#pragma unroll
                for (int r = 0; r < 4; ++r) { o[mt][r] *= dn; ss += o[mt][r] * o[mt][r]; }
            ss += __shfl_xor(ss, 16); ss += __shfl_xor(ss, 32);
            const float rstd = 1.0f / sqrtf(ss * (1.0f / 128.0f) + EPS);
            const size_t row = (size_t)(t0 + j);
#pragma unroll
            for (int mt = 0; mt < 8; ++mt) { const int v = 16 * mt + 4 * g;
                const f32x4 go4 = *(const f32x4*)(gout + v); const v2u mx = *(const v2u*)(proj + row * PROJ_LD + C_MO + h * 128 + v);
                v2u wv; wv.x = pk2(o[mt][0] * rstd * go4.x * sigmoidf_(bflo(mx.x)), o[mt][1] * rstd * go4.y * sigmoidf_(bfhi(mx.x))); wv.y = pk2(o[mt][2] * rstd * go4.z * sigmoidf_(bflo(mx.y)), o[mt][3] * rstd * go4.w * sigmoidf_(bfhi(mx.y)));
                *(v2u*)(Y + row * DM + h * 128 + v) = wv; }
        }
    }
}

__device__ __forceinline__ void mix_a(Frame& F, int l) {
    if (!(FAST_GLA && FAST_MLSTM && FAST_SWA)) mix_prep(F, l);
    if (FAST_SWA) for (int u = F.vcu; u < 256; u += F.G) swa_unit(F, l, u);
    if (FAST_MLSTM) for (int u = F.vcu; u < 512; u += F.G) mlstm_u_unit(F, l, u);
    if (FAST_GLA) for (int u = F.vcu; u < 1024; u += F.G) gla_u_unit(F, l, u);
}
__device__ __forceinline__ void mix_b(Frame& F, int l) {
    if (!(FAST_GLA && FAST_MLSTM && FAST_SWA)) mix_naive(F, l);
    if (FAST_MLSTM) for (int ug = F.vcu; ug < 256; ug += F.G) mlstm_out_group(F, l, ug);
    if (FAST_GLA) for (int ug = F.vcu; ug < 256; ug += F.G) gla_out_group(F, l, ug);
}

#ifndef PROBE_REPEAT
#define PROBE_REPEAT -1
#endif
#ifndef MK_ONE_LAUNCH
#define MK_ONE_LAUNCH 1
#endif
constexpr int NPH = 19;
struct Args { const float* in[26]; float* out; unsigned char* ws; int ph_lo, ph_hi; };
__global__ void __launch_bounds__(NWAVES * 64, 2) hybrid_fwd(Args args) {
    extern __shared__ __attribute__((aligned(16))) unsigned char lds[];
    Frame F;
    F.lds = (LAS unsigned char*)lds;
    F.tid = threadIdx.x; F.lane = F.tid & 63; F.wave = __builtin_amdgcn_readfirstlane(F.tid >> 6);
    F.G = gridDim.x; { const int bx = blockIdx.x; F.vcu = (F.G % 8 == 0) ? (bx % 8) * (F.G / 8) + bx / 8 : bx; }
    F.ws = args.ws; F.out = args.out; F.ctl = (gu32*)(args.ws + WS_CTL);
    F.in = (cfp_k*)__builtin_amdgcn_kernarg_segment_ptr();
    for (int u = F.tid; u < (LDS_BYTES - MISC_OFF) / 4; u += NWAVES * 64) ((LAS unsigned*)(F.lds + MISC_OFF))[u] = 0u;
    __syncthreads();
    const int lo = args.ph_lo, hi = args.ph_hi;
    XcdBarrier bar; bar.bar = (unsigned*)(F.ctl + CW_BAR); bar.x = 0; bar.st = nullptr;
    if (hi - lo > 1) bar = xcd_barrier_post((unsigned*)(F.ctl + CW_BAR), (volatile LAS unsigned*)(F.lds + MISC_OFF));
#define IN(k) (lo <= (k) && (k) < hi)
#define SEAM(k) do { if (IN(k) && IN((k) + 1)) xcd_barrier(bar); } while (0)
    bf16* const XN = (bf16*)(F.ws + WS_XN); bf16* const Yb = (bf16*)(F.ws + WS_Y); float* const XA = (float*)(F.ws + WS_XA);
    bf16* const PROJ = (bf16*)(F.ws + WS_PROJ); float* const SIDE = (float*)(F.ws + WS_SIDE); bf16* const HID = (bf16*)(F.ws + WS_HID); bf16* const AS = (bf16*)(F.ws + WS_AS);
    const float* const MOD = (const float*)(F.ws + WS_MOD);

    if (IN(0)) { p0_prologue(F); if (PROBE_REPEAT == 0) p0_prologue(F); }
    SEAM(0);
#define LAYER_MIX(l) do { \
        const int pb = 1 + 8 * (l); \
        const float* modl = MOD + (size_t)(l) * 8 * 12288; \
        const float* xin = (l) == 0 ? F.in[IN_X] : (const float*)F.out; \
        if (IN(pb)) { norm_phase<false>(F, xin, F.in[IN_GMIX] + (l) * DM, modl, 0, 2048); if (PROBE_REPEAT == pb) norm_phase<false>(F, xin, F.in[IN_GMIX] + (l) * DM, modl, 0, 2048); } \
        SEAM(pb); \
        if (IN(pb + 1)) { \
            pg8::Gemm g{XN, (const bf16*)(F.ws + WS_WIN) + (size_t)(l) * NPROJ * DM, M, NPROJ, DM}; pg8::StaticOrder S; S.init(M, NPROJ, F.G, (int)blockIdx.x); \
            pg8::EpiProj E{PROJ, SIDE}; \
            pg8::gemm_phase<pg8::EpiProj, pg8::StaticOrder, true, true>(F.lds + RING_OFF, g, S, E); \
            if (PROBE_REPEAT == pb + 1) pg8::gemm_phase<pg8::EpiProj, pg8::StaticOrder, true, true>(F.lds + RING_OFF, g, S, E); \
        } \
        SEAM(pb + 1); \
        if (IN(pb + 2)) { mix_a(F, (l)); if (PROBE_REPEAT == pb + 2) mix_a(F, (l)); } \
        SEAM(pb + 2); \
        if (IN(pb + 3)) { mix_b(F, (l)); if (PROBE_REPEAT == pb + 3) mix_b(F, (l)); } \
        SEAM(pb + 3); \
        if (IN(pb + 4)) { \
            pg8::Gemm g{Yb, (const bf16*)(F.ws + WS_WOUT) + (size_t)(l) * DM * DM, M, DM, DM}; pg8::StaticOrder S; S.init(M, DM, F.G, (int)blockIdx.x); \
            pg8::EpiResid E{xin, XA, modl + 4096}; \
            pg8::gemm_phase<pg8::EpiResid, pg8::StaticOrder, true, true>(F.lds + RING_OFF, g, S, E); \
            if (PROBE_REPEAT == pb + 4) pg8::gemm_phase<pg8::EpiResid, pg8::StaticOrder, true, true>(F.lds + RING_OFF, g, S, E); \
        } \
        SEAM(pb + 4); \
    } while (0)
    LAYER_MIX(0);
    {
        const float* modl = MOD;
        if (IN(6)) { norm_phase<false>(F, XA, F.in[IN_GFFN], modl, 6144, 8192); if (PROBE_REPEAT == 6) norm_phase<false>(F, XA, F.in[IN_GFFN], modl, 6144, 8192); }
        SEAM(6);
        if (IN(7)) {
            pg8::Gemm g{XN, (const bf16*)(F.ws + WS_WGU0), M, 2 * DFF, DM}; pg8::StaticOrder S; S.init(M, 2 * DFF, F.G, (int)blockIdx.x);
            pg8::EpiSwiglu E{HID, DFF, 44};
            pg8::gemm_phase<pg8::EpiSwiglu, pg8::StaticOrder, true, true>(F.lds + RING_OFF, g, S, E);
            if (PROBE_REPEAT == 7) pg8::gemm_phase<pg8::EpiSwiglu, pg8::StaticOrder, true, true>(F.lds + RING_OFF, g, S, E);
        }
        SEAM(7);
        if (IN(8)) {
            pg8::Gemm g{HID, (const bf16*)(F.ws + WS_WDN0), M, DM, DFF}; pg8::StaticOrder S; S.init(M, DM, F.G, (int)blockIdx.x);
            pg8::EpiResid E{XA, F.out, modl + 10240};
            pg8::gemm_phase<pg8::EpiResid, pg8::StaticOrder, true, true>(F.lds + RING_OFF, g, S, E);
            if (PROBE_REPEAT == 8) pg8::gemm_phase<pg8::EpiResid, pg8::StaticOrder, true, true>(F.lds + RING_OFF, g, S, E);
        }
        SEAM(8);
    }
    LAYER_MIX(1);
    const float* mod1 = MOD + (size_t)8 * 12288;
    if (IN(14)) norm_phase<true>(F, XA, F.in[IN_GFFN] + DM, mod1, 6144, 8192);
    SEAM(14);
    if (IN(15)) { moe_gather(F); if (PROBE_REPEAT == 15) moe_gather(F); }
    SEAM(15);
    if (IN(16)) {
        const int T = moe_tables(F);
        pg8::Gemm g{AS, (const bf16*)(F.ws + WS_WGU1), T * 256, 2 * DFFE, DM}; pg8::GroupedOrder S; S.init(T, 56, F.G, (int)blockIdx.x, (const LAS int*)(F.lds + MISC_OFF + 64));
        pg8::EpiSwiglu E{HID, DFFE, 56};
        pg8::gemm_phase<pg8::EpiSwiglu, pg8::GroupedOrder, true, true>(F.lds + RING_OFF, g, S, E);
        if (PROBE_REPEAT == 16) pg8::gemm_phase<pg8::EpiSwiglu, pg8::GroupedOrder, true, true>(F.lds + RING_OFF, g, S, E);
    }
    SEAM(16);
    if (IN(17)) {
        const int T = moe_tables(F);
        pg8::Gemm g{HID, (const bf16*)(F.ws + WS_WDN1), T * 256, DM, DFFE}; pg8::GroupedOrder S; S.init(T, 8, F.G, (int)blockIdx.x, (const LAS int*)(F.lds + MISC_OFF + 64));
        pg8::EpiPlainBf16 E{AS, DM, 8};
        pg8::gemm_phase<pg8::EpiPlainBf16, pg8::GroupedOrder, true, true>(F.lds + RING_OFF, g, S, E);
        if (PROBE_REPEAT == 17) pg8::gemm_phase<pg8::EpiPlainBf16, pg8::GroupedOrder, true, true>(F.lds + RING_OFF, g, S, E);
    }
    SEAM(17);
    if (IN(18)) { moe_combine(F, mod1 + 10240); if (PROBE_REPEAT == 18) moe_combine(F, mod1 + 10240); }
#undef IN
#undef SEAM
}

extern "C" void kernel_launch(void* const* d_in, const int* in_sizes, int n_in, void* d_out, int out_size, void* d_ws, size_t ws_size, hipStream_t stream) {
    static int grid = 0;
    if (grid == 0) {
        if (n_in != 26 || in_sizes[0] != M * DM || out_size != M * DM || ws_size < WS_END) { fprintf(stderr, "kernel_launch: unexpected shapes (n_in %d, in0 %d, out %d, ws %zu < %zu)\n", n_in, n_in > 0 ? in_sizes[0] : -1, out_size, ws_size, (size_t)WS_END); grid = -1; return; }
        int dev = 0, cus = 0, per_cu = 0;
        if (hipGetDevice(&dev) != hipSuccess || hipDeviceGetAttribute(&cus, hipDeviceAttributeMultiprocessorCount, dev) != hipSuccess) { grid = -1; return; }
        if (hipFuncSetAttribute((const void*)hybrid_fwd, hipFuncAttributeMaxDynamicSharedMemorySize, LDS_BYTES) != hipSuccess) { fprintf(stderr, "kernel_launch: hipFuncSetAttribute failed\n"); grid = -1; return; }
        if (hipOccupancyMaxActiveBlocksPerMultiprocessor(&per_cu, (const void*)hybrid_fwd, NWAVES * 64, LDS_BYTES) != hipSuccess || per_cu < 1) fprintf(stderr, "kernel_launch: occupancy query says %d\n", per_cu);
        (void)hipGetLastError();
        grid = cus < 256 ? cus : 256;
    }
    if (grid < 0) return;
    if (hipMemsetAsync((char*)d_ws + WS_CTL, 0, CTL_ZERO_BYTES, stream) != hipSuccess) return;
    Args a{};
    for (int i = 0; i < 26; ++i) a.in[i] = (const float*)d_in[i];
    a.out = (float*)d_out; a.ws = (unsigned char*)d_ws;
#if MK_ONE_LAUNCH
    a.ph_lo = 0; a.ph_hi = NPH;
    hipLaunchKernelGGL(hybrid_fwd, dim3(grid), dim3(NWAVES * 64), LDS_BYTES, stream, a);
#else
    for (int p = 0; p < NPH; ++p) { a.ph_lo = p; a.ph_hi = p + 1; hipLaunchKernelGGL(hybrid_fwd, dim3(grid), dim3(NWAVES * 64), LDS_BYTES, stream, a); }
#endif
}
```

```cpp
#include <hip/hip_runtime.h>
#include <cstdio>
#include <cstdint>
namespace pg8 {
#define PG8_LAS __attribute__((address_space(3)))
typedef unsigned short bf16_t;
typedef short bf16x8 __attribute__((ext_vector_type(8)));
typedef float f32x4 __attribute__((ext_vector_type(4)));
typedef unsigned u32x4 __attribute__((ext_vector_type(4)));
constexpr int BM = 256, BK = 64, HALF = 128, HTB = HALF * BK * 2  , STAGE_BYTES = 8 * HTB, NXCD = 8, WGM = 8;

__host__ __device__ __forceinline__ int lds_byte(int r, int c) { const int st = (r >> 4) * 2 + (c >> 5), rr = r & 15, cc = c & 31, ob = rr * 64 + cc * 2; return st * 1024 + (ob ^ (((ob >> 9) & 1) << 5)); }
__host__ __device__ __forceinline__ void stage_rc(int b, int& R, int& C) { const int st = b / 1024, sb = b % 1024, swz = sb ^ (((sb >> 9) & 1) << 5); R = (st >> 1) * 16 + swz / 64; C = (st & 1) * 32 + (swz % 64) / 2; }
__host__ __device__ __forceinline__ int perm32(int rho) { const int n = rho >> 4, i = rho & 15; return 8 * (i >> 2) + 4 * n + (i & 3); }

struct Unit { int pm, pn; };
struct Gemm { const bf16_t* A; const bf16_t* Bt; int M, N, K; };

struct StaticOrder {
    int nM, nN, nwg, G, c;
    __host__ __device__ void init(int M, int N, int G_, int c_) { nM = M / BM; nN = N / BM; nwg = nM * nN; G = G_; c = c_; }
    __host__ __device__ bool next(int i, Unit& u) const {
        const long L = (long)i * G + c; if (L >= nwg) return false;
        int wgid = (int)L; { const int q = nwg / NXCD, r = nwg % NXCD, xcd = wgid % NXCD, off = wgid / NXCD; wgid = (xcd < r ? xcd * (q + 1) : r * (q + 1) + (xcd - r) * q) + off; }
        const int nig = WGM * nN, gid = wgid / nig, fm = gid * WGM, gsz = (nM - fm) < WGM ? (nM - fm) : WGM;
        u.pm = fm + ((wgid % nig) % gsz); u.pn = (wgid % nig) / gsz; return true;
    }
    __device__ __forceinline__ void a_ready(const Unit&) const {}
    __device__ __forceinline__ void done(const Unit&) const {}
};
__device__ __forceinline__ unsigned cvt_pk_bf16(float lo, float hi) { unsigned r; asm volatile("v_cvt_pk_bf16_f32 %0, %1, %2" : "=v"(r) : "v"(lo), "v"(hi)); return r; }
typedef int i32x8 __attribute__((ext_vector_type(8)));
typedef int i32x4 __attribute__((ext_vector_type(4)));
__device__ __forceinline__ i32x8 cat8(bf16x8 lo, bf16x8 hi) { const i32x4 a = __builtin_bit_cast(i32x4, lo), b = __builtin_bit_cast(i32x4, hi); return __builtin_shufflevector(a, b, 0, 1, 2, 3, 4, 5, 6, 7); }
typedef unsigned u32x2 __attribute__((ext_vector_type(2)));
__device__ __forceinline__ float fast_silu(float g) { return g * __builtin_amdgcn_rcpf(1.0f + __expf(-g)); }
struct EpiProj {
    static constexpr bool PERM = true, AFTER_DRAIN = false, FP8 = false; static constexpr int SCALE_W = 127, SCALE_X = 127;
    bf16_t* O; float* side;
    __device__ __forceinline__ void operator()(const f32x4 (&acc)[2][2][4][2], const Unit& u, int wr, int wc, int fr, int fq) const {
        const int row0 = u.pm * BM + wr * 64 + fr;
        if (u.pn < 17) {
            const int col0 = u.pn * BM + wc * 32 + 8 * fq;
#pragma unroll
            for (int ai = 0; ai < 2; ++ai)
#pragma unroll
                for (int m = 0; m < 4; ++m) { bf16_t* rowp = O + (size_t)(row0 + ai * HALF + m * 16) * 4352 + col0;
#pragma unroll
                    for (int bj = 0; bj < 2; ++bj) { const f32x4 v0 = acc[ai][bj][m][0], v1 = acc[ai][bj][m][1];
                        u32x4 w; w.x = cvt_pk_bf16(v0[0], v0[1]); w.y = cvt_pk_bf16(v0[2], v0[3]); w.z = cvt_pk_bf16(v1[0], v1[1]); w.w = cvt_pk_bf16(v1[2], v1[3]);
                        *(u32x4*)(rowp + bj * HALF) = w; } }
        } else if (wc == 0) {
#pragma unroll
            for (int ai = 0; ai < 2; ++ai)
#pragma unroll
                for (int m = 0; m < 4; ++m) { float* rowp = side + (size_t)(row0 + ai * HALF + m * 16) * 32 + 8 * fq;
                    *(f32x4*)(rowp) = acc[ai][0][m][0]; *(f32x4*)(rowp + 4) = acc[ai][0][m][1]; }
        }
    }
};
struct EpiResid {
    static constexpr bool PERM = false, AFTER_DRAIN = false, FP8 = false; static constexpr int SCALE_W = 127, SCALE_X = 127;
    const float* base; float* out; const float* gate;
    __device__ __forceinline__ void operator()(const f32x4 (&acc)[2][2][4][2], const Unit& u, int wr, int wc, int fr, int fq) const {
        const int row0 = u.pm * BM + wr * 64 + fr, col0 = u.pn * BM + wc * 32 + 4 * fq;
        const float* __restrict__ gp = gate + (size_t)(u.pm >> 3) * 12288 + col0;
        const float* __restrict__ bp = base + (size_t)row0 * 2048 + col0; float* __restrict__ op = out + (size_t)row0 * 2048 + col0;
        f32x4 gv[2][2];
#pragma unroll
        for (int bj = 0; bj < 2; ++bj)
#pragma unroll
            for (int n = 0; n < 2; ++n) gv[bj][n] = *(const f32x4*)(gp + bj * HALF + n * 16);
        f32x4 cur[2][2], nxt[2][2];
#pragma unroll
        for (int bj = 0; bj < 2; ++bj)
#pragma unroll
            for (int n = 0; n < 2; ++n) cur[bj][n] = *(const f32x4*)(bp + bj * HALF + n * 16);
#pragma unroll
        for (int g = 0; g < 8; ++g) { const int ai = g >> 2, m = g & 3; const size_t off = (size_t)(ai * HALF + m * 16) * 2048;
            if (g < 7) { const int ai2 = (g + 1) >> 2, m2 = (g + 1) & 3; const size_t off2 = (size_t)(ai2 * HALF + m2 * 16) * 2048;
#pragma unroll
                for (int bj = 0; bj < 2; ++bj)
#pragma unroll
                    for (int n = 0; n < 2; ++n) nxt[bj][n] = *(const f32x4*)(bp + off2 + bj * HALF + n * 16); }
#pragma unroll
            for (int bj = 0; bj < 2; ++bj)
#pragma unroll
                for (int n = 0; n < 2; ++n) *(f32x4*)(op + off + bj * HALF + n * 16) = cur[bj][n] + gv[bj][n] * acc[ai][bj][m][n];
#pragma unroll
            for (int bj = 0; bj < 2; ++bj)
#pragma unroll
                for (int n = 0; n < 2; ++n) cur[bj][n] = nxt[bj][n];
            asm volatile("" ::: "memory"); }
    }
};
struct EpiSwiglu {
    static constexpr bool PERM = true, AFTER_DRAIN = false, FP8 = false; static constexpr int SCALE_W = 127, SCALE_X = 127;
    bf16_t* O; int ldc; int nN;
    __device__ __forceinline__ void operator()(const f32x4 (&acc)[2][2][4][2], const Unit& u, int wr, int wc, int fr, int fq) const {
        const int row0 = u.pm * BM + wr * 64 + fr, col0 = (u.pn % nN) * HALF + wc * 32 + 8 * fq;
#pragma unroll
        for (int ai = 0; ai < 2; ++ai)
#pragma unroll
            for (int m = 0; m < 4; ++m) { bf16_t* rowp = O + (size_t)(row0 + ai * HALF + m * 16) * ldc + col0;
                const f32x4 g0 = acc[ai][0][m][0], g1 = acc[ai][0][m][1], u0 = acc[ai][1][m][0], u1 = acc[ai][1][m][1];
                u32x4 w; w.x = cvt_pk_bf16(fast_silu(g0[0]) * u0[0], fast_silu(g0[1]) * u0[1]); w.y = cvt_pk_bf16(fast_silu(g0[2]) * u0[2], fast_silu(g0[3]) * u0[3]);
                w.z = cvt_pk_bf16(fast_silu(g1[0]) * u1[0], fast_silu(g1[1]) * u1[1]); w.w = cvt_pk_bf16(fast_silu(g1[2]) * u1[2], fast_silu(g1[3]) * u1[3]);
                *(u32x4*)(rowp) = w; }
    }
};
struct EpiPlainBf16 {
    static constexpr bool PERM = true, AFTER_DRAIN = false, FP8 = false; static constexpr int SCALE_W = 127, SCALE_X = 127;
    bf16_t* O; int ldc; int nN;
    __device__ __forceinline__ void operator()(const f32x4 (&acc)[2][2][4][2], const Unit& u, int wr, int wc, int fr, int fq) const {
        const int row0 = u.pm * BM + wr * 64 + fr, col0 = (u.pn % nN) * BM + wc * 32 + 8 * fq;
#pragma unroll
        for (int ai = 0; ai < 2; ++ai)
#pragma unroll
            for (int m = 0; m < 4; ++m) { bf16_t* rowp = O + (size_t)(row0 + ai * HALF + m * 16) * ldc + col0;
#pragma unroll
                for (int bj = 0; bj < 2; ++bj) { const f32x4 v0 = acc[ai][bj][m][0], v1 = acc[ai][bj][m][1];
                    u32x4 w; w.x = cvt_pk_bf16(v0[0], v0[1]); w.y = cvt_pk_bf16(v0[2], v0[3]); w.z = cvt_pk_bf16(v1[0], v1[1]); w.w = cvt_pk_bf16(v1[2], v1[3]);
                    *(u32x4*)(rowp + bj * HALF) = w; } }
    }
};
__device__ __forceinline__ float clamp448(float x) { return fminf(fmaxf(x, -448.f), 448.f); }
__device__ __forceinline__ unsigned pk4_fp8(float a, float b, float c, float d) { int w = 0; w = __builtin_amdgcn_cvt_pk_fp8_f32(clamp448(a), clamp448(b), w, false); w = __builtin_amdgcn_cvt_pk_fp8_f32(clamp448(c), clamp448(d), w, true); return (unsigned)w; }
struct EpiSwigluF8 {
    static constexpr bool PERM = true, AFTER_DRAIN = false, FP8 = true; static constexpr int SCALE_W = 122, SCALE_X = 127;
    unsigned char* O; int ldc; int nN;
    __device__ __forceinline__ void operator()(const f32x4 (&acc)[2][2][4][2], const Unit& u, int wr, int wc, int fr, int fq) const {
        const int row0 = u.pm * BM + wr * 64 + fr, col0 = (u.pn % nN) * HALF + wc * 32 + 8 * fq;
#pragma unroll
        for (int ai = 0; ai < 2; ++ai)
#pragma unroll
            for (int m = 0; m < 4; ++m) { unsigned char* rowp = O + (size_t)(row0 + ai * HALF + m * 16) * ldc + col0;
                const f32x4 g0 = acc[ai][0][m][0], g1 = acc[ai][0][m][1], u0 = acc[ai][1][m][0], u1 = acc[ai][1][m][1];
                u32x2 w; w.x = pk4_fp8(8.f * fast_silu(g0[0]) * u0[0], 8.f * fast_silu(g0[1]) * u0[1], 8.f * fast_silu(g0[2]) * u0[2], 8.f * fast_silu(g0[3]) * u0[3]);
                w.y = pk4_fp8(8.f * fast_silu(g1[0]) * u1[0], 8.f * fast_silu(g1[1]) * u1[1], 8.f * fast_silu(g1[2]) * u1[2], 8.f * fast_silu(g1[3]) * u1[3]);
                *(u32x2*)(rowp) = w; }
    }
};
struct EpiPlainBf16F8 {
    static constexpr bool PERM = true, AFTER_DRAIN = false, FP8 = true; static constexpr int SCALE_W = 121, SCALE_X = 124;
    bf16_t* O; int ldc; int nN;
    __device__ __forceinline__ void operator()(const f32x4 (&acc)[2][2][4][2], const Unit& u, int wr, int wc, int fr, int fq) const {
        const int row0 = u.pm * BM + wr * 64 + fr, col0 = (u.pn % nN) * BM + wc * 32 + 8 * fq;
#pragma unroll
        for (int ai = 0; ai < 2; ++ai)
#pragma unroll
            for (int m = 0; m < 4; ++m) { bf16_t* rowp = O + (size_t)(row0 + ai * HALF + m * 16) * ldc + col0;
#pragma unroll
                for (int bj = 0; bj < 2; ++bj) { const f32x4 v0 = acc[ai][bj][m][0], v1 = acc[ai][bj][m][1];
                    u32x4 w; w.x = cvt_pk_bf16(v0[0], v0[1]); w.y = cvt_pk_bf16(v0[2], v0[3]); w.z = cvt_pk_bf16(v1[0], v1[1]); w.w = cvt_pk_bf16(v1[2], v1[3]);
                    *(u32x4*)(rowp + bj * HALF) = w; } }
    }
};
struct GroupedOrder {
    int nM, nN, nwg, G, c; const PG8_LAS int* tile_e;
    __device__ void init(int nM_, int nN_, int G_, int c_, const PG8_LAS int* te) { nM = nM_; nN = nN_; nwg = nM * nN; G = G_; c = c_; tile_e = te; }
    __device__ bool next(int i, Unit& u) const {
        const long L = (long)i * G + c; if (L >= nwg) return false;
        int wgid = (int)L; { const int q = nwg / NXCD, r = nwg % NXCD, xcd = wgid % NXCD, off = wgid / NXCD; wgid = (xcd < r ? xcd * (q + 1) : r * (q + 1) + (xcd - r) * q) + off; }
        const int nig = WGM * nN, gid = wgid / nig, fm = gid * WGM, gsz = (nM - fm) < WGM ? (nM - fm) : WGM;
        u.pm = fm + ((wgid % nig) % gsz); u.pn = tile_e[u.pm] * nN + (wgid % nig) / gsz; return true;
    }
    __device__ __forceinline__ void a_ready(const Unit&) const {}
    __device__ __forceinline__ void done(const Unit&) const {}
};
template <class Epi, class Sched, bool ALIGN_EPI = false, bool SP2 = false>
__device__ __forceinline__ void gemm_phase(PG8_LAS unsigned char* lds, const Gemm g, const Sched& S, const Epi& E) {
    const int tid = threadIdx.x, wid = __builtin_amdgcn_readfirstlane(tid >> 6), lane = tid & 63, wr = wid >> 2, wc = wid & 3, fr = lane & 15, fq = lane >> 4;
    const int K = g.K, nt = K / BK;
    unsigned voffA[2], voffB[2];
#pragma unroll
    for (int i = 0; i < 2; ++i) { int R, C; stage_rc(tid * 16 + i * 8192, R, C); const int Rb = Epi::PERM ? ((R & ~31) + perm32(R & 31)) : R;
        voffA[i] = (unsigned)(R * K + C) * 2u; voffB[i] = (unsigned)(Rb * K + C) * 2u; }
    const size_t kstep = (size_t)(BK * 2);
    const size_t hstep = (size_t)HALF * K * 2;
    const size_t tstep = 2 * hstep;
    const unsigned ldsw = (unsigned)wid * 1024u;
    const int aoff = lds_byte(wr * 64 + fr, fq * 8), boff = lds_byte(wc * 32 + fr, fq * 8);
#define PG8_SA(b, h) (((b) * 2 + (h)) * HTB)
#define PG8_SB(b, h) ((4 + (b) * 2 + (h)) * HTB)
#define PG8_STAGE(bufoff, gbase, voff) do { _Pragma("unroll") for (int _i = 0; _i < 2; ++_i) \
        __builtin_amdgcn_global_load_lds((const unsigned*)((const char*)(gbase) + (voff)[_i]), (PG8_LAS unsigned*)(lds + (bufoff) + ldsw + _i * 8192), 16, 0, 0); } while (0)
#define PG8_LDA(dst, b, h) do { _Pragma("unroll") for (int m = 0; m < 4; ++m) _Pragma("unroll") for (int k = 0; k < 2; ++k) dst[m][k] = *(const PG8_LAS bf16x8*)(lds + PG8_SA(b, h) + aoff + m * 2048 + k * 1024); } while (0)
#define PG8_LDB(dst, b, h) do { _Pragma("unroll") for (int n = 0; n < 2; ++n) _Pragma("unroll") for (int k = 0; k < 2; ++k) dst[n][k] = *(const PG8_LAS bf16x8*)(lds + PG8_SB(b, h) + boff + n * 2048 + k * 1024); } while (0)
#define PG8_MMA(ai, bj, At, Bt) do { __builtin_amdgcn_s_setprio(1); _Pragma("unroll") for (int m = 0; m < 4; ++m) _Pragma("unroll") for (int n = 0; n < 2; ++n) { \
        if constexpr (Epi::FP8) { asm volatile("v_mfma_scale_f32_16x16x128_f8f6f4 %0, %1, %2, %0, %3, %4 op_sel_hi:[0,0,0]" : "+v"(acc[ai][bj][m][n]) : "v"(cat8(Bt[n][0], Bt[n][1])), "v"(cat8(At[m][0], At[m][1])), "v"(f8_sw), "v"(f8_sx)); } \
        else { _Pragma("unroll") for (int k = 0; k < 2; ++k) acc[ai][bj][m][n] = __builtin_amdgcn_mfma_f32_16x16x32_bf16(Bt[n][k], At[m][k], acc[ai][bj][m][n], 0, 0, 0); } } __builtin_amdgcn_s_setprio(0); } while (0)
#define PG8_WAIT_V(n) asm volatile("s_waitcnt vmcnt(" #n ")" ::: "memory")
#define PG8_WAIT_L(n) asm volatile("s_waitcnt lgkmcnt(" #n ")" ::: "memory")
#define PG8_BAR __builtin_amdgcn_s_barrier()
#define PG8_SCHED __builtin_amdgcn_sched_barrier(0)
    Unit cur, nxt; int ui = 0;
    if (!S.next(0, cur)) return;
    int f8_sw = Epi::SCALE_W, f8_sx = Epi::SCALE_X;
    if constexpr (Epi::FP8) asm volatile("" : "+v"(f8_sw), "+v"(f8_sx));
    f32x4 acc[2][2][4][2];
#pragma unroll
    for (int a = 0; a < 2; ++a)
#pragma unroll
        for (int b = 0; b < 2; ++b)
#pragma unroll
            for (int m = 0; m < 4; ++m)
#pragma unroll
                for (int n = 0; n < 2; ++n) acc[a][b][m][n] = (f32x4){0.f, 0.f, 0.f, 0.f};
    bf16x8 At[4][2], B0[2][2], B1[2][2];
    const char* cA = (const char*)g.A + (size_t)cur.pm * tstep; const char* cB = (const char*)g.Bt + (size_t)cur.pn * tstep;
    S.a_ready(cur);
    if constexpr (SP2) {
        PG8_STAGE(PG8_SB(0, 0), cB, voffB); PG8_STAGE(PG8_SB(0, 1), cB + hstep, voffB); PG8_STAGE(PG8_SA(0, 0), cA, voffA); PG8_STAGE(PG8_SA(0, 1), cA + hstep, voffA);
        if (wr == 1) PG8_BAR;
        PG8_WAIT_V(2); PG8_BAR;
        PG8_STAGE(PG8_SB(1, 0), cB + kstep, voffB); PG8_STAGE(PG8_SA(1, 0), cA + kstep, voffA); PG8_STAGE(PG8_SB(1, 1), cB + hstep + kstep, voffB);
        PG8_WAIT_V(6); PG8_BAR;
    } else {
        PG8_STAGE(PG8_SB(0, 0), cB, voffB); PG8_STAGE(PG8_SA(0, 0), cA, voffA); PG8_STAGE(PG8_SB(0, 1), cB + hstep, voffB); PG8_STAGE(PG8_SA(0, 1), cA + hstep, voffA);
        if (wr == 1) PG8_BAR;
        PG8_WAIT_V(4); PG8_BAR;
        PG8_STAGE(PG8_SB(1, 0), cB + kstep, voffB); PG8_STAGE(PG8_SA(1, 0), cA + kstep, voffA); PG8_STAGE(PG8_SB(1, 1), cB + hstep + kstep, voffB);
        PG8_WAIT_V(6); PG8_BAR;
    }
    for (;;) {
        const bool has_next = S.next(ui + 1, nxt);
        const char* nA = has_next ? (const char*)g.A + (size_t)nxt.pm * tstep : cA; const char* nB = has_next ? (const char*)g.Bt + (size_t)nxt.pn * tstep : cB;
        for (int t = 0; t < nt; t += 2) {
            const bool last = (t == nt - 2);
            const char* a1 = cA + (size_t)(t + 1) * kstep;
            const char* a2 = last ? nA : cA + (size_t)(t + 2) * kstep; const char* b2 = last ? nB : cB + (size_t)(t + 2) * kstep;
            const char* a3 = a2 + kstep; const char* b3 = b2 + kstep;
            if (last && has_next) S.a_ready(nxt);
            if constexpr (SP2) {
            PG8_LDB(B0, 0, 0); PG8_LDB(B1, 0, 1); PG8_SCHED; PG8_LDA(At, 0, 0); PG8_STAGE(PG8_SA(1, 1), a1 + hstep, voffA);
            PG8_WAIT_V(8); PG8_WAIT_L(0); PG8_BAR; PG8_MMA(0, 0, At, B0); PG8_MMA(0, 1, At, B1); PG8_BAR; PG8_SCHED;
            PG8_LDA(At, 0, 1); PG8_STAGE(PG8_SB(0, 0), b2, voffB); PG8_STAGE(PG8_SB(0, 1), b2 + hstep, voffB); PG8_STAGE(PG8_SA(0, 0), a2, voffA);
            PG8_WAIT_V(8); PG8_WAIT_L(0); PG8_BAR; PG8_MMA(1, 0, At, B0); PG8_MMA(1, 1, At, B1); PG8_BAR; PG8_SCHED;
            PG8_LDB(B0, 1, 0); PG8_LDB(B1, 1, 1); PG8_SCHED; PG8_LDA(At, 1, 0); PG8_STAGE(PG8_SA(0, 1), a2 + hstep, voffA);
            PG8_WAIT_V(8); PG8_WAIT_L(0); PG8_BAR; PG8_MMA(0, 0, At, B0); PG8_MMA(0, 1, At, B1); PG8_BAR; PG8_SCHED;
            PG8_LDA(At, 1, 1); PG8_STAGE(PG8_SB(1, 0), b3, voffB); PG8_STAGE(PG8_SB(1, 1), b3 + hstep, voffB); PG8_STAGE(PG8_SA(1, 0), a3, voffA);
            PG8_WAIT_V(8); PG8_WAIT_L(0); PG8_BAR; PG8_MMA(1, 0, At, B0); PG8_MMA(1, 1, At, B1); PG8_BAR; PG8_SCHED;
            } else {
            PG8_LDB(B0, 0, 0); PG8_SCHED; PG8_LDA(At, 0, 0); PG8_STAGE(PG8_SA(1, 1), a1 + hstep, voffA);
            PG8_WAIT_L(8); PG8_BAR; PG8_WAIT_L(0); PG8_MMA(0, 0, At, B0); PG8_BAR; PG8_SCHED;
            PG8_LDB(B1, 0, 1); PG8_STAGE(PG8_SB(0, 0), b2, voffB);
            PG8_BAR; PG8_WAIT_L(0); PG8_MMA(0, 1, At, B1); PG8_BAR;
            PG8_LDA(At, 0, 1); PG8_STAGE(PG8_SA(0, 0), a2, voffA);
            PG8_BAR; PG8_WAIT_L(0); PG8_MMA(1, 0, At, B0); PG8_BAR; PG8_SCHED;
            PG8_STAGE(PG8_SB(0, 1), b2 + hstep, voffB);
            PG8_WAIT_V(6); PG8_BAR; PG8_MMA(1, 1, At, B1); PG8_BAR;
            PG8_LDB(B0, 1, 0); PG8_SCHED; PG8_LDA(At, 1, 0); PG8_STAGE(PG8_SA(0, 1), a2 + hstep, voffA);
            PG8_WAIT_L(8); PG8_BAR; PG8_WAIT_L(0); PG8_MMA(0, 0, At, B0); PG8_BAR; PG8_SCHED;
            PG8_LDB(B1, 1, 1); PG8_STAGE(PG8_SB(1, 0), b3, voffB);
            PG8_BAR; PG8_WAIT_L(0); PG8_MMA(0, 1, At, B1); PG8_BAR;
            PG8_LDA(At, 1, 1); PG8_STAGE(PG8_SA(1, 0), a3, voffA);
            PG8_BAR; PG8_WAIT_L(0); PG8_MMA(1, 0, At, B0); PG8_BAR; PG8_SCHED;
            PG8_STAGE(PG8_SB(1, 1), b3 + hstep, voffB);
            PG8_WAIT_V(6); PG8_BAR; PG8_MMA(1, 1, At, B1); PG8_BAR;
            }
        }
        if constexpr (ALIGN_EPI) { if (wr == 0) PG8_BAR; }
        if constexpr (!Epi::AFTER_DRAIN) { E(acc, cur, wr, wc, fr, fq); S.done(cur); }
        if (!has_next) break;
#pragma unroll
        for (int a = 0; a < 2; ++a)
#pragma unroll
            for (int b = 0; b < 2; ++b)
#pragma unroll
                for (int m = 0; m < 4; ++m)
#pragma unroll
                    for (int n = 0; n < 2; ++n) acc[a][b][m][n] = (f32x4){0.f, 0.f, 0.f, 0.f};
        cur = nxt; cA = nA; cB = nB; ++ui;
        if constexpr (ALIGN_EPI) { if (wr == 1) PG8_BAR; }
    }
    PG8_WAIT_V(0);
    if constexpr (!ALIGN_EPI) { if (wr == 0) PG8_BAR; }
    PG8_BAR;
    if constexpr (Epi::AFTER_DRAIN) { E.fused(acc, cur, wr, wc, fr, fq, lds, wid, lane); S.done(cur); }
#undef PG8_SA
#undef PG8_SB
#undef PG8_STAGE
#undef PG8_LDA
#undef PG8_LDB
#undef PG8_MMA
#undef PG8_WAIT_V
#undef PG8_WAIT_L
#undef PG8_BAR
#undef PG8_SCHED
}
}

constexpr int NWAVES = 8;
constexpr int BATCH = 8, SEQ = 2048, DM = 2048, M = BATCH * SEQ;
constexpr int NPROJ = 4608, PROJ_LD = 4352;
constexpr int DFF = 5632, DFFE = 7168, NE = 8;
constexpr int C_MQ = 0, C_MK = 256, C_MV = 512, C_MO = 1024, C_GQ = 1536, C_GK = 1792, C_GV = 2048, C_GG = 2560, C_AQ = 3072, C_AK = 4096, C_AV = 4224;
constexpr float EPS = 1e-6f;
constexpr int MAXROWS_S = M * 2 + NE * 256;

constexpr size_t MiB = 1u << 20;
constexpr size_t WS_CTL = 0, CTL_ZERO_BYTES = 1 * MiB;
constexpr size_t WS_MOD = 1 * MiB;
constexpr size_t WS_WIN = 2 * MiB;
constexpr size_t WS_WOUT = 38 * MiB;
constexpr size_t WS_WGU0 = 54 * MiB;
constexpr size_t WS_WDN0 = 98 * MiB;
constexpr size_t WS_WGU1 = 120 * MiB;
constexpr size_t WS_WDN1 = 568 * MiB;
constexpr size_t WS_XA = 792 * MiB;
constexpr size_t WS_XN = 920 * MiB;
constexpr size_t WS_Y = 984 * MiB;
constexpr size_t WS_SIDE = 1048 * MiB;
constexpr size_t WS_TOK = 1050 * MiB;
constexpr size_t WS_BIG = 1052 * MiB;
constexpr size_t WS_HID = WS_BIG;
constexpr size_t WS_AS = WS_BIG + 476 * MiB;
constexpr size_t WS_PROJ = WS_BIG;
constexpr size_t WS_QKC = WS_BIG + 144 * MiB;
constexpr size_t WS_LA = WS_BIG + 160 * MiB;
constexpr size_t WS_KN = WS_BIG + 176 * MiB;
constexpr size_t WS_UM = WS_BIG + 192 * MiB;
constexpr size_t WS_UG = WS_BIG + 212 * MiB;
constexpr size_t WS_GAUX = WS_BIG + 244 * MiB;
constexpr size_t WS_END = WS_BIG + 612 * MiB;
constexpr int TOK_E = 0, TOK_SLOT = 32768, TOK_W = 65536, TOK_POS = 98304;

constexpr int CW_TMO = 0, CW_CODE = 1, CW_BAR = 4096, CW_CNT = 8192;

constexpr int RING_OFF = 0, RING_BYTES = 131072;
constexpr int MISC_OFF = RING_BYTES;
constexpr int LDS_BYTES = 147456;

#define GAS __attribute__((address_space(1)))
#define LAS __attribute__((address_space(3)))
typedef unsigned short bf16;
typedef unsigned v4u __attribute__((ext_vector_type(4)));
typedef unsigned v2u __attribute__((ext_vector_type(2)));
typedef float f32x4 __attribute__((ext_vector_type(4)));
typedef short bf16x8 __attribute__((ext_vector_type(8)));
typedef GAS unsigned gu32;
#define RLX_AGENT __ATOMIC_RELAXED, __HIP_MEMORY_SCOPE_AGENT
#define LDS_WAIT() asm volatile("s_waitcnt lgkmcnt(0)" ::: "memory")
#define VM_WAIT() asm volatile("s_waitcnt vmcnt(0)" ::: "memory")
__device__ __forceinline__ unsigned f2bf(float f) { unsigned u = __builtin_bit_cast(unsigned, f); return (u + 0x7fffu + ((u >> 16) & 1u)) >> 16; }
__device__ __forceinline__ unsigned pk2(float lo, float hi) { return f2bf(lo) | (f2bf(hi) << 16); }
__device__ __forceinline__ float bflo(unsigned w) { return __builtin_bit_cast(float, w << 16); }
__device__ __forceinline__ float bfhi(unsigned w) { return __builtin_bit_cast(float, w & 0xffff0000u); }
__device__ __forceinline__ float bf1(bf16 b) { return __builtin_bit_cast(float, ((unsigned)b) << 16); }
__device__ __forceinline__ float wave_sum(float v) {
#pragma unroll
    for (int o = 1; o < 64; o <<= 1) v += __shfl_xor(v, o);
    return v;
}
__device__ __forceinline__ float sigmoidf_(float x) { return 1.0f / (1.0f + __expf(-x)); }
__device__ __forceinline__ float siluf_(float x) { return x / (1.0f + __expf(-x)); }
__device__ __forceinline__ float logsigmoidf_(float z) { return fminf(z, 0.f) - log1pf(expf(-fabsf(z))); }

#ifndef FAST_SWA
#define FAST_SWA 1
#endif
#ifndef FAST_GLA
#define FAST_GLA 1
#endif
#ifndef FAST_MLSTM
#define FAST_MLSTM 1
#endif
#define XB_TMO      128
#define XB_XCNT(j)  (256  + 64 * (j))
#define XB_XSUB(j)  (1280 + 64 * (j))
#define XB_XGEN(j)  (2304 + 64 * (j))
#define XB_TOP      3328
#define XB_TOPGEN   3392
#define XCD_BAR_WORDS 3456
#define XB_SPIN_CAP (1u << 18)

__device__ __forceinline__ unsigned xb_ld(unsigned* p)              { return __hip_atomic_load(p, __ATOMIC_RELAXED, __HIP_MEMORY_SCOPE_AGENT); }
__device__ __forceinline__ unsigned xb_add(unsigned* p, unsigned v) { return __hip_atomic_fetch_add(p, v, __ATOMIC_RELAXED, __HIP_MEMORY_SCOPE_AGENT); }
__device__ __forceinline__ unsigned xb_xcc_id() { return (unsigned)__builtin_amdgcn_s_getreg((3 << 11) | 20) & 0xFu; }
#define XB_SPIN(cond, bar) do { unsigned _sp = 0; while (cond) { __builtin_amdgcn_s_sleep(1); \
    if ((++_sp & 255u) == 0u) { if (xb_ld(&(bar)[XB_TMO])) break; if (_sp > XB_SPIN_CAP) { atomicAdd(&(bar)[XB_TMO], 1u); break; } } } } while (0)

struct XcdBarrier {
    unsigned* bar; unsigned x;
    volatile LAS unsigned* st;
};

__device__ __forceinline__ XcdBarrier xcd_barrier_post(unsigned* bar, volatile LAS unsigned* st) {
    XcdBarrier b; b.bar = bar; b.x = xb_xcc_id(); b.st = st;
    if (threadIdx.x == 0) (void)xb_add(&bar[XB_XCNT(b.x)], 1u);
    return b;
}
__device__ __forceinline__ void xcd_barrier_complete(unsigned* bar, unsigned x, unsigned& nloc, unsigned& nx) {
    const unsigned G = gridDim.x * gridDim.y * gridDim.z;
    unsigned sum, cnt, mine, sp = 0u;
    for (;;) {
        sum = 0u; cnt = 0u; mine = 0u;
#pragma unroll
        for (unsigned j = 0; j < 16; ++j) { const unsigned c = xb_ld(&bar[XB_XCNT(j)]); sum += c; cnt += (c > 0u) ? 1u : 0u; mine = (j == x) ? c : mine; }
        if (sum == G) break;
        __builtin_amdgcn_s_sleep(1);
        if ((++sp & 255u) == 0u) { if (xb_ld(&bar[XB_TMO])) break; if (sp > XB_SPIN_CAP) { atomicAdd(&bar[XB_TMO], 1u); break; } }
    }
    nloc = mine > 0u ? mine : 1u; nx = cnt > 0u ? cnt : 1u;
}

__device__ __forceinline__ void xcd_barrier(const XcdBarrier& b) {
    asm volatile("s_waitcnt vmcnt(0)" ::: "memory");
    __syncthreads();
    if (threadIdx.x == 0) {
        unsigned* bar = b.bar;
        __builtin_amdgcn_s_waitcnt(0);
        unsigned nloc = b.st[0], nx = b.st[1];
        if (nloc == 0u) { xcd_barrier_complete(bar, b.x, nloc, nx); b.st[0] = nloc; b.st[1] = nx; }
        const unsigned old = xb_add(&bar[XB_XSUB(b.x)], 1u);
        const unsigned gen = old / nloc;
        if (old + 1u == (gen + 1u) * nloc) {
            __builtin_amdgcn_fence(__ATOMIC_RELEASE, "agent");
            asm volatile("s_waitcnt vmcnt(0)" ::: "memory");
            const unsigned og = xb_add(&bar[XB_TOP], 1u);
            const unsigned tg = og / nx;
            if (og + 1u == (tg + 1u) * nx) xb_add(&bar[XB_TOPGEN], 1u);
            else XB_SPIN(xb_ld(&bar[XB_TOPGEN]) == tg, bar);
            __builtin_amdgcn_fence(__ATOMIC_ACQUIRE, "agent");
            xb_add(&bar[XB_XGEN(b.x)], 1u);
            asm volatile("s_waitcnt vmcnt(0)" ::: "memory");
        } else {
            XB_SPIN(xb_ld(&bar[XB_XGEN(b.x)]) == gen, bar);
            __builtin_amdgcn_fence(__ATOMIC_ACQUIRE, "agent");
            asm volatile("s_waitcnt vmcnt(0)" ::: "memory");
        }
    }
    __syncthreads();
}

typedef const float* cfp;
typedef __attribute__((address_space(4))) cfp cfp_k;
struct Frame {
    LAS unsigned char* lds;
    gu32* ctl;
    int tid, lane, wave, vcu, G;
    cfp_k* in;
    float* out; unsigned char* ws;
};
#define IN_X 0
#define IN_C 1
#define IN_WADA 2
#define IN_BADA 3
#define IN_GMIX 4
#define IN_GFFN 5
#define IN_WIN 6
#define IN_BGATES 7
#define IN_WCONV 8
#define IN_BCONV 9
#define IN_GOUTM 10
#define IN_WDEC 11
#define IN_BDEC 12
#define IN_GOUTG 13
#define IN_GQN 14
#define IN_GKN 15
#define IN_SINKS 16
#define IN_RELB 17
#define IN_WOUT 18
#define IN_WFG 19
#define IN_WFU 20
#define IN_WFD 21
#define IN_WROUTER 22
#define IN_WMG 23
#define IN_WMU 24
#define IN_WMD 25

__device__ __forceinline__ int rowmap(int kind, int off, int n) {
    if (kind == 0) return off + n;
    if (kind == 1) return off + ((n >> 7) << 8) + (n & 127);
    if (n < 1536) return n; if (n < 1544) return 4352 + (n - 1536); if (n < 3080) return n - 8; if (n < 3096) return 4360 + (n - 3080); return n - 24;
}
__device__ __forceinline__ void transpose_item(const float* W, int N, bf16* WT, int ldt, int kind, int off, int item, int lane) {
    const int nblk = (N + 63) >> 6, kb = item / nblk, nb = item - kb * nblk, k0 = 64 * kb + 8 * (lane & 7), n = 64 * nb + 4 * (lane >> 3);
    const f32x4* src = (const f32x4*)(W + (size_t)k0 * N + n);
    f32x4 v[2][8];
#pragma unroll
    for (int hh = 0; hh < 2; ++hh) { if (n + 32 * hh < N) {
#pragma unroll
        for (int j = 0; j < 8; ++j) v[hh][j] = __builtin_nontemporal_load(src + (size_t)j * (N >> 2) + 8 * hh); } }
#pragma unroll
    for (int hh = 0; hh < 2; ++hh) { if (n + 32 * hh < N) {
#pragma unroll
        for (int i = 0; i < 4; ++i) { v4u o; o.x = pk2(v[hh][0][i], v[hh][1][i]); o.y = pk2(v[hh][2][i], v[hh][3][i]); o.z = pk2(v[hh][4][i], v[hh][5][i]); o.w = pk2(v[hh][6][i], v[hh][7][i]);
            *(v4u*)(WT + (size_t)rowmap(kind, off, n + 32 * hh + i) * ldt + k0) = o; } } }
}
__device__ __forceinline__ void transpose_item_f8(const float* W, int N, unsigned char* WT, int ldt, int kind, int off, int item, int lane, float scale) {
    const int nblk = (N + 63) >> 6, kb = item / nblk, nb = item - kb * nblk, k0 = 64 * kb + 16 * (lane & 3), n = 64 * nb + 4 * (lane >> 2);
    if (n >= N) return;
    const f32x4* src = (const f32x4*)(W + (size_t)k0 * N + n);
    f32x4 v[16];
#pragma unroll
    for (int j = 0; j < 16; ++j) v[j] = __builtin_nontemporal_load(src + (size_t)j * (N >> 2)) * scale;
#pragma unroll
    for (int i = 0; i < 4; ++i) { v4u o; o.x = pg8::pk4_fp8(v[0][i], v[1][i], v[2][i], v[3][i]); o.y = pg8::pk4_fp8(v[4][i], v[5][i], v[6][i], v[7][i]); o.z = pg8::pk4_fp8(v[8][i], v[9][i], v[10][i], v[11][i]); o.w = pg8::pk4_fp8(v[12][i], v[13][i], v[14][i], v[15][i]);
        *(v4u*)(WT + (size_t)rowmap(kind, off, n + i) * ldt + k0) = o; }
}
__device__ __forceinline__ void p0_prologue(Frame& F) {
    __syncthreads();
    {
        LAS float* cond = (LAS float*)(F.lds + RING_OFF);
        LAS float* red = (LAS float*)(F.lds + RING_OFF + 65536);
        float* mod = (float*)(F.ws + WS_MOD);
        bool have = false;
        for (int it = F.vcu; it < 192; it += F.G) {
            if (!have) { for (int i = F.tid; i < 8 * 2048; i += NWAVES * 64) { const float cv = F.in[IN_C][i]; cond[i] = cv / (1.0f + expf(-cv)); } have = true; }
            __syncthreads();
            const int l = it / 96, cg = it % 96, c4 = F.tid & 31, dp = F.tid >> 5;
            f32x4 acc[8];
#pragma unroll
            for (int b = 0; b < 8; ++b) acc[b] = (f32x4){0.f, 0.f, 0.f, 0.f};
            const f32x4* wp = (const f32x4*)(F.in[IN_WADA] + (size_t)l * 2048 * 12288 + (size_t)(dp * 128) * 12288 + cg * 128 + 4 * c4);
            const LAS float* cp = cond + dp * 128;
#pragma unroll 8
            for (int d = 0; d < 128; ++d) { const f32x4 w = __builtin_nontemporal_load(wp + (size_t)d * 3072);
#pragma unroll
                for (int b = 0; b < 8; ++b) acc[b] += w * cp[b * 2048 + d]; }
#pragma unroll
            for (int b = 0; b < 8; ++b) *(LAS f32x4*)(red + (dp * 8 + b) * 128 + 4 * c4) = acc[b];
            __syncthreads();
            for (int i = F.tid; i < 8 * 128; i += NWAVES * 64) { const int b = i >> 7, cc = i & 127; float s = 0.f;
#pragma unroll
                for (int q = 0; q < 16; ++q) s += red[(q * 8 + b) * 128 + cc];
                mod[(size_t)(l * 8 + b) * 12288 + cg * 128 + cc] = s + F.in[IN_BADA][l * 12288 + cg * 128 + cc]; }
        }
        __syncthreads();
    }
    const int gw = F.vcu * NWAVES + F.wave, NGW = F.G * NWAVES;
    constexpr int NITEMS = 100928;
    for (int it = gw; it < NITEMS; it += NGW) {
        int r = it; const float* W; bf16* WT; int N, ldt, kind, off; float f8s = 0.f;
        if (r < 4416) { const int l = r / 2208; r -= l * 2208; W = F.in[IN_WIN] + (size_t)l * 2048 * 4376; N = 4376; WT = (bf16*)(F.ws + WS_WIN) + (size_t)l * NPROJ * 2048; ldt = 2048; kind = 2; off = 0; }
        else if ((r -= 4416) < 2048) { const int l = r / 1024; r -= l * 1024; W = F.in[IN_WOUT] + (size_t)l * 2048 * 2048; N = 2048; WT = (bf16*)(F.ws + WS_WOUT) + (size_t)l * 2048 * 2048; ldt = 2048; kind = 0; off = 0; }
        else if ((r -= 2048) < 2816) { W = F.in[IN_WFG]; N = DFF; WT = (bf16*)(F.ws + WS_WGU0); ldt = 2048; kind = 1; off = 0; }
        else if ((r -= 2816) < 2816) { W = F.in[IN_WFU]; N = DFF; WT = (bf16*)(F.ws + WS_WGU0); ldt = 2048; kind = 1; off = 128; }
        else if ((r -= 2816) < 2816) { W = F.in[IN_WFD]; N = 2048; WT = (bf16*)(F.ws + WS_WDN0); ldt = DFF; kind = 0; off = 0; }
        else if ((r -= 2816) < 28672) { const int e = r / 3584; r -= e * 3584; W = F.in[IN_WMG] + (size_t)e * 2048 * DFFE; N = DFFE; WT = (bf16*)(F.ws + WS_WGU1 + (size_t)e * 14336 * 2048); ldt = 2048; kind = 1; off = 0; f8s = 32.f; }
        else if ((r -= 28672) < 28672) { const int e = r / 3584; r -= e * 3584; W = F.in[IN_WMU] + (size_t)e * 2048 * DFFE; N = DFFE; WT = (bf16*)(F.ws + WS_WGU1 + (size_t)e * 14336 * 2048); ldt = 2048; kind = 1; off = 128; f8s = 32.f; }
        else { r -= 28672; const int e = r / 3584; r -= e * 3584; W = F.in[IN_WMD] + (size_t)e * DFFE * 2048; N = 2048; WT = (bf16*)(F.ws + WS_WDN1 + (size_t)e * 2048 * DFFE); ldt = DFFE; kind = 0; off = 0; f8s = 64.f; }
        if (f8s != 0.f) transpose_item_f8(W, N, (unsigned char*)WT, ldt, kind, off, r, F.lane, f8s);
        else transpose_item(W, N, WT, ldt, kind, off, r, F.lane);
    }
    for (int i = gw; i < 2 * 232; i += NGW) { const int l = i / 232, rr = 4376 + i % 232; v4u* p = (v4u*)((bf16*)(F.ws + WS_WIN) + ((size_t)l * NPROJ + rr) * 2048);
#pragma unroll
        for (int j = 0; j < 4; ++j) p[F.lane + 64 * j] = (v4u){0u, 0u, 0u, 0u}; }
}

template <bool ROUTER>
__device__ __forceinline__ void norm_phase(Frame& F, const float* xin, const float* g, const float* modl, int sh_off, int sc_off) {
    bf16* XN = (bf16*)(F.ws + WS_XN);
    const int gw = F.vcu * NWAVES + F.wave, NGW = F.G * NWAVES;
    LAS float* wrT = (LAS float*)(F.lds + RING_OFF);
    LAS int* lcnt = (LAS int*)(F.lds + MISC_OFF + 1152);
    LAS int* lbase = (LAS int*)(F.lds + MISC_OFF + 1216);
    LAS int* rtab = (LAS int*)(F.lds + MISC_OFF + 2048);
    int nrow = 0;
    if (ROUTER) {
        for (int i = F.tid; i < 2048 * 8; i += NWAVES * 64) wrT[(i & 7) * 2048 + (i >> 3)] = F.in[IN_WROUTER][i];
        if (F.tid < 8) lcnt[F.tid] = 0;
        __syncthreads();
    }
    for (int m = gw; m < M; m += NGW, ++nrow) {
        const int b = m >> 11;
        const f32x4* xr = (const f32x4*)(xin + (size_t)m * DM) + F.lane;
        f32x4 v[8]; float ss = 0.f;
#pragma unroll
        for (int j = 0; j < 8; ++j) { v[j] = xr[64 * j]; ss += (v[j].x * v[j].x + v[j].y * v[j].y) + (v[j].z * v[j].z + v[j].w * v[j].w); }
        const float rstd = 1.0f / sqrtf(wave_sum(ss) * (1.0f / DM) + EPS);
        const f32x4* gp = (const f32x4*)g + F.lane; const f32x4* scp = (const f32x4*)(modl + (size_t)b * 12288 + sc_off) + F.lane; const f32x4* shp = (const f32x4*)(modl + (size_t)b * 12288 + sh_off) + F.lane;
        v2u* o8 = (v2u*)(XN + (size_t)m * DM) + F.lane;
#pragma unroll
        for (int j = 0; j < 8; ++j) { const f32x4 gg = gp[64 * j], sc = scp[64 * j], sh = shp[64 * j];
            v[j] = v[j] * rstd * gg * (sc + 1.0f) + sh;
            if (ROUTER) ((unsigned*)((unsigned char*)XN + (size_t)m * DM))[F.lane + 64 * j] = pg8::pk4_fp8(v[j].x, v[j].y, v[j].z, v[j].w);
            else { v2u w; w.x = pk2(v[j].x, v[j].y); w.y = pk2(v[j].z, v[j].w); o8[64 * j] = w; } }
        if (ROUTER) {
            float lg[8];
#pragma unroll
            for (int e = 0; e < 8; ++e) { float p = 0.f; const LAS f32x4* wp = (const LAS f32x4*)(wrT + e * 2048) + F.lane;
#pragma unroll
                for (int j = 0; j < 8; ++j) { const f32x4 w = wp[64 * j]; p += (v[j].x * w.x + v[j].y * w.y) + (v[j].z * w.z + v[j].w * w.w); }
                lg[e] = wave_sum(p); }
            int e1 = 0; float v1 = lg[0];
#pragma unroll
            for (int e = 1; e < 8; ++e) if (lg[e] > v1) { v1 = lg[e]; e1 = e; }
            int e2 = -1; float v2 = -3.0e38f;
#pragma unroll
            for (int e = 0; e < 8; ++e) if (e != e1 && lg[e] > v2) { v2 = lg[e]; e2 = e; }
            const float w1 = 1.0f / (1.0f + expf(v2 - v1)), w2 = 1.0f - w1;
            if (F.lane == 0) {
                const int r1 = atomicAdd((int*)(lcnt + e1), 1), r2 = atomicAdd((int*)(lcnt + e2), 1);
                LAS int* en = rtab + (F.wave * 16 + nrow) * 8;
                en[0] = m; en[1] = e1; en[2] = r1; en[3] = __builtin_bit_cast(int, w1); en[4] = m; en[5] = e2; en[6] = r2; en[7] = __builtin_bit_cast(int, w2);
            }
        }
    }
    if (ROUTER) {
        __syncthreads();
        if (F.tid < 8) lbase[F.tid] = (int)__hip_atomic_fetch_add((unsigned*)(F.ctl + CW_CNT + 64 * F.tid), (unsigned)lcnt[F.tid], RLX_AGENT);
        __syncthreads();
        int* tk = (int*)(F.ws + WS_TOK);
        const int per = (M + NGW - 1) / NGW;
        for (int i = F.tid; i < NWAVES * per * 2; i += NWAVES * 64) { const int w = i / (per * 2), rr = (i % (per * 2)) >> 1, k = i & 1;
            const int mrow = F.vcu * NWAVES + w + rr * NGW; if (mrow >= M) continue;
            const LAS int* en = rtab + (w * 16 + rr) * 8 + 4 * k;
            const int t = en[0], e = en[1];
            tk[TOK_E + t * 2 + k] = e; tk[TOK_SLOT + t * 2 + k] = lbase[e] + en[2]; tk[TOK_W + t * 2 + k] = en[3]; }
    }
}

__device__ const unsigned char T5_BUCKET[128] = {0, 1, 2, 3, 4, 5, 6, 7, 8, 9, 10, 11, 12, 13, 14, 15, 16, 16, 16, 17, 17, 18, 18, 18, 19, 19, 19, 20, 20, 20, 20, 21, 21, 21, 21, 22, 22, 22, 22, 22, 23, 23, 23, 23, 23, 23, 24, 24, 24, 24, 24, 24, 25, 25, 25, 25, 25, 25, 25, 26, 26, 26, 26, 26, 26, 26, 26, 27, 27, 27, 27, 27, 27, 27, 27, 27, 27, 28, 28, 28, 28, 28, 28, 28, 28, 28, 28, 29, 29, 29, 29, 29, 29, 29, 29, 29, 29, 29, 29, 30, 30, 30, 30, 30, 30, 30, 30, 30, 30, 30, 30, 30, 30, 31, 31, 31, 31, 31, 31, 31, 31, 31, 31, 31, 31, 31, 31, 31};

__device__ __forceinline__ void mix_prep(Frame& F, int l) {
    const bf16* proj = (const bf16*)(F.ws + WS_PROJ); const float* side = (const float*)(F.ws + WS_SIDE);
    bf16* qkc = (bf16*)(F.ws + WS_QKC); float* la = (float*)(F.ws + WS_LA); bf16* kn = (bf16*)(F.ws + WS_KN);
    const int gw = F.vcu * NWAVES + F.wave, NGW = F.G * NWAVES, lane = F.lane;
    const float* wc = F.in[IN_WCONV] + l * 4 * 512; const float* bc = F.in[IN_BCONV] + l * 512;
    const float* wd = F.in[IN_WDEC] + l * 16 * 256; const float* bd = F.in[IN_BDEC] + l * 256; const float* gk = F.in[IN_GKN] + l * 64;
    for (int m = gw; m < M; m += NGW) {
        const int pos = m & (SEQ - 1);
        {
            float y[8]; const int ch = lane * 8;
            { const f32x4 b0 = *(const f32x4*)(bc + ch), b1 = *(const f32x4*)(bc + ch + 4); y[0] = b0.x; y[1] = b0.y; y[2] = b0.z; y[3] = b0.w; y[4] = b1.x; y[5] = b1.y; y[6] = b1.z; y[7] = b1.w; }
#pragma unroll
            for (int i = 0; i < 4; ++i) { if (pos - 3 + i >= 0) {
                const v4u xv = *(const v4u*)(proj + (size_t)(m - 3 + i) * PROJ_LD + ch);
                const f32x4 w0 = *(const f32x4*)(wc + i * 512 + ch), w1 = *(const f32x4*)(wc + i * 512 + ch + 4);
                y[0] += w0.x * bflo(xv.x); y[1] += w0.y * bfhi(xv.x); y[2] += w0.z * bflo(xv.y); y[3] += w0.w * bfhi(xv.y);
                y[4] += w1.x * bflo(xv.z); y[5] += w1.y * bfhi(xv.z); y[6] += w1.z * bflo(xv.w); y[7] += w1.w * bfhi(xv.w); } }
            const float sc = ch >= 256 ? 0.125f : 1.0f;
#pragma unroll
            for (int i = 0; i < 8; ++i) y[i] = siluf_(y[i]) * sc;
            v4u o; o.x = pk2(y[0], y[1]); o.y = pk2(y[2], y[3]); o.z = pk2(y[4], y[5]); o.w = pk2(y[6], y[7]);
            *(v4u*)(qkc + (size_t)m * 512 + ch) = o;
        }
        {
            const int c = lane * 4; f32x4 z = *(const f32x4*)(bd + c);
            const f32x4* gp = (const f32x4*)(side + (size_t)m * 32 + 8);
            const f32x4 g0 = gp[0], g1 = gp[1], g2 = gp[2], g3 = gp[3];
            const float ga[16] = {g0.x, g0.y, g0.z, g0.w, g1.x, g1.y, g1.z, g1.w, g2.x, g2.y, g2.z, g2.w, g3.x, g3.y, g3.z, g3.w};
#pragma unroll
            for (int r = 0; r < 16; ++r) { const f32x4 w = *(const f32x4*)(wd + r * 256 + c); z += w * ga[r]; }
            f32x4 o; o.x = logsigmoidf_(z.x) * 0.0625f; o.y = logsigmoidf_(z.y) * 0.0625f; o.z = logsigmoidf_(z.z) * 0.0625f; o.w = logsigmoidf_(z.w) * 0.0625f;
            *(f32x4*)(la + (size_t)m * 256 + c) = o;
        }
        {
            const unsigned kv = *(const unsigned*)(proj + (size_t)m * PROJ_LD + C_AK + 2 * lane);
            const float k0 = bflo(kv), k1 = bfhi(kv); float ss = k0 * k0 + k1 * k1;
#pragma unroll
            for (int o = 1; o < 32; o <<= 1) ss += __shfl_xor(ss, o);
            const float rstd = 1.0f / sqrtf(ss * (1.0f / 64.0f) + EPS);
            *(unsigned*)(kn + (size_t)m * 128 + 2 * lane) = pk2(k0 * rstd * gk[(2 * lane) & 63], k1 * rstd * gk[(2 * lane + 1) & 63]);
        }
    }
}

__device__ __forceinline__ void naive_mlstm(Frame& F, int l, int bh) {
    const int b = bh >> 2, h = bh & 3, tid = F.tid, v = tid >> 2, kq = tid & 3;
    const bf16* proj = (const bf16*)(F.ws + WS_PROJ); const float* side = (const float*)(F.ws + WS_SIDE); const bf16* qkc = (const bf16*)(F.ws + WS_QKC);
    bf16* Y = (bf16*)(F.ws + WS_Y);
    LAS float* red = (LAS float*)(F.lds + RING_OFF);
    const float bi = F.in[IN_BGATES][l * 8 + h], bfg = F.in[IN_BGATES][l * 8 + 4 + h];
    const float gout = F.in[IN_GOUTM][l * 512 + h * 128 + v];
    float C[16], n[16]; float mst = 0.f;
#pragma unroll
    for (int i = 0; i < 16; ++i) { C[i] = 0.f; n[i] = 0.f; }
    for (int t = 0; t < SEQ; ++t) {
        const size_t row = (size_t)b * SEQ + t;
        const v4u q0 = *(const v4u*)(qkc + row * 512 + h * 64 + kq * 16), q1 = *(const v4u*)(qkc + row * 512 + h * 64 + kq * 16 + 8);
        const v4u k0 = *(const v4u*)(qkc + row * 512 + 256 + h * 64 + kq * 16), k1 = *(const v4u*)(qkc + row * 512 + 256 + h * 64 + kq * 16 + 8);
        const float q[16] = {bflo(q0.x), bfhi(q0.x), bflo(q0.y), bfhi(q0.y), bflo(q0.z), bfhi(q0.z), bflo(q0.w), bfhi(q0.w), bflo(q1.x), bfhi(q1.x), bflo(q1.y), bfhi(q1.y), bflo(q1.z), bfhi(q1.z), bflo(q1.w), bfhi(q1.w)};
        const float k[16] = {bflo(k0.x), bfhi(k0.x), bflo(k0.y), bfhi(k0.y), bflo(k0.z), bfhi(k0.z), bflo(k0.w), bfhi(k0.w), bflo(k1.x), bfhi(k1.x), bflo(k1.y), bfhi(k1.y), bflo(k1.z), bfhi(k1.z), bflo(k1.w), bfhi(k1.w)};
        const float vv = bf1(proj[row * PROJ_LD + C_MV + h * 128 + v]);
        const float ip = side[row * 32 + h] + bi, lf = logsigmoidf_(side[row * 32 + 4 + h] + bfg);
        const float mn = fmaxf(lf + mst, ip), fd = expf(lf + mst - mn), iw = expf(ip - mn); mst = mn;
        float num = 0.f, den = 0.f;
#pragma unroll
        for (int i = 0; i < 16; ++i) { C[i] = fd * C[i] + (iw * vv) * k[i]; n[i] = fd * n[i] + iw * k[i]; num += C[i] * q[i]; den += n[i] * q[i]; }
        num += __shfl_xor(num, 1); num += __shfl_xor(num, 2); den += __shfl_xor(den, 1); den += __shfl_xor(den, 2);
        const float hv = num / fmaxf(fabsf(den), expf(-mst));
        const float s2 = wave_sum(kq == 0 ? hv * hv : 0.f);
        if (F.lane == 0) red[(t & 1) * 8 + F.wave] = s2;
        __syncthreads();
        float tot = 0.f;
#pragma unroll
        for (int w = 0; w < 8; ++w) tot += red[(t & 1) * 8 + w];
        const float rstd = 1.0f / sqrtf(tot * (1.0f / 128.0f) + EPS);
        if (kq == 0) { const float mo = bf1(proj[row * PROJ_LD + C_MO + h * 128 + v]);
            Y[row * DM + h * 128 + v] = (bf16)f2bf(hv * rstd * gout * sigmoidf_(mo)); }
    }
    __syncthreads();
}
__device__ __forceinline__ void naive_gla(Frame& F, int l, int bh) {
    const int b = bh >> 2, h = bh & 3, tid = F.tid, v = tid >> 2, kq = tid & 3;
    const bf16* proj = (const bf16*)(F.ws + WS_PROJ); const float* la = (const float*)(F.ws + WS_LA);
    bf16* Y = (bf16*)(F.ws + WS_Y);
    LAS float* red = (LAS float*)(F.lds + RING_OFF);
    const float gout = F.in[IN_GOUTG][l * 512 + h * 128 + v];
    float S[16];
#pragma unroll
    for (int i = 0; i < 16; ++i) S[i] = 0.f;
    for (int t = 0; t < SEQ; ++t) {
        const size_t row = (size_t)b * SEQ + t;
        const v4u q0 = *(const v4u*)(proj + row * PROJ_LD + C_GQ + h * 64 + kq * 16), q1 = *(const v4u*)(proj + row * PROJ_LD + C_GQ + h * 64 + kq * 16 + 8);
        const v4u k0 = *(const v4u*)(proj + row * PROJ_LD + C_GK + h * 64 + kq * 16), k1 = *(const v4u*)(proj + row * PROJ_LD + C_GK + h * 64 + kq * 16 + 8);
        const float q[16] = {bflo(q0.x), bfhi(q0.x), bflo(q0.y), bfhi(q0.y), bflo(q0.z), bfhi(q0.z), bflo(q0.w), bfhi(q0.w), bflo(q1.x), bfhi(q1.x), bflo(q1.y), bfhi(q1.y), bflo(q1.z), bfhi(q1.z), bflo(q1.w), bfhi(q1.w)};
        const float k[16] = {bflo(k0.x), bfhi(k0.x), bflo(k0.y), bfhi(k0.y), bflo(k0.z), bfhi(k0.z), bflo(k0.w), bfhi(k0.w), bflo(k1.x), bfhi(k1.x), bflo(k1.y), bfhi(k1.y), bflo(k1.z), bfhi(k1.z), bflo(k1.w), bfhi(k1.w)};
        const f32x4* lp = (const f32x4*)(la + row * 256 + h * 64 + kq * 16);
        const f32x4 a0 = lp[0], a1 = lp[1], a2 = lp[2], a3 = lp[3];
        const float a[16] = {a0.x, a0.y, a0.z, a0.w, a1.x, a1.y, a1.z, a1.w, a2.x, a2.y, a2.z, a2.w, a3.x, a3.y, a3.z, a3.w};
        const float vv = bf1(proj[row * PROJ_LD + C_GV + h * 128 + v]);
        float o = 0.f;
#pragma unroll
        for (int i = 0; i < 16; ++i) { S[i] = expf(a[i]) * S[i] + k[i] * vv; o += (q[i] * 0.125f) * S[i]; }
        o += __shfl_xor(o, 1); o += __shfl_xor(o, 2);
        const float s2 = wave_sum(kq == 0 ? o * o : 0.f);
        if (F.lane == 0) red[(t & 1) * 8 + F.wave] = s2;
        __syncthreads();
        float tot = 0.f;
#pragma unroll
        for (int w = 0; w < 8; ++w) tot += red[(t & 1) * 8 + w];
        const float rstd = 1.0f / sqrtf(tot * (1.0f / 128.0f) + EPS);
        if (kq == 0) { const float gg = bf1(proj[row * PROJ_LD + C_GG + h * 128 + v]);
            Y[row * DM + 512 + h * 128 + v] = (bf16)f2bf(o * rstd * gout * siluf_(gg)); }
    }
    __syncthreads();
}
__device__ __forceinline__ void naive_swa(Frame& F, int l, int blk) {
    const int tid = F.tid, hq = tid & 15, row = blk * 32 + (tid >> 4), kvh = hq >> 3, pos = row & (SEQ - 1);
    const bf16* proj = (const bf16*)(F.ws + WS_PROJ); const bf16* kn = (const bf16*)(F.ws + WS_KN); bf16* Y = (bf16*)(F.ws + WS_Y);
    const float* gq = F.in[IN_GQN] + l * 64; const float* relb = F.in[IN_RELB];
    float q[64], o[64];
    { float ss = 0.f;
#pragma unroll
      for (int c = 0; c < 8; ++c) { const v4u x = *(const v4u*)(proj + (size_t)row * PROJ_LD + C_AQ + hq * 64 + 8 * c);
          q[8 * c + 0] = bflo(x.x); q[8 * c + 1] = bfhi(x.x); q[8 * c + 2] = bflo(x.y); q[8 * c + 3] = bfhi(x.y); q[8 * c + 4] = bflo(x.z); q[8 * c + 5] = bfhi(x.z); q[8 * c + 6] = bflo(x.w); q[8 * c + 7] = bfhi(x.w); }
#pragma unroll
      for (int d = 0; d < 64; ++d) ss += q[d] * q[d];
      const float rstd = 1.0f / sqrtf(ss * (1.0f / 64.0f) + EPS);
#pragma unroll
      for (int d = 0; d < 64; ++d) { q[d] = q[d] * rstd * gq[d] * 0.125f; o[d] = 0.f; } }
    float mx = F.in[IN_SINKS][l * 16 + hq], den = 1.0f;
    const int s0 = pos - 127 < 0 ? 0 : pos - 127;
    for (int s = s0; s <= pos; ++s) {
        const size_t kr = (size_t)(row - pos + s);
        float dot = 0.f;
#pragma unroll
        for (int c = 0; c < 8; ++c) { const v4u x = *(const v4u*)(kn + kr * 128 + kvh * 64 + 8 * c);
            dot += q[8 * c + 0] * bflo(x.x) + q[8 * c + 1] * bfhi(x.x) + q[8 * c + 2] * bflo(x.y) + q[8 * c + 3] * bfhi(x.y) + q[8 * c + 4] * bflo(x.z) + q[8 * c + 5] * bfhi(x.z) + q[8 * c + 6] * bflo(x.w) + q[8 * c + 7] * bfhi(x.w); }
        const float sc = dot + relb[T5_BUCKET[pos - s] * 16 + hq];
        const float mn = fmaxf(mx, sc), corr = expf(mx - mn), p = expf(sc - mn); mx = mn; den = den * corr + p;
#pragma unroll
        for (int c = 0; c < 8; ++c) { const v4u x = *(const v4u*)(proj + kr * PROJ_LD + C_AV + kvh * 64 + 8 * c);
            o[8 * c + 0] = o[8 * c + 0] * corr + p * bflo(x.x); o[8 * c + 1] = o[8 * c + 1] * corr + p * bfhi(x.x); o[8 * c + 2] = o[8 * c + 2] * corr + p * bflo(x.y); o[8 * c + 3] = o[8 * c + 3] * corr + p * bfhi(x.y);
            o[8 * c + 4] = o[8 * c + 4] * corr + p * bflo(x.z); o[8 * c + 5] = o[8 * c + 5] * corr + p * bfhi(x.z); o[8 * c + 6] = o[8 * c + 6] * corr + p * bflo(x.w); o[8 * c + 7] = o[8 * c + 7] * corr + p * bfhi(x.w); }
    }
    const float inv = 1.0f / den;
#pragma unroll
    for (int c = 0; c < 8; ++c) { v4u w; w.x = pk2(o[8 * c] * inv, o[8 * c + 1] * inv); w.y = pk2(o[8 * c + 2] * inv, o[8 * c + 3] * inv); w.z = pk2(o[8 * c + 4] * inv, o[8 * c + 5] * inv); w.w = pk2(o[8 * c + 6] * inv, o[8 * c + 7] * inv);
        *(v4u*)(Y + (size_t)row * DM + 1024 + hq * 64 + 8 * c) = w; }
}
__device__ __forceinline__ void mix_naive(Frame& F, int l) {
    for (int u = F.vcu; u < 64 + 512; u += F.G) {
        if (u < 32) { if (!FAST_MLSTM) naive_mlstm(F, l, u); }
        else if (u < 64) { if (!FAST_GLA) naive_gla(F, l, u - 32); }
        else { if (!FAST_SWA) naive_swa(F, l, u - 64); }
    }
}

__device__ __forceinline__ int moe_tables(Frame& F) {
    LAS int* seg = (LAS int*)(F.lds + MISC_OFF + 1024); LAS int* tile_e = (LAS int*)(F.lds + MISC_OFF + 64);
    if (F.tid == 0) { int s = 0;
        for (int e = 0; e < 8; ++e) { seg[e] = s; const int c = (int)__hip_atomic_load(F.ctl + CW_CNT + 64 * e, RLX_AGENT); const int nt = (c + 255) >> 8; for (int i = 0; i < nt; ++i) tile_e[(s >> 8) + i] = e; s += nt << 8; }
        seg[8] = s; }
    __syncthreads();
    return seg[8] >> 8;
}
__device__ __forceinline__ void moe_gather(Frame& F) {
    (void)moe_tables(F);
    const LAS int* seg = (const LAS int*)(F.lds + MISC_OFF + 1024);
    const int gw = F.vcu * NWAVES + F.wave, NGW = F.G * NWAVES;
    int* tk = (int*)(F.ws + WS_TOK); const unsigned char* XN = (const unsigned char*)(F.ws + WS_XN); unsigned char* AS = (unsigned char*)(F.ws + WS_AS);
    for (int m = gw; m < M; m += NGW) {
        const v4u* src = (const v4u*)(XN + (size_t)m * DM) + F.lane; v4u r[2];
#pragma unroll
        for (int j = 0; j < 2; ++j) r[j] = src[64 * j];
#pragma unroll
        for (int k = 0; k < 2; ++k) { const int e = tk[TOK_E + m * 2 + k], dest = seg[e] + tk[TOK_SLOT + m * 2 + k];
            v4u* dst = (v4u*)(AS + (size_t)dest * DM) + F.lane;
#pragma unroll
            for (int j = 0; j < 2; ++j) dst[64 * j] = r[j];
            if (F.lane == 0) tk[TOK_POS + m * 2 + k] = dest; }
    }
    for (int e = 0; e < 8; ++e) { const int c = (int)__hip_atomic_load(F.ctl + CW_CNT + 64 * e, RLX_AGENT);
        for (int r = seg[e] + c + gw; r < seg[e + 1]; r += NGW) { v4u* dst = (v4u*)(AS + (size_t)r * DM) + F.lane;
#pragma unroll
            for (int j = 0; j < 2; ++j) dst[64 * j] = (v4u){0u, 0u, 0u, 0u}; } }
}
__device__ __forceinline__ void moe_combine(Frame& F, const float* gtf) {
    const int gw = F.vcu * NWAVES + F.wave, NGW = F.G * NWAVES;
    const int* tk = (const int*)(F.ws + WS_TOK); const float* xa = (const float*)(F.ws + WS_XA); const bf16* YS = (const bf16*)(F.ws + WS_AS);
    for (int m = gw; m < M; m += NGW) {
        const int b = m >> 11, p1 = tk[TOK_POS + 2 * m], p2 = tk[TOK_POS + 2 * m + 1];
        const float w1 = __builtin_bit_cast(float, tk[TOK_W + 2 * m]), w2 = __builtin_bit_cast(float, tk[TOK_W + 2 * m + 1]);
        const f32x4* xr = (const f32x4*)(xa + (size_t)m * DM) + F.lane; const f32x4* gp = (const f32x4*)(gtf + (size_t)b * 12288) + F.lane;
        const v2u* y1 = (const v2u*)(YS + (size_t)p1 * DM) + F.lane; const v2u* y2 = (const v2u*)(YS + (size_t)p2 * DM) + F.lane;
        f32x4* op = (f32x4*)(F.out + (size_t)m * DM) + F.lane;
#pragma unroll
        for (int j = 0; j < 8; ++j) { const f32x4 x = xr[64 * j], g = gp[64 * j]; const v2u a = y1[64 * j], c = y2[64 * j];
            f32x4 y; y.x = w1 * bflo(a.x) + w2 * bflo(c.x); y.y = w1 * bfhi(a.x) + w2 * bfhi(c.x); y.z = w1 * bflo(a.y) + w2 * bflo(c.y); y.w = w1 * bfhi(a.y) + w2 * bfhi(c.y);
            op[64 * j] = x + g * y; }
    }
}

typedef short v4i16_t __attribute__((ext_vector_type(4)));
#define MFMA16(a, b, c) __builtin_amdgcn_mfma_f32_16x16x32_bf16((a), (b), (c), 0, 0, 0)
__device__ __forceinline__ bf16x8 frag_row(const LAS unsigned char* base, int ldb, int r0, int k0, int lane) {
    return *(const LAS bf16x8*)(base + (r0 + (lane & 15)) * ldb + (k0 + 8 * (lane >> 4)) * 2);
}
__device__ __forceinline__ bf16x8 frag_tr2(const LAS unsigned char* base, int ldb, int ra, int rb, int c0, int lane) {
    const int g = lane >> 4, q = (lane & 15) >> 2, p = lane & 3;
    const LAS unsigned char* a0 = base + (ra + 4 * g + q) * ldb + (c0 + 4 * p) * 2;
    const LAS unsigned char* a1 = base + (rb + 4 * g + q) * ldb + (c0 + 4 * p) * 2;
    const v4i16_t lo = __builtin_amdgcn_ds_read_tr16_b64_v4i16((LAS v4i16_t*)a0), hi = __builtin_amdgcn_ds_read_tr16_b64_v4i16((LAS v4i16_t*)a1);
    bf16x8 r; r[0] = lo[0]; r[1] = lo[1]; r[2] = lo[2]; r[3] = lo[3]; r[4] = hi[0]; r[5] = hi[1]; r[6] = hi[2]; r[7] = hi[3]; return r;
}
__device__ __forceinline__ bf16x8 frag_tr(const LAS unsigned char* base, int ldb, int k0, int c0, int lane) {
    const int g = lane >> 4;
    return frag_tr2(base, ldb, k0 + 4 * g, k0 + 4 * g + 4, c0, lane);
}
__device__ __forceinline__ bf16x8 pack8(float a, float b, float c, float d, float e, float f, float g, float h) {
    v4u w; w.x = pk2(a, b); w.y = pk2(c, d); w.z = pk2(e, f); w.w = pk2(g, h); return __builtin_bit_cast(bf16x8, w);
}
__device__ __forceinline__ float scan_add(float v, int lane) {
#pragma unroll
    for (int d = 1; d < 64; d <<= 1) { const float t = __shfl_up(v, d); if (lane >= d) v += t; }
    return v;
}
__device__ __forceinline__ float scan_max(float v, int lane) {
#pragma unroll
    for (int d = 1; d < 64; d <<= 1) { const float t = __shfl_up(v, d); if (lane >= d) v = fmaxf(v, t); }
    return v;
}

__device__ __forceinline__ void swa_unit(Frame& F, int l, int unit) {
    const int b = unit >> 5, kvh = (unit >> 4) & 1, nb = unit & 15;
    const int tid = F.tid, lane = F.lane, w = F.wave, g = lane >> 4, n = lane & 15;
    const bf16* proj = (const bf16*)(F.ws + WS_PROJ); bf16* Y = (bf16*)(F.ws + WS_Y);
    LAS unsigned char* Kt = F.lds + RING_OFF; LAS unsigned char* Vt = Kt + 36864; LAS float* bias = (LAS float*)(Kt + 73728);
    constexpr int LDB = 144;
    __syncthreads();
    {
        const int r = tid >> 1, hf = tid & 1, pos = nb * 128 - 128 + r;
        v4u kx[4], vx[4];
        if (pos >= 0) { const bf16* kp = proj + (size_t)(b * SEQ + pos) * PROJ_LD + C_AK + kvh * 64 + hf * 32; const bf16* vp = proj + (size_t)(b * SEQ + pos) * PROJ_LD + C_AV + kvh * 64 + hf * 32;
#pragma unroll
            for (int j = 0; j < 4; ++j) { kx[j] = *(const v4u*)(kp + 8 * j); vx[j] = *(const v4u*)(vp + 8 * j); } }
        else {
#pragma unroll
            for (int j = 0; j < 4; ++j) { kx[j] = (v4u){0u, 0u, 0u, 0u}; vx[j] = (v4u){0u, 0u, 0u, 0u}; } }
        float kf[32]; float ss = 0.f;
#pragma unroll
        for (int j = 0; j < 4; ++j) { kf[8 * j + 0] = bflo(kx[j].x); kf[8 * j + 1] = bfhi(kx[j].x); kf[8 * j + 2] = bflo(kx[j].y); kf[8 * j + 3] = bfhi(kx[j].y); kf[8 * j + 4] = bflo(kx[j].z); kf[8 * j + 5] = bfhi(kx[j].z); kf[8 * j + 6] = bflo(kx[j].w); kf[8 * j + 7] = bfhi(kx[j].w); }
#pragma unroll
        for (int i = 0; i < 32; ++i) ss += kf[i] * kf[i];
        ss += __shfl_xor(ss, 1);
        const float rstd = 1.0f / sqrtf(ss * (1.0f / 64.0f) + EPS);
        const float* gk = F.in[IN_GKN] + l * 64 + hf * 32;
#pragma unroll
        for (int j = 0; j < 4; ++j) { const f32x4 g0 = *(const f32x4*)(gk + 8 * j), g1 = *(const f32x4*)(gk + 8 * j + 4);
            v4u o; o.x = pk2(kf[8 * j] * rstd * g0.x, kf[8 * j + 1] * rstd * g0.y); o.y = pk2(kf[8 * j + 2] * rstd * g0.z, kf[8 * j + 3] * rstd * g0.w);
            o.z = pk2(kf[8 * j + 4] * rstd * g1.x, kf[8 * j + 5] * rstd * g1.y); o.w = pk2(kf[8 * j + 6] * rstd * g1.z, kf[8 * j + 7] * rstd * g1.w);
            *(LAS v4u*)(Kt + r * LDB + hf * 64 + 16 * j) = o; *(LAS v4u*)(Vt + r * LDB + hf * 64 + 16 * j) = vx[j]; }
    }
    for (int i = tid; i < 1024; i += NWAVES * 64) bias[i] = F.in[IN_RELB][T5_BUCKET[i & 127] * 16 + kvh * 8 + (i >> 7)];
    __syncthreads();
    const int hq = kvh * 8 + w;
    const float sink = F.in[IN_SINKS][l * 16 + hq];
    const float* gq = F.in[IN_GQN] + l * 64;
    const f32x4 gq0 = *(const f32x4*)(gq + 8 * g), gq1 = *(const f32x4*)(gq + 8 * g + 4), gq2 = *(const f32x4*)(gq + 32 + 8 * g), gq3 = *(const f32x4*)(gq + 32 + 8 * g + 4);
    const LAS float* bw = bias + w * 128;
    for (int qb = 0; qb < 4; ++qb) {
        const int j0 = qb * 32;
        bf16x8 qf[2][2];
#pragma unroll
        for (int jt = 0; jt < 2; ++jt) {
            const bf16* qp = proj + (size_t)(b * SEQ + nb * 128 + j0 + jt * 16 + n) * PROJ_LD + C_AQ + hq * 64;
            const v4u x0 = *(const v4u*)(qp + 8 * g), x1 = *(const v4u*)(qp + 32 + 8 * g);
            float f[16] = {bflo(x0.x), bfhi(x0.x), bflo(x0.y), bfhi(x0.y), bflo(x0.z), bfhi(x0.z), bflo(x0.w), bfhi(x0.w), bflo(x1.x), bfhi(x1.x), bflo(x1.y), bfhi(x1.y), bflo(x1.z), bfhi(x1.z), bflo(x1.w), bfhi(x1.w)};
            float ss = 0.f;
#pragma unroll
            for (int i = 0; i < 16; ++i) ss += f[i] * f[i];
            ss += __shfl_xor(ss, 16); ss += __shfl_xor(ss, 32);
            const float rs = 0.125f / sqrtf(ss * (1.0f / 64.0f) + EPS);
            qf[jt][0] = pack8(f[0] * rs * gq0.x, f[1] * rs * gq0.y, f[2] * rs * gq0.z, f[3] * rs * gq0.w, f[4] * rs * gq1.x, f[5] * rs * gq1.y, f[6] * rs * gq1.z, f[7] * rs * gq1.w);
            qf[jt][1] = pack8(f[8] * rs * gq2.x, f[9] * rs * gq2.y, f[10] * rs * gq2.z, f[11] * rs * gq2.w, f[12] * rs * gq3.x, f[13] * rs * gq3.y, f[14] * rs * gq3.z, f[15] * rs * gq3.w);
        }
        f32x4 sc[2][10];
#pragma unroll
        for (int i = 0; i < 10; ++i) { const int kt = 2 * qb + i;
            const bf16x8 k0 = frag_row(Kt, LDB, 16 * kt, 0, lane), k1 = frag_row(Kt, LDB, 16 * kt, 32, lane);
#pragma unroll
            for (int jt = 0; jt < 2; ++jt) { f32x4 a = (f32x4){0.f, 0.f, 0.f, 0.f}; a = MFMA16(k0, qf[jt][0], a); a = MFMA16(k1, qf[jt][1], a); sc[jt][i] = a; } }
        float inv[2];
#pragma unroll
        for (int jt = 0; jt < 2; ++jt) { const int j = j0 + 16 * jt + n; float mx = sink;
#pragma unroll
            for (int i = 0; i < 10; ++i)
#pragma unroll
                for (int r = 0; r < 4; ++r) { const int s = 16 * (2 * qb + i) + 4 * g + r, dist = j + 128 - s; const bool ok = (dist >= 0) && (dist < 128) && (nb > 0 || s >= 128);
                    const float v = ok ? sc[jt][i][r] + bw[dist & 127] : -INFINITY; sc[jt][i][r] = v; mx = fmaxf(mx, v); }
            mx = fmaxf(mx, __shfl_xor(mx, 16)); mx = fmaxf(mx, __shfl_xor(mx, 32));
            float sum = 0.f;
#pragma unroll
            for (int i = 0; i < 10; ++i)
#pragma unroll
                for (int r = 0; r < 4; ++r) { const float p = __expf(sc[jt][i][r] - mx); sc[jt][i][r] = p; sum += p; }
            sum += __shfl_xor(sum, 16); sum += __shfl_xor(sum, 32);
            inv[jt] = 1.0f / (sum + __expf(sink - mx)); }
        f32x4 o[4][2];
#pragma unroll
        for (int dt = 0; dt < 4; ++dt) { o[dt][0] = (f32x4){0.f, 0.f, 0.f, 0.f}; o[dt][1] = (f32x4){0.f, 0.f, 0.f, 0.f}; }
#pragma unroll
        for (int kk = 0; kk < 5; ++kk) { bf16x8 pf[2];
#pragma unroll
            for (int jt = 0; jt < 2; ++jt) pf[jt] = pack8(sc[jt][2 * kk][0], sc[jt][2 * kk][1], sc[jt][2 * kk][2], sc[jt][2 * kk][3], sc[jt][2 * kk + 1][0], sc[jt][2 * kk + 1][1], sc[jt][2 * kk + 1][2], sc[jt][2 * kk + 1][3]);
            const int ra = 16 * (2 * qb + 2 * kk);
#pragma unroll
            for (int dt = 0; dt < 4; ++dt) { const bf16x8 a = frag_tr2(Vt, LDB, ra, ra + 16, 16 * dt, lane);
                o[dt][0] = MFMA16(a, pf[0], o[dt][0]); o[dt][1] = MFMA16(a, pf[1], o[dt][1]); } }
#pragma unroll
        for (int jt = 0; jt < 2; ++jt) { bf16* yp = Y + (size_t)(b * SEQ + nb * 128 + j0 + 16 * jt + n) * DM + 1024 + hq * 64 + 4 * g;
#pragma unroll
            for (int dt = 0; dt < 4; ++dt) { v2u wv; wv.x = pk2(o[dt][jt][0] * inv[jt], o[dt][jt][1] * inv[jt]); wv.y = pk2(o[dt][jt][2] * inv[jt], o[dt][jt][3] * inv[jt]); *(v2u*)(yp + 16 * dt) = wv; } }
    }
}

__device__ __forceinline__ void gla_u_unit(Frame& F, int l, int u) {
    const int b = u >> 7, h = (u >> 5) & 3, c = u & 31, t0 = b * SEQ + 64 * c;
    const int tid = F.tid, lane = F.lane, w = F.wave, g = lane >> 4, n = lane & 15;
    const bf16* proj = (const bf16*)(F.ws + WS_PROJ); const float* side = (const float*)(F.ws + WS_SIDE);
    bf16* QT = (bf16*)(F.ws + WS_GAUX); bf16* QP = QT + (size_t)M * 256; bf16* KT = QP + (size_t)M * 256; float* BL = (float*)(KT + (size_t)M * 256); float* UG = (float*)(F.ws + WS_UG);
    LAS float* LAm = (LAS float*)(F.lds + RING_OFF);
    LAS unsigned char* KP = F.lds + RING_OFF + 16640;
    LAS unsigned char* VT = F.lds + RING_OFF + 25856;
    __syncthreads();
    const int s = tid >> 3, kg = tid & 7;
    {
        const float* wd = F.in[IN_WDEC] + l * 16 * 256 + h * 64 + 8 * kg; const float* bd = F.in[IN_BDEC] + l * 256 + h * 64 + 8 * kg;
        f32x4 z0 = *(const f32x4*)(bd), z1 = *(const f32x4*)(bd + 4);
        const f32x4* gp = (const f32x4*)(side + (size_t)(t0 + s) * 32 + 8);
        const f32x4 g0 = gp[0], g1 = gp[1], g2 = gp[2], g3 = gp[3];
        const float ga[16] = {g0.x, g0.y, g0.z, g0.w, g1.x, g1.y, g1.z, g1.w, g2.x, g2.y, g2.z, g2.w, g3.x, g3.y, g3.z, g3.w};
#pragma unroll
        for (int r = 0; r < 16; ++r) { z0 += *(const f32x4*)(wd + r * 256) * ga[r]; z1 += *(const f32x4*)(wd + r * 256 + 4) * ga[r]; }
        LAS float* lp = LAm + s * 65 + 8 * kg;
        lp[0] = logsigmoidf_(z0.x) * 0.0625f; lp[1] = logsigmoidf_(z0.y) * 0.0625f; lp[2] = logsigmoidf_(z0.z) * 0.0625f; lp[3] = logsigmoidf_(z0.w) * 0.0625f;
        lp[4] = logsigmoidf_(z1.x) * 0.0625f; lp[5] = logsigmoidf_(z1.y) * 0.0625f; lp[6] = logsigmoidf_(z1.z) * 0.0625f; lp[7] = logsigmoidf_(z1.w) * 0.0625f;
        const bf16* vp = proj + (size_t)(t0 + s) * PROJ_LD + C_GV + h * 128 + 16 * kg;
        *(LAS v4u*)(VT + s * 272 + 32 * kg) = *(const v4u*)(vp); *(LAS v4u*)(VT + s * 272 + 32 * kg + 16) = *(const v4u*)(vp + 8);
    }
    __syncthreads();
#pragma unroll
    for (int ci = 0; ci < 8; ++ci) { const int k = 8 * w + ci; const float v = scan_add(LAm[lane * 65 + k], lane); LAm[lane * 65 + k] = v; }
    __syncthreads();
    {
        const bf16* kp = proj + (size_t)(t0 + s) * PROJ_LD + C_GK + h * 64 + 8 * kg; const bf16* qp = proj + (size_t)(t0 + s) * PROJ_LD + C_GQ + h * 64 + 8 * kg;
        const v4u kx = *(const v4u*)kp, qx = *(const v4u*)qp;
        const float kf[8] = {bflo(kx.x), bfhi(kx.x), bflo(kx.y), bfhi(kx.y), bflo(kx.z), bfhi(kx.z), bflo(kx.w), bfhi(kx.w)};
        const float qf[8] = {bflo(qx.x), bfhi(qx.x), bflo(qx.y), bfhi(qx.y), bflo(qx.z), bfhi(qx.z), bflo(qx.w), bfhi(qx.w)};
        float o1[8], o2[8], o3[8], o4[8];
#pragma unroll
        for (int i = 0; i < 8; ++i) { const float bb = LAm[s * 65 + 8 * kg + i], bl = LAm[63 * 65 + 8 * kg + i], br = LAm[31 * 65 + 8 * kg + i];
            o1[i] = kf[i] * __expf(bl - bb); o2[i] = qf[i] * 0.125f * __expf(bb - br); o3[i] = qf[i] * 0.125f * __expf(bb); o4[i] = kf[i] * __expf(br - bb);
            if (s == 63) BL[(size_t)u * 64 + 8 * kg + i] = bl; }
        v4u o; o.x = pk2(o1[0], o1[1]); o.y = pk2(o1[2], o1[3]); o.z = pk2(o1[4], o1[5]); o.w = pk2(o1[6], o1[7]); *(LAS v4u*)(KP + s * 144 + 16 * kg) = o;
        const size_t go = (size_t)(t0 + s) * 256 + h * 64 + 8 * kg;
        o.x = pk2(o2[0], o2[1]); o.y = pk2(o2[2], o2[3]); o.z = pk2(o2[4], o2[5]); o.w = pk2(o2[6], o2[7]); *(v4u*)(QT + go) = o;
        o.x = pk2(o3[0], o3[1]); o.y = pk2(o3[2], o3[3]); o.z = pk2(o3[4], o3[5]); o.w = pk2(o3[6], o3[7]); *(v4u*)(QP + go) = o;
        o.x = pk2(o4[0], o4[1]); o.y = pk2(o4[2], o4[3]); o.z = pk2(o4[4], o4[5]); o.w = pk2(o4[6], o4[7]); *(v4u*)(KT + go) = o;
    }
    __syncthreads();
    {
        f32x4 acc[4];
#pragma unroll
        for (int mt = 0; mt < 4; ++mt) acc[mt] = (f32x4){0.f, 0.f, 0.f, 0.f};
#pragma unroll
        for (int ks = 0; ks < 2; ++ks) { const bf16x8 bv = frag_tr(VT, 272, 32 * ks, 16 * w, lane);
#pragma unroll
            for (int mt = 0; mt < 4; ++mt) { const bf16x8 a = frag_tr(KP, 144, 32 * ks, 16 * mt, lane); acc[mt] = MFMA16(a, bv, acc[mt]); } }
        float* up = UG + (size_t)u * 64 * 128 + 16 * w + n;
#pragma unroll
        for (int mt = 0; mt < 4; ++mt)
#pragma unroll
            for (int r = 0; r < 4; ++r) up[(size_t)(16 * mt + 4 * g + r) * 128] = acc[mt][r];
    }
}
__device__ __forceinline__ void gla_out_group(Frame& F, int l, int ug) {
    const int bh = ug >> 3, jj = ug & 7, b = bh >> 2, h = bh & 3;
    const int tid = F.tid, lane = F.lane, w = F.wave, g = lane >> 4, n = lane & 15;
    const bf16* proj = (const bf16*)(F.ws + WS_PROJ); bf16* Y = (bf16*)(F.ws + WS_Y);
    const bf16* QT = (const bf16*)(F.ws + WS_GAUX); const bf16* QP = QT + (size_t)M * 256; const bf16* KT = QP + (size_t)M * 256; const float* BL = (const float*)(KT + (size_t)M * 256); const float* UG = (const float*)(F.ws + WS_UG);
    LAS unsigned char* LQT = F.lds + RING_OFF; LAS unsigned char* LQP = LQT + 9216; LAS unsigned char* LKT = LQT + 18432; LAS unsigned char* VT = LQT + 27648; LAS unsigned char* ST = LQT + 45056;
    LAS float* SS = (LAS float*)(LQT + 62464);
    float S[16];
#pragma unroll
    for (int i = 0; i < 16; ++i) S[i] = 0.f;
    const int sk = tid >> 3, sv = (tid & 7) * 16;
    int cdone = 0;
    const float* gout = F.in[IN_GOUTG] + l * 512 + h * 128;
    for (int oi = 0; oi < 4; ++oi) {
        const int c = oi == 0 ? jj : (oi == 1 ? 15 - jj : (oi == 2 ? 16 + jj : 31 - jj));
        for (; cdone < c; ++cdone) { const int uu = bh * 32 + cdone; const float dec = __expf(BL[(size_t)uu * 64 + sk]);
            const f32x4* up = (const f32x4*)(UG + (size_t)uu * 64 * 128 + sk * 128 + sv);
#pragma unroll
            for (int q = 0; q < 4; ++q) { const f32x4 x = up[q]; S[4 * q] = dec * S[4 * q] + x.x; S[4 * q + 1] = dec * S[4 * q + 1] + x.y; S[4 * q + 2] = dec * S[4 * q + 2] + x.z; S[4 * q + 3] = dec * S[4 * q + 3] + x.w; } }
        const int t0 = b * SEQ + 64 * c;
        __syncthreads();
        {
            v4u o; o.x = pk2(S[0], S[1]); o.y = pk2(S[2], S[3]); o.z = pk2(S[4], S[5]); o.w = pk2(S[6], S[7]); *(LAS v4u*)(ST + sk * 272 + sv * 2) = o;
            o.x = pk2(S[8], S[9]); o.y = pk2(S[10], S[11]); o.z = pk2(S[12], S[13]); o.w = pk2(S[14], S[15]); *(LAS v4u*)(ST + sk * 272 + sv * 2 + 16) = o;
            const int s = tid >> 3, kg = tid & 7; const size_t go = (size_t)(t0 + s) * 256 + h * 64 + 8 * kg;
            *(LAS v4u*)(LQT + s * 144 + 16 * kg) = *(const v4u*)(QT + go); *(LAS v4u*)(LQP + s * 144 + 16 * kg) = *(const v4u*)(QP + go); *(LAS v4u*)(LKT + s * 144 + 16 * kg) = *(const v4u*)(KT + go);
            const bf16* vp = proj + (size_t)(t0 + s) * PROJ_LD + C_GV + h * 128 + 16 * kg;
            *(LAS v4u*)(VT + s * 272 + 32 * kg) = *(const v4u*)(vp); *(LAS v4u*)(VT + s * 272 + 32 * kg + 16) = *(const v4u*)(vp + 8);
        }
        __syncthreads();
        const int jt = w & 3, vh = w >> 2;
        bf16x8 qf[2], qpf[2];
#pragma unroll
        for (int ks = 0; ks < 2; ++ks) { qf[ks] = frag_row(LQT, 144, 16 * jt, 32 * ks, lane); qpf[ks] = frag_row(LQP, 144, 16 * jt, 32 * ks, lane); }
        f32x4 at[4];
#pragma unroll
        for (int st = 0; st < 4; ++st) { at[st] = (f32x4){0.f, 0.f, 0.f, 0.f};
            if (st <= jt) {
#pragma unroll
                for (int ks = 0; ks < 2; ++ks) at[st] = MFMA16(frag_row(LKT, 144, 16 * st, 32 * ks, lane), qf[ks], at[st]);
                if (st == jt) {
#pragma unroll
                    for (int r = 0; r < 4; ++r) if (4 * g + r > n) at[st][r] = 0.f; } } }
        f32x4 o[4];
#pragma unroll
        for (int mt = 0; mt < 4; ++mt) { o[mt] = (f32x4){0.f, 0.f, 0.f, 0.f};
#pragma unroll
            for (int ks = 0; ks < 2; ++ks) o[mt] = MFMA16(frag_tr(ST, 272, 32 * ks, 64 * vh + 16 * mt, lane), qpf[ks], o[mt]); }
#pragma unroll
        for (int kk = 0; kk < 2; ++kk) { if (2 * kk <= jt) {
            const bf16x8 pf = pack8(at[2 * kk][0], at[2 * kk][1], at[2 * kk][2], at[2 * kk][3], at[2 * kk + 1][0], at[2 * kk + 1][1], at[2 * kk + 1][2], at[2 * kk + 1][3]);
#pragma unroll
            for (int mt = 0; mt < 4; ++mt) o[mt] = MFMA16(frag_tr2(VT, 272, 32 * kk, 32 * kk + 16, 64 * vh + 16 * mt, lane), pf, o[mt]); } }
        float ss = 0.f;
#pragma unroll
        for (int mt = 0; mt < 4; ++mt)
#pragma unroll
            for (int r = 0; r < 4; ++r) ss += o[mt][r] * o[mt][r];
        ss += __shfl_xor(ss, 16); ss += __shfl_xor(ss, 32);
        if (g == 0) SS[w * 16 + n] = ss;
        __syncthreads();
        const float rstd = 1.0f / sqrtf((SS[w * 16 + n] + SS[(w ^ 4) * 16 + n]) * (1.0f / 128.0f) + EPS);
        const size_t row = (size_t)(t0 + 16 * jt + n);
#pragma unroll
        for (int mt = 0; mt < 4; ++mt) { const int v = 64 * vh + 16 * mt + 4 * g;
            const f32x4 go4 = *(const f32x4*)(gout + v); const v2u gx = *(const v2u*)(proj + row * PROJ_LD + C_GG + h * 128 + v);
            v2u wv; wv.x = pk2(o[mt][0] * rstd * go4.x * siluf_(bflo(gx.x)), o[mt][1] * rstd * go4.y * siluf_(bfhi(gx.x))); wv.y = pk2(o[mt][2] * rstd * go4.z * siluf_(bflo(gx.y)), o[mt][3] * rstd * go4.w * siluf_(bfhi(gx.y)));
            *(v2u*)(Y + row * DM + 512 + h * 128 + v) = wv; }
    }
}

__device__ __forceinline__ void mlstm_u_unit(Frame& F, int l, int u) {
    const int b = u >> 6, h = (u >> 4) & 3, c = u & 15, t0 = b * SEQ + 128 * c;
    const int tid = F.tid, lane = F.lane, w = F.wave, g = lane >> 4, n = lane & 15;
    const bf16* proj = (const bf16*)(F.ws + WS_PROJ); const float* side = (const float*)(F.ws + WS_SIDE); bf16* qkc = (bf16*)(F.ws + WS_QKC);
    float* UM = (float*)(F.ws + WS_UM); float* MS = UM + (size_t)512 * 136 * 64;
    LAS unsigned char* KP = F.lds + RING_OFF;
    LAS unsigned char* VT = F.lds + RING_OFF + 18432;
    LAS float* GF = (LAS float*)(F.lds + RING_OFF + 53248);
    __syncthreads();
    const int s = tid >> 2, qd = tid & 3;
    float kc[16];
    {
        const float* wc = F.in[IN_WCONV] + l * 4 * 512; const float* bc = F.in[IN_BCONV] + l * 512;
        const int pos = 128 * c + s;
#pragma unroll
        for (int part = 0; part < 2; ++part) { const int ch = part * 256 + h * 64 + 16 * qd; float y[16];
#pragma unroll
            for (int q4 = 0; q4 < 4; ++q4) { const f32x4 bb = *(const f32x4*)(bc + ch + 4 * q4); y[4 * q4] = bb.x; y[4 * q4 + 1] = bb.y; y[4 * q4 + 2] = bb.z; y[4 * q4 + 3] = bb.w; }
#pragma unroll
            for (int i = 0; i < 4; ++i) { if (pos - 3 + i >= 0) { const bf16* xp = proj + (size_t)(t0 + s - 3 + i) * PROJ_LD + ch; const v4u x0 = *(const v4u*)xp, x1 = *(const v4u*)(xp + 8);
                const float xf[16] = {bflo(x0.x), bfhi(x0.x), bflo(x0.y), bfhi(x0.y), bflo(x0.z), bfhi(x0.z), bflo(x0.w), bfhi(x0.w), bflo(x1.x), bfhi(x1.x), bflo(x1.y), bfhi(x1.y), bflo(x1.z), bfhi(x1.z), bflo(x1.w), bfhi(x1.w)};
#pragma unroll
                for (int q4 = 0; q4 < 4; ++q4) { const f32x4 ww = *(const f32x4*)(wc + i * 512 + ch + 4 * q4); y[4 * q4] += ww.x * xf[4 * q4]; y[4 * q4 + 1] += ww.y * xf[4 * q4 + 1]; y[4 * q4 + 2] += ww.z * xf[4 * q4 + 2]; y[4 * q4 + 3] += ww.w * xf[4 * q4 + 3]; } } }
            const float scl = part ? 0.125f : 1.0f;
#pragma unroll
            for (int i = 0; i < 16; ++i) y[i] = siluf_(y[i]) * scl;
            v4u o0, o1; o0.x = pk2(y[0], y[1]); o0.y = pk2(y[2], y[3]); o0.z = pk2(y[4], y[5]); o0.w = pk2(y[6], y[7]); o1.x = pk2(y[8], y[9]); o1.y = pk2(y[10], y[11]); o1.z = pk2(y[12], y[13]); o1.w = pk2(y[14], y[15]);
            *(v4u*)(qkc + (size_t)(t0 + s) * 512 + ch) = o0; *(v4u*)(qkc + (size_t)(t0 + s) * 512 + ch + 8) = o1;
            if (part) {
#pragma unroll
                for (int i = 0; i < 16; ++i) kc[i] = y[i]; } }
        const bf16* vp = proj + (size_t)(t0 + s) * PROJ_LD + C_MV + h * 128 + 32 * qd;
#pragma unroll
        for (int j = 0; j < 4; ++j) *(LAS v4u*)(VT + s * 272 + 64 * qd + 16 * j) = *(const v4u*)(vp + 8 * j);
        if (tid < 128) { GF[tid] = logsigmoidf_(side[(size_t)(t0 + tid) * 32 + 4 + h] + F.in[IN_BGATES][l * 8 + 4 + h]); GF[128 + tid] = side[(size_t)(t0 + tid) * 32 + h] + F.in[IN_BGATES][l * 8 + h]; }
    }
    __syncthreads();
    if (w == 0) {
        const float a0 = GF[2 * lane], a1 = GF[2 * lane + 1]; const float P = scan_add(a0 + a1, lane);
        const float blast = __shfl(P, 63);
        const float lw0 = blast - (P - a1) + GF[128 + 2 * lane], lw1 = blast - P + GF[128 + 2 * lane + 1];
        float mx = fmaxf(lw0, lw1);
#pragma unroll
        for (int o = 1; o < 64; o <<= 1) mx = fmaxf(mx, __shfl_xor(mx, o));
        GF[256 + 2 * lane] = expf(lw0 - mx); GF[256 + 2 * lane + 1] = expf(lw1 - mx);
        if (lane == 0) { MS[(size_t)u * 2] = blast; MS[(size_t)u * 2 + 1] = mx; }
    }
    __syncthreads();
    {   const float wg = GF[256 + s];
        v4u o0, o1; o0.x = pk2(kc[0] * wg, kc[1] * wg); o0.y = pk2(kc[2] * wg, kc[3] * wg); o0.z = pk2(kc[4] * wg, kc[5] * wg); o0.w = pk2(kc[6] * wg, kc[7] * wg);
        o1.x = pk2(kc[8] * wg, kc[9] * wg); o1.y = pk2(kc[10] * wg, kc[11] * wg); o1.z = pk2(kc[12] * wg, kc[13] * wg); o1.w = pk2(kc[14] * wg, kc[15] * wg);
        *(LAS v4u*)(KP + s * 144 + 32 * qd) = o0; *(LAS v4u*)(KP + s * 144 + 32 * qd + 16) = o1; }
    __syncthreads();
    {
        const int nt = w & 3, m0 = w >> 2;
        f32x4 acc[5];
#pragma unroll
        for (int i = 0; i < 5; ++i) acc[i] = (f32x4){0.f, 0.f, 0.f, 0.f};
        const bf16x8 ones = (n == 0) ? pack8(1.f, 1.f, 1.f, 1.f, 1.f, 1.f, 1.f, 1.f) : pack8(0.f, 0.f, 0.f, 0.f, 0.f, 0.f, 0.f, 0.f);
#pragma unroll
        for (int ks = 0; ks < 4; ++ks) { const bf16x8 bv = frag_tr(KP, 144, 32 * ks, 16 * nt, lane);
#pragma unroll
            for (int i = 0; i < 4; ++i) acc[i] = MFMA16(frag_tr(VT, 272, 32 * ks, 16 * (m0 + 2 * i), lane), bv, acc[i]);
            if (m0 == 0) acc[4] = MFMA16(ones, bv, acc[4]); }
        float* up = UM + (size_t)u * 136 * 64 + 16 * nt + n;
#pragma unroll
        for (int i = 0; i < 4; ++i)
#pragma unroll
            for (int r = 0; r < 4; ++r) up[(size_t)(16 * (m0 + 2 * i) + 4 * g + r) * 64] = acc[i][r];
        if (m0 == 0 && g == 0) up[(size_t)128 * 64] = acc[4][0];
    }
}
__device__ __forceinline__ void mlstm_out_group(Frame& F, int l, int ug) {
    const int bh = ug >> 3, jj = ug & 7, b = bh >> 2, h = bh & 3;
    const int tid = F.tid, lane = F.lane, w = F.wave, g = lane >> 4, n = lane & 15;
    const bf16* proj = (const bf16*)(F.ws + WS_PROJ); const float* side = (const float*)(F.ws + WS_SIDE); const bf16* qkc = (const bf16*)(F.ws + WS_QKC); bf16* Y = (bf16*)(F.ws + WS_Y);
    const float* UM = (const float*)(F.ws + WS_UM); const float* MS = UM + (size_t)512 * 136 * 64;
    LAS unsigned char* QC = F.lds + RING_OFF; LAS unsigned char* KC = QC + 18432; LAS unsigned char* VT = QC + 36864; LAS unsigned char* CS = QC + 71680;
    LAS float* GF = (LAS float*)(QC + 92416);
    float C[16], nn = 0.f, mst = 0.f;
#pragma unroll
    for (int i = 0; i < 16; ++i) C[i] = 0.f;
    const int cv = tid >> 2, ck = (tid & 3) * 16;
    int cdone = 0;
    const float* gout = F.in[IN_GOUTM] + l * 512 + h * 128;
    for (int oi = 0; oi < 2; ++oi) {
        const int c = oi == 0 ? jj : 15 - jj;
        for (; cdone < c; ++cdone) { const int uu = bh * 16 + cdone; const float Bc = MS[(size_t)uu * 2], ml = MS[(size_t)uu * 2 + 1];
            const float mn = fmaxf(Bc + mst, ml), d1 = expf(Bc + mst - mn), d2 = expf(ml - mn); mst = mn;
            const f32x4* up = (const f32x4*)(UM + (size_t)uu * 136 * 64 + cv * 64 + ck);
#pragma unroll
            for (int q = 0; q < 4; ++q) { const f32x4 x = up[q]; C[4 * q] = d1 * C[4 * q] + d2 * x.x; C[4 * q + 1] = d1 * C[4 * q + 1] + d2 * x.y; C[4 * q + 2] = d1 * C[4 * q + 2] + d2 * x.z; C[4 * q + 3] = d1 * C[4 * q + 3] + d2 * x.w; }
            if (tid < 64) nn = d1 * nn + d2 * UM[(size_t)uu * 136 * 64 + 128 * 64 + tid]; }
        const int t0 = b * SEQ + 128 * c;
        __syncthreads();
        {
            v4u o; o.x = pk2(C[0], C[1]); o.y = pk2(C[2], C[3]); o.z = pk2(C[4], C[5]); o.w = pk2(C[6], C[7]); *(LAS v4u*)(CS + cv * 144 + ck * 2) = o;
            o.x = pk2(C[8], C[9]); o.y = pk2(C[10], C[11]); o.z = pk2(C[12], C[13]); o.w = pk2(C[14], C[15]); *(LAS v4u*)(CS + cv * 144 + ck * 2 + 16) = o;
            if (tid < 64) *(LAS bf16*)(CS + 128 * 144 + tid * 2) = (bf16)f2bf(nn);
            for (int i = tid; i < 15 * 72; i += NWAVES * 64) *(LAS bf16*)(CS + 129 * 144 + i * 2) = (bf16)0;
            const int s = tid >> 2, qd = tid & 3;
            const bf16* qp = qkc + (size_t)(t0 + s) * 512 + h * 64 + 16 * qd;
            *(LAS v4u*)(QC + s * 144 + 32 * qd) = *(const v4u*)qp; *(LAS v4u*)(QC + s * 144 + 32 * qd + 16) = *(const v4u*)(qp + 8);
            *(LAS v4u*)(KC + s * 144 + 32 * qd) = *(const v4u*)(qp + 256); *(LAS v4u*)(KC + s * 144 + 32 * qd + 16) = *(const v4u*)(qp + 256 + 8);
            const bf16* vp = proj + (size_t)(t0 + s) * PROJ_LD + C_MV + h * 128 + 32 * qd;
#pragma unroll
            for (int j = 0; j < 4; ++j) *(LAS v4u*)(VT + s * 272 + 64 * qd + 16 * j) = *(const v4u*)(vp + 8 * j);
            if (tid < 128) { GF[tid] = logsigmoidf_(side[(size_t)(t0 + tid) * 32 + 4 + h] + F.in[IN_BGATES][l * 8 + 4 + h]); GF[128 + tid] = side[(size_t)(t0 + tid) * 32 + h] + F.in[IN_BGATES][l * 8 + h]; }
        }
        __syncthreads();
        if (w == 0) {
            const float a0 = GF[2 * lane], a1 = GF[2 * lane + 1]; const float P = scan_add(a0 + a1, lane);
            const float b0 = P - a1, b1 = P; const float x0 = GF[128 + 2 * lane] - b0, x1 = GF[128 + 2 * lane + 1] - b1;
            const float cm = scan_max(fmaxf(x0, x1), lane);
            float prev = __shfl_up(cm, 1); if (lane == 0) prev = -INFINITY;
            const float M0 = fmaxf(mst, fmaxf(prev, x0)), M1 = fmaxf(mst, cm);
            GF[2 * lane] = x0; GF[2 * lane + 1] = x1; GF[128 + 2 * lane] = M0; GF[128 + 2 * lane + 1] = M1; GF[256 + 2 * lane] = b0; GF[256 + 2 * lane + 1] = b1;
        }
        __syncthreads();
        {
            const int j = 16 * w + n; const float Mj = GF[128 + j], bj = GF[256 + j];
            bf16x8 qf[2];
#pragma unroll
            for (int ks = 0; ks < 2; ++ks) qf[ks] = frag_row(QC, 144, 16 * w, 32 * ks, lane);
            f32x4 p[8];
#pragma unroll
            for (int st = 0; st < 8; ++st) { p[st] = (f32x4){0.f, 0.f, 0.f, 0.f};
                if (st <= w) {
#pragma unroll
                    for (int ks = 0; ks < 2; ++ks) p[st] = MFMA16(frag_row(KC, 144, 16 * st, 32 * ks, lane), qf[ks], p[st]);
                    const f32x4 as = *(const LAS f32x4*)(GF + 16 * st + 4 * g);
#pragma unroll
                    for (int r = 0; r < 4; ++r) { const float e = __expf(as[r] - Mj); p[st][r] = (st < w || 4 * g + r <= n) ? p[st][r] * e : 0.f; } } }
            f32x4 o[9];
            const float wi = __expf(mst - Mj);
#pragma unroll
            for (int mt = 0; mt < 9; ++mt) { o[mt] = (f32x4){0.f, 0.f, 0.f, 0.f};
#pragma unroll
                for (int ks = 0; ks < 2; ++ks) o[mt] = MFMA16(frag_row(CS, 144, 16 * mt, 32 * ks, lane), qf[ks], o[mt]);
                o[mt] = o[mt] * wi; }
            const bf16x8 ones = (n == 0) ? pack8(1.f, 1.f, 1.f, 1.f, 1.f, 1.f, 1.f, 1.f) : pack8(0.f, 0.f, 0.f, 0.f, 0.f, 0.f, 0.f, 0.f);
#pragma unroll
            for (int kk = 0; kk < 4; ++kk) { if (2 * kk <= w) {
                const bf16x8 pf = pack8(p[2 * kk][0], p[2 * kk][1], p[2 * kk][2], p[2 * kk][3], p[2 * kk + 1][0], p[2 * kk + 1][1], p[2 * kk + 1][2], p[2 * kk + 1][3]);
#pragma unroll
                for (int mt = 0; mt < 8; ++mt) o[mt] = MFMA16(frag_tr2(VT, 272, 32 * kk, 32 * kk + 16, 16 * mt, lane), pf, o[mt]);
                o[8] = MFMA16(ones, pf, o[8]); } }
            const float den = __shfl(o[8][0], n);
            const float dn = 1.0f / fmaxf(fabsf(den), __expf(-(bj + Mj)));
            float ss = 0.f;
#pragma unroll
            for (int mt = 0; mt < 8; ++mt)
#pragma unroll
                for (int r = 0; r < 4; ++r) { o[mt][r] *= dn; ss += o[mt][r] * o[mt][r]; }
            ss += __shfl_xor(ss, 16); ss += __shfl_xor(ss, 32);
            const float rstd = 1.0f / sqrtf(ss * (1.0f / 128.0f) + EPS);
            const size_t row = (size_t)(t0 + j);
#pragma unroll
            for (int mt = 0; mt < 8; ++mt) { const int v = 16 * mt + 4 * g;
                const f32x4 go4 = *(const f32x4*)(gout + v); const v2u mx = *(const v2u*)(proj + row * PROJ_LD + C_MO + h * 128 + v);
                v2u wv; wv.x = pk2(o[mt][0] * rstd * go4.x * sigmoidf_(bflo(mx.x)), o[mt][1] * rstd * go4.y * sigmoidf_(bfhi(mx.x))); wv.y = pk2(o[mt][2] * rstd * go4.z * sigmoidf_(bflo(mx.y)), o[mt][3] * rstd * go4.w * sigmoidf_(bfhi(mx.y)));
                *(v2u*)(Y + row * DM + h * 128 + v) = wv; }
        }
    }
}

__device__ __forceinline__ void mix_a(Frame& F, int l) {
    if (!(FAST_GLA && FAST_MLSTM && FAST_SWA)) mix_prep(F, l);
    if (FAST_SWA) for (int u = F.vcu; u < 256; u += F.G) swa_unit(F, l, u);
    if (FAST_MLSTM) for (int u = F.vcu; u < 512; u += F.G) mlstm_u_unit(F, l, u);
    if (FAST_GLA) for (int u = F.vcu; u < 1024; u += F.G) gla_u_unit(F, l, u);
}
__device__ __forceinline__ void mix_b(Frame& F, int l) {
    if (!(FAST_GLA && FAST_MLSTM && FAST_SWA)) mix_naive(F, l);
    if (FAST_MLSTM) for (int ug = F.vcu; ug < 256; ug += F.G) mlstm_out_group(F, l, ug);
    if (FAST_GLA) for (int ug = F.vcu; ug < 256; ug += F.G) gla_out_group(F, l, ug);
}

#ifndef PROBE_REPEAT
#define PROBE_REPEAT -1
#endif
#ifndef MK_ONE_LAUNCH
#define MK_ONE_LAUNCH 1
#endif
constexpr int NPH = 19;
struct Args { const float* in[26]; float* out; unsigned char* ws; int ph_lo, ph_hi; };
__global__ void __launch_bounds__(NWAVES * 64, 2) hybrid_fwd(Args args) {
    extern __shared__ __attribute__((aligned(16))) unsigned char lds[];
    Frame F;
    F.lds = (LAS unsigned char*)lds;
    F.tid = threadIdx.x; F.lane = F.tid & 63; F.wave = __builtin_amdgcn_readfirstlane(F.tid >> 6);
    F.G = gridDim.x; { const int bx = blockIdx.x; F.vcu = (F.G % 8 == 0) ? (bx % 8) * (F.G / 8) + bx / 8 : bx; }
    F.ws = args.ws; F.out = args.out; F.ctl = (gu32*)(args.ws + WS_CTL);
    F.in = (cfp_k*)__builtin_amdgcn_kernarg_segment_ptr();
    for (int u = F.tid; u < (LDS_BYTES - MISC_OFF) / 4; u += NWAVES * 64) ((LAS unsigned*)(F.lds + MISC_OFF))[u] = 0u;
    __syncthreads();
    const int lo = args.ph_lo, hi = args.ph_hi;
    XcdBarrier bar; bar.bar = (unsigned*)(F.ctl + CW_BAR); bar.x = 0; bar.st = nullptr;
    if (hi - lo > 1) bar = xcd_barrier_post((unsigned*)(F.ctl + CW_BAR), (volatile LAS unsigned*)(F.lds + MISC_OFF));
#define IN(k) (lo <= (k) && (k) < hi)
#define SEAM(k) do { if (IN(k) && IN((k) + 1)) xcd_barrier(bar); } while (0)
    bf16* const XN = (bf16*)(F.ws + WS_XN); bf16* const Yb = (bf16*)(F.ws + WS_Y); float* const XA = (float*)(F.ws + WS_XA);
    bf16* const PROJ = (bf16*)(F.ws + WS_PROJ); float* const SIDE = (float*)(F.ws + WS_SIDE); bf16* const HID = (bf16*)(F.ws + WS_HID); bf16* const AS = (bf16*)(F.ws + WS_AS);
    const float* const MOD = (const float*)(F.ws + WS_MOD);

    if (IN(0)) { p0_prologue(F); if (PROBE_REPEAT == 0) p0_prologue(F); }
    SEAM(0);
#define LAYER_MIX(l) do { \
        const int pb = 1 + 8 * (l); \
        const float* modl = MOD + (size_t)(l) * 8 * 12288; \
        const float* xin = (l) == 0 ? F.in[IN_X] : (const float*)F.out; \
        if (IN(pb)) { norm_phase<false>(F, xin, F.in[IN_GMIX] + (l) * DM, modl, 0, 2048); if (PROBE_REPEAT == pb) norm_phase<false>(F, xin, F.in[IN_GMIX] + (l) * DM, modl, 0, 2048); } \
        SEAM(pb); \
        if (IN(pb + 1)) { \
            pg8::Gemm g{XN, (const bf16*)(F.ws + WS_WIN) + (size_t)(l) * NPROJ * DM, M, NPROJ, DM}; pg8::StaticOrder S; S.init(M, NPROJ, F.G, (int)blockIdx.x); \
            pg8::EpiProj E{PROJ, SIDE}; \
            pg8::gemm_phase<pg8::EpiProj, pg8::StaticOrder, true, true>(F.lds + RING_OFF, g, S, E); \
            if (PROBE_REPEAT == pb + 1) pg8::gemm_phase<pg8::EpiProj, pg8::StaticOrder, true, true>(F.lds + RING_OFF, g, S, E); \
        } \
        SEAM(pb + 1); \
        if (IN(pb + 2)) { mix_a(F, (l)); if (PROBE_REPEAT == pb + 2) mix_a(F, (l)); } \
        SEAM(pb + 2); \
        if (IN(pb + 3)) { mix_b(F, (l)); if (PROBE_REPEAT == pb + 3) mix_b(F, (l)); } \
        SEAM(pb + 3); \
        if (IN(pb + 4)) { \
            pg8::Gemm g{Yb, (const bf16*)(F.ws + WS_WOUT) + (size_t)(l) * DM * DM, M, DM, DM}; pg8::StaticOrder S; S.init(M, DM, F.G, (int)blockIdx.x); \
            pg8::EpiResid E{xin, XA, modl + 4096}; \
            pg8::gemm_phase<pg8::EpiResid, pg8::StaticOrder, true, true>(F.lds + RING_OFF, g, S, E); \
            if (PROBE_REPEAT == pb + 4) pg8::gemm_phase<pg8::EpiResid, pg8::StaticOrder, true, true>(F.lds + RING_OFF, g, S, E); \
        } \
        SEAM(pb + 4); \
    } while (0)
    LAYER_MIX(0);
    {
        const float* modl = MOD;
        if (IN(6)) { norm_phase<false>(F, XA, F.in[IN_GFFN], modl, 6144, 8192); if (PROBE_REPEAT == 6) norm_phase<false>(F, XA, F.in[IN_GFFN], modl, 6144, 8192); }
        SEAM(6);
        if (IN(7)) {
            pg8::Gemm g{XN, (const bf16*)(F.ws + WS_WGU0), M, 2 * DFF, DM}; pg8::StaticOrder S; S.init(M, 2 * DFF, F.G, (int)blockIdx.x);
            pg8::EpiSwiglu E{HID, DFF, 44};
            pg8::gemm_phase<pg8::EpiSwiglu, pg8::StaticOrder, true, true>(F.lds + RING_OFF, g, S, E);
            if (PROBE_REPEAT == 7) pg8::gemm_phase<pg8::EpiSwiglu, pg8::StaticOrder, true, true>(F.lds + RING_OFF, g, S, E);
        }
        SEAM(7);
        if (IN(8)) {
            pg8::Gemm g{HID, (const bf16*)(F.ws + WS_WDN0), M, DM, DFF}; pg8::StaticOrder S; S.init(M, DM, F.G, (int)blockIdx.x);
            pg8::EpiResid E{XA, F.out, modl + 10240};
            pg8::gemm_phase<pg8::EpiResid, pg8::StaticOrder, true, true>(F.lds + RING_OFF, g, S, E);
            if (PROBE_REPEAT == 8) pg8::gemm_phase<pg8::EpiResid, pg8::StaticOrder, true, true>(F.lds + RING_OFF, g, S, E);
        }
        SEAM(8);
    }
    LAYER_MIX(1);
    const float* mod1 = MOD + (size_t)8 * 12288;
    if (IN(14)) norm_phase<true>(F, XA, F.in[IN_GFFN] + DM, mod1, 6144, 8192);
    SEAM(14);
    if (IN(15)) { moe_gather(F); if (PROBE_REPEAT == 15) moe_gather(F); }
    SEAM(15);
    if (IN(16)) {
        const int T = moe_tables(F);
        pg8::Gemm g{AS, (const bf16*)(F.ws + WS_WGU1), T * 256, 2 * DFFE, DM / 2}; pg8::GroupedOrder S; S.init(T, 56, F.G, (int)blockIdx.x, (const LAS int*)(F.lds + MISC_OFF + 64));
        pg8::EpiSwigluF8 E{(unsigned char*)HID, DFFE, 56};
        pg8::gemm_phase<pg8::EpiSwigluF8, pg8::GroupedOrder, true, true>(F.lds + RING_OFF, g, S, E);
        if (PROBE_REPEAT == 16) pg8::gemm_phase<pg8::EpiSwigluF8, pg8::GroupedOrder, true, true>(F.lds + RING_OFF, g, S, E);
    }
    SEAM(16);
    if (IN(17)) {
        const int T = moe_tables(F);
        pg8::Gemm g{HID, (const bf16*)(F.ws + WS_WDN1), T * 256, DM, DFFE / 2}; pg8::GroupedOrder S; S.init(T, 8, F.G, (int)blockIdx.x, (const LAS int*)(F.lds + MISC_OFF + 64));
        pg8::EpiPlainBf16F8 E{AS, DM, 8};
        pg8::gemm_phase<pg8::EpiPlainBf16F8, pg8::GroupedOrder, true, true>(F.lds + RING_OFF, g, S, E);
        if (PROBE_REPEAT == 17) pg8::gemm_phase<pg8::EpiPlainBf16F8, pg8::GroupedOrder, true, true>(F.lds + RING_OFF, g, S, E);
    }
    SEAM(17);
    if (IN(18)) { moe_combine(F, mod1 + 10240); if (PROBE_REPEAT == 18) moe_combine(F, mod1 + 10240); }
#undef IN
#undef SEAM
}

extern "C" void kernel_launch(void* const* d_in, const int* in_sizes, int n_in, void* d_out, int out_size, void* d_ws, size_t ws_size, hipStream_t stream) {
    static int grid = 0;
    if (grid == 0) {
        if (n_in != 26 || in_sizes[0] != M * DM || out_size != M * DM || ws_size < WS_END) { fprintf(stderr, "kernel_launch: unexpected shapes (n_in %d, in0 %d, out %d, ws %zu < %zu)\n", n_in, n_in > 0 ? in_sizes[0] : -1, out_size, ws_size, (size_t)WS_END); grid = -1; return; }
        int dev = 0, cus = 0, per_cu = 0;
        if (hipGetDevice(&dev) != hipSuccess || hipDeviceGetAttribute(&cus, hipDeviceAttributeMultiprocessorCount, dev) != hipSuccess) { grid = -1; return; }
        if (hipFuncSetAttribute((const void*)hybrid_fwd, hipFuncAttributeMaxDynamicSharedMemorySize, LDS_BYTES) != hipSuccess) { fprintf(stderr, "kernel_launch: hipFuncSetAttribute failed\n"); grid = -1; return; }
        if (hipOccupancyMaxActiveBlocksPerMultiprocessor(&per_cu, (const void*)hybrid_fwd, NWAVES * 64, LDS_BYTES) != hipSuccess || per_cu < 1) fprintf(stderr, "kernel_launch: occupancy query says %d\n", per_cu);
        (void)hipGetLastError();
        grid = cus < 256 ? cus : 256;
    }
    if (grid < 0) return;
    if (hipMemsetAsync((char*)d_ws + WS_CTL, 0, CTL_ZERO_BYTES, stream) != hipSuccess) return;
    Args a{};
    for (int i = 0; i < 26; ++i) a.in[i] = (const float*)d_in[i];
    a.out = (float*)d_out; a.ws = (unsigned char*)d_ws;
#if MK_ONE_LAUNCH
    a.ph_lo = 0; a.ph_hi = NPH;
    hipLaunchKernelGGL(hybrid_fwd, dim3(grid), dim3(NWAVES * 64), LDS_BYTES, stream, a);
#else
    for (int p = 0; p < NPH; ++p) { a.ph_lo = p; a.ph_hi = p + 1; hipLaunchKernelGGL(hybrid_fwd, dim3(grid), dim3(NWAVES * 64), LDS_BYTES, stream, a); }
#endif
}
```

```cpp
#include <hip/hip_runtime.h>
#include <cstdio>
#include <cstdint>
namespace pg8 {
#define PG8_LAS __attribute__((address_space(3)))
typedef unsigned short bf16_t;
typedef short bf16x8 __attribute__((ext_vector_type(8)));
typedef float f32x4 __attribute__((ext_vector_type(4)));
typedef unsigned u32x4 __attribute__((ext_vector_type(4)));
constexpr int BM = 256, BK = 64, HALF = 128, HTB = HALF * BK * 2  , STAGE_BYTES = 8 * HTB, NXCD = 8, WGM = 8;

__host__ __device__ __forceinline__ int lds_byte(int r, int c) { const int st = (r >> 4) * 2 + (c >> 5), rr = r & 15, cc = c & 31, ob = rr * 64 + cc * 2; return st * 1024 + (ob ^ (((ob >> 9) & 1) << 5)); }
__host__ __device__ __forceinline__ void stage_rc(int b, int& R, int& C) { const int st = b / 1024, sb = b % 1024, swz = sb ^ (((sb >> 9) & 1) << 5); R = (st >> 1) * 16 + swz / 64; C = (st & 1) * 32 + (swz % 64) / 2; }
__host__ __device__ __forceinline__ int perm32(int rho) { const int n = rho >> 4, i = rho & 15; return 8 * (i >> 2) + 4 * n + (i & 3); }

struct Unit { int pm, pn; };
struct Gemm { const bf16_t* A; const bf16_t* Bt; int M, N, K; };

struct StaticOrder {
    int nM, nN, nwg, G, c;
    __host__ __device__ void init(int M, int N, int G_, int c_) { nM = M / BM; nN = N / BM; nwg = nM * nN; G = G_; c = c_; }
    __host__ __device__ bool next(int i, Unit& u) const {
        const long L = (long)i * G + c; if (L >= nwg) return false;
        int wgid = (int)L; { const int q = nwg / NXCD, r = nwg % NXCD, xcd = wgid % NXCD, off = wgid / NXCD; wgid = (xcd < r ? xcd * (q + 1) : r * (q + 1) + (xcd - r) * q) + off; }
        const int nig = WGM * nN, gid = wgid / nig, fm = gid * WGM, gsz = (nM - fm) < WGM ? (nM - fm) : WGM;
        u.pm = fm + ((wgid % nig) % gsz); u.pn = (wgid % nig) / gsz; return true;
    }
    __device__ __forceinline__ void a_ready(const Unit&) const {}
    __device__ __forceinline__ void done(const Unit&) const {}
};
__device__ __forceinline__ unsigned cvt_pk_bf16(float lo, float hi) { unsigned r; asm volatile("v_cvt_pk_bf16_f32 %0, %1, %2" : "=v"(r) : "v"(lo), "v"(hi)); return r; }
typedef int i32x8 __attribute__((ext_vector_type(8)));
typedef int i32x4 __attribute__((ext_vector_type(4)));
__device__ __forceinline__ i32x8 cat8(bf16x8 lo, bf16x8 hi) { const i32x4 a = __builtin_bit_cast(i32x4, lo), b = __builtin_bit_cast(i32x4, hi); return __builtin_shufflevector(a, b, 0, 1, 2, 3, 4, 5, 6, 7); }
typedef unsigned u32x2 __attribute__((ext_vector_type(2)));
__device__ __forceinline__ float fast_silu(float g) { return g * __builtin_amdgcn_rcpf(1.0f + __expf(-g)); }
struct EpiProj {
    static constexpr bool PERM = true, AFTER_DRAIN = false, FP8 = false; static constexpr int SCALE_W = 127, SCALE_X = 127;
    bf16_t* O; float* side;
    __device__ __forceinline__ void operator()(const f32x4 (&acc)[2][2][4][2], const Unit& u, int wr, int wc, int fr, int fq) const {
        const int row0 = u.pm * BM + wr * 64 + fr;
        if (u.pn < 17) {
            const int col0 = u.pn * BM + wc * 32 + 8 * fq;
#pragma unroll
            for (int ai = 0; ai < 2; ++ai)
#pragma unroll
                for (int m = 0; m < 4; ++m) { bf16_t* rowp = O + (size_t)(row0 + ai * HALF + m * 16) * 4352 + col0;
#pragma unroll
                    for (int bj = 0; bj < 2; ++bj) { const f32x4 v0 = acc[ai][bj][m][0], v1 = acc[ai][bj][m][1];
                        u32x4 w; w.x = cvt_pk_bf16(v0[0], v0[1]); w.y = cvt_pk_bf16(v0[2], v0[3]); w.z = cvt_pk_bf16(v1[0], v1[1]); w.w = cvt_pk_bf16(v1[2], v1[3]);
                        *(u32x4*)(rowp + bj * HALF) = w; } }
        } else if (wc == 0) {
#pragma unroll
            for (int ai = 0; ai < 2; ++ai)
#pragma unroll
                for (int m = 0; m < 4; ++m) { float* rowp = side + (size_t)(row0 + ai * HALF + m * 16) * 32 + 8 * fq;
                    *(f32x4*)(rowp) = acc[ai][0][m][0]; *(f32x4*)(rowp + 4) = acc[ai][0][m][1]; }
        }
    }
};
struct EpiResid {
    static constexpr bool PERM = false, AFTER_DRAIN = false, FP8 = false; static constexpr int SCALE_W = 127, SCALE_X = 127;
    const float* base; float* out; const float* gate;
    __device__ __forceinline__ void operator()(const f32x4 (&acc)[2][2][4][2], const Unit& u, int wr, int wc, int fr, int fq) const {
        const int row0 = u.pm * BM + wr * 64 + fr, col0 = u.pn * BM + wc * 32 + 4 * fq;
        const float* __restrict__ gp = gate + (size_t)(u.pm >> 3) * 12288 + col0;
        const float* __restrict__ bp = base + (size_t)row0 * 2048 + col0; float* __restrict__ op = out + (size_t)row0 * 2048 + col0;
        f32x4 gv[2][2];
#pragma unroll
        for (int bj = 0; bj < 2; ++bj)
#pragma unroll
            for (int n = 0; n < 2; ++n) gv[bj][n] = *(const f32x4*)(gp + bj * HALF + n * 16);
        f32x4 cur[2][2], nxt[2][2];
#pragma unroll
        for (int bj = 0; bj < 2; ++bj)
#pragma unroll
            for (int n = 0; n < 2; ++n) cur[bj][n] = *(const f32x4*)(bp + bj * HALF + n * 16);
#pragma unroll
        for (int g = 0; g < 8; ++g) { const int ai = g >> 2, m = g & 3; const size_t off = (size_t)(ai * HALF + m * 16) * 2048;
            if (g < 7) { const int ai2 = (g + 1) >> 2, m2 = (g + 1) & 3; const size_t off2 = (size_t)(ai2 * HALF + m2 * 16) * 2048;
#pragma unroll
                for (int bj = 0; bj < 2; ++bj)
#pragma unroll
                    for (int n = 0; n < 2; ++n) nxt[bj][n] = *(const f32x4*)(bp + off2 + bj * HALF + n * 16); }
#pragma unroll
            for (int bj = 0; bj < 2; ++bj)
#pragma unroll
                for (int n = 0; n < 2; ++n) *(f32x4*)(op + off + bj * HALF + n * 16) = cur[bj][n] + gv[bj][n] * acc[ai][bj][m][n];
#pragma unroll
            for (int bj = 0; bj < 2; ++bj)
#pragma unroll
                for (int n = 0; n < 2; ++n) cur[bj][n] = nxt[bj][n];
            asm volatile("" ::: "memory"); }
    }
};
struct EpiSwiglu {
    static constexpr bool PERM = true, AFTER_DRAIN = false, FP8 = false; static constexpr int SCALE_W = 127, SCALE_X = 127;
    bf16_t* O; int ldc; int nN;
    __device__ __forceinline__ void operator()(const f32x4 (&acc)[2][2][4][2], const Unit& u, int wr, int wc, int fr, int fq) const {
        const int row0 = u.pm * BM + wr * 64 + fr, col0 = (u.pn % nN) * HALF + wc * 32 + 8 * fq;
#pragma unroll
        for (int ai = 0; ai < 2; ++ai)
#pragma unroll
            for (int m = 0; m < 4; ++m) { bf16_t* rowp = O + (size_t)(row0 + ai * HALF + m * 16) * ldc + col0;
                const f32x4 g0 = acc[ai][0][m][0], g1 = acc[ai][0][m][1], u0 = acc[ai][1][m][0], u1 = acc[ai][1][m][1];
                u32x4 w; w.x = cvt_pk_bf16(fast_silu(g0[0]) * u0[0], fast_silu(g0[1]) * u0[1]); w.y = cvt_pk_bf16(fast_silu(g0[2]) * u0[2], fast_silu(g0[3]) * u0[3]);
                w.z = cvt_pk_bf16(fast_silu(g1[0]) * u1[0], fast_silu(g1[1]) * u1[1]); w.w = cvt_pk_bf16(fast_silu(g1[2]) * u1[2], fast_silu(g1[3]) * u1[3]);
                *(u32x4*)(rowp) = w; }
    }
};
struct EpiPlainBf16 {
    static constexpr bool PERM = true, AFTER_DRAIN = false, FP8 = false; static constexpr int SCALE_W = 127, SCALE_X = 127;
    bf16_t* O; int ldc; int nN;
    __device__ __forceinline__ void operator()(const f32x4 (&acc)[2][2][4][2], const Unit& u, int wr, int wc, int fr, int fq) const {
        const int row0 = u.pm * BM + wr * 64 + fr, col0 = (u.pn % nN) * BM + wc * 32 + 8 * fq;
#pragma unroll
        for (int ai = 0; ai < 2; ++ai)
#pragma unroll
            for (int m = 0; m < 4; ++m) { bf16_t* rowp = O + (size_t)(row0 + ai * HALF + m * 16) * ldc + col0;
#pragma unroll
                for (int bj = 0; bj < 2; ++bj) { const f32x4 v0 = acc[ai][bj][m][0], v1 = acc[ai][bj][m][1];
                    u32x4 w; w.x = cvt_pk_bf16(v0[0], v0[1]); w.y = cvt_pk_bf16(v0[2], v0[3]); w.z = cvt_pk_bf16(v1[0], v1[1]); w.w = cvt_pk_bf16(v1[2], v1[3]);
                    *(u32x4*)(rowp + bj * HALF) = w; } }
    }
};
__device__ __forceinline__ float clamp448(float x) { return fminf(fmaxf(x, -448.f), 448.f); }
__device__ __forceinline__ unsigned pk4_fp8(float a, float b, float c, float d) { int w = 0; w = __builtin_amdgcn_cvt_pk_fp8_f32(clamp448(a), clamp448(b), w, false); w = __builtin_amdgcn_cvt_pk_fp8_f32(clamp448(c), clamp448(d), w, true); return (unsigned)w; }
struct EpiSwigluF8 {
    static constexpr bool PERM = true, AFTER_DRAIN = false, FP8 = true; static constexpr int SCALE_W = 122, SCALE_X = 127;
    unsigned char* O; int ldc; int nN;
    __device__ __forceinline__ void operator()(const f32x4 (&acc)[2][2][4][2], const Unit& u, int wr, int wc, int fr, int fq) const {
        const int row0 = u.pm * BM + wr * 64 + fr, col0 = (u.pn % nN) * HALF + wc * 32 + 8 * fq;
#pragma unroll
        for (int ai = 0; ai < 2; ++ai)
#pragma unroll
            for (int m = 0; m < 4; ++m) { unsigned char* rowp = O + (size_t)(row0 + ai * HALF + m * 16) * ldc + col0;
                const f32x4 g0 = acc[ai][0][m][0], g1 = acc[ai][0][m][1], u0 = acc[ai][1][m][0], u1 = acc[ai][1][m][1];
                u32x2 w; w.x = pk4_fp8(8.f * fast_silu(g0[0]) * u0[0], 8.f * fast_silu(g0[1]) * u0[1], 8.f * fast_silu(g0[2]) * u0[2], 8.f * fast_silu(g0[3]) * u0[3]);
                w.y = pk4_fp8(8.f * fast_silu(g1[0]) * u1[0], 8.f * fast_silu(g1[1]) * u1[1], 8.f * fast_silu(g1[2]) * u1[2], 8.f * fast_silu(g1[3]) * u1[3]);
                *(u32x2*)(rowp) = w; }
    }
};
struct EpiPlainBf16F8 {
    static constexpr bool PERM = true, AFTER_DRAIN = false, FP8 = true; static constexpr int SCALE_W = 121, SCALE_X = 124;
    bf16_t* O; int ldc; int nN;
    __device__ __forceinline__ void operator()(const f32x4 (&acc)[2][2][4][2], const Unit& u, int wr, int wc, int fr, int fq) const {
        const int row0 = u.pm * BM + wr * 64 + fr, col0 = (u.pn % nN) * BM + wc * 32 + 8 * fq;
#pragma unroll
        for (int ai = 0; ai < 2; ++ai)
#pragma unroll
            for (int m = 0; m < 4; ++m) { bf16_t* rowp = O + (size_t)(row0 + ai * HALF + m * 16) * ldc + col0;
#pragma unroll
                for (int bj = 0; bj < 2; ++bj) { const f32x4 v0 = acc[ai][bj][m][0], v1 = acc[ai][bj][m][1];
                    u32x4 w; w.x = cvt_pk_bf16(v0[0], v0[1]); w.y = cvt_pk_bf16(v0[2], v0[3]); w.z = cvt_pk_bf16(v1[0], v1[1]); w.w = cvt_pk_bf16(v1[2], v1[3]);
                    *(u32x4*)(rowp + bj * HALF) = w; } }
    }
};
struct GroupedOrder {
    int nM, nN, nwg, G, c; const PG8_LAS int* tile_e;
    __device__ void init(int nM_, int nN_, int G_, int c_, const PG8_LAS int* te) { nM = nM_; nN = nN_; nwg = nM * nN; G = G_; c = c_; tile_e = te; }
    __device__ bool next(int i, Unit& u) const {
        const long L = (long)i * G + c; if (L >= nwg) return false;
        int wgid = (int)L; { const int q = nwg / NXCD, r = nwg % NXCD, xcd = wgid % NXCD, off = wgid / NXCD; wgid = (xcd < r ? xcd * (q + 1) : r * (q + 1) + (xcd - r) * q) + off; }
        const int nig = WGM * nN, gid = wgid / nig, fm = gid * WGM, gsz = (nM - fm) < WGM ? (nM - fm) : WGM;
        u.pm = fm + ((wgid % nig) % gsz); u.pn = tile_e[u.pm] * nN + (wgid % nig) / gsz; return true;
    }
    __device__ __forceinline__ void a_ready(const Unit&) const {}
    __device__ __forceinline__ void done(const Unit&) const {}
};
template <class Epi, class Sched, bool ALIGN_EPI = false, bool SP2 = false>
__device__ __forceinline__ void gemm_phase(PG8_LAS unsigned char* lds, const Gemm g, const Sched& S, const Epi& E) {
    const int tid = threadIdx.x, wid = __builtin_amdgcn_readfirstlane(tid >> 6), lane = tid & 63, wr = wid >> 2, wc = wid & 3, fr = lane & 15, fq = lane >> 4;
    const int K = g.K, nt = K / BK;
    unsigned voffA[2], voffB[2];
#pragma unroll
    for (int i = 0; i < 2; ++i) { int R, C; stage_rc(tid * 16 + i * 8192, R, C); const int Rb = Epi::PERM ? ((R & ~31) + perm32(R & 31)) : R;
        voffA[i] = (unsigned)(R * K + C) * 2u; voffB[i] = (unsigned)(Rb * K + C) * 2u; }
    const size_t kstep = (size_t)(BK * 2);
    const size_t hstep = (size_t)HALF * K * 2;
    const size_t tstep = 2 * hstep;
    const unsigned ldsw = (unsigned)wid * 1024u;
    const int aoff = lds_byte(wr * 64 + fr, fq * 8), boff = lds_byte(wc * 32 + fr, fq * 8);
#define PG8_SA(b, h) (((b) * 2 + (h)) * HTB)
#define PG8_SB(b, h) ((4 + (b) * 2 + (h)) * HTB)
#define PG8_STAGE(bufoff, gbase, voff) do { _Pragma("unroll") for (int _i = 0; _i < 2; ++_i) \
        __builtin_amdgcn_global_load_lds((const unsigned*)((const char*)(gbase) + (voff)[_i]), (PG8_LAS unsigned*)(lds + (bufoff) + ldsw + _i * 8192), 16, 0, 0); } while (0)
#define PG8_LDA(dst, b, h) do { _Pragma("unroll") for (int m = 0; m < 4; ++m) _Pragma("unroll") for (int k = 0; k < 2; ++k) dst[m][k] = *(const PG8_LAS bf16x8*)(lds + PG8_SA(b, h) + aoff + m * 2048 + k * 1024); } while (0)
#define PG8_LDB(dst, b, h) do { _Pragma("unroll") for (int n = 0; n < 2; ++n) _Pragma("unroll") for (int k = 0; k < 2; ++k) dst[n][k] = *(const PG8_LAS bf16x8*)(lds + PG8_SB(b, h) + boff + n * 2048 + k * 1024); } while (0)
#define PG8_MMA(ai, bj, At, Bt) do { __builtin_amdgcn_s_setprio(1); _Pragma("unroll") for (int m = 0; m < 4; ++m) _Pragma("unroll") for (int n = 0; n < 2; ++n) { \
        if constexpr (Epi::FP8) { asm volatile("v_mfma_scale_f32_16x16x128_f8f6f4 %0, %1, %2, %0, %3, %4 op_sel_hi:[0,0,0]" : "+v"(acc[ai][bj][m][n]) : "v"(cat8(Bt[n][0], Bt[n][1])), "v"(cat8(At[m][0], At[m][1])), "v"(f8_sw), "v"(f8_sx)); } \
        else { _Pragma("unroll") for (int k = 0; k < 2; ++k) acc[ai][bj][m][n] = __builtin_amdgcn_mfma_f32_16x16x32_bf16(Bt[n][k], At[m][k], acc[ai][bj][m][n], 0, 0, 0); } } __builtin_amdgcn_s_setprio(0); } while (0)
#define PG8_WAIT_V(n) asm volatile("s_waitcnt vmcnt(" #n ")" ::: "memory")
#define PG8_WAIT_L(n) asm volatile("s_waitcnt lgkmcnt(" #n ")" ::: "memory")
#define PG8_BAR __builtin_amdgcn_s_barrier()
#define PG8_SCHED __builtin_amdgcn_sched_barrier(0)
    Unit cur, nxt; int ui = 0;
    if (!S.next(0, cur)) return;
    int f8_sw = Epi::SCALE_W, f8_sx = Epi::SCALE_X;
    if constexpr (Epi::FP8) asm volatile("" : "+v"(f8_sw), "+v"(f8_sx));
    f32x4 acc[2][2][4][2];
#pragma unroll
    for (int a = 0; a < 2; ++a)
#pragma unroll
        for (int b = 0; b < 2; ++b)
#pragma unroll
            for (int m = 0; m < 4; ++m)
#pragma unroll
                for (int n = 0; n < 2; ++n) acc[a][b][m][n] = (f32x4){0.f, 0.f, 0.f, 0.f};
    bf16x8 At[4][2], B0[2][2], B1[2][2];
    const char* cA = (const char*)g.A + (size_t)cur.pm * tstep; const char* cB = (const char*)g.Bt + (size_t)cur.pn * tstep;
    S.a_ready(cur);
    if constexpr (SP2) {
        PG8_STAGE(PG8_SB(0, 0), cB, voffB); PG8_STAGE(PG8_SB(0, 1), cB + hstep, voffB); PG8_STAGE(PG8_SA(0, 0), cA, voffA); PG8_STAGE(PG8_SA(0, 1), cA + hstep, voffA);
        if (wr == 1) PG8_BAR;
        PG8_WAIT_V(2); PG8_BAR;
        PG8_STAGE(PG8_SB(1, 0), cB + kstep, voffB); PG8_STAGE(PG8_SA(1, 0), cA + kstep, voffA); PG8_STAGE(PG8_SB(1, 1), cB + hstep + kstep, voffB);
        PG8_WAIT_V(6); PG8_BAR;
    } else {
        PG8_STAGE(PG8_SB(0, 0), cB, voffB); PG8_STAGE(PG8_SA(0, 0), cA, voffA); PG8_STAGE(PG8_SB(0, 1), cB + hstep, voffB); PG8_STAGE(PG8_SA(0, 1), cA + hstep, voffA);
        if (wr == 1) PG8_BAR;
        PG8_WAIT_V(4); PG8_BAR;
        PG8_STAGE(PG8_SB(1, 0), cB + kstep, voffB); PG8_STAGE(PG8_SA(1, 0), cA + kstep, voffA); PG8_STAGE(PG8_SB(1, 1), cB + hstep + kstep, voffB);
        PG8_WAIT_V(6); PG8_BAR;
    }
    for (;;) {
        const bool has_next = S.next(ui + 1, nxt);
        const char* nA = has_next ? (const char*)g.A + (size_t)nxt.pm * tstep : cA; const char* nB = has_next ? (const char*)g.Bt + (size_t)nxt.pn * tstep : cB;
        for (int t = 0; t < nt; t += 2) {
            const bool last = (t == nt - 2);
            const char* a1 = cA + (size_t)(t + 1) * kstep;
            const char* a2 = last ? nA : cA + (size_t)(t + 2) * kstep; const char* b2 = last ? nB : cB + (size_t)(t + 2) * kstep;
            const char* a3 = a2 + kstep; const char* b3 = b2 + kstep;
            if (last && has_next) S.a_ready(nxt);
            if constexpr (SP2) {
            PG8_LDB(B0, 0, 0); PG8_LDB(B1, 0, 1); PG8_SCHED; PG8_LDA(At, 0, 0); PG8_STAGE(PG8_SA(1, 1), a1 + hstep, voffA);
            PG8_WAIT_V(8); PG8_WAIT_L(0); PG8_BAR; PG8_MMA(0, 0, At, B0); PG8_MMA(0, 1, At, B1); PG8_BAR; PG8_SCHED;
            PG8_LDA(At, 0, 1); PG8_STAGE(PG8_SB(0, 0), b2, voffB); PG8_STAGE(PG8_SB(0, 1), b2 + hstep, voffB); PG8_STAGE(PG8_SA(0, 0), a2, voffA);
            PG8_WAIT_V(8); PG8_WAIT_L(0); PG8_BAR; PG8_MMA(1, 0, At, B0); PG8_MMA(1, 1, At, B1); PG8_BAR; PG8_SCHED;
            PG8_LDB(B0, 1, 0); PG8_LDB(B1, 1, 1); PG8_SCHED; PG8_LDA(At, 1, 0); PG8_STAGE(PG8_SA(0, 1), a2 + hstep, voffA);
            PG8_WAIT_V(8); PG8_WAIT_L(0); PG8_BAR; PG8_MMA(0, 0, At, B0); PG8_MMA(0, 1, At, B1); PG8_BAR; PG8_SCHED;
            PG8_LDA(At, 1, 1); PG8_STAGE(PG8_SB(1, 0), b3, voffB); PG8_STAGE(PG8_SB(1, 1), b3 + hstep, voffB); PG8_STAGE(PG8_SA(1, 0), a3, voffA);
            PG8_WAIT_V(8); PG8_WAIT_L(0); PG8_BAR; PG8_MMA(1, 0, At, B0); PG8_MMA(1, 1, At, B1); PG8_BAR; PG8_SCHED;
            } else {
            PG8_LDB(B0, 0, 0); PG8_SCHED; PG8_LDA(At, 0, 0); PG8_STAGE(PG8_SA(1, 1), a1 + hstep, voffA);
            PG8_WAIT_L(8); PG8_BAR; PG8_WAIT_L(0); PG8_MMA(0, 0, At, B0); PG8_BAR; PG8_SCHED;
            PG8_LDB(B1, 0, 1); PG8_STAGE(PG8_SB(0, 0), b2, voffB);
            PG8_BAR; PG8_WAIT_L(0); PG8_MMA(0, 1, At, B1); PG8_BAR;
            PG8_LDA(At, 0, 1); PG8_STAGE(PG8_SA(0, 0), a2, voffA);
            PG8_BAR; PG8_WAIT_L(0); PG8_MMA(1, 0, At, B0); PG8_BAR; PG8_SCHED;
            PG8_STAGE(PG8_SB(0, 1), b2 + hstep, voffB);
            PG8_WAIT_V(6); PG8_BAR; PG8_MMA(1, 1, At, B1); PG8_BAR;
            PG8_LDB(B0, 1, 0); PG8_SCHED; PG8_LDA(At, 1, 0); PG8_STAGE(PG8_SA(0, 1), a2 + hstep, voffA);
            PG8_WAIT_L(8); PG8_BAR; PG8_WAIT_L(0); PG8_MMA(0, 0, At, B0); PG8_BAR; PG8_SCHED;
            PG8_LDB(B1, 1, 1); PG8_STAGE(PG8_SB(1, 0), b3, voffB);
            PG8_BAR; PG8_WAIT_L(0); PG8_MMA(0, 1, At, B1); PG8_BAR;
            PG8_LDA(At, 1, 1); PG8_STAGE(PG8_SA(1, 0), a3, voffA);
            PG8_BAR; PG8_WAIT_L(0); PG8_MMA(1, 0, At, B0); PG8_BAR; PG8_SCHED;
            PG8_STAGE(PG8_SB(1, 1), b3 + hstep, voffB);
            PG8_WAIT_V(6); PG8_BAR; PG8_MMA(1, 1, At, B1); PG8_BAR;
            }
        }
        if constexpr (ALIGN_EPI) { if (wr == 0) PG8_BAR; }
        if constexpr (!Epi::AFTER_DRAIN) { E(acc, cur, wr, wc, fr, fq); S.done(cur); }
        if (!has_next) break;
#pragma unroll
        for (int a = 0; a < 2; ++a)
#pragma unroll
            for (int b = 0; b < 2; ++b)
#pragma unroll
                for (int m = 0; m < 4; ++m)
#pragma unroll
                    for (int n = 0; n < 2; ++n) acc[a][b][m][n] = (f32x4){0.f, 0.f, 0.f, 0.f};
        cur = nxt; cA = nA; cB = nB; ++ui;
        if constexpr (ALIGN_EPI) { if (wr == 1) PG8_BAR; }
    }
    PG8_WAIT_V(0);
    if constexpr (!ALIGN_EPI) { if (wr == 0) PG8_BAR; }
    PG8_BAR;
    if constexpr (Epi::AFTER_DRAIN) { E.fused(acc, cur, wr, wc, fr, fq, lds, wid, lane); S.done(cur); }
#undef PG8_SA
#undef PG8_SB
#undef PG8_STAGE
#undef PG8_LDA
#undef PG8_LDB
#undef PG8_MMA
#undef PG8_WAIT_V
#undef PG8_WAIT_L
#undef PG8_BAR
#undef PG8_SCHED
}
}

constexpr int NWAVES = 8;
constexpr int BATCH = 8, SEQ = 2048, DM = 2048, M = BATCH * SEQ;
constexpr int NPROJ = 4608, PROJ_LD = 4352;
constexpr int DFF = 5632, DFFE = 7168, NE = 8;
constexpr int C_MQ = 0, C_MK = 256, C_MV = 512, C_MO = 1024, C_GQ = 1536, C_GK = 1792, C_GV = 2048, C_GG = 2560, C_AQ = 3072, C_AK = 4096, C_AV = 4224;
constexpr float EPS = 1e-6f;
constexpr int MAXROWS_S = M * 2 + NE * 256;

constexpr size_t MiB = 1u << 20;
constexpr size_t WS_CTL = 0, CTL_ZERO_BYTES = 1 * MiB;
constexpr size_t WS_MOD = 1 * MiB;
constexpr size_t WS_WIN = 2 * MiB;
constexpr size_t WS_WOUT = 38 * MiB;
constexpr size_t WS_WGU0 = 54 * MiB;
constexpr size_t WS_WDN0 = 98 * MiB;
constexpr size_t WS_WGU1 = 120 * MiB;
constexpr size_t WS_WDN1 = 568 * MiB;
constexpr size_t WS_XA = 792 * MiB;
constexpr size_t WS_XN = 920 * MiB;
constexpr size_t WS_Y = 984 * MiB;
constexpr size_t WS_SIDE = 1048 * MiB;
constexpr size_t WS_TOK = 1050 * MiB;
constexpr size_t WS_BIG = 1052 * MiB;
constexpr size_t WS_HID = WS_BIG;
constexpr size_t WS_AS = WS_BIG + 476 * MiB;
constexpr size_t WS_PROJ = WS_BIG;
constexpr size_t WS_QKC = WS_BIG + 144 * MiB;
constexpr size_t WS_LA = WS_BIG + 160 * MiB;
constexpr size_t WS_KN = WS_BIG + 176 * MiB;
constexpr size_t WS_UM = WS_BIG + 192 * MiB;
constexpr size_t WS_UG = WS_BIG + 212 * MiB;
constexpr size_t WS_GAUX = WS_BIG + 244 * MiB;
constexpr size_t WS_END = WS_BIG + 612 * MiB;
constexpr int TOK_E = 0, TOK_SLOT = 32768, TOK_W = 65536, TOK_POS = 98304;

constexpr int CW_TMO = 0, CW_CODE = 1, CW_BAR = 4096, CW_CNT = 8192;

constexpr int RING_OFF = 0, RING_BYTES = 131072;
constexpr int MISC_OFF = RING_BYTES;
constexpr int LDS_BYTES = 147456;

#define GAS __attribute__((address_space(1)))
#define LAS __attribute__((address_space(3)))
typedef unsigned short bf16;
typedef unsigned v4u __attribute__((ext_vector_type(4)));
typedef unsigned v2u __attribute__((ext_vector_type(2)));
typedef float f32x4 __attribute__((ext_vector_type(4)));
typedef short bf16x8 __attribute__((ext_vector_type(8)));
typedef GAS unsigned gu32;
#define RLX_AGENT __ATOMIC_RELAXED, __HIP_MEMORY_SCOPE_AGENT
#define LDS_WAIT() asm volatile("s_waitcnt lgkmcnt(0)" ::: "memory")
#define VM_WAIT() asm volatile("s_waitcnt vmcnt(0)" ::: "memory")
typedef float f32x2_t __attribute__((ext_vector_type(2)));
typedef __bf16 bf16x2_t __attribute__((ext_vector_type(2)));
__device__ __forceinline__ unsigned pk2(float lo, float hi) { const f32x2_t v = {lo, hi}; return __builtin_bit_cast(unsigned, __builtin_convertvector(v, bf16x2_t)); }
__device__ __forceinline__ unsigned f2bf(float f) { return pk2(f, 0.f) & 0xffffu; }
__device__ __forceinline__ float bflo(unsigned w) { return __builtin_bit_cast(float, w << 16); }
__device__ __forceinline__ float bfhi(unsigned w) { return __builtin_bit_cast(float, w & 0xffff0000u); }
__device__ __forceinline__ float bf1(bf16 b) { return __builtin_bit_cast(float, ((unsigned)b) << 16); }
__device__ __forceinline__ float wave_sum(float v) {
#pragma unroll
    for (int o = 1; o < 64; o <<= 1) v += __shfl_xor(v, o);
    return v;
}
__device__ __forceinline__ float sigmoidf_(float x) { return 1.0f / (1.0f + __expf(-x)); }
__device__ __forceinline__ float siluf_(float x) { return x / (1.0f + __expf(-x)); }
__device__ __forceinline__ float logsigmoidf_(float z) { return fminf(z, 0.f) - __logf(1.0f + __expf(-fabsf(z))); }

#ifndef FAST_SWA
#define FAST_SWA 1
#endif
#ifndef FAST_GLA
#define FAST_GLA 1
#endif
#ifndef FAST_MLSTM
#define FAST_MLSTM 1
#endif
#ifndef PROBE_REPEAT
#define PROBE_REPEAT -1
#endif
#define XB_TMO      128
#define XB_XCNT(j)  (256  + 64 * (j))
#define XB_XSUB(j)  (1280 + 64 * (j))
#define XB_XGEN(j)  (2304 + 64 * (j))
#define XB_TOP      3328
#define XB_TOPGEN   3392
#define XCD_BAR_WORDS 3456
#define XB_SPIN_CAP (1u << 18)

__device__ __forceinline__ unsigned xb_ld(unsigned* p)              { return __hip_atomic_load(p, __ATOMIC_RELAXED, __HIP_MEMORY_SCOPE_AGENT); }
__device__ __forceinline__ unsigned xb_add(unsigned* p, unsigned v) { return __hip_atomic_fetch_add(p, v, __ATOMIC_RELAXED, __HIP_MEMORY_SCOPE_AGENT); }
__device__ __forceinline__ unsigned xb_xcc_id() { return (unsigned)__builtin_amdgcn_s_getreg((3 << 11) | 20) & 0xFu; }
#define XB_SPIN(cond, bar) do { unsigned _sp = 0; while (cond) { __builtin_amdgcn_s_sleep(1); \
    if ((++_sp & 255u) == 0u) { if (xb_ld(&(bar)[XB_TMO])) break; if (_sp > XB_SPIN_CAP) { atomicAdd(&(bar)[XB_TMO], 1u); break; } } } } while (0)

struct XcdBarrier {
    unsigned* bar; unsigned x;
    volatile LAS unsigned* st;
};

__device__ __forceinline__ XcdBarrier xcd_barrier_post(unsigned* bar, volatile LAS unsigned* st) {
    XcdBarrier b; b.bar = bar; b.x = xb_xcc_id(); b.st = st;
    if (threadIdx.x == 0) (void)xb_add(&bar[XB_XCNT(b.x)], 1u);
    return b;
}
__device__ __forceinline__ void xcd_barrier_complete(unsigned* bar, unsigned x, unsigned& nloc, unsigned& nx) {
    const unsigned G = gridDim.x * gridDim.y * gridDim.z;
    unsigned sum, cnt, mine, sp = 0u;
    for (;;) {
        sum = 0u; cnt = 0u; mine = 0u;
#pragma unroll
        for (unsigned j = 0; j < 16; ++j) { const unsigned c = xb_ld(&bar[XB_XCNT(j)]); sum += c; cnt += (c > 0u) ? 1u : 0u; mine = (j == x) ? c : mine; }
        if (sum == G) break;
        __builtin_amdgcn_s_sleep(1);
        if ((++sp & 255u) == 0u) { if (xb_ld(&bar[XB_TMO])) break; if (sp > XB_SPIN_CAP) { atomicAdd(&bar[XB_TMO], 1u); break; } }
    }
    nloc = mine > 0u ? mine : 1u; nx = cnt > 0u ? cnt : 1u;
}

__device__ __forceinline__ void xcd_barrier(const XcdBarrier& b) {
    asm volatile("s_waitcnt vmcnt(0)" ::: "memory");
    __syncthreads();
    if (threadIdx.x == 0) {
        unsigned* bar = b.bar;
        __builtin_amdgcn_s_waitcnt(0);
        unsigned nloc = b.st[0], nx = b.st[1];
        if (nloc == 0u) { xcd_barrier_complete(bar, b.x, nloc, nx); b.st[0] = nloc; b.st[1] = nx; }
        const unsigned old = xb_add(&bar[XB_XSUB(b.x)], 1u);
        const unsigned gen = old / nloc;
        if (old + 1u == (gen + 1u) * nloc) {
            __builtin_amdgcn_fence(__ATOMIC_RELEASE, "agent");
            asm volatile("s_waitcnt vmcnt(0)" ::: "memory");
            const unsigned og = xb_add(&bar[XB_TOP], 1u);
            const unsigned tg = og / nx;
            if (og + 1u == (tg + 1u) * nx) xb_add(&bar[XB_TOPGEN], 1u);
            else XB_SPIN(xb_ld(&bar[XB_TOPGEN]) == tg, bar);
            __builtin_amdgcn_fence(__ATOMIC_ACQUIRE, "agent");
            xb_add(&bar[XB_XGEN(b.x)], 1u);
            asm volatile("s_waitcnt vmcnt(0)" ::: "memory");
        } else {
            XB_SPIN(xb_ld(&bar[XB_XGEN(b.x)]) == gen, bar);
            __builtin_amdgcn_fence(__ATOMIC_ACQUIRE, "agent");
            asm volatile("s_waitcnt vmcnt(0)" ::: "memory");
        }
    }
    __syncthreads();
}

typedef const float* cfp;
typedef __attribute__((address_space(4))) cfp cfp_k;
struct Frame {
    LAS unsigned char* lds;
    gu32* ctl;
    int tid, lane, wave, vcu, G;
    cfp_k* in;
    float* out; unsigned char* ws;
};
#define IN_X 0
#define IN_C 1
#define IN_WADA 2
#define IN_BADA 3
#define IN_GMIX 4
#define IN_GFFN 5
#define IN_WIN 6
#define IN_BGATES 7
#define IN_WCONV 8
#define IN_BCONV 9
#define IN_GOUTM 10
#define IN_WDEC 11
#define IN_BDEC 12
#define IN_GOUTG 13
#define IN_GQN 14
#define IN_GKN 15
#define IN_SINKS 16
#define IN_RELB 17
#define IN_WOUT 18
#define IN_WFG 19
#define IN_WFU 20
#define IN_WFD 21
#define IN_WROUTER 22
#define IN_WMG 23
#define IN_WMU 24
#define IN_WMD 25

__device__ __forceinline__ int rowmap(int kind, int off, int n) {
    if (kind == 0) return off + n;
    if (kind == 1) return off + ((n >> 7) << 8) + (n & 127);
    if (n < 1536) return n; if (n < 1544) return 4352 + (n - 1536); if (n < 3080) return n - 8; if (n < 3096) return 4360 + (n - 3080); return n - 24;
}
__device__ __forceinline__ void transpose_item(const float* W, int N, bf16* WT, int ldt, int kind, int off, int item, int lane) {
    const int nblk = (N + 63) >> 6, kb = item / nblk, nb = item - kb * nblk, k0 = 64 * kb + 8 * (lane & 7), n = 64 * nb + 4 * (lane >> 3);
    const f32x4* src = (const f32x4*)(W + (size_t)k0 * N + n);
    f32x4 v[2][8];
#pragma unroll
    for (int hh = 0; hh < 2; ++hh) { if (n + 32 * hh < N) {
#pragma unroll
        for (int j = 0; j < 8; ++j) v[hh][j] = __builtin_nontemporal_load(src + (size_t)j * (N >> 2) + 8 * hh); } }
#pragma unroll
    for (int hh = 0; hh < 2; ++hh) { if (n + 32 * hh < N) {
#pragma unroll
        for (int i = 0; i < 4; ++i) { v4u o; o.x = pk2(v[hh][0][i], v[hh][1][i]); o.y = pk2(v[hh][2][i], v[hh][3][i]); o.z = pk2(v[hh][4][i], v[hh][5][i]); o.w = pk2(v[hh][6][i], v[hh][7][i]);
            *(v4u*)(WT + (size_t)rowmap(kind, off, n + 32 * hh + i) * ldt + k0) = o; } } }
}
__device__ __forceinline__ void transpose_item_f8(const float* W, int N, unsigned char* WT, int ldt, int kind, int off, int item, int lane, float scale) {
    const int nblk = (N + 63) >> 6, kb = item / nblk, nb = item - kb * nblk, k0 = 128 * kb + 16 * (lane & 3), n = 64 * nb + 4 * (lane >> 2);
    if (n >= N) return;
    const f32x4* src = (const f32x4*)(W + (size_t)k0 * N + n);
    f32x4 v[2][16];
#pragma unroll
    for (int hh = 0; hh < 2; ++hh)
#pragma unroll
        for (int j = 0; j < 16; ++j) v[hh][j] = __builtin_nontemporal_load(src + (size_t)(64 * hh + j) * (N >> 2));
#pragma unroll
    for (int hh = 0; hh < 2; ++hh)
#pragma unroll
        for (int i = 0; i < 4; ++i) { v4u o; o.x = pg8::pk4_fp8(v[hh][0][i] * scale, v[hh][1][i] * scale, v[hh][2][i] * scale, v[hh][3][i] * scale); o.y = pg8::pk4_fp8(v[hh][4][i] * scale, v[hh][5][i] * scale, v[hh][6][i] * scale, v[hh][7][i] * scale);
            o.z = pg8::pk4_fp8(v[hh][8][i] * scale, v[hh][9][i] * scale, v[hh][10][i] * scale, v[hh][11][i] * scale); o.w = pg8::pk4_fp8(v[hh][12][i] * scale, v[hh][13][i] * scale, v[hh][14][i] * scale, v[hh][15][i] * scale);
            __builtin_nontemporal_store(o, (v4u*)(WT + (size_t)rowmap(kind, off, n + i) * ldt + k0 + 64 * hh)); }
}
constexpr int MOE_ITEMS = 3 * 14336, MOE_TAILQ = 0;
__device__ __forceinline__ void moe_convert(Frame& F, int lo, int hi, int rank, int nrank) {
    for (int it = lo + rank; it < hi; it += nrank) {
        int r = it; const float* W; unsigned char* WT; int N, ldt, kind, off; float f8s;
        if (r < 14336) { const int e = r / 1792; r -= e * 1792; W = F.in[IN_WMG] + (size_t)e * 2048 * DFFE; N = DFFE; WT = F.ws + WS_WGU1 + (size_t)e * 14336 * 2048; ldt = 2048; kind = 1; off = 0; f8s = 32.f; }
        else if ((r -= 14336) < 14336) { const int e = r / 1792; r -= e * 1792; W = F.in[IN_WMU] + (size_t)e * 2048 * DFFE; N = DFFE; WT = F.ws + WS_WGU1 + (size_t)e * 14336 * 2048; ldt = 2048; kind = 1; off = 128; f8s = 32.f; }
        else { r -= 14336; const int e = r / 1792; r -= e * 1792; W = F.in[IN_WMD] + (size_t)e * DFFE * 2048; N = 2048; WT = F.ws + WS_WDN1 + (size_t)e * 2048 * DFFE; ldt = DFFE; kind = 0; off = 0; f8s = 64.f; }
        transpose_item_f8(W, N, WT, ldt, kind, off, r, F.lane, f8s);
    }
}
__device__ __forceinline__ void p0_prologue(Frame& F) {
    __syncthreads();
    {
        LAS float* cond = (LAS float*)(F.lds + RING_OFF);
        LAS float* red = (LAS float*)(F.lds + RING_OFF + 65536);
        float* mod = (float*)(F.ws + WS_MOD);
        bool have = false;
        for (int it = F.vcu; it < 192; it += F.G) {
            if (!have) { for (int i = F.tid; i < 8 * 2048; i += NWAVES * 64) { const float cv = F.in[IN_C][i]; cond[i] = cv / (1.0f + expf(-cv)); } have = true; }
            __syncthreads();
            const int l = it / 96, cg = it % 96, c4 = F.tid & 31, dp = F.tid >> 5;
            f32x4 acc[8];
#pragma unroll
            for (int b = 0; b < 8; ++b) acc[b] = (f32x4){0.f, 0.f, 0.f, 0.f};
            const f32x4* wp = (const f32x4*)(F.in[IN_WADA] + (size_t)l * 2048 * 12288 + (size_t)(dp * 128) * 12288 + cg * 128 + 4 * c4);
            const LAS float* cp = cond + dp * 128;
#pragma unroll 8
            for (int d = 0; d < 128; ++d) { const f32x4 w = __builtin_nontemporal_load(wp + (size_t)d * 3072);
#pragma unroll
                for (int b = 0; b < 8; ++b) acc[b] += w * cp[b * 2048 + d]; }
#pragma unroll
            for (int b = 0; b < 8; ++b) *(LAS f32x4*)(red + (dp * 8 + b) * 128 + 4 * c4) = acc[b];
            __syncthreads();
            for (int i = F.tid; i < 8 * 128; i += NWAVES * 64) { const int b = i >> 7, cc = i & 127; float s = 0.f;
#pragma unroll
                for (int q = 0; q < 16; ++q) s += red[(q * 8 + b) * 128 + cc];
                mod[(size_t)(l * 8 + b) * 12288 + cg * 128 + cc] = s + F.in[IN_BADA][l * 12288 + cg * 128 + cc]; }
        }
        __syncthreads();
    }
    const int gw = F.vcu * NWAVES + F.wave, NGW = F.G * NWAVES;
    constexpr int NITEMS = 4416 + 2048 + 3 * 2816;
    for (int it = gw; it < NITEMS; it += NGW) {
        int r = it; const float* W; bf16* WT; int N, ldt, kind, off;
        if (r < 4416) { const int l = r / 2208; r -= l * 2208; W = F.in[IN_WIN] + (size_t)l * 2048 * 4376; N = 4376; WT = (bf16*)(F.ws + WS_WIN) + (size_t)l * NPROJ * 2048; ldt = 2048; kind = 2; off = 0; }
        else if ((r -= 4416) < 2048) { const int l = r / 1024; r -= l * 1024; W = F.in[IN_WOUT] + (size_t)l * 2048 * 2048; N = 2048; WT = (bf16*)(F.ws + WS_WOUT) + (size_t)l * 2048 * 2048; ldt = 2048; kind = 0; off = 0; }
        else if ((r -= 2048) < 2816) { W = F.in[IN_WFG]; N = DFF; WT = (bf16*)(F.ws + WS_WGU0); ldt = 2048; kind = 1; off = 0; }
        else if ((r -= 2816) < 2816) { W = F.in[IN_WFU]; N = DFF; WT = (bf16*)(F.ws + WS_WGU0); ldt = 2048; kind = 1; off = 128; }
        else { r -= 2816; W = F.in[IN_WFD]; N = 2048; WT = (bf16*)(F.ws + WS_WDN0); ldt = DFF; kind = 0; off = 0; }
        transpose_item(W, N, WT, ldt, kind, off, r, F.lane);
    }
    moe_convert(F, 0, MOE_ITEMS - 2 * MOE_TAILQ, gw, NGW);
    for (int i = gw; i < 2 * 232; i += NGW) { const int l = i / 232, rr = 4376 + i % 232; v4u* p = (v4u*)((bf16*)(F.ws + WS_WIN) + ((size_t)l * NPROJ + rr) * 2048);
#pragma unroll
        for (int j = 0; j < 4; ++j) p[F.lane + 64 * j] = (v4u){0u, 0u, 0u, 0u}; }
}

template <bool ROUTER>
__device__ __forceinline__ void norm_phase(Frame& F, const float* xin, const float* g, const float* modl, int sh_off, int sc_off) {
    bf16* XN = (bf16*)(F.ws + WS_XN);
    const int gw = F.vcu * NWAVES + F.wave, NGW = F.G * NWAVES;
    LAS float* wrT = (LAS float*)(F.lds + RING_OFF);
    LAS int* lcnt = (LAS int*)(F.lds + MISC_OFF + 1152);
    LAS int* lbase = (LAS int*)(F.lds + MISC_OFF + 1216);
    LAS int* rtab = (LAS int*)(F.lds + MISC_OFF + 2048);
    int nrow = 0;
    if (ROUTER) {
        for (int i = F.tid; i < 2048 * 8; i += NWAVES * 64) wrT[(i & 7) * 2048 + (i >> 3)] = F.in[IN_WROUTER][i];
        if (F.tid < 8) lcnt[F.tid] = 0;
        __syncthreads();
    }
    for (int m = gw; m < M; m += NGW, ++nrow) {
        const int b = m >> 11;
        const f32x4* xr = (const f32x4*)(xin + (size_t)m * DM) + F.lane;
        f32x4 v[8]; float ss = 0.f;
#pragma unroll
        for (int j = 0; j < 8; ++j) { v[j] = xr[64 * j]; ss += (v[j].x * v[j].x + v[j].y * v[j].y) + (v[j].z * v[j].z + v[j].w * v[j].w); }
        const float rstd = 1.0f / sqrtf(wave_sum(ss) * (1.0f / DM) + EPS);
        const f32x4* gp = (const f32x4*)g + F.lane; const f32x4* scp = (const f32x4*)(modl + (size_t)b * 12288 + sc_off) + F.lane; const f32x4* shp = (const f32x4*)(modl + (size_t)b * 12288 + sh_off) + F.lane;
        v2u* o8 = (v2u*)(XN + (size_t)m * DM) + F.lane;
#pragma unroll
        for (int j = 0; j < 8; ++j) { const f32x4 gg = gp[64 * j], sc = scp[64 * j], sh = shp[64 * j];
            v[j] = v[j] * rstd * gg * (sc + 1.0f) + sh;
            if (ROUTER) ((unsigned*)((unsigned char*)XN + (size_t)m * DM))[F.lane + 64 * j] = pg8::pk4_fp8(v[j].x, v[j].y, v[j].z, v[j].w);
            else { v2u w; w.x = pk2(v[j].x, v[j].y); w.y = pk2(v[j].z, v[j].w); o8[64 * j] = w; } }
        if (ROUTER) {
            float lg[8];
#pragma unroll
            for (int e = 0; e < 8; ++e) { float p = 0.f; const LAS f32x4* wp = (const LAS f32x4*)(wrT + e * 2048) + F.lane;
#pragma unroll
                for (int j = 0; j < 8; ++j) { const f32x4 w = wp[64 * j]; p += (v[j].x * w.x + v[j].y * w.y) + (v[j].z * w.z + v[j].w * w.w); }
                lg[e] = wave_sum(p); }
            int e1 = 0; float v1 = lg[0];
#pragma unroll
            for (int e = 1; e < 8; ++e) if (lg[e] > v1) { v1 = lg[e]; e1 = e; }
            int e2 = -1; float v2 = -3.0e38f;
#pragma unroll
            for (int e = 0; e < 8; ++e) if (e != e1 && lg[e] > v2) { v2 = lg[e]; e2 = e; }
            const float w1 = 1.0f / (1.0f + expf(v2 - v1)), w2 = 1.0f - w1;
            if (F.lane == 0) {
                const int r1 = atomicAdd((int*)(lcnt + e1), 1), r2 = atomicAdd((int*)(lcnt + e2), 1);
                LAS int* en = rtab + (F.wave * 16 + nrow) * 8;
                en[0] = m; en[1] = e1; en[2] = r1; en[3] = __builtin_bit_cast(int, w1); en[4] = m; en[5] = e2; en[6] = r2; en[7] = __builtin_bit_cast(int, w2);
            }
        }
    }
    if (ROUTER) {
        __syncthreads();
        if (F.tid < 8) lbase[F.tid] = (int)__hip_atomic_fetch_add((unsigned*)(F.ctl + CW_CNT + 64 * F.tid), (unsigned)lcnt[F.tid], RLX_AGENT);
        __syncthreads();
        int* tk = (int*)(F.ws + WS_TOK);
        const int per = (M + NGW - 1) / NGW;
        for (int i = F.tid; i < NWAVES * per * 2; i += NWAVES * 64) { const int w = i / (per * 2), rr = (i % (per * 2)) >> 1, k = i & 1;
            const int mrow = F.vcu * NWAVES + w + rr * NGW; if (mrow >= M) continue;
            const LAS int* en = rtab + (w * 16 + rr) * 8 + 4 * k;
            const int t = en[0], e = en[1];
            tk[TOK_E + t * 2 + k] = e; tk[TOK_SLOT + t * 2 + k] = lbase[e] + en[2]; tk[TOK_W + t * 2 + k] = en[3]; }
    }
}

__device__ const unsigned char T5_BUCKET[128] = {0, 1, 2, 3, 4, 5, 6, 7, 8, 9, 10, 11, 12, 13, 14, 15, 16, 16, 16, 17, 17, 18, 18, 18, 19, 19, 19, 20, 20, 20, 20, 21, 21, 21, 21, 22, 22, 22, 22, 22, 23, 23, 23, 23, 23, 23, 24, 24, 24, 24, 24, 24, 25, 25, 25, 25, 25, 25, 25, 26, 26, 26, 26, 26, 26, 26, 26, 27, 27, 27, 27, 27, 27, 27, 27, 27, 27, 28, 28, 28, 28, 28, 28, 28, 28, 28, 28, 29, 29, 29, 29, 29, 29, 29, 29, 29, 29, 29, 29, 30, 30, 30, 30, 30, 30, 30, 30, 30, 30, 30, 30, 30, 30, 31, 31, 31, 31, 31, 31, 31, 31, 31, 31, 31, 31, 31, 31, 31};

__device__ __forceinline__ void mix_prep(Frame& F, int l) {
    const bf16* proj = (const bf16*)(F.ws + WS_PROJ); const float* side = (const float*)(F.ws + WS_SIDE);
    bf16* qkc = (bf16*)(F.ws + WS_QKC); float* la = (float*)(F.ws + WS_LA); bf16* kn = (bf16*)(F.ws + WS_KN);
    const int gw = F.vcu * NWAVES + F.wave, NGW = F.G * NWAVES, lane = F.lane;
    const float* wc = F.in[IN_WCONV] + l * 4 * 512; const float* bc = F.in[IN_BCONV] + l * 512;
    const float* wd = F.in[IN_WDEC] + l * 16 * 256; const float* bd = F.in[IN_BDEC] + l * 256; const float* gk = F.in[IN_GKN] + l * 64;
    for (int m = gw; m < M; m += NGW) {
        const int pos = m & (SEQ - 1);
        {
            float y[8]; const int ch = lane * 8;
            { const f32x4 b0 = *(const f32x4*)(bc + ch), b1 = *(const f32x4*)(bc + ch + 4); y[0] = b0.x; y[1] = b0.y; y[2] = b0.z; y[3] = b0.w; y[4] = b1.x; y[5] = b1.y; y[6] = b1.z; y[7] = b1.w; }
#pragma unroll
            for (int i = 0; i < 4; ++i) { if (pos - 3 + i >= 0) {
                const v4u xv = *(const v4u*)(proj + (size_t)(m - 3 + i) * PROJ_LD + ch);
                const f32x4 w0 = *(const f32x4*)(wc + i * 512 + ch), w1 = *(const f32x4*)(wc + i * 512 + ch + 4);
                y[0] += w0.x * bflo(xv.x); y[1] += w0.y * bfhi(xv.x); y[2] += w0.z * bflo(xv.y); y[3] += w0.w * bfhi(xv.y);
                y[4] += w1.x * bflo(xv.z); y[5] += w1.y * bfhi(xv.z); y[6] += w1.z * bflo(xv.w); y[7] += w1.w * bfhi(xv.w); } }
            const float sc = ch >= 256 ? 0.125f : 1.0f;
#pragma unroll
            for (int i = 0; i < 8; ++i) y[i] = siluf_(y[i]) * sc;
            v4u o; o.x = pk2(y[0], y[1]); o.y = pk2(y[2], y[3]); o.z = pk2(y[4], y[5]); o.w = pk2(y[6], y[7]);
            *(v4u*)(qkc + (size_t)m * 512 + ch) = o;
        }
        {
            const int c = lane * 4; f32x4 z = *(const f32x4*)(bd + c);
            const f32x4* gp = (const f32x4*)(side + (size_t)m * 32 + 8);
            const f32x4 g0 = gp[0], g1 = gp[1], g2 = gp[2], g3 = gp[3];
            const float ga[16] = {g0.x, g0.y, g0.z, g0.w, g1.x, g1.y, g1.z, g1.w, g2.x, g2.y, g2.z, g2.w, g3.x, g3.y, g3.z, g3.w};
#pragma unroll
            for (int r = 0; r < 16; ++r) { const f32x4 w = *(const f32x4*)(wd + r * 256 + c); z += w * ga[r]; }
            f32x4 o; o.x = logsigmoidf_(z.x) * 0.0625f; o.y = logsigmoidf_(z.y) * 0.0625f; o.z = logsigmoidf_(z.z) * 0.0625f; o.w = logsigmoidf_(z.w) * 0.0625f;
            *(f32x4*)(la + (size_t)m * 256 + c) = o;
        }
        {
            const unsigned kv = *(const unsigned*)(proj + (size_t)m * PROJ_LD + C_AK + 2 * lane);
            const float k0 = bflo(kv), k1 = bfhi(kv); float ss = k0 * k0 + k1 * k1;
#pragma unroll
            for (int o = 1; o < 32; o <<= 1) ss += __shfl_xor(ss, o);
            const float rstd = 1.0f / sqrtf(ss * (1.0f / 64.0f) + EPS);
            *(unsigned*)(kn + (size_t)m * 128 + 2 * lane) = pk2(k0 * rstd * gk[(2 * lane) & 63], k1 * rstd * gk[(2 * lane + 1) & 63]);
        }
    }
}

__device__ __forceinline__ void naive_mlstm(Frame& F, int l, int bh) {
    const int b = bh >> 2, h = bh & 3, tid = F.tid, v = tid >> 2, kq = tid & 3;
    const bf16* proj = (const bf16*)(F.ws + WS_PROJ); const float* side = (const float*)(F.ws + WS_SIDE); const bf16* qkc = (const bf16*)(F.ws + WS_QKC);
    bf16* Y = (bf16*)(F.ws + WS_Y);
    LAS float* red = (LAS float*)(F.lds + RING_OFF);
    const float bi = F.in[IN_BGATES][l * 8 + h], bfg = F.in[IN_BGATES][l * 8 + 4 + h];
    const float gout = F.in[IN_GOUTM][l * 512 + h * 128 + v];
    float C[16], n[16]; float mst = 0.f;
#pragma unroll
    for (int i = 0; i < 16; ++i) { C[i] = 0.f; n[i] = 0.f; }
    for (int t = 0; t < SEQ; ++t) {
        const size_t row = (size_t)b * SEQ + t;
        const v4u q0 = *(const v4u*)(qkc + row * 512 + h * 64 + kq * 16), q1 = *(const v4u*)(qkc + row * 512 + h * 64 + kq * 16 + 8);
        const v4u k0 = *(const v4u*)(qkc + row * 512 + 256 + h * 64 + kq * 16), k1 = *(const v4u*)(qkc + row * 512 + 256 + h * 64 + kq * 16 + 8);
        const float q[16] = {bflo(q0.x), bfhi(q0.x), bflo(q0.y), bfhi(q0.y), bflo(q0.z), bfhi(q0.z), bflo(q0.w), bfhi(q0.w), bflo(q1.x), bfhi(q1.x), bflo(q1.y), bfhi(q1.y), bflo(q1.z), bfhi(q1.z), bflo(q1.w), bfhi(q1.w)};
        const float k[16] = {bflo(k0.x), bfhi(k0.x), bflo(k0.y), bfhi(k0.y), bflo(k0.z), bfhi(k0.z), bflo(k0.w), bfhi(k0.w), bflo(k1.x), bfhi(k1.x), bflo(k1.y), bfhi(k1.y), bflo(k1.z), bfhi(k1.z), bflo(k1.w), bfhi(k1.w)};
        const float vv = bf1(proj[row * PROJ_LD + C_MV + h * 128 + v]);
        const float ip = side[row * 32 + h] + bi, lf = logsigmoidf_(side[row * 32 + 4 + h] + bfg);
        const float mn = fmaxf(lf + mst, ip), fd = expf(lf + mst - mn), iw = expf(ip - mn); mst = mn;
        float num = 0.f, den = 0.f;
#pragma unroll
        for (int i = 0; i < 16; ++i) { C[i] = fd * C[i] + (iw * vv) * k[i]; n[i] = fd * n[i] + iw * k[i]; num += C[i] * q[i]; den += n[i] * q[i]; }
        num += __shfl_xor(num, 1); num += __shfl_xor(num, 2); den += __shfl_xor(den, 1); den += __shfl_xor(den, 2);
        const float hv = num / fmaxf(fabsf(den), expf(-mst));
        const float s2 = wave_sum(kq == 0 ? hv * hv : 0.f);
        if (F.lane == 0) red[(t & 1) * 8 + F.wave] = s2;
        __syncthreads();
        float tot = 0.f;
#pragma unroll
        for (int w = 0; w < 8; ++w) tot += red[(t & 1) * 8 + w];
        const float rstd = 1.0f / sqrtf(tot * (1.0f / 128.0f) + EPS);
        if (kq == 0) { const float mo = bf1(proj[row * PROJ_LD + C_MO + h * 128 + v]);
            Y[row * DM + h * 128 + v] = (bf16)f2bf(hv * rstd * gout * sigmoidf_(mo)); }
    }
    __syncthreads();
}
__device__ __forceinline__ void naive_gla(Frame& F, int l, int bh) {
    const int b = bh >> 2, h = bh & 3, tid = F.tid, v = tid >> 2, kq = tid & 3;
    const bf16* proj = (const bf16*)(F.ws + WS_PROJ); const float* la = (const float*)(F.ws + WS_LA);
    bf16* Y = (bf16*)(F.ws + WS_Y);
    LAS float* red = (LAS float*)(F.lds + RING_OFF);
    const float gout = F.in[IN_GOUTG][l * 512 + h * 128 + v];
    float S[16];
#pragma unroll
    for (int i = 0; i < 16; ++i) S[i] = 0.f;
    for (int t = 0; t < SEQ; ++t) {
        const size_t row = (size_t)b * SEQ + t;
        const v4u q0 = *(const v4u*)(proj + row * PROJ_LD + C_GQ + h * 64 + kq * 16), q1 = *(const v4u*)(proj + row * PROJ_LD + C_GQ + h * 64 + kq * 16 + 8);
        const v4u k0 = *(const v4u*)(proj + row * PROJ_LD + C_GK + h * 64 + kq * 16), k1 = *(const v4u*)(proj + row * PROJ_LD + C_GK + h * 64 + kq * 16 + 8);
        const float q[16] = {bflo(q0.x), bfhi(q0.x), bflo(q0.y), bfhi(q0.y), bflo(q0.z), bfhi(q0.z), bflo(q0.w), bfhi(q0.w), bflo(q1.x), bfhi(q1.x), bflo(q1.y), bfhi(q1.y), bflo(q1.z), bfhi(q1.z), bflo(q1.w), bfhi(q1.w)};
        const float k[16] = {bflo(k0.x), bfhi(k0.x), bflo(k0.y), bfhi(k0.y), bflo(k0.z), bfhi(k0.z), bflo(k0.w), bfhi(k0.w), bflo(k1.x), bfhi(k1.x), bflo(k1.y), bfhi(k1.y), bflo(k1.z), bfhi(k1.z), bflo(k1.w), bfhi(k1.w)};
        const f32x4* lp = (const f32x4*)(la + row * 256 + h * 64 + kq * 16);
        const f32x4 a0 = lp[0], a1 = lp[1], a2 = lp[2], a3 = lp[3];
        const float a[16] = {a0.x, a0.y, a0.z, a0.w, a1.x, a1.y, a1.z, a1.w, a2.x, a2.y, a2.z, a2.w, a3.x, a3.y, a3.z, a3.w};
        const float vv = bf1(proj[row * PROJ_LD + C_GV + h * 128 + v]);
        float o = 0.f;
#pragma unroll
        for (int i = 0; i < 16; ++i) { S[i] = expf(a[i]) * S[i] + k[i] * vv; o += (q[i] * 0.125f) * S[i]; }
        o += __shfl_xor(o, 1); o += __shfl_xor(o, 2);
        const float s2 = wave_sum(kq == 0 ? o * o : 0.f);
        if (F.lane == 0) red[(t & 1) * 8 + F.wave] = s2;
        __syncthreads();
        float tot = 0.f;
#pragma unroll
        for (int w = 0; w < 8; ++w) tot += red[(t & 1) * 8 + w];
        const float rstd = 1.0f / sqrtf(tot * (1.0f / 128.0f) + EPS);
        if (kq == 0) { const float gg = bf1(proj[row * PROJ_LD + C_GG + h * 128 + v]);
            Y[row * DM + 512 + h * 128 + v] = (bf16)f2bf(o * rstd * gout * siluf_(gg)); }
    }
    __syncthreads();
}
__device__ __forceinline__ void naive_swa(Frame& F, int l, int blk) {
    const int tid = F.tid, hq = tid & 15, row = blk * 32 + (tid >> 4), kvh = hq >> 3, pos = row & (SEQ - 1);
    const bf16* proj = (const bf16*)(F.ws + WS_PROJ); const bf16* kn = (const bf16*)(F.ws + WS_KN); bf16* Y = (bf16*)(F.ws + WS_Y);
    const float* gq = F.in[IN_GQN] + l * 64; const float* relb = F.in[IN_RELB];
    float q[64], o[64];
    { float ss = 0.f;
#pragma unroll
      for (int c = 0; c < 8; ++c) { const v4u x = *(const v4u*)(proj + (size_t)row * PROJ_LD + C_AQ + hq * 64 + 8 * c);
          q[8 * c + 0] = bflo(x.x); q[8 * c + 1] = bfhi(x.x); q[8 * c + 2] = bflo(x.y); q[8 * c + 3] = bfhi(x.y); q[8 * c + 4] = bflo(x.z); q[8 * c + 5] = bfhi(x.z); q[8 * c + 6] = bflo(x.w); q[8 * c + 7] = bfhi(x.w); }
#pragma unroll
      for (int d = 0; d < 64; ++d) ss += q[d] * q[d];
      const float rstd = 1.0f / sqrtf(ss * (1.0f / 64.0f) + EPS);
#pragma unroll
      for (int d = 0; d < 64; ++d) { q[d] = q[d] * rstd * gq[d] * 0.125f; o[d] = 0.f; } }
    float mx = F.in[IN_SINKS][l * 16 + hq], den = 1.0f;
    const int s0 = pos - 127 < 0 ? 0 : pos - 127;
    for (int s = s0; s <= pos; ++s) {
        const size_t kr = (size_t)(row - pos + s);
        float dot = 0.f;
#pragma unroll
        for (int c = 0; c < 8; ++c) { const v4u x = *(const v4u*)(kn + kr * 128 + kvh * 64 + 8 * c);
            dot += q[8 * c + 0] * bflo(x.x) + q[8 * c + 1] * bfhi(x.x) + q[8 * c + 2] * bflo(x.y) + q[8 * c + 3] * bfhi(x.y) + q[8 * c + 4] * bflo(x.z) + q[8 * c + 5] * bfhi(x.z) + q[8 * c + 6] * bflo(x.w) + q[8 * c + 7] * bfhi(x.w); }
        const float sc = dot + relb[T5_BUCKET[pos - s] * 16 + hq];
        const float mn = fmaxf(mx, sc), corr = expf(mx - mn), p = expf(sc - mn); mx = mn; den = den * corr + p;
#pragma unroll
        for (int c = 0; c < 8; ++c) { const v4u x = *(const v4u*)(proj + kr * PROJ_LD + C_AV + kvh * 64 + 8 * c);
            o[8 * c + 0] = o[8 * c + 0] * corr + p * bflo(x.x); o[8 * c + 1] = o[8 * c + 1] * corr + p * bfhi(x.x); o[8 * c + 2] = o[8 * c + 2] * corr + p * bflo(x.y); o[8 * c + 3] = o[8 * c + 3] * corr + p * bfhi(x.y);
            o[8 * c + 4] = o[8 * c + 4] * corr + p * bflo(x.z); o[8 * c + 5] = o[8 * c + 5] * corr + p * bfhi(x.z); o[8 * c + 6] = o[8 * c + 6] * corr + p * bflo(x.w); o[8 * c + 7] = o[8 * c + 7] * corr + p * bfhi(x.w); }
    }
    const float inv = 1.0f / den;
#pragma unroll
    for (int c = 0; c < 8; ++c) { v4u w; w.x = pk2(o[8 * c] * inv, o[8 * c + 1] * inv); w.y = pk2(o[8 * c + 2] * inv, o[8 * c + 3] * inv); w.z = pk2(o[8 * c + 4] * inv, o[8 * c + 5] * inv); w.w = pk2(o[8 * c + 6] * inv, o[8 * c + 7] * inv);
        *(v4u*)(Y + (size_t)row * DM + 1024 + hq * 64 + 8 * c) = w; }
}
__device__ __forceinline__ void mix_naive(Frame& F, int l) {
    for (int u = F.vcu; u < 64 + 512; u += F.G) {
        if (u < 32) { if (!FAST_MLSTM) naive_mlstm(F, l, u); }
        else if (u < 64) { if (!FAST_GLA) naive_gla(F, l, u - 32); }
        else { if (!FAST_SWA) naive_swa(F, l, u - 64); }
    }
}

__device__ __forceinline__ int moe_tables(Frame& F) {
    LAS int* seg = (LAS int*)(F.lds + MISC_OFF + 1024); LAS int* tile_e = (LAS int*)(F.lds + MISC_OFF + 64);
    if (F.tid == 0) { int s = 0;
        for (int e = 0; e < 8; ++e) { seg[e] = s; const int c = (int)__hip_atomic_load(F.ctl + CW_CNT + 64 * e, RLX_AGENT); const int nt = (c + 255) >> 8; for (int i = 0; i < nt; ++i) tile_e[(s >> 8) + i] = e; s += nt << 8; }
        seg[8] = s; }
    __syncthreads();
    return seg[8] >> 8;
}
__device__ __forceinline__ void moe_gather(Frame& F) {
    (void)moe_tables(F);
    const LAS int* seg = (const LAS int*)(F.lds + MISC_OFF + 1024);
    const int gw = F.vcu * NWAVES + F.wave, NGW = F.G * NWAVES;
    int* tk = (int*)(F.ws + WS_TOK); const unsigned char* XN = (const unsigned char*)(F.ws + WS_XN); unsigned char* AS = (unsigned char*)(F.ws + WS_AS);
    for (int m = gw; m < M; m += NGW) {
        const v4u* src = (const v4u*)(XN + (size_t)m * DM) + F.lane; v4u r[2];
#pragma unroll
        for (int j = 0; j < 2; ++j) r[j] = src[64 * j];
#pragma unroll
        for (int k = 0; k < 2; ++k) { const int e = tk[TOK_E + m * 2 + k], dest = seg[e] + tk[TOK_SLOT + m * 2 + k];
            v4u* dst = (v4u*)(AS + (size_t)dest * DM) + F.lane;
#pragma unroll
            for (int j = 0; j < 2; ++j) dst[64 * j] = r[j];
            if (F.lane == 0) tk[TOK_POS + m * 2 + k] = dest; }
    }
    for (int e = 0; e < 8; ++e) { const int c = (int)__hip_atomic_load(F.ctl + CW_CNT + 64 * e, RLX_AGENT);
        for (int r = seg[e] + c + gw; r < seg[e + 1]; r += NGW) { v4u* dst = (v4u*)(AS + (size_t)r * DM) + F.lane;
#pragma unroll
            for (int j = 0; j < 2; ++j) dst[64 * j] = (v4u){0u, 0u, 0u, 0u}; } }
}
__device__ __forceinline__ void moe_combine(Frame& F, const float* gtf) {
    const int gw = F.vcu * NWAVES + F.wave, NGW = F.G * NWAVES;
    const int* tk = (const int*)(F.ws + WS_TOK); const float* xa = (const float*)(F.ws + WS_XA); const bf16* YS = (const bf16*)(F.ws + WS_AS);
    for (int m = gw; m < M; m += NGW) {
        const int b = m >> 11, p1 = tk[TOK_POS + 2 * m], p2 = tk[TOK_POS + 2 * m + 1];
        const float w1 = __builtin_bit_cast(float, tk[TOK_W + 2 * m]), w2 = __builtin_bit_cast(float, tk[TOK_W + 2 * m + 1]);
        const f32x4* xr = (const f32x4*)(xa + (size_t)m * DM) + F.lane; const f32x4* gp = (const f32x4*)(gtf + (size_t)b * 12288) + F.lane;
        const v2u* y1 = (const v2u*)(YS + (size_t)p1 * DM) + F.lane; const v2u* y2 = (const v2u*)(YS + (size_t)p2 * DM) + F.lane;
        f32x4* op = (f32x4*)(F.out + (size_t)m * DM) + F.lane;
#pragma unroll
        for (int j = 0; j < 8; ++j) { const f32x4 x = xr[64 * j], g = gp[64 * j]; const v2u a = y1[64 * j], c = y2[64 * j];
            f32x4 y; y.x = w1 * bflo(a.x) + w2 * bflo(c.x); y.y = w1 * bfhi(a.x) + w2 * bfhi(c.x); y.z = w1 * bflo(a.y) + w2 * bflo(c.y); y.w = w1 * bfhi(a.y) + w2 * bfhi(c.y);
            op[64 * j] = x + g * y; }
    }
}

typedef short v4i16_t __attribute__((ext_vector_type(4)));
#define MFMA16(a, b, c) __builtin_amdgcn_mfma_f32_16x16x32_bf16((a), (b), (c), 0, 0, 0)
__device__ __forceinline__ bf16x8 frag_row(const LAS unsigned char* base, int ldb, int r0, int k0, int lane) {
    return *(const LAS bf16x8*)(base + (r0 + (lane & 15)) * ldb + (k0 + 8 * (lane >> 4)) * 2);
}
__device__ __forceinline__ bf16x8 frag_tr2(const LAS unsigned char* base, int ldb, int ra, int rb, int c0, int lane) {
    const int g = lane >> 4, q = (lane & 15) >> 2, p = lane & 3;
    const LAS unsigned char* a0 = base + (ra + 4 * g + q) * ldb + (c0 + 4 * p) * 2;
    const LAS unsigned char* a1 = base + (rb + 4 * g + q) * ldb + (c0 + 4 * p) * 2;
    const v4i16_t lo = __builtin_amdgcn_ds_read_tr16_b64_v4i16((LAS v4i16_t*)a0), hi = __builtin_amdgcn_ds_read_tr16_b64_v4i16((LAS v4i16_t*)a1);
    bf16x8 r; r[0] = lo[0]; r[1] = lo[1]; r[2] = lo[2]; r[3] = lo[3]; r[4] = hi[0]; r[5] = hi[1]; r[6] = hi[2]; r[7] = hi[3]; return r;
}
__device__ __forceinline__ bf16x8 frag_tr(const LAS unsigned char* base, int ldb, int k0, int c0, int lane) {
    const int g = lane >> 4;
    return frag_tr2(base, ldb, k0 + 4 * g, k0 + 4 * g + 4, c0, lane);
}
__device__ __forceinline__ bf16x8 pack8(float a, float b, float c, float d, float e, float f, float g, float h) {
    v4u w; w.x = pk2(a, b); w.y = pk2(c, d); w.z = pk2(e, f); w.w = pk2(g, h); return __builtin_bit_cast(bf16x8, w);
}
__device__ __forceinline__ float scan_add(float v, int lane) {
#pragma unroll
    for (int d = 1; d < 64; d <<= 1) { const float t = __shfl_up(v, d); if (lane >= d) v += t; }
    return v;
}
__device__ __forceinline__ float scan_max(float v, int lane) {
#pragma unroll
    for (int d = 1; d < 64; d <<= 1) { const float t = __shfl_up(v, d); if (lane >= d) v = fmaxf(v, t); }
    return v;
}

__device__ __forceinline__ void swa_unit(Frame& F, int l, int unit) {
    const int b = unit >> 5, kvh = (unit >> 4) & 1, nb = unit & 15;
    const int tid = F.tid, lane = F.lane, w = F.wave, g = lane >> 4, n = lane & 15;
    const bf16* proj = (const bf16*)(F.ws + WS_PROJ); bf16* Y = (bf16*)(F.ws + WS_Y);
    LAS unsigned char* Kt = F.lds + RING_OFF; LAS unsigned char* Vt = Kt + 36864; LAS float* bias = (LAS float*)(Kt + 73728);
    constexpr int LDB = 144;
    const int hq = kvh * 8 + w;
    v4u qn[2][2];
    const bf16* qbase = proj + (size_t)(b * SEQ + nb * 128 + n) * PROJ_LD + C_AQ + hq * 64 + 8 * g;
#pragma unroll
    for (int jt = 0; jt < 2; ++jt) { qn[jt][0] = *(const v4u*)(qbase + (size_t)(jt * 16) * PROJ_LD); qn[jt][1] = *(const v4u*)(qbase + (size_t)(jt * 16) * PROJ_LD + 32); }
    __syncthreads();
    {
        const int r = tid >> 1, hf = tid & 1, pos = nb * 128 - 128 + r;
        v4u kx[4], vx[4];
        if (pos >= 0) { const bf16* kp = proj + (size_t)(b * SEQ + pos) * PROJ_LD + C_AK + kvh * 64 + hf * 32; const bf16* vp = proj + (size_t)(b * SEQ + pos) * PROJ_LD + C_AV + kvh * 64 + hf * 32;
#pragma unroll
            for (int j = 0; j < 4; ++j) { kx[j] = *(const v4u*)(kp + 8 * j); vx[j] = *(const v4u*)(vp + 8 * j); } }
        else {
#pragma unroll
            for (int j = 0; j < 4; ++j) { kx[j] = (v4u){0u, 0u, 0u, 0u}; vx[j] = (v4u){0u, 0u, 0u, 0u}; } }
        float kf[32]; float ss = 0.f;
#pragma unroll
        for (int j = 0; j < 4; ++j) { kf[8 * j + 0] = bflo(kx[j].x); kf[8 * j + 1] = bfhi(kx[j].x); kf[8 * j + 2] = bflo(kx[j].y); kf[8 * j + 3] = bfhi(kx[j].y); kf[8 * j + 4] = bflo(kx[j].z); kf[8 * j + 5] = bfhi(kx[j].z); kf[8 * j + 6] = bflo(kx[j].w); kf[8 * j + 7] = bfhi(kx[j].w); }
#pragma unroll
        for (int i = 0; i < 32; ++i) ss += kf[i] * kf[i];
        ss += __shfl_xor(ss, 1);
        const float rstd = 1.0f / sqrtf(ss * (1.0f / 64.0f) + EPS);
        const float* gk = F.in[IN_GKN] + l * 64 + hf * 32;
#pragma unroll
        for (int j = 0; j < 4; ++j) { const f32x4 g0 = *(const f32x4*)(gk + 8 * j), g1 = *(const f32x4*)(gk + 8 * j + 4);
            v4u o; o.x = pk2(kf[8 * j] * rstd * g0.x, kf[8 * j + 1] * rstd * g0.y); o.y = pk2(kf[8 * j + 2] * rstd * g0.z, kf[8 * j + 3] * rstd * g0.w);
            o.z = pk2(kf[8 * j + 4] * rstd * g1.x, kf[8 * j + 5] * rstd * g1.y); o.w = pk2(kf[8 * j + 6] * rstd * g1.z, kf[8 * j + 7] * rstd * g1.w);
            *(LAS v4u*)(Kt + r * LDB + hf * 64 + 16 * j) = o; *(LAS v4u*)(Vt + r * LDB + hf * 64 + 16 * j) = vx[j]; }
    }
    for (int i = tid; i < 1024; i += NWAVES * 64) bias[i] = F.in[IN_RELB][T5_BUCKET[i & 127] * 16 + kvh * 8 + (i >> 7)];
    __syncthreads();
    const float sink = F.in[IN_SINKS][l * 16 + hq];
    const float* gq = F.in[IN_GQN] + l * 64;
    const f32x4 gq0 = *(const f32x4*)(gq + 8 * g), gq1 = *(const f32x4*)(gq + 8 * g + 4), gq2 = *(const f32x4*)(gq + 32 + 8 * g), gq3 = *(const f32x4*)(gq + 32 + 8 * g + 4);
    const LAS float* bw = bias + w * 128;
    for (int qb = 0; qb < 4; ++qb) {
        const int j0 = qb * 32;
        bf16x8 qf[2][2];
        v4u qc[2][2];
#pragma unroll
        for (int jt = 0; jt < 2; ++jt) { qc[jt][0] = qn[jt][0]; qc[jt][1] = qn[jt][1]; }
        if (qb < 3) {
#pragma unroll
            for (int jt = 0; jt < 2; ++jt) { qn[jt][0] = *(const v4u*)(qbase + (size_t)(j0 + 32 + jt * 16) * PROJ_LD); qn[jt][1] = *(const v4u*)(qbase + (size_t)(j0 + 32 + jt * 16) * PROJ_LD + 32); } }
#pragma unroll
        for (int jt = 0; jt < 2; ++jt) {
            const v4u x0 = qc[jt][0], x1 = qc[jt][1];
            float f[16] = {bflo(x0.x), bfhi(x0.x), bflo(x0.y), bfhi(x0.y), bflo(x0.z), bfhi(x0.z), bflo(x0.w), bfhi(x0.w), bflo(x1.x), bfhi(x1.x), bflo(x1.y), bfhi(x1.y), bflo(x1.z), bfhi(x1.z), bflo(x1.w), bfhi(x1.w)};
            float ss = 0.f;
#pragma unroll
            for (int i = 0; i < 16; ++i) ss += f[i] * f[i];
            ss += __shfl_xor(ss, 16); ss += __shfl_xor(ss, 32);
            const float rs = 0.125f / sqrtf(ss * (1.0f / 64.0f) + EPS);
            qf[jt][0] = pack8(f[0] * rs * gq0.x, f[1] * rs * gq0.y, f[2] * rs * gq0.z, f[3] * rs * gq0.w, f[4] * rs * gq1.x, f[5] * rs * gq1.y, f[6] * rs * gq1.z, f[7] * rs * gq1.w);
            qf[jt][1] = pack8(f[8] * rs * gq2.x, f[9] * rs * gq2.y, f[10] * rs * gq2.z, f[11] * rs * gq2.w, f[12] * rs * gq3.x, f[13] * rs * gq3.y, f[14] * rs * gq3.z, f[15] * rs * gq3.w);
        }
        f32x4 sc[2][10];
#pragma unroll
        for (int i = 0; i < 10; ++i) { const int kt = 2 * qb + i;
            const bf16x8 k0 = frag_row(Kt, LDB, 16 * kt, 0, lane), k1 = frag_row(Kt, LDB, 16 * kt, 32, lane);
#pragma unroll
            for (int jt = 0; jt < 2; ++jt) { f32x4 a = (f32x4){0.f, 0.f, 0.f, 0.f}; a = MFMA16(k0, qf[jt][0], a); a = MFMA16(k1, qf[jt][1], a); sc[jt][i] = a; } }
        float inv[2];
#pragma unroll
        for (int jt = 0; jt < 2; ++jt) { const int j = j0 + 16 * jt + n; float mx = sink;
#pragma unroll
            for (int i = 0; i < 10; ++i)
#pragma unroll
                for (int r = 0; r < 4; ++r) { const int s = 16 * (2 * qb + i) + 4 * g + r, dist = j + 128 - s; const bool ok = (dist >= 0) && (dist < 128) && (nb > 0 || s >= 128);
                    const float v = ok ? sc[jt][i][r] + bw[dist & 127] : -INFINITY; sc[jt][i][r] = v; mx = fmaxf(mx, v); }
            mx = fmaxf(mx, __shfl_xor(mx, 16)); mx = fmaxf(mx, __shfl_xor(mx, 32));
            float sum = 0.f;
#pragma unroll
            for (int i = 0; i < 10; ++i)
#pragma unroll
                for (int r = 0; r < 4; ++r) { const float p = __expf(sc[jt][i][r] - mx); sc[jt][i][r] = p; sum += p; }
            sum += __shfl_xor(sum, 16); sum += __shfl_xor(sum, 32);
            inv[jt] = 1.0f / (sum + __expf(sink - mx)); }
        f32x4 o[4][2];
#pragma unroll
        for (int dt = 0; dt < 4; ++dt) { o[dt][0] = (f32x4){0.f, 0.f, 0.f, 0.f}; o[dt][1] = (f32x4){0.f, 0.f, 0.f, 0.f}; }
#pragma unroll
        for (int kk = 0; kk < 5; ++kk) { bf16x8 pf[2];
#pragma unroll
            for (int jt = 0; jt < 2; ++jt) pf[jt] = pack8(sc[jt][2 * kk][0], sc[jt][2 * kk][1], sc[jt][2 * kk][2], sc[jt][2 * kk][3], sc[jt][2 * kk + 1][0], sc[jt][2 * kk + 1][1], sc[jt][2 * kk + 1][2], sc[jt][2 * kk + 1][3]);
            const int ra = 16 * (2 * qb + 2 * kk);
#pragma unroll
            for (int dt = 0; dt < 4; ++dt) { const bf16x8 a = frag_tr2(Vt, LDB, ra, ra + 16, 16 * dt, lane);
                o[dt][0] = MFMA16(a, pf[0], o[dt][0]); o[dt][1] = MFMA16(a, pf[1], o[dt][1]); } }
#pragma unroll
        for (int jt = 0; jt < 2; ++jt) { bf16* yp = Y + (size_t)(b * SEQ + nb * 128 + j0 + 16 * jt + n) * DM + 1024 + hq * 64 + 4 * g;
#pragma unroll
            for (int dt = 0; dt < 4; ++dt) { v2u wv; wv.x = pk2(o[dt][jt][0] * inv[jt], o[dt][jt][1] * inv[jt]); wv.y = pk2(o[dt][jt][2] * inv[jt], o[dt][jt][3] * inv[jt]); *(v2u*)(yp + 16 * dt) = wv; } }
    }
}

__device__ __forceinline__ void gla_u_unit(Frame& F, int l, int u) {
    const int b = u >> 7, h = (u >> 5) & 3, c = u & 31, t0 = b * SEQ + 64 * c;
    const int tid = F.tid, lane = F.lane, w = F.wave, g = lane >> 4, n = lane & 15;
    const bf16* proj = (const bf16*)(F.ws + WS_PROJ); const float* side = (const float*)(F.ws + WS_SIDE);
    bf16* QT = (bf16*)(F.ws + WS_GAUX); bf16* QP = QT + (size_t)M * 256; bf16* KT = QP + (size_t)M * 256; float* BL = (float*)(KT + (size_t)M * 256); float* UG = (float*)(F.ws + WS_UG);
    LAS float* LAm = (LAS float*)(F.lds + RING_OFF);
    LAS unsigned char* KP = F.lds + RING_OFF + 16640;
    LAS unsigned char* VT = F.lds + RING_OFF + 25856;
    __syncthreads();
    const int s = tid >> 3, kg = tid & 7;
    const v4u kx = *(const v4u*)(proj + (size_t)(t0 + s) * PROJ_LD + C_GK + h * 64 + 8 * kg), qx = *(const v4u*)(proj + (size_t)(t0 + s) * PROJ_LD + C_GQ + h * 64 + 8 * kg);
    {
        const float* wd = F.in[IN_WDEC] + l * 16 * 256 + h * 64 + 8 * kg; const float* bd = F.in[IN_BDEC] + l * 256 + h * 64 + 8 * kg;
        f32x4 z0 = *(const f32x4*)(bd), z1 = *(const f32x4*)(bd + 4);
        const f32x4* gp = (const f32x4*)(side + (size_t)(t0 + s) * 32 + 8);
        const f32x4 g0 = gp[0], g1 = gp[1], g2 = gp[2], g3 = gp[3];
        const float ga[16] = {g0.x, g0.y, g0.z, g0.w, g1.x, g1.y, g1.z, g1.w, g2.x, g2.y, g2.z, g2.w, g3.x, g3.y, g3.z, g3.w};
#pragma unroll
        for (int r = 0; r < 16; ++r) { z0 += *(const f32x4*)(wd + r * 256) * ga[r]; z1 += *(const f32x4*)(wd + r * 256 + 4) * ga[r]; }
        LAS float* lp = LAm + s * 65 + 8 * kg;
        lp[0] = logsigmoidf_(z0.x) * 0.0625f; lp[1] = logsigmoidf_(z0.y) * 0.0625f; lp[2] = logsigmoidf_(z0.z) * 0.0625f; lp[3] = logsigmoidf_(z0.w) * 0.0625f;
        lp[4] = logsigmoidf_(z1.x) * 0.0625f; lp[5] = logsigmoidf_(z1.y) * 0.0625f; lp[6] = logsigmoidf_(z1.z) * 0.0625f; lp[7] = logsigmoidf_(z1.w) * 0.0625f;
        const bf16* vp = proj + (size_t)(t0 + s) * PROJ_LD + C_GV + h * 128 + 16 * kg;
        *(LAS v4u*)(VT + s * 272 + 32 * kg) = *(const v4u*)(vp); *(LAS v4u*)(VT + s * 272 + 32 * kg + 16) = *(const v4u*)(vp + 8);
    }
    __syncthreads();
#pragma unroll
    for (int ci = 0; ci < 8; ++ci) { const int k = 8 * w + ci; const float v = scan_add(LAm[lane * 65 + k], lane); LAm[lane * 65 + k] = v; }
    __syncthreads();
    {
        const float kf[8] = {bflo(kx.x), bfhi(kx.x), bflo(kx.y), bfhi(kx.y), bflo(kx.z), bfhi(kx.z), bflo(kx.w), bfhi(kx.w)};
        const float qf[8] = {bflo(qx.x), bfhi(qx.x), bflo(qx.y), bfhi(qx.y), bflo(qx.z), bfhi(qx.z), bflo(qx.w), bfhi(qx.w)};
        float o1[8], o2[8], o3[8], o4[8];
#pragma unroll
        for (int i = 0; i < 8; ++i) { const float bb = LAm[s * 65 + 8 * kg + i], bl = LAm[63 * 65 + 8 * kg + i], br = LAm[31 * 65 + 8 * kg + i];
            o1[i] = kf[i] * __expf(bl - bb); o2[i] = qf[i] * 0.125f * __expf(bb - br); o3[i] = qf[i] * 0.125f * __expf(bb); o4[i] = kf[i] * __expf(br - bb);
            if (s == 63) BL[(size_t)u * 64 + 8 * kg + i] = bl; }
        v4u o; o.x = pk2(o1[0], o1[1]); o.y = pk2(o1[2], o1[3]); o.z = pk2(o1[4], o1[5]); o.w = pk2(o1[6], o1[7]); *(LAS v4u*)(KP + s * 144 + 16 * kg) = o;
        const size_t go = (size_t)(t0 + s) * 256 + h * 64 + 8 * kg;
        o.x = pk2(o2[0], o2[1]); o.y = pk2(o2[2], o2[3]); o.z = pk2(o2[4], o2[5]); o.w = pk2(o2[6], o2[7]); *(v4u*)(QT + go) = o;
        o.x = pk2(o3[0], o3[1]); o.y = pk2(o3[2], o3[3]); o.z = pk2(o3[4], o3[5]); o.w = pk2(o3[6], o3[7]); *(v4u*)(QP + go) = o;
        o.x = pk2(o4[0], o4[1]); o.y = pk2(o4[2], o4[3]); o.z = pk2(o4[4], o4[5]); o.w = pk2(o4[6], o4[7]); *(v4u*)(KT + go) = o;
    }
    __syncthreads();
    {
        f32x4 acc[4];
#pragma unroll
        for (int mt = 0; mt < 4; ++mt) acc[mt] = (f32x4){0.f, 0.f, 0.f, 0.f};
#pragma unroll
        for (int ks = 0; ks < 2; ++ks) { const bf16x8 bv = frag_tr(VT, 272, 32 * ks, 16 * w, lane);
#pragma unroll
            for (int mt = 0; mt < 4; ++mt) { const bf16x8 a = frag_tr(KP, 144, 32 * ks, 16 * mt, lane); acc[mt] = MFMA16(a, bv, acc[mt]); } }
        float* up = UG + (size_t)u * 64 * 128 + 16 * w + n;
#pragma unroll
        for (int mt = 0; mt < 4; ++mt)
#pragma unroll
            for (int r = 0; r < 4; ++r) up[(size_t)(16 * mt + 4 * g + r) * 128] = acc[mt][r];
    }
}
__device__ __forceinline__ void gla_out_group(Frame& F, int l, int ug) {
    const int bh = ug >> 3, jj = ug & 7, b = bh >> 2, h = bh & 3;
    const int tid = F.tid, lane = F.lane, w = F.wave, g = lane >> 4, n = lane & 15;
    const bf16* proj = (const bf16*)(F.ws + WS_PROJ); bf16* Y = (bf16*)(F.ws + WS_Y);
    const bf16* QT = (const bf16*)(F.ws + WS_GAUX); const bf16* QP = QT + (size_t)M * 256; const bf16* KT = QP + (size_t)M * 256; const float* BL = (const float*)(KT + (size_t)M * 256); const float* UG = (const float*)(F.ws + WS_UG);
    LAS unsigned char* LQT = F.lds + RING_OFF; LAS unsigned char* LQP = LQT + 9216; LAS unsigned char* LKT = LQT + 18432; LAS unsigned char* VT = LQT + 27648; LAS unsigned char* ST = LQT + 45056;
    LAS float* SS = (LAS float*)(LQT + 62464);
    float S[16];
#pragma unroll
    for (int i = 0; i < 16; ++i) S[i] = 0.f;
    const int sk = tid >> 3, sv = (tid & 7) * 16;
    int cdone = 0;
    const float* gout = F.in[IN_GOUTG] + l * 512 + h * 128;
#pragma clang loop unroll(disable)
    for (int oi = 0; oi < 4; ++oi) {
        asm volatile("" : "+s"(proj), "+s"(Y), "+s"(QT), "+s"(QP), "+s"(KT), "+s"(BL), "+s"(UG), "+s"(gout));
        const int c = oi == 0 ? jj : (oi == 1 ? 15 - jj : (oi == 2 ? 16 + jj : 31 - jj));
        while (cdone < c) {
            const int nbt = (c - cdone) < 4 ? (c - cdone) : 4; f32x4 xb[4][4]; float db[4];
#pragma unroll
            for (int i = 0; i < 4; ++i) if (i < nbt) { const int uu = bh * 32 + cdone + i; db[i] = BL[(size_t)uu * 64 + sk];
                const f32x4* up = (const f32x4*)(UG + (size_t)uu * 64 * 128 + sk * 128 + sv);
#pragma unroll
                for (int q = 0; q < 4; ++q) xb[i][q] = up[q]; }
#pragma unroll
            for (int i = 0; i < 4; ++i) if (i < nbt) { const float dec = __expf(db[i]);
#pragma unroll
                for (int q = 0; q < 4; ++q) { const f32x4 x = xb[i][q]; S[4 * q] = dec * S[4 * q] + x.x; S[4 * q + 1] = dec * S[4 * q + 1] + x.y; S[4 * q + 2] = dec * S[4 * q + 2] + x.z; S[4 * q + 3] = dec * S[4 * q + 3] + x.w; } }
            cdone += nbt; }
        const int t0 = b * SEQ + 64 * c;
        __syncthreads();
        {
            v4u o; o.x = pk2(S[0], S[1]); o.y = pk2(S[2], S[3]); o.z = pk2(S[4], S[5]); o.w = pk2(S[6], S[7]); *(LAS v4u*)(ST + sk * 272 + sv * 2) = o;
            o.x = pk2(S[8], S[9]); o.y = pk2(S[10], S[11]); o.z = pk2(S[12], S[13]); o.w = pk2(S[14], S[15]); *(LAS v4u*)(ST + sk * 272 + sv * 2 + 16) = o;
            const int s = tid >> 3, kg = tid & 7; const size_t go = (size_t)(t0 + s) * 256 + h * 64 + 8 * kg;
            *(LAS v4u*)(LQT + s * 144 + 16 * kg) = *(const v4u*)(QT + go); *(LAS v4u*)(LQP + s * 144 + 16 * kg) = *(const v4u*)(QP + go); *(LAS v4u*)(LKT + s * 144 + 16 * kg) = *(const v4u*)(KT + go);
            const bf16* vp = proj + (size_t)(t0 + s) * PROJ_LD + C_GV + h * 128 + 16 * kg;
            *(LAS v4u*)(VT + s * 272 + 32 * kg) = *(const v4u*)(vp); *(LAS v4u*)(VT + s * 272 + 32 * kg + 16) = *(const v4u*)(vp + 8);
        }
        __syncthreads();
        const int jt = w & 3, vh = w >> 2;
        bf16x8 qf[2], qpf[2];
#pragma unroll
        for (int ks = 0; ks < 2; ++ks) { qf[ks] = frag_row(LQT, 144, 16 * jt, 32 * ks, lane); qpf[ks] = frag_row(LQP, 144, 16 * jt, 32 * ks, lane); }
        f32x4 at[4];
#pragma unroll
        for (int st = 0; st < 4; ++st) { at[st] = (f32x4){0.f, 0.f, 0.f, 0.f};
            if (st <= jt) {
#pragma unroll
                for (int ks = 0; ks < 2; ++ks) at[st] = MFMA16(frag_row(LKT, 144, 16 * st, 32 * ks, lane), qf[ks], at[st]);
                if (st == jt) {
#pragma unroll
                    for (int r = 0; r < 4; ++r) if (4 * g + r > n) at[st][r] = 0.f; } } }
        f32x4 o[4];
#pragma unroll
        for (int mt = 0; mt < 4; ++mt) { o[mt] = (f32x4){0.f, 0.f, 0.f, 0.f};
#pragma unroll
            for (int ks = 0; ks < 2; ++ks) o[mt] = MFMA16(frag_tr(ST, 272, 32 * ks, 64 * vh + 16 * mt, lane), qpf[ks], o[mt]); }
#pragma unroll
        for (int kk = 0; kk < 2; ++kk) { if (2 * kk <= jt) {
            const bf16x8 pf = pack8(at[2 * kk][0], at[2 * kk][1], at[2 * kk][2], at[2 * kk][3], at[2 * kk + 1][0], at[2 * kk + 1][1], at[2 * kk + 1][2], at[2 * kk + 1][3]);
#pragma unroll
            for (int mt = 0; mt < 4; ++mt) o[mt] = MFMA16(frag_tr2(VT, 272, 32 * kk, 32 * kk + 16, 64 * vh + 16 * mt, lane), pf, o[mt]); } }
        float ss = 0.f;
#pragma unroll
        for (int mt = 0; mt < 4; ++mt)
#pragma unroll
            for (int r = 0; r < 4; ++r) ss += o[mt][r] * o[mt][r];
        ss += __shfl_xor(ss, 16); ss += __shfl_xor(ss, 32);
        if (g == 0) SS[w * 16 + n] = ss;
        __syncthreads();
        const float rstd = 1.0f / sqrtf((SS[w * 16 + n] + SS[(w ^ 4) * 16 + n]) * (1.0f / 128.0f) + EPS);
        const size_t row = (size_t)(t0 + 16 * jt + n);
#pragma unroll
        for (int mt = 0; mt < 4; ++mt) { const int v = 64 * vh + 16 * mt + 4 * g;
            const f32x4 go4 = *(const f32x4*)(gout + v); const v2u gx = *(const v2u*)(proj + row * PROJ_LD + C_GG + h * 128 + v);
            v2u wv; wv.x = pk2(o[mt][0] * rstd * go4.x * siluf_(bflo(gx.x)), o[mt][1] * rstd * go4.y * siluf_(bfhi(gx.x))); wv.y = pk2(o[mt][2] * rstd * go4.z * siluf_(bflo(gx.y)), o[mt][3] * rstd * go4.w * siluf_(bfhi(gx.y)));
            *(v2u*)(Y + row * DM + 512 + h * 128 + v) = wv; }
    }
}

__device__ __forceinline__ void mlstm_u_unit(Frame& F, int l, int u) {
    const int b = u >> 6, h = (u >> 4) & 3, c = u & 15, t0 = b * SEQ + 128 * c;
    const int tid = F.tid, lane = F.lane, w = F.wave, g = lane >> 4, n = lane & 15;
    const bf16* proj = (const bf16*)(F.ws + WS_PROJ); const float* side = (const float*)(F.ws + WS_SIDE); bf16* qkc = (bf16*)(F.ws + WS_QKC);
    float* UM = (float*)(F.ws + WS_UM); float* MS = UM + (size_t)512 * 136 * 64;
    LAS unsigned char* KP = F.lds + RING_OFF;
    LAS unsigned char* VT = F.lds + RING_OFF + 18432;
    LAS float* GF = (LAS float*)(F.lds + RING_OFF + 53248);
    __syncthreads();
    const int s = tid >> 2, qd = tid & 3;
    float kc[16];
    {
        const float* wc = F.in[IN_WCONV] + l * 4 * 512; const float* bc = F.in[IN_BCONV] + l * 512;
        const int pos = 128 * c + s;
#pragma unroll
        for (int part = 0; part < 2; ++part) { const int ch = part * 256 + h * 64 + 16 * qd; float y[16];
#pragma unroll
            for (int q4 = 0; q4 < 4; ++q4) { const f32x4 bb = *(const f32x4*)(bc + ch + 4 * q4); y[4 * q4] = bb.x; y[4 * q4 + 1] = bb.y; y[4 * q4 + 2] = bb.z; y[4 * q4 + 3] = bb.w; }
#pragma unroll
            for (int i = 0; i < 4; ++i) { if (pos - 3 + i >= 0) { const bf16* xp = proj + (size_t)(t0 + s - 3 + i) * PROJ_LD + ch; const v4u x0 = *(const v4u*)xp, x1 = *(const v4u*)(xp + 8);
                const float xf[16] = {bflo(x0.x), bfhi(x0.x), bflo(x0.y), bfhi(x0.y), bflo(x0.z), bfhi(x0.z), bflo(x0.w), bfhi(x0.w), bflo(x1.x), bfhi(x1.x), bflo(x1.y), bfhi(x1.y), bflo(x1.z), bfhi(x1.z), bflo(x1.w), bfhi(x1.w)};
#pragma unroll
                for (int q4 = 0; q4 < 4; ++q4) { const f32x4 ww = *(const f32x4*)(wc + i * 512 + ch + 4 * q4); y[4 * q4] += ww.x * xf[4 * q4]; y[4 * q4 + 1] += ww.y * xf[4 * q4 + 1]; y[4 * q4 + 2] += ww.z * xf[4 * q4 + 2]; y[4 * q4 + 3] += ww.w * xf[4 * q4 + 3]; } } }
            const float scl = part ? 0.125f : 1.0f;
#pragma unroll
            for (int i = 0; i < 16; ++i) y[i] = siluf_(y[i]) * scl;
            v4u o0, o1; o0.x = pk2(y[0], y[1]); o0.y = pk2(y[2], y[3]); o0.z = pk2(y[4], y[5]); o0.w = pk2(y[6], y[7]); o1.x = pk2(y[8], y[9]); o1.y = pk2(y[10], y[11]); o1.z = pk2(y[12], y[13]); o1.w = pk2(y[14], y[15]);
            *(v4u*)(qkc + (size_t)(t0 + s) * 512 + ch) = o0; *(v4u*)(qkc + (size_t)(t0 + s) * 512 + ch + 8) = o1;
            if (part) {
#pragma unroll
                for (int i = 0; i < 16; ++i) kc[i] = y[i]; } }
        const bf16* vp = proj + (size_t)(t0 + s) * PROJ_LD + C_MV + h * 128 + 32 * qd;
#pragma unroll
        for (int j = 0; j < 4; ++j) *(LAS v4u*)(VT + s * 272 + 64 * qd + 16 * j) = *(const v4u*)(vp + 8 * j);
        if (tid < 128) { GF[tid] = logsigmoidf_(side[(size_t)(t0 + tid) * 32 + 4 + h] + F.in[IN_BGATES][l * 8 + 4 + h]); GF[128 + tid] = side[(size_t)(t0 + tid) * 32 + h] + F.in[IN_BGATES][l * 8 + h]; }
    }
    __syncthreads();
    if (w == 0) {
        const float a0 = GF[2 * lane], a1 = GF[2 * lane + 1]; const float P = scan_add(a0 + a1, lane);
        const float blast = __shfl(P, 63);
        const float lw0 = blast - (P - a1) + GF[128 + 2 * lane], lw1 = blast - P + GF[128 + 2 * lane + 1];
        float mx = fmaxf(lw0, lw1);
#pragma unroll
        for (int o = 1; o < 64; o <<= 1) mx = fmaxf(mx, __shfl_xor(mx, o));
        GF[256 + 2 * lane] = expf(lw0 - mx); GF[256 + 2 * lane + 1] = expf(lw1 - mx);
        if (lane == 0) { MS[(size_t)u * 2] = blast; MS[(size_t)u * 2 + 1] = mx; }
    }
    __syncthreads();
    {   const float wg = GF[256 + s];
        v4u o0, o1; o0.x = pk2(kc[0] * wg, kc[1] * wg); o0.y = pk2(kc[2] * wg, kc[3] * wg); o0.z = pk2(kc[4] * wg, kc[5] * wg); o0.w = pk2(kc[6] * wg, kc[7] * wg);
        o1.x = pk2(kc[8] * wg, kc[9] * wg); o1.y = pk2(kc[10] * wg, kc[11] * wg); o1.z = pk2(kc[12] * wg, kc[13] * wg); o1.w = pk2(kc[14] * wg, kc[15] * wg);
        *(LAS v4u*)(KP + s * 144 + 32 * qd) = o0; *(LAS v4u*)(KP + s * 144 + 32 * qd + 16) = o1; }
    __syncthreads();
    {
        const int nt = w & 3, m0 = w >> 2;
        f32x4 acc[5];
#pragma unroll
        for (int i = 0; i < 5; ++i) acc[i] = (f32x4){0.f, 0.f, 0.f, 0.f};
        const bf16x8 ones = (n == 0) ? pack8(1.f, 1.f, 1.f, 1.f, 1.f, 1.f, 1.f, 1.f) : pack8(0.f, 0.f, 0.f, 0.f, 0.f, 0.f, 0.f, 0.f);
#pragma unroll
        for (int ks = 0; ks < 4; ++ks) { const bf16x8 bv = frag_tr(KP, 144, 32 * ks, 16 * nt, lane);
#pragma unroll
            for (int i = 0; i < 4; ++i) acc[i] = MFMA16(frag_tr(VT, 272, 32 * ks, 16 * (m0 + 2 * i), lane), bv, acc[i]);
            if (m0 == 0) acc[4] = MFMA16(ones, bv, acc[4]); }
        float* up = UM + (size_t)u * 136 * 64 + 16 * nt + n;
#pragma unroll
        for (int i = 0; i < 4; ++i)
#pragma unroll
            for (int r = 0; r < 4; ++r) up[(size_t)(16 * (m0 + 2 * i) + 4 * g + r) * 64] = acc[i][r];
        if (m0 == 0 && g == 0) up[(size_t)128 * 64] = acc[4][0];
    }
}
__device__ __forceinline__ void mlstm_out_group(Frame& F, int l, int ug) {
    const int bh = ug >> 3, jj = ug & 7, b = bh >> 2, h = bh & 3;
    const int tid = F.tid, lane = F.lane, w = F.wave, g = lane >> 4, n = lane & 15;
    const bf16* proj = (const bf16*)(F.ws + WS_PROJ); const float* side = (const float*)(F.ws + WS_SIDE); const bf16* qkc = (const bf16*)(F.ws + WS_QKC); bf16* Y = (bf16*)(F.ws + WS_Y);
    const float* UM = (const float*)(F.ws + WS_UM); const float* MS = UM + (size_t)512 * 136 * 64;
    LAS unsigned char* QC = F.lds + RING_OFF; LAS unsigned char* KC = QC + 18432; LAS unsigned char* VT = QC + 36864; LAS unsigned char* CS = QC + 71680;
    LAS float* GF = (LAS float*)(QC + 92416);
    float C[16], nn = 0.f, mst = 0.f;
#pragma unroll
    for (int i = 0; i < 16; ++i) C[i] = 0.f;
    const int cv = tid >> 2, ck = (tid & 3) * 16;
    int cdone = 0;
    const float* gout = F.in[IN_GOUTM] + l * 512 + h * 128;
#pragma clang loop unroll(disable)
    for (int oi = 0; oi < 2; ++oi) {
        asm volatile("" : "+s"(proj), "+s"(side), "+s"(qkc), "+s"(Y), "+s"(UM), "+s"(MS), "+s"(gout));
        const int c = oi == 0 ? jj : 15 - jj;
        while (cdone < c) {
            const int nbt = (c - cdone) < 4 ? (c - cdone) : 4; f32x4 xb[4][4]; float bb[4], mb[4], nb4[4];
#pragma unroll
            for (int i = 0; i < 4; ++i) if (i < nbt) { const int uu = bh * 16 + cdone + i; bb[i] = MS[(size_t)uu * 2]; mb[i] = MS[(size_t)uu * 2 + 1];
                const f32x4* up = (const f32x4*)(UM + (size_t)uu * 136 * 64 + cv * 64 + ck);
#pragma unroll
                for (int q = 0; q < 4; ++q) xb[i][q] = up[q];
                nb4[i] = UM[(size_t)uu * 136 * 64 + 128 * 64 + (tid & 63)]; }
#pragma unroll
            for (int i = 0; i < 4; ++i) if (i < nbt) { const float Bc = bb[i], ml = mb[i];
                const float mn = fmaxf(Bc + mst, ml), d1 = expf(Bc + mst - mn), d2 = expf(ml - mn); mst = mn;
#pragma unroll
                for (int q = 0; q < 4; ++q) { const f32x4 x = xb[i][q]; C[4 * q] = d1 * C[4 * q] + d2 * x.x; C[4 * q + 1] = d1 * C[4 * q + 1] + d2 * x.y; C[4 * q + 2] = d1 * C[4 * q + 2] + d2 * x.z; C[4 * q + 3] = d1 * C[4 * q + 3] + d2 * x.w; }
                nn = d1 * nn + d2 * nb4[i]; }
            cdone += nbt; }
        const int t0 = b * SEQ + 128 * c;
        __syncthreads();
        {
            v4u o; o.x = pk2(C[0], C[1]); o.y = pk2(C[2], C[3]); o.z = pk2(C[4], C[5]); o.w = pk2(C[6], C[7]); *(LAS v4u*)(CS + cv * 144 + ck * 2) = o;
            o.x = pk2(C[8], C[9]); o.y = pk2(C[10], C[11]); o.z = pk2(C[12], C[13]); o.w = pk2(C[14], C[15]); *(LAS v4u*)(CS + cv * 144 + ck * 2 + 16) = o;
            if (tid < 64) *(LAS bf16*)(CS + 128 * 144 + tid * 2) = (bf16)f2bf(nn);
            for (int i = tid; i < 15 * 72; i += NWAVES * 64) *(LAS bf16*)(CS + 129 * 144 + i * 2) = (bf16)0;
            const int s = tid >> 2, qd = tid & 3;
            const bf16* qp = qkc + (size_t)(t0 + s) * 512 + h * 64 + 16 * qd;
            *(LAS v4u*)(QC + s * 144 + 32 * qd) = *(const v4u*)qp; *(LAS v4u*)(QC + s * 144 + 32 * qd + 16) = *(const v4u*)(qp + 8);
            *(LAS v4u*)(KC + s * 144 + 32 * qd) = *(const v4u*)(qp + 256); *(LAS v4u*)(KC + s * 144 + 32 * qd + 16) = *(const v4u*)(qp + 256 + 8);
            const bf16* vp = proj + (size_t)(t0 + s) * PROJ_LD + C_MV + h * 128 + 32 * qd;
#pragma unroll
            for (int j = 0; j < 4; ++j) *(LAS v4u*)(VT + s * 272 + 64 * qd + 16 * j) = *(const v4u*)(vp + 8 * j);
            if (tid < 128) { GF[tid] = logsigmoidf_(side[(size_t)(t0 + tid) * 32 + 4 + h] + F.in[IN_BGATES][l * 8 + 4 + h]); GF[128 + tid] = side[(size_t)(t0 + tid) * 32 + h] + F.in[IN_BGATES][l * 8 + h]; }
        }
        __syncthreads();
        if (w == 0) {
            const float a0 = GF[2 * lane], a1 = GF[2 * lane + 1]; const float P = scan_add(a0 + a1, lane);
            const float b0 = P - a1, b1 = P; const float x0 = GF[128 + 2 * lane] - b0, x1 = GF[128 + 2 * lane + 1] - b1;
            const float cm = scan_max(fmaxf(x0, x1), lane);
            float prev = __shfl_up(cm, 1); if (lane == 0) prev = -INFINITY;
            const float M0 = fmaxf(mst, fmaxf(prev, x0)), M1 = fmaxf(mst, cm);
            GF[2 * lane] = x0; GF[2 * lane + 1] = x1; GF[128 + 2 * lane] = M0; GF[128 + 2 * lane + 1] = M1; GF[256 + 2 * lane] = b0; GF[256 + 2 * lane + 1] = b1;
        }
        __syncthreads();
        {
            const int j = 16 * w + n; const float Mj = GF[128 + j], bj = GF[256 + j];
            bf16x8 qf[2];
#pragma unroll
            for (int ks = 0; ks < 2; ++ks) qf[ks] = frag_row(QC, 144, 16 * w, 32 * ks, lane);
            f32x4 p[8];
#pragma unroll
            for (int st = 0; st < 8; ++st) { p[st] = (f32x4){0.f, 0.f, 0.f, 0.f};
                if (st <= w) {
#pragma unroll
                    for (int ks = 0; ks < 2; ++ks) p[st] = MFMA16(frag_row(KC, 144, 16 * st, 32 * ks, lane), qf[ks], p[st]);
                    const f32x4 as = *(const LAS f32x4*)(GF + 16 * st + 4 * g);
#pragma unroll
                    for (int r = 0; r < 4; ++r) { const float e = __expf(as[r] - Mj); p[st][r] = (st < w || 4 * g + r <= n) ? p[st][r] * e : 0.f; } } }
            f32x4 o[9];
            const float wi = __expf(mst - Mj);
#pragma unroll
            for (int mt = 0; mt < 9; ++mt) { o[mt] = (f32x4){0.f, 0.f, 0.f, 0.f};
#pragma unroll
                for (int ks = 0; ks < 2; ++ks) o[mt] = MFMA16(frag_row(CS, 144, 16 * mt, 32 * ks, lane), qf[ks], o[mt]);
                o[mt] = o[mt] * wi; }
            const bf16x8 ones = (n == 0) ? pack8(1.f, 1.f, 1.f, 1.f, 1.f, 1.f, 1.f, 1.f) : pack8(0.f, 0.f, 0.f, 0.f, 0.f, 0.f, 0.f, 0.f);
#pragma unroll
            for (int kk = 0; kk < 4; ++kk) { if (2 * kk <= w) {
                const bf16x8 pf = pack8(p[2 * kk][0], p[2 * kk][1], p[2 * kk][2], p[2 * kk][3], p[2 * kk + 1][0], p[2 * kk + 1][1], p[2 * kk + 1][2], p[2 * kk + 1][3]);
#pragma unroll
                for (int mt = 0; mt < 8; ++mt) o[mt] = MFMA16(frag_tr2(VT, 272, 32 * kk, 32 * kk + 16, 16 * mt, lane), pf, o[mt]);
                o[8] = MFMA16(ones, pf, o[8]); } }
            const float den = __shfl(o[8][0], n);
            const float dn = 1.0f / fmaxf(fabsf(den), __expf(-(bj + Mj)));
            float ss = 0.f;
#pragma unroll
            for (int mt = 0; mt < 8; ++mt)
#pragma unroll
                for (int r = 0; r < 4; ++r) { o[mt][r] *= dn; ss += o[mt][r] * o[mt][r]; }
            ss += __shfl_xor(ss, 16); ss += __shfl_xor(ss, 32);
            const float rstd = 1.0f / sqrtf(ss * (1.0f / 128.0f) + EPS);
            const size_t row = (size_t)(t0 + j);
#pragma unroll
            for (int mt = 0; mt < 8; ++mt) { const int v = 16 * mt + 4 * g;
                const f32x4 go4 = *(const f32x4*)(gout + v); const v2u mx = *(const v2u*)(proj + row * PROJ_LD + C_MO + h * 128 + v);
                v2u wv; wv.x = pk2(o[mt][0] * rstd * go4.x * sigmoidf_(bflo(mx.x)), o[mt][1] * rstd * go4.y * sigmoidf_(bfhi(mx.x))); wv.y = pk2(o[mt][2] * rstd * go4.z * sigmoidf_(bflo(mx.y)), o[mt][3] * rstd * go4.w * sigmoidf_(bfhi(mx.y)));
                *(v2u*)(Y + row * DM + h * 128 + v) = wv; }
        }
    }
}

#define PROBE_SUBREP(id) (PROBE_REPEAT == (id) ? 5 : 1)
__device__ __forceinline__ void mix_a(Frame& F, int l) {
    if (!(FAST_GLA && FAST_MLSTM && FAST_SWA)) mix_prep(F, l);
    if (FAST_SWA) for (int rep = 0; rep < PROBE_SUBREP(201); ++rep) for (int u = F.vcu; u < 256; u += F.G) swa_unit(F, l, u);
    if (FAST_MLSTM) for (int rep = 0; rep < PROBE_SUBREP(202); ++rep) for (int u = F.vcu; u < 512; u += F.G) mlstm_u_unit(F, l, u);
    if (FAST_GLA) for (int rep = 0; rep < PROBE_SUBREP(203); ++rep) for (int u = F.vcu; u < 1024; u += F.G) gla_u_unit(F, l, u);
}
__device__ __forceinline__ void mix_b(Frame& F, int l) {
    if (!(FAST_GLA && FAST_MLSTM && FAST_SWA)) mix_naive(F, l);
    if (FAST_MLSTM) for (int rep = 0; rep < PROBE_SUBREP(204); ++rep) for (int ug = F.vcu; ug < 256; ug += F.G) mlstm_out_group(F, l, ug);
    if (FAST_GLA) for (int rep = 0; rep < PROBE_SUBREP(205); ++rep) for (int ug = F.vcu; ug < 256; ug += F.G) gla_out_group(F, l, ug);
}

#ifndef MK_ONE_LAUNCH
#define MK_ONE_LAUNCH 1
#endif
constexpr int NPH = 19;
struct Args { const float* in[26]; float* out; unsigned char* ws; int ph_lo, ph_hi; };
__global__ void __launch_bounds__(NWAVES * 64, 2) hybrid_fwd(Args args) {
    extern __shared__ __attribute__((aligned(16))) unsigned char lds[];
    Frame F;
    F.lds = (LAS unsigned char*)lds;
    F.tid = threadIdx.x; F.lane = F.tid & 63; F.wave = __builtin_amdgcn_readfirstlane(F.tid >> 6);
    F.G = gridDim.x; { const int bx = blockIdx.x; F.vcu = (F.G % 8 == 0) ? (bx % 8) * (F.G / 8) + bx / 8 : bx; }
    F.ws = args.ws; F.out = args.out; F.ctl = (gu32*)(args.ws + WS_CTL);
    F.in = (cfp_k*)__builtin_amdgcn_kernarg_segment_ptr();
    for (int u = F.tid; u < (LDS_BYTES - MISC_OFF) / 4; u += NWAVES * 64) ((LAS unsigned*)(F.lds + MISC_OFF))[u] = 0u;
    __syncthreads();
    const int lo = args.ph_lo, hi = args.ph_hi;
    XcdBarrier bar; bar.bar = (unsigned*)(F.ctl + CW_BAR); bar.x = 0; bar.st = nullptr;
    if (hi - lo > 1) bar = xcd_barrier_post((unsigned*)(F.ctl + CW_BAR), (volatile LAS unsigned*)(F.lds + MISC_OFF));
#define IN(k) (lo <= (k) && (k) < hi)
#define SEAM(k) do { if (IN(k) && IN((k) + 1)) { xcd_barrier(bar); if (PROBE_REPEAT == 100) xcd_barrier(bar); } } while (0)
    bf16* const XN = (bf16*)(F.ws + WS_XN); bf16* const Yb = (bf16*)(F.ws + WS_Y); float* const XA = (float*)(F.ws + WS_XA);
    bf16* const PROJ = (bf16*)(F.ws + WS_PROJ); float* const SIDE = (float*)(F.ws + WS_SIDE); bf16* const HID = (bf16*)(F.ws + WS_HID); bf16* const AS = (bf16*)(F.ws + WS_AS);
    const float* const MOD = (const float*)(F.ws + WS_MOD);

    if (IN(0)) { p0_prologue(F); if (PROBE_REPEAT == 0) p0_prologue(F); }
    SEAM(0);
#define LAYER_MIX(l) do { \
        const int pb = 1 + 8 * (l); \
        const float* modl = MOD + (size_t)(l) * 8 * 12288; \
        const float* xin = (l) == 0 ? F.in[IN_X] : (const float*)F.out; \
        if (IN(pb)) { norm_phase<false>(F, xin, F.in[IN_GMIX] + (l) * DM, modl, 0, 2048); if (PROBE_REPEAT == pb) norm_phase<false>(F, xin, F.in[IN_GMIX] + (l) * DM, modl, 0, 2048); } \
        SEAM(pb); \
        if (IN(pb + 1)) { \
            pg8::Gemm g{XN, (const bf16*)(F.ws + WS_WIN) + (size_t)(l) * NPROJ * DM, M, NPROJ, DM}; pg8::StaticOrder S; S.init(M, NPROJ, F.G, (int)blockIdx.x); \
            pg8::EpiProj E{PROJ, SIDE}; \
            pg8::gemm_phase<pg8::EpiProj, pg8::StaticOrder, true, true>(F.lds + RING_OFF, g, S, E); \
            if (PROBE_REPEAT == pb + 1) pg8::gemm_phase<pg8::EpiProj, pg8::StaticOrder, true, true>(F.lds + RING_OFF, g, S, E); \
            if (F.G == 256 && blockIdx.x >= 128) moe_convert(F, MOE_ITEMS - (2 - (l)) * MOE_TAILQ, MOE_ITEMS - (1 - (l)) * MOE_TAILQ, ((int)blockIdx.x - 128) * NWAVES + F.wave, 128 * NWAVES);     \
            else if (F.G != 256) moe_convert(F, MOE_ITEMS - (2 - (l)) * MOE_TAILQ, MOE_ITEMS - (1 - (l)) * MOE_TAILQ, F.vcu * NWAVES + F.wave, F.G * NWAVES); \
        } \
        SEAM(pb + 1); \
        if (IN(pb + 2)) { mix_a(F, (l)); if (PROBE_REPEAT == pb + 2) mix_a(F, (l)); } \
        SEAM(pb + 2); \
        if (IN(pb + 3)) { mix_b(F, (l)); if (PROBE_REPEAT == pb + 3) mix_b(F, (l)); } \
        SEAM(pb + 3); \
        if (IN(pb + 4)) { \
            pg8::Gemm g{Yb, (const bf16*)(F.ws + WS_WOUT) + (size_t)(l) * DM * DM, M, DM, DM}; pg8::StaticOrder S; S.init(M, DM, F.G, (int)blockIdx.x); \
            pg8::EpiResid E{xin, XA, modl + 4096}; \
            pg8::gemm_phase<pg8::EpiResid, pg8::StaticOrder, true, true>(F.lds + RING_OFF, g, S, E); \
            if (PROBE_REPEAT == pb + 4) pg8::gemm_phase<pg8::EpiResid, pg8::StaticOrder, true, true>(F.lds + RING_OFF, g, S, E); \
        } \
        SEAM(pb + 4); \
    } while (0)
    LAYER_MIX(0);
    {
        const float* modl = MOD;
        if (IN(6)) { norm_phase<false>(F, XA, F.in[IN_GFFN], modl, 6144, 8192); if (PROBE_REPEAT == 6) norm_phase<false>(F, XA, F.in[IN_GFFN], modl, 6144, 8192); }
        SEAM(6);
        if (IN(7)) {
            pg8::Gemm g{XN, (const bf16*)(F.ws + WS_WGU0), M, 2 * DFF, DM}; pg8::StaticOrder S; S.init(M, 2 * DFF, F.G, (int)blockIdx.x);
            pg8::EpiSwiglu E{HID, DFF, 44};
            pg8::gemm_phase<pg8::EpiSwiglu, pg8::StaticOrder, true, true>(F.lds + RING_OFF, g, S, E);
            if (PROBE_REPEAT == 7) pg8::gemm_phase<pg8::EpiSwiglu, pg8::StaticOrder, true, true>(F.lds + RING_OFF, g, S, E);
        }
        SEAM(7);
        if (IN(8)) {
            pg8::Gemm g{HID, (const bf16*)(F.ws + WS_WDN0), M, DM, DFF}; pg8::StaticOrder S; S.init(M, DM, F.G, (int)blockIdx.x);
            pg8::EpiResid E{XA, F.out, modl + 10240};
            pg8::gemm_phase<pg8::EpiResid, pg8::StaticOrder, true, true>(F.lds + RING_OFF, g, S, E);
            if (PROBE_REPEAT == 8) pg8::gemm_phase<pg8::EpiResid, pg8::StaticOrder, true, true>(F.lds + RING_OFF, g, S, E);
        }
        SEAM(8);
    }
    LAYER_MIX(1);
    const float* mod1 = MOD + (size_t)8 * 12288;
    if (IN(14)) norm_phase<true>(F, XA, F.in[IN_GFFN] + DM, mod1, 6144, 8192);
    SEAM(14);
    if (IN(15)) { moe_gather(F); if (PROBE_REPEAT == 15) moe_gather(F); }
    SEAM(15);
    if (IN(16)) {
        const int T = moe_tables(F);
        pg8::Gemm g{AS, (const bf16*)(F.ws + WS_WGU1), T * 256, 2 * DFFE, DM / 2}; pg8::GroupedOrder S; S.init(T, 56, F.G, (int)blockIdx.x, (const LAS int*)(F.lds + MISC_OFF + 64));
        pg8::EpiSwigluF8 E{(unsigned char*)HID, DFFE, 56};
        pg8::gemm_phase<pg8::EpiSwigluF8, pg8::GroupedOrder, true, true>(F.lds + RING_OFF, g, S, E);
        if (PROBE_REPEAT == 16) pg8::gemm_phase<pg8::EpiSwigluF8, pg8::GroupedOrder, true, true>(F.lds + RING_OFF, g, S, E);
    }
    SEAM(16);
    if (IN(17)) {
        const int T = moe_tables(F);
        pg8::Gemm g{HID, (const bf16*)(F.ws + WS_WDN1), T * 256, DM, DFFE / 2}; pg8::GroupedOrder S; S.init(T, 8, F.G, (int)blockIdx.x, (const LAS int*)(F.lds + MISC_OFF + 64));
        pg8::EpiPlainBf16F8 E{AS, DM, 8};
        pg8::gemm_phase<pg8::EpiPlainBf16F8, pg8::GroupedOrder, true, true>(F.lds + RING_OFF, g, S, E);
        if (PROBE_REPEAT == 17) pg8::gemm_phase<pg8::EpiPlainBf16F8, pg8::GroupedOrder, true, true>(F.lds + RING_OFF, g, S, E);
    }
    SEAM(17);
    if (IN(18)) { moe_combine(F, mod1 + 10240); if (PROBE_REPEAT == 18) moe_combine(F, mod1 + 10240); }
#undef IN
#undef SEAM
}

extern "C" void kernel_launch(void* const* d_in, const int* in_sizes, int n_in, void* d_out, int out_size, void* d_ws, size_t ws_size, hipStream_t stream) {
    static int grid = 0;
    if (grid == 0) {
        if (n_in != 26 || in_sizes[0] != M * DM || out_size != M * DM || ws_size < WS_END) { fprintf(stderr, "kernel_launch: unexpected shapes (n_in %d, in0 %d, out %d, ws %zu < %zu)\n", n_in, n_in > 0 ? in_sizes[0] : -1, out_size, ws_size, (size_t)WS_END); grid = -1; return; }
        int dev = 0, cus = 0, per_cu = 0;
        if (hipGetDevice(&dev) != hipSuccess || hipDeviceGetAttribute(&cus, hipDeviceAttributeMultiprocessorCount, dev) != hipSuccess) { grid = -1; return; }
        if (hipFuncSetAttribute((const void*)hybrid_fwd, hipFuncAttributeMaxDynamicSharedMemorySize, LDS_BYTES) != hipSuccess) { fprintf(stderr, "kernel_launch: hipFuncSetAttribute failed\n"); grid = -1; return; }
        if (hipOccupancyMaxActiveBlocksPerMultiprocessor(&per_cu, (const void*)hybrid_fwd, NWAVES * 64, LDS_BYTES) != hipSuccess || per_cu < 1) fprintf(stderr, "kernel_launch: occupancy query says %d\n", per_cu);
        (void)hipGetLastError();
        grid = cus < 256 ? cus : 256;
    }
    if (grid < 0) return;
    if (hipMemsetAsync((char*)d_ws + WS_CTL, 0, CTL_ZERO_BYTES, stream) != hipSuccess) return;
    Args a{};
    for (int i = 0; i < 26; ++i) a.in[i] = (const float*)d_in[i];
    a.out = (float*)d_out; a.ws = (unsigned char*)d_ws;
#if MK_ONE_LAUNCH
    a.ph_lo = 0; a.ph_hi = NPH;
    hipLaunchKernelGGL(hybrid_fwd, dim3(grid), dim3(NWAVES * 64), LDS_BYTES, stream, a);
#else
    for (int p = 0; p < NPH; ++p) { a.ph_lo = p; a.ph_hi = p + 1; hipLaunchKernelGGL(hybrid_fwd, dim3(grid), dim3(NWAVES * 64), LDS_BYTES, stream, a); }
#endif
}
```

```cpp
#include <hip/hip_runtime.h>
#include <cstdio>
#include <cstdint>
namespace pg8 {
#define PG8_LAS __attribute__((address_space(3)))
typedef unsigned short bf16_t;
typedef short bf16x8 __attribute__((ext_vector_type(8)));
typedef float f32x4 __attribute__((ext_vector_type(4)));
typedef unsigned u32x4 __attribute__((ext_vector_type(4)));
constexpr int BM = 256, BK = 64, HALF = 128, HTB = HALF * BK * 2  , STAGE_BYTES = 8 * HTB, NXCD = 8, WGM = 8;

__host__ __device__ __forceinline__ int lds_byte(int r, int c) { const int st = (r >> 4) * 2 + (c >> 5), rr = r & 15, cc = c & 31, ob = rr * 64 + cc * 2; return st * 1024 + (ob ^ (((ob >> 9) & 1) << 5)); }
__host__ __device__ __forceinline__ void stage_rc(int b, int& R, int& C) { const int st = b / 1024, sb = b % 1024, swz = sb ^ (((sb >> 9) & 1) << 5); R = (st >> 1) * 16 + swz / 64; C = (st & 1) * 32 + (swz % 64) / 2; }
__host__ __device__ __forceinline__ int perm32(int rho) { const int n = rho >> 4, i = rho & 15; return 8 * (i >> 2) + 4 * n + (i & 3); }

struct Unit { int pm, pn; };
struct Gemm { const bf16_t* A; const bf16_t* Bt; int M, N, K; };

struct StaticOrder {
    int nM, nN, nwg, G, c;
    __host__ __device__ void init(int M, int N, int G_, int c_) { nM = M / BM; nN = N / BM; nwg = nM * nN; G = G_; c = c_; }
    __host__ __device__ bool next(int i, Unit& u) const {
        const long L = (long)i * G + c; if (L >= nwg) return false;
        int wgid = (int)L; { const int q = nwg / NXCD, r = nwg % NXCD, xcd = wgid % NXCD, off = wgid / NXCD; wgid = (xcd < r ? xcd * (q + 1) : r * (q + 1) + (xcd - r) * q) + off; }
        const int nig = WGM * nN, gid = wgid / nig, fm = gid * WGM, gsz = (nM - fm) < WGM ? (nM - fm) : WGM;
        u.pm = fm + ((wgid % nig) % gsz); u.pn = (wgid % nig) / gsz; return true;
    }
    __device__ __forceinline__ void a_ready(const Unit&) const {}
    __device__ __forceinline__ void done(const Unit&) const {}
};
__device__ __forceinline__ unsigned cvt_pk_bf16(float lo, float hi) { unsigned r; asm volatile("v_cvt_pk_bf16_f32 %0, %1, %2" : "=v"(r) : "v"(lo), "v"(hi)); return r; }
typedef int i32x8 __attribute__((ext_vector_type(8)));
typedef int i32x4 __attribute__((ext_vector_type(4)));
__device__ __forceinline__ i32x8 cat8(bf16x8 lo, bf16x8 hi) { const i32x4 a = __builtin_bit_cast(i32x4, lo), b = __builtin_bit_cast(i32x4, hi); return __builtin_shufflevector(a, b, 0, 1, 2, 3, 4, 5, 6, 7); }
typedef unsigned u32x2 __attribute__((ext_vector_type(2)));
__device__ __forceinline__ float fast_silu(float g) { return g * __builtin_amdgcn_rcpf(1.0f + __expf(-g)); }
struct EpiProj {
    static constexpr bool PERM = true, AFTER_DRAIN = false, FP8 = false; static constexpr int SCALE_W = 127, SCALE_X = 127;
    bf16_t* O; float* side;
    __device__ __forceinline__ void operator()(const f32x4 (&acc)[2][2][4][2], const Unit& u, int wr, int wc, int fr, int fq) const {
        const int row0 = u.pm * BM + wr * 64 + fr;
        if (u.pn < 17) {
            const int col0 = u.pn * BM + wc * 32 + 8 * fq;
#pragma unroll
            for (int ai = 0; ai < 2; ++ai)
#pragma unroll
                for (int m = 0; m < 4; ++m) { bf16_t* rowp = O + (size_t)(row0 + ai * HALF + m * 16) * 4352 + col0;
#pragma unroll
                    for (int bj = 0; bj < 2; ++bj) { const f32x4 v0 = acc[ai][bj][m][0], v1 = acc[ai][bj][m][1];
                        u32x4 w; w.x = cvt_pk_bf16(v0[0], v0[1]); w.y = cvt_pk_bf16(v0[2], v0[3]); w.z = cvt_pk_bf16(v1[0], v1[1]); w.w = cvt_pk_bf16(v1[2], v1[3]);
                        *(u32x4*)(rowp + bj * HALF) = w; } }
        } else if (wc == 0) {
#pragma unroll
            for (int ai = 0; ai < 2; ++ai)
#pragma unroll
                for (int m = 0; m < 4; ++m) { float* rowp = side + (size_t)(row0 + ai * HALF + m * 16) * 32 + 8 * fq;
                    *(f32x4*)(rowp) = acc[ai][0][m][0]; *(f32x4*)(rowp + 4) = acc[ai][0][m][1]; }
        }
    }
};
struct EpiResid {
    static constexpr bool PERM = false, AFTER_DRAIN = false, FP8 = false; static constexpr int SCALE_W = 127, SCALE_X = 127;
    const float* base; float* out; const float* gate;
    __device__ __forceinline__ void operator()(const f32x4 (&acc)[2][2][4][2], const Unit& u, int wr, int wc, int fr, int fq) const {
        const int row0 = u.pm * BM + wr * 64 + fr, col0 = u.pn * BM + wc * 32 + 4 * fq;
        const float* __restrict__ gp = gate + (size_t)(u.pm >> 3) * 12288 + col0;
        const float* __restrict__ bp = base + (size_t)row0 * 2048 + col0; float* __restrict__ op = out + (size_t)row0 * 2048 + col0;
        f32x4 gv[2][2];
#pragma unroll
        for (int bj = 0; bj < 2; ++bj)
#pragma unroll
            for (int n = 0; n < 2; ++n) gv[bj][n] = *(const f32x4*)(gp + bj * HALF + n * 16);
        f32x4 cur[2][2], nxt[2][2];
#pragma unroll
        for (int bj = 0; bj < 2; ++bj)
#pragma unroll
            for (int n = 0; n < 2; ++n) cur[bj][n] = *(const f32x4*)(bp + bj * HALF + n * 16);
#pragma unroll
        for (int g = 0; g < 8; ++g) { const int ai = g >> 2, m = g & 3; const size_t off = (size_t)(ai * HALF + m * 16) * 2048;
            if (g < 7) { const int ai2 = (g + 1) >> 2, m2 = (g + 1) & 3; const size_t off2 = (size_t)(ai2 * HALF + m2 * 16) * 2048;
#pragma unroll
                for (int bj = 0; bj < 2; ++bj)
#pragma unroll
                    for (int n = 0; n < 2; ++n) nxt[bj][n] = *(const f32x4*)(bp + off2 + bj * HALF + n * 16); }
#pragma unroll
            for (int bj = 0; bj < 2; ++bj)
#pragma unroll
                for (int n = 0; n < 2; ++n) *(f32x4*)(op + off + bj * HALF + n * 16) = cur[bj][n] + gv[bj][n] * acc[ai][bj][m][n];
#pragma unroll
            for (int bj = 0; bj < 2; ++bj)
#pragma unroll
                for (int n = 0; n < 2; ++n) cur[bj][n] = nxt[bj][n];
            asm volatile("" ::: "memory"); }
    }
};
struct EpiSwiglu {
    static constexpr bool PERM = true, AFTER_DRAIN = false, FP8 = false; static constexpr int SCALE_W = 127, SCALE_X = 127;
    bf16_t* O; int ldc; int nN;
    __device__ __forceinline__ void operator()(const f32x4 (&acc)[2][2][4][2], const Unit& u, int wr, int wc, int fr, int fq) const {
        const int row0 = u.pm * BM + wr * 64 + fr, col0 = (u.pn % nN) * HALF + wc * 32 + 8 * fq;
#pragma unroll
        for (int ai = 0; ai < 2; ++ai)
#pragma unroll
            for (int m = 0; m < 4; ++m) { bf16_t* rowp = O + (size_t)(row0 + ai * HALF + m * 16) * ldc + col0;
                const f32x4 g0 = acc[ai][0][m][0], g1 = acc[ai][0][m][1], u0 = acc[ai][1][m][0], u1 = acc[ai][1][m][1];
                u32x4 w; w.x = cvt_pk_bf16(fast_silu(g0[0]) * u0[0], fast_silu(g0[1]) * u0[1]); w.y = cvt_pk_bf16(fast_silu(g0[2]) * u0[2], fast_silu(g0[3]) * u0[3]);
                w.z = cvt_pk_bf16(fast_silu(g1[0]) * u1[0], fast_silu(g1[1]) * u1[1]); w.w = cvt_pk_bf16(fast_silu(g1[2]) * u1[2], fast_silu(g1[3]) * u1[3]);
                *(u32x4*)(rowp) = w; }
    }
};
struct EpiPlainBf16 {
    static constexpr bool PERM = true, AFTER_DRAIN = false, FP8 = false; static constexpr int SCALE_W = 127, SCALE_X = 127;
    bf16_t* O; int ldc; int nN;
    __device__ __forceinline__ void operator()(const f32x4 (&acc)[2][2][4][2], const Unit& u, int wr, int wc, int fr, int fq) const {
        const int row0 = u.pm * BM + wr * 64 + fr, col0 = (u.pn % nN) * BM + wc * 32 + 8 * fq;
#pragma unroll
        for (int ai = 0; ai < 2; ++ai)
#pragma unroll
            for (int m = 0; m < 4; ++m) { bf16_t* rowp = O + (size_t)(row0 + ai * HALF + m * 16) * ldc + col0;
#pragma unroll
                for (int bj = 0; bj < 2; ++bj) { const f32x4 v0 = acc[ai][bj][m][0], v1 = acc[ai][bj][m][1];
                    u32x4 w; w.x = cvt_pk_bf16(v0[0], v0[1]); w.y = cvt_pk_bf16(v0[2], v0[3]); w.z = cvt_pk_bf16(v1[0], v1[1]); w.w = cvt_pk_bf16(v1[2], v1[3]);
                    *(u32x4*)(rowp + bj * HALF) = w; } }
    }
};
__device__ __forceinline__ float clamp448(float x) { return __builtin_amdgcn_fmed3f(x, -448.f, 448.f); }
__device__ __forceinline__ unsigned pk4_fp8(float a, float b, float c, float d) { int w = 0; w = __builtin_amdgcn_cvt_pk_fp8_f32(clamp448(a), clamp448(b), w, false); w = __builtin_amdgcn_cvt_pk_fp8_f32(clamp448(c), clamp448(d), w, true); return (unsigned)w; }
struct EpiSwigluF8 {
    static constexpr bool PERM = true, AFTER_DRAIN = false, FP8 = true; static constexpr int SCALE_W = 122, SCALE_X = 127;
    unsigned char* O; int ldc; int nN;
    __device__ __forceinline__ void operator()(const f32x4 (&acc)[2][2][4][2], const Unit& u, int wr, int wc, int fr, int fq) const {
        const int row0 = u.pm * BM + wr * 64 + fr, col0 = (u.pn % nN) * HALF + wc * 32 + 8 * fq;
#pragma unroll
        for (int ai = 0; ai < 2; ++ai)
#pragma unroll
            for (int m = 0; m < 4; ++m) { unsigned char* rowp = O + (size_t)(row0 + ai * HALF + m * 16) * ldc + col0;
                const f32x4 g0 = acc[ai][0][m][0], g1 = acc[ai][0][m][1], u0 = acc[ai][1][m][0], u1 = acc[ai][1][m][1];
                u32x2 w; w.x = pk4_fp8(fast_silu(g0[0]) * u0[0], fast_silu(g0[1]) * u0[1], fast_silu(g0[2]) * u0[2], fast_silu(g0[3]) * u0[3]);
                w.y = pk4_fp8(fast_silu(g1[0]) * u1[0], fast_silu(g1[1]) * u1[1], fast_silu(g1[2]) * u1[2], fast_silu(g1[3]) * u1[3]);
                *(u32x2*)(rowp) = w; }
    }
};
struct EpiPlainBf16F8 {
    static constexpr bool PERM = true, AFTER_DRAIN = false, FP8 = true; static constexpr int SCALE_W = 121, SCALE_X = 124;
    bf16_t* O; int ldc; int nN;
    __device__ __forceinline__ void operator()(const f32x4 (&acc)[2][2][4][2], const Unit& u, int wr, int wc, int fr, int fq) const {
        const int row0 = u.pm * BM + wr * 64 + fr, col0 = (u.pn % nN) * BM + wc * 32 + 8 * fq;
#pragma unroll
        for (int ai = 0; ai < 2; ++ai)
#pragma unroll
            for (int m = 0; m < 4; ++m) { bf16_t* rowp = O + (size_t)(row0 + ai * HALF + m * 16) * ldc + col0;
#pragma unroll
                for (int bj = 0; bj < 2; ++bj) { const f32x4 v0 = acc[ai][bj][m][0], v1 = acc[ai][bj][m][1];
                    u32x4 w; w.x = cvt_pk_bf16(v0[0], v0[1]); w.y = cvt_pk_bf16(v0[2], v0[3]); w.z = cvt_pk_bf16(v1[0], v1[1]); w.w = cvt_pk_bf16(v1[2], v1[3]);
                    *(u32x4*)(rowp + bj * HALF) = w; } }
    }
};
struct GroupedOrder {
    int nM, nN, nwg, G, c; const PG8_LAS int* tile_e;
    __device__ void init(int nM_, int nN_, int G_, int c_, const PG8_LAS int* te) { nM = nM_; nN = nN_; nwg = nM * nN; G = G_; c = c_; tile_e = te; }
    __device__ bool next(int i, Unit& u) const {
        const long L = (long)i * G + c; if (L >= nwg) return false;
        int wgid = (int)L; { const int q = nwg / NXCD, r = nwg % NXCD, xcd = wgid % NXCD, off = wgid / NXCD; wgid = (xcd < r ? xcd * (q + 1) : r * (q + 1) + (xcd - r) * q) + off; }
        const int nig = WGM * nN, gid = wgid / nig, fm = gid * WGM, gsz = (nM - fm) < WGM ? (nM - fm) : WGM;
        u.pm = fm + ((wgid % nig) % gsz); u.pn = tile_e[u.pm] * nN + (wgid % nig) / gsz; return true;
    }
    __device__ __forceinline__ void a_ready(const Unit&) const {}
    __device__ __forceinline__ void done(const Unit&) const {}
};
template <class Epi, class Sched, bool ALIGN_EPI = false, bool SP2 = false>
__device__ __forceinline__ void gemm_phase(PG8_LAS unsigned char* lds, const Gemm g, const Sched& S, const Epi& E) {
    const int tid = threadIdx.x, wid = __builtin_amdgcn_readfirstlane(tid >> 6), lane = tid & 63, wr = wid >> 2, wc = wid & 3, fr = lane & 15, fq = lane >> 4;
    const int K = g.K, nt = K / BK;
    unsigned voffA[2], voffB[2];
#pragma unroll
    for (int i = 0; i < 2; ++i) { int R, C; stage_rc(tid * 16 + i * 8192, R, C); const int Rb = Epi::PERM ? ((R & ~31) + perm32(R & 31)) : R;
        voffA[i] = (unsigned)(R * K + C) * 2u; voffB[i] = (unsigned)(Rb * K + C) * 2u; }
    const size_t kstep = (size_t)(BK * 2);
    const size_t hstep = (size_t)HALF * K * 2;
    const size_t tstep = 2 * hstep;
    const unsigned ldsw = (unsigned)wid * 1024u;
    const int aoff = lds_byte(wr * 64 + fr, fq * 8), boff = lds_byte(wc * 32 + fr, fq * 8);
#define PG8_SA(b, h) (((b) * 2 + (h)) * HTB)
#define PG8_SB(b, h) ((4 + (b) * 2 + (h)) * HTB)
#define PG8_STAGE(bufoff, gbase, voff) do { _Pragma("unroll") for (int _i = 0; _i < 2; ++_i) \
        __builtin_amdgcn_global_load_lds((const unsigned*)((const char*)(gbase) + (voff)[_i]), (PG8_LAS unsigned*)(lds + (bufoff) + ldsw + _i * 8192), 16, 0, 0); } while (0)
#define PG8_LDA(dst, b, h) do { _Pragma("unroll") for (int m = 0; m < 4; ++m) _Pragma("unroll") for (int k = 0; k < 2; ++k) dst[m][k] = *(const PG8_LAS bf16x8*)(lds + PG8_SA(b, h) + aoff + m * 2048 + k * 1024); } while (0)
#define PG8_LDB(dst, b, h) do { _Pragma("unroll") for (int n = 0; n < 2; ++n) _Pragma("unroll") for (int k = 0; k < 2; ++k) dst[n][k] = *(const PG8_LAS bf16x8*)(lds + PG8_SB(b, h) + boff + n * 2048 + k * 1024); } while (0)
#define PG8_MMA(ai, bj, At, Bt) do { __builtin_amdgcn_s_setprio(1); _Pragma("unroll") for (int m = 0; m < 4; ++m) _Pragma("unroll") for (int n = 0; n < 2; ++n) { \
        if constexpr (Epi::FP8) { asm volatile("v_mfma_scale_f32_16x16x128_f8f6f4 %0, %1, %2, %0, %3, %4 op_sel_hi:[0,0,0]" : "+v"(acc[ai][bj][m][n]) : "v"(cat8(Bt[n][0], Bt[n][1])), "v"(cat8(At[m][0], At[m][1])), "v"(f8_sw), "v"(f8_sx)); } \
        else { _Pragma("unroll") for (int k = 0; k < 2; ++k) acc[ai][bj][m][n] = __builtin_amdgcn_mfma_f32_16x16x32_bf16(Bt[n][k], At[m][k], acc[ai][bj][m][n], 0, 0, 0); } } __builtin_amdgcn_s_setprio(0); } while (0)
#define PG8_WAIT_V(n) asm volatile("s_waitcnt vmcnt(" #n ")" ::: "memory")
#define PG8_WAIT_L(n) asm volatile("s_waitcnt lgkmcnt(" #n ")" ::: "memory")
#define PG8_BAR __builtin_amdgcn_s_barrier()
#define PG8_SCHED __builtin_amdgcn_sched_barrier(0)
    Unit cur, nxt; int ui = 0;
    if (!S.next(0, cur)) return;
    int f8_sw = Epi::SCALE_W, f8_sx = Epi::SCALE_X;
    if constexpr (Epi::FP8) asm volatile("" : "+v"(f8_sw), "+v"(f8_sx));
    f32x4 acc[2][2][4][2];
#pragma unroll
    for (int a = 0; a < 2; ++a)
#pragma unroll
        for (int b = 0; b < 2; ++b)
#pragma unroll
            for (int m = 0; m < 4; ++m)
#pragma unroll
                for (int n = 0; n < 2; ++n) acc[a][b][m][n] = (f32x4){0.f, 0.f, 0.f, 0.f};
    bf16x8 At[4][2], B0[2][2], B1[2][2];
    const char* cA = (const char*)g.A + (size_t)cur.pm * tstep; const char* cB = (const char*)g.Bt + (size_t)cur.pn * tstep;
    S.a_ready(cur);
    if constexpr (SP2) {
        PG8_STAGE(PG8_SB(0, 0), cB, voffB); PG8_STAGE(PG8_SB(0, 1), cB + hstep, voffB); PG8_STAGE(PG8_SA(0, 0), cA, voffA); PG8_STAGE(PG8_SA(0, 1), cA + hstep, voffA);
        if (wr == 1) PG8_BAR;
        PG8_WAIT_V(2); PG8_BAR;
        PG8_STAGE(PG8_SB(1, 0), cB + kstep, voffB); PG8_STAGE(PG8_SA(1, 0), cA + kstep, voffA); PG8_STAGE(PG8_SB(1, 1), cB + hstep + kstep, voffB);
        PG8_WAIT_V(6); PG8_BAR;
    } else {
        PG8_STAGE(PG8_SB(0, 0), cB, voffB); PG8_STAGE(PG8_SA(0, 0), cA, voffA); PG8_STAGE(PG8_SB(0, 1), cB + hstep, voffB); PG8_STAGE(PG8_SA(0, 1), cA + hstep, voffA);
        if (wr == 1) PG8_BAR;
        PG8_WAIT_V(4); PG8_BAR;
        PG8_STAGE(PG8_SB(1, 0), cB + kstep, voffB); PG8_STAGE(PG8_SA(1, 0), cA + kstep, voffA); PG8_STAGE(PG8_SB(1, 1), cB + hstep + kstep, voffB);
        PG8_WAIT_V(6); PG8_BAR;
    }
    for (;;) {
        const bool has_next = S.next(ui + 1, nxt);
        const char* nA = has_next ? (const char*)g.A + (size_t)nxt.pm * tstep : cA; const char* nB = has_next ? (const char*)g.Bt + (size_t)nxt.pn * tstep : cB;
        for (int t = 0; t < nt; t += 2) {
            const bool last = (t == nt - 2);
            const char* a1 = cA + (size_t)(t + 1) * kstep;
            const char* a2 = last ? nA : cA + (size_t)(t + 2) * kstep; const char* b2 = last ? nB : cB + (size_t)(t + 2) * kstep;
            const char* a3 = a2 + kstep; const char* b3 = b2 + kstep;
            if (last && has_next) S.a_ready(nxt);
            if constexpr (SP2) {
            PG8_LDB(B0, 0, 0); PG8_LDB(B1, 0, 1); PG8_SCHED; PG8_LDA(At, 0, 0); PG8_STAGE(PG8_SA(1, 1), a1 + hstep, voffA);
            PG8_WAIT_V(8); PG8_WAIT_L(0); PG8_BAR; PG8_MMA(0, 0, At, B0); PG8_MMA(0, 1, At, B1); PG8_BAR; PG8_SCHED;
            PG8_LDA(At, 0, 1); PG8_STAGE(PG8_SB(0, 0), b2, voffB); PG8_STAGE(PG8_SB(0, 1), b2 + hstep, voffB); PG8_STAGE(PG8_SA(0, 0), a2, voffA);
            PG8_WAIT_V(8); PG8_WAIT_L(0); PG8_BAR; PG8_MMA(1, 0, At, B0); PG8_MMA(1, 1, At, B1); PG8_BAR; PG8_SCHED;
            PG8_LDB(B0, 1, 0); PG8_LDB(B1, 1, 1); PG8_SCHED; PG8_LDA(At, 1, 0); PG8_STAGE(PG8_SA(0, 1), a2 + hstep, voffA);
            PG8_WAIT_V(8); PG8_WAIT_L(0); PG8_BAR; PG8_MMA(0, 0, At, B0); PG8_MMA(0, 1, At, B1); PG8_BAR; PG8_SCHED;
            PG8_LDA(At, 1, 1); PG8_STAGE(PG8_SB(1, 0), b3, voffB); PG8_STAGE(PG8_SB(1, 1), b3 + hstep, voffB); PG8_STAGE(PG8_SA(1, 0), a3, voffA);
            PG8_WAIT_V(8); PG8_WAIT_L(0); PG8_BAR; PG8_MMA(1, 0, At, B0); PG8_MMA(1, 1, At, B1); PG8_BAR; PG8_SCHED;
            } else {
            PG8_LDB(B0, 0, 0); PG8_SCHED; PG8_LDA(At, 0, 0); PG8_STAGE(PG8_SA(1, 1), a1 + hstep, voffA);
            PG8_WAIT_L(8); PG8_BAR; PG8_WAIT_L(0); PG8_MMA(0, 0, At, B0); PG8_BAR; PG8_SCHED;
            PG8_LDB(B1, 0, 1); PG8_STAGE(PG8_SB(0, 0), b2, voffB);
            PG8_BAR; PG8_WAIT_L(0); PG8_MMA(0, 1, At, B1); PG8_BAR;
            PG8_LDA(At, 0, 1); PG8_STAGE(PG8_SA(0, 0), a2, voffA);
            PG8_BAR; PG8_WAIT_L(0); PG8_MMA(1, 0, At, B0); PG8_BAR; PG8_SCHED;
            PG8_STAGE(PG8_SB(0, 1), b2 + hstep, voffB);
            PG8_WAIT_V(6); PG8_BAR; PG8_MMA(1, 1, At, B1); PG8_BAR;
            PG8_LDB(B0, 1, 0); PG8_SCHED; PG8_LDA(At, 1, 0); PG8_STAGE(PG8_SA(0, 1), a2 + hstep, voffA);
            PG8_WAIT_L(8); PG8_BAR; PG8_WAIT_L(0); PG8_MMA(0, 0, At, B0); PG8_BAR; PG8_SCHED;
            PG8_LDB(B1, 1, 1); PG8_STAGE(PG8_SB(1, 0), b3, voffB);
            PG8_BAR; PG8_WAIT_L(0); PG8_MMA(0, 1, At, B1); PG8_BAR;
            PG8_LDA(At, 1, 1); PG8_STAGE(PG8_SA(1, 0), a3, voffA);
            PG8_BAR; PG8_WAIT_L(0); PG8_MMA(1, 0, At, B0); PG8_BAR; PG8_SCHED;
            PG8_STAGE(PG8_SB(1, 1), b3 + hstep, voffB);
            PG8_WAIT_V(6); PG8_BAR; PG8_MMA(1, 1, At, B1); PG8_BAR;
            }
        }
        if constexpr (ALIGN_EPI) { if (wr == 0) PG8_BAR; }
        if constexpr (!Epi::AFTER_DRAIN) { E(acc, cur, wr, wc, fr, fq); S.done(cur); }
        if (!has_next) break;
#pragma unroll
        for (int a = 0; a < 2; ++a)
#pragma unroll
            for (int b = 0; b < 2; ++b)
#pragma unroll
                for (int m = 0; m < 4; ++m)
#pragma unroll
                    for (int n = 0; n < 2; ++n) acc[a][b][m][n] = (f32x4){0.f, 0.f, 0.f, 0.f};
        cur = nxt; cA = nA; cB = nB; ++ui;
        if constexpr (ALIGN_EPI) { if (wr == 1) PG8_BAR; }
    }
    PG8_WAIT_V(0);
    if constexpr (!ALIGN_EPI) { if (wr == 0) PG8_BAR; }
    PG8_BAR;
    if constexpr (Epi::AFTER_DRAIN) { E.fused(acc, cur, wr, wc, fr, fq, lds, wid, lane); S.done(cur); }
#undef PG8_SA
#undef PG8_SB
#undef PG8_STAGE
#undef PG8_LDA
#undef PG8_LDB
#undef PG8_MMA
#undef PG8_WAIT_V
#undef PG8_WAIT_L
#undef PG8_BAR
#undef PG8_SCHED
}
}

constexpr int NWAVES = 8;
constexpr int BATCH = 8, SEQ = 2048, DM = 2048, M = BATCH * SEQ;
constexpr int NPROJ = 4608, PROJ_LD = 4352;
constexpr int DFF = 5632, DFFE = 7168, NE = 8;
constexpr int C_MQ = 0, C_MK = 256, C_MV = 512, C_MO = 1024, C_GQ = 1536, C_GK = 1792, C_GV = 2048, C_GG = 2560, C_AQ = 3072, C_AK = 4096, C_AV = 4224;
constexpr float EPS = 1e-6f;
constexpr int MAXROWS_S = M * 2 + NE * 256;

constexpr size_t MiB = 1u << 20;
constexpr size_t WS_CTL = 0, CTL_ZERO_BYTES = 65536;
constexpr size_t WS_MOD = 1 * MiB;
constexpr size_t WS_WIN = 2 * MiB;
constexpr size_t WS_WOUT = 38 * MiB;
constexpr size_t WS_WGU0 = 54 * MiB;
constexpr size_t WS_WDN0 = 98 * MiB;
constexpr size_t WS_WGU1 = 120 * MiB;
constexpr size_t WS_WDN1 = 568 * MiB;
constexpr size_t WS_XA = 792 * MiB;
constexpr size_t WS_XN = 920 * MiB;
constexpr size_t WS_Y = 984 * MiB;
constexpr size_t WS_SIDE = 1048 * MiB;
constexpr size_t WS_TOK = 1050 * MiB;
constexpr size_t WS_BIG = 1052 * MiB;
constexpr size_t WS_HID = WS_BIG;
constexpr size_t WS_AS = WS_BIG + 476 * MiB;
constexpr size_t WS_PROJ = WS_BIG;
constexpr size_t WS_QKC = WS_BIG + 144 * MiB;
constexpr size_t WS_LA = WS_BIG + 160 * MiB;
constexpr size_t WS_KN = WS_BIG + 176 * MiB;
constexpr size_t WS_UM = WS_BIG + 192 * MiB;
constexpr size_t WS_UG = WS_BIG + 212 * MiB;
constexpr size_t WS_GAUX = WS_BIG + 244 * MiB;
constexpr size_t WS_END = WS_BIG + 612 * MiB;
constexpr int TOK_E = 0, TOK_SLOT = 32768, TOK_W = 65536, TOK_POS = 98304;

constexpr int CW_TMO = 0, CW_CODE = 1, CW_BAR = 4096, CW_CNT = 8192;

constexpr int RING_OFF = 0, RING_BYTES = 131072;
constexpr int MISC_OFF = RING_BYTES;
constexpr int LDS_BYTES = 147456;

#define GAS __attribute__((address_space(1)))
#define LAS __attribute__((address_space(3)))
typedef unsigned short bf16;
typedef unsigned v4u __attribute__((ext_vector_type(4)));
typedef unsigned v2u __attribute__((ext_vector_type(2)));
typedef float f32x4 __attribute__((ext_vector_type(4)));
typedef short bf16x8 __attribute__((ext_vector_type(8)));
typedef GAS unsigned gu32;
#define RLX_AGENT __ATOMIC_RELAXED, __HIP_MEMORY_SCOPE_AGENT
#define LDS_WAIT() asm volatile("s_waitcnt lgkmcnt(0)" ::: "memory")
#define VM_WAIT() asm volatile("s_waitcnt vmcnt(0)" ::: "memory")
typedef float f32x2_t __attribute__((ext_vector_type(2)));
typedef __bf16 bf16x2_t __attribute__((ext_vector_type(2)));
__device__ __forceinline__ unsigned pk2(float lo, float hi) { const f32x2_t v = {lo, hi}; return __builtin_bit_cast(unsigned, __builtin_convertvector(v, bf16x2_t)); }
__device__ __forceinline__ unsigned f2bf(float f) { return pk2(f, 0.f) & 0xffffu; }
__device__ __forceinline__ float bflo(unsigned w) { return __builtin_bit_cast(float, w << 16); }
__device__ __forceinline__ float bfhi(unsigned w) { return __builtin_bit_cast(float, w & 0xffff0000u); }
__device__ __forceinline__ float bf1(bf16 b) { return __builtin_bit_cast(float, ((unsigned)b) << 16); }
__device__ __forceinline__ float wave_sum(float v) {
#pragma unroll
    for (int o = 1; o < 64; o <<= 1) v += __shfl_xor(v, o);
    return v;
}
__device__ __forceinline__ float sigmoidf_(float x) { return 1.0f / (1.0f + __expf(-x)); }
__device__ __forceinline__ float siluf_(float x) { return x / (1.0f + __expf(-x)); }
__device__ __forceinline__ float logsigmoidf_(float z) { return fminf(z, 0.f) - __logf(1.0f + __expf(-fabsf(z))); }

#ifndef FAST_SWA
#define FAST_SWA 1
#endif
#ifndef FAST_GLA
#define FAST_GLA 1
#endif
#ifndef FAST_MLSTM
#define FAST_MLSTM 1
#endif
#ifndef PROBE_REPEAT
#define PROBE_REPEAT -1
#endif
#define XB_TMO      128
#define XB_XCNT(j)  (256  + 64 * (j))
#define XB_XSUB(j)  (1280 + 64 * (j))
#define XB_XGEN(j)  (2304 + 64 * (j))
#define XB_TOP      3328
#define XB_TOPGEN   3392
#define XCD_BAR_WORDS 3456
#define XB_SPIN_CAP (1u << 18)

__device__ __forceinline__ unsigned xb_ld(unsigned* p)              { return __hip_atomic_load(p, __ATOMIC_RELAXED, __HIP_MEMORY_SCOPE_AGENT); }
__device__ __forceinline__ unsigned xb_add(unsigned* p, unsigned v) { return __hip_atomic_fetch_add(p, v, __ATOMIC_RELAXED, __HIP_MEMORY_SCOPE_AGENT); }
__device__ __forceinline__ unsigned xb_xcc_id() { return (unsigned)__builtin_amdgcn_s_getreg((3 << 11) | 20) & 0xFu; }
#define XB_SPIN(cond, bar) do { unsigned _sp = 0; while (cond) { __builtin_amdgcn_s_sleep(1); \
    if ((++_sp & 255u) == 0u) { if (xb_ld(&(bar)[XB_TMO])) break; if (_sp > XB_SPIN_CAP) { atomicAdd(&(bar)[XB_TMO], 1u); break; } } } } while (0)

struct XcdBarrier {
    unsigned* bar; unsigned x;
    volatile LAS unsigned* st;
};

__device__ __forceinline__ XcdBarrier xcd_barrier_post(unsigned* bar, volatile LAS unsigned* st) {
    XcdBarrier b; b.bar = bar; b.x = xb_xcc_id(); b.st = st;
    if (threadIdx.x == 0) (void)xb_add(&bar[XB_XCNT(b.x)], 1u);
    return b;
}
__device__ __forceinline__ void xcd_barrier_complete(unsigned* bar, unsigned x, unsigned& nloc, unsigned& nx) {
    const unsigned G = gridDim.x * gridDim.y * gridDim.z;
    unsigned sum, cnt, mine, sp = 0u;
    for (;;) {
        sum = 0u; cnt = 0u; mine = 0u;
#pragma unroll
        for (unsigned j = 0; j < 16; ++j) { const unsigned c = xb_ld(&bar[XB_XCNT(j)]); sum += c; cnt += (c > 0u) ? 1u : 0u; mine = (j == x) ? c : mine; }
        if (sum == G) break;
        __builtin_amdgcn_s_sleep(1);
        if ((++sp & 255u) == 0u) { if (xb_ld(&bar[XB_TMO])) break; if (sp > XB_SPIN_CAP) { atomicAdd(&bar[XB_TMO], 1u); break; } }
    }
    nloc = mine > 0u ? mine : 1u; nx = cnt > 0u ? cnt : 1u;
}

__device__ __forceinline__ void xcd_barrier(const XcdBarrier& b) {
    asm volatile("s_waitcnt vmcnt(0)" ::: "memory");
    __syncthreads();
    if (threadIdx.x == 0) {
        unsigned* bar = b.bar;
        __builtin_amdgcn_s_waitcnt(0);
        unsigned nloc = b.st[0], nx = b.st[1];
        if (nloc == 0u) { xcd_barrier_complete(bar, b.x, nloc, nx); b.st[0] = nloc; b.st[1] = nx; }
        const unsigned old = xb_add(&bar[XB_XSUB(b.x)], 1u);
        const unsigned gen = old / nloc;
        if (old + 1u == (gen + 1u) * nloc) {
            __builtin_amdgcn_fence(__ATOMIC_RELEASE, "agent");
            asm volatile("s_waitcnt vmcnt(0)" ::: "memory");
            const unsigned og = xb_add(&bar[XB_TOP], 1u);
            const unsigned tg = og / nx;
            if (og + 1u == (tg + 1u) * nx) xb_add(&bar[XB_TOPGEN], 1u);
            else XB_SPIN(xb_ld(&bar[XB_TOPGEN]) == tg, bar);
            __builtin_amdgcn_fence(__ATOMIC_ACQUIRE, "agent");
            xb_add(&bar[XB_XGEN(b.x)], 1u);
            asm volatile("s_waitcnt vmcnt(0)" ::: "memory");
        } else {
            XB_SPIN(xb_ld(&bar[XB_XGEN(b.x)]) == gen, bar);
            __builtin_amdgcn_fence(__ATOMIC_ACQUIRE, "agent");
            asm volatile("s_waitcnt vmcnt(0)" ::: "memory");
        }
    }
    __syncthreads();
}

typedef const float* cfp;
typedef __attribute__((address_space(4))) cfp cfp_k;
struct Frame {
    LAS unsigned char* lds;
    gu32* ctl;
    int tid, lane, wave, vcu, G;
    cfp_k* in;
    float* out; unsigned char* ws;
};
#define IN_X 0
#define IN_C 1
#define IN_WADA 2
#define IN_BADA 3
#define IN_GMIX 4
#define IN_GFFN 5
#define IN_WIN 6
#define IN_BGATES 7
#define IN_WCONV 8
#define IN_BCONV 9
#define IN_GOUTM 10
#define IN_WDEC 11
#define IN_BDEC 12
#define IN_GOUTG 13
#define IN_GQN 14
#define IN_GKN 15
#define IN_SINKS 16
#define IN_RELB 17
#define IN_WOUT 18
#define IN_WFG 19
#define IN_WFU 20
#define IN_WFD 21
#define IN_WROUTER 22
#define IN_WMG 23
#define IN_WMU 24
#define IN_WMD 25

__device__ __forceinline__ int rowmap(int kind, int off, int n) {
    if (kind == 0) return off + n;
    if (kind == 1) return off + ((n >> 7) << 8) + (n & 127);
    if (n < 1536) return n; if (n < 1544) return 4352 + (n - 1536); if (n < 3080) return n - 8; if (n < 3096) return 4360 + (n - 3080); return n - 24;
}
__device__ __forceinline__ void transpose_item(const float* W, int N, bf16* WT, int ldt, int kind, int off, int item, int lane) {
    const int nblk = (N + 63) >> 6, kb = item / nblk, nb = item - kb * nblk, k0 = 64 * kb + 8 * (lane & 7), n = 64 * nb + 4 * (lane >> 3);
    const f32x4* src = (const f32x4*)(W + (size_t)k0 * N + n);
    f32x4 v[2][8];
#pragma unroll
    for (int hh = 0; hh < 2; ++hh) { if (n + 32 * hh < N) {
#pragma unroll
        for (int j = 0; j < 8; ++j) v[hh][j] = __builtin_nontemporal_load(src + (size_t)j * (N >> 2) + 8 * hh); } }
#pragma unroll
    for (int hh = 0; hh < 2; ++hh) { if (n + 32 * hh < N) {
#pragma unroll
        for (int i = 0; i < 4; ++i) { v4u o; o.x = pk2(v[hh][0][i], v[hh][1][i]); o.y = pk2(v[hh][2][i], v[hh][3][i]); o.z = pk2(v[hh][4][i], v[hh][5][i]); o.w = pk2(v[hh][6][i], v[hh][7][i]);
            *(v4u*)(WT + (size_t)rowmap(kind, off, n + 32 * hh + i) * ldt + k0) = o; } } }
}
__device__ __forceinline__ void transpose_item_f8(const float* W, int N, unsigned char* WT, int ldt, int kind, int off, int item, int lane, float scale) {
    const int nblk = (N + 63) >> 6, kb = item / nblk, nb = item - kb * nblk, k0 = 128 * kb + 16 * (lane & 3), n = 64 * nb + 4 * (lane >> 2);
    if (n >= N) return;
    const f32x4* src = (const f32x4*)(W + (size_t)k0 * N + n);
    f32x4 v[2][16];
#pragma unroll
    for (int hh = 0; hh < 2; ++hh)
#pragma unroll
        for (int j = 0; j < 16; ++j) v[hh][j] = __builtin_nontemporal_load(src + (size_t)(64 * hh + j) * (N >> 2));
#pragma unroll
    for (int hh = 0; hh < 2; ++hh)
#pragma unroll
        for (int i = 0; i < 4; ++i) { v4u o; o.x = pg8::pk4_fp8(v[hh][0][i] * scale, v[hh][1][i] * scale, v[hh][2][i] * scale, v[hh][3][i] * scale); o.y = pg8::pk4_fp8(v[hh][4][i] * scale, v[hh][5][i] * scale, v[hh][6][i] * scale, v[hh][7][i] * scale);
            o.z = pg8::pk4_fp8(v[hh][8][i] * scale, v[hh][9][i] * scale, v[hh][10][i] * scale, v[hh][11][i] * scale); o.w = pg8::pk4_fp8(v[hh][12][i] * scale, v[hh][13][i] * scale, v[hh][14][i] * scale, v[hh][15][i] * scale);
            __builtin_nontemporal_store(o, (v4u*)(WT + (size_t)rowmap(kind, off, n + i) * ldt + k0 + 64 * hh)); }
}
constexpr int MOE_ITEMS = 3 * 14336, MOE_TAILQ = 0;
__device__ __forceinline__ void moe_convert(Frame& F, int lo, int hi, int rank, int nrank) {
    for (int it = lo + rank; it < hi; it += nrank) {
        int r = it; const float* W; unsigned char* WT; int N, ldt, kind, off; float f8s;
        if (r < 14336) { const int e = r / 1792; r -= e * 1792; W = F.in[IN_WMG] + (size_t)e * 2048 * DFFE; N = DFFE; WT = F.ws + WS_WGU1 + (size_t)e * 14336 * 2048; ldt = 2048; kind = 1; off = 0; f8s = 32.f; }
        else if ((r -= 14336) < 14336) { const int e = r / 1792; r -= e * 1792; W = F.in[IN_WMU] + (size_t)e * 2048 * DFFE; N = DFFE; WT = F.ws + WS_WGU1 + (size_t)e * 14336 * 2048; ldt = 2048; kind = 1; off = 128; f8s = 256.f; }
        else { r -= 14336; const int e = r / 1792; r -= e * 1792; W = F.in[IN_WMD] + (size_t)e * DFFE * 2048; N = 2048; WT = F.ws + WS_WDN1 + (size_t)e * 2048 * DFFE; ldt = DFFE; kind = 0; off = 0; f8s = 64.f; }
        transpose_item_f8(W, N, WT, ldt, kind, off, r, F.lane, f8s);
    }
}
__device__ __forceinline__ void p0_prologue(Frame& F) {
    __syncthreads();
    {
        LAS float* cond = (LAS float*)(F.lds + RING_OFF);
        LAS float* red = (LAS float*)(F.lds + RING_OFF + 65536);
        float* mod = (float*)(F.ws + WS_MOD);
        bool have = false;
        for (int it = F.vcu; it < 192; it += F.G) {
            if (!have) { for (int i = F.tid; i < 8 * 2048; i += NWAVES * 64) { const float cv = F.in[IN_C][i]; cond[i] = cv / (1.0f + expf(-cv)); } have = true; }
            __syncthreads();
            const int l = it / 96, cg = it % 96, c4 = F.tid & 31, dp = F.tid >> 5;
            f32x4 acc[8];
#pragma unroll
            for (int b = 0; b < 8; ++b) acc[b] = (f32x4){0.f, 0.f, 0.f, 0.f};
            const f32x4* wp = (const f32x4*)(F.in[IN_WADA] + (size_t)l * 2048 * 12288 + (size_t)(dp * 128) * 12288 + cg * 128 + 4 * c4);
            const LAS float* cp = cond + dp * 128;
#pragma unroll 8
            for (int d = 0; d < 128; ++d) { const f32x4 w = __builtin_nontemporal_load(wp + (size_t)d * 3072);
#pragma unroll
                for (int b = 0; b < 8; ++b) acc[b] += w * cp[b * 2048 + d]; }
#pragma unroll
            for (int b = 0; b < 8; ++b) *(LAS f32x4*)(red + (dp * 8 + b) * 128 + 4 * c4) = acc[b];
            __syncthreads();
            for (int i = F.tid; i < 8 * 128; i += NWAVES * 64) { const int b = i >> 7, cc = i & 127; float s = 0.f;
#pragma unroll
                for (int q = 0; q < 16; ++q) s += red[(q * 8 + b) * 128 + cc];
                mod[(size_t)(l * 8 + b) * 12288 + cg * 128 + cc] = s + F.in[IN_BADA][l * 12288 + cg * 128 + cc]; }
        }
        __syncthreads();
    }
    const int gw = F.vcu * NWAVES + F.wave, NGW = F.G * NWAVES;
    constexpr int NITEMS = 4416 + 2048 + 3 * 2816;
    for (int it = gw; it < NITEMS; it += NGW) {
        int r = it; const float* W; bf16* WT; int N, ldt, kind, off;
        if (r < 4416) { const int l = r / 2208; r -= l * 2208; W = F.in[IN_WIN] + (size_t)l * 2048 * 4376; N = 4376; WT = (bf16*)(F.ws + WS_WIN) + (size_t)l * NPROJ * 2048; ldt = 2048; kind = 2; off = 0; }
        else if ((r -= 4416) < 2048) { const int l = r / 1024; r -= l * 1024; W = F.in[IN_WOUT] + (size_t)l * 2048 * 2048; N = 2048; WT = (bf16*)(F.ws + WS_WOUT) + (size_t)l * 2048 * 2048; ldt = 2048; kind = 0; off = 0; }
        else if ((r -= 2048) < 2816) { W = F.in[IN_WFG]; N = DFF; WT = (bf16*)(F.ws + WS_WGU0); ldt = 2048; kind = 1; off = 0; }
        else if ((r -= 2816) < 2816) { W = F.in[IN_WFU]; N = DFF; WT = (bf16*)(F.ws + WS_WGU0); ldt = 2048; kind = 1; off = 128; }
        else { r -= 2816; W = F.in[IN_WFD]; N = 2048; WT = (bf16*)(F.ws + WS_WDN0); ldt = DFF; kind = 0; off = 0; }
        transpose_item(W, N, WT, ldt, kind, off, r, F.lane);
    }
    moe_convert(F, 0, MOE_ITEMS - 2 * MOE_TAILQ, gw, NGW);
    for (int i = gw; i < 2 * 232; i += NGW) { const int l = i / 232, rr = 4376 + i % 232; v4u* p = (v4u*)((bf16*)(F.ws + WS_WIN) + ((size_t)l * NPROJ + rr) * 2048);
#pragma unroll
        for (int j = 0; j < 4; ++j) p[F.lane + 64 * j] = (v4u){0u, 0u, 0u, 0u}; }
}

template <bool ROUTER>
__device__ __forceinline__ void norm_phase(Frame& F, const float* xin, const float* g, const float* modl, int sh_off, int sc_off) {
    bf16* XN = (bf16*)(F.ws + WS_XN);
    const int gw = F.vcu * NWAVES + F.wave, NGW = F.G * NWAVES;
    LAS float* wrT = (LAS float*)(F.lds + RING_OFF);
    LAS int* lcnt = (LAS int*)(F.lds + MISC_OFF + 1152);
    LAS int* lbase = (LAS int*)(F.lds + MISC_OFF + 1216);
    LAS int* rtab = (LAS int*)(F.lds + MISC_OFF + 2048);
    int nrow = 0;
    if (ROUTER) {
        for (int i = F.tid; i < 2048 * 8; i += NWAVES * 64) wrT[(i & 7) * 2048 + (i >> 3)] = F.in[IN_WROUTER][i];
        if (F.tid < 8) lcnt[F.tid] = 0;
        __syncthreads();
    }
    for (int m = gw; m < M; m += NGW, ++nrow) {
        const int b = m >> 11;
        const f32x4* xr = (const f32x4*)(xin + (size_t)m * DM) + F.lane;
        f32x4 v[8]; float ss = 0.f;
#pragma unroll
        for (int j = 0; j < 8; ++j) { v[j] = xr[64 * j]; ss += (v[j].x * v[j].x + v[j].y * v[j].y) + (v[j].z * v[j].z + v[j].w * v[j].w); }
        const float rstd = 1.0f / sqrtf(wave_sum(ss) * (1.0f / DM) + EPS);
        const f32x4* gp = (const f32x4*)g + F.lane; const f32x4* scp = (const f32x4*)(modl + (size_t)b * 12288 + sc_off) + F.lane; const f32x4* shp = (const f32x4*)(modl + (size_t)b * 12288 + sh_off) + F.lane;
        v2u* o8 = (v2u*)(XN + (size_t)m * DM) + F.lane;
#pragma unroll
        for (int j = 0; j < 8; ++j) { const f32x4 gg = gp[64 * j], sc = scp[64 * j], sh = shp[64 * j];
            v[j] = v[j] * rstd * gg * (sc + 1.0f) + sh;
            if (ROUTER) ((unsigned*)((unsigned char*)XN + (size_t)m * DM))[F.lane + 64 * j] = pg8::pk4_fp8(v[j].x, v[j].y, v[j].z, v[j].w);
            else { v2u w; w.x = pk2(v[j].x, v[j].y); w.y = pk2(v[j].z, v[j].w); o8[64 * j] = w; } }
        if (ROUTER) {
            float lg[8];
#pragma unroll
            for (int e = 0; e < 8; ++e) { float p = 0.f; const LAS f32x4* wp = (const LAS f32x4*)(wrT + e * 2048) + F.lane;
#pragma unroll
                for (int j = 0; j < 8; ++j) { const f32x4 w = wp[64 * j]; p += (v[j].x * w.x + v[j].y * w.y) + (v[j].z * w.z + v[j].w * w.w); }
                lg[e] = wave_sum(p); }
            int e1 = 0; float v1 = lg[0];
#pragma unroll
            for (int e = 1; e < 8; ++e) if (lg[e] > v1) { v1 = lg[e]; e1 = e; }
            int e2 = -1; float v2 = -3.0e38f;
#pragma unroll
            for (int e = 0; e < 8; ++e) if (e != e1 && lg[e] > v2) { v2 = lg[e]; e2 = e; }
            const float w1 = 1.0f / (1.0f + expf(v2 - v1)), w2 = 1.0f - w1;
            if (F.lane == 0) {
                const int r1 = atomicAdd((int*)(lcnt + e1), 1), r2 = atomicAdd((int*)(lcnt + e2), 1);
                LAS int* en = rtab + (F.wave * 16 + nrow) * 8;
                en[0] = m; en[1] = e1; en[2] = r1; en[3] = __builtin_bit_cast(int, w1); en[4] = m; en[5] = e2; en[6] = r2; en[7] = __builtin_bit_cast(int, w2);
            }
        }
    }
    if (ROUTER) {
        __syncthreads();
        if (F.tid < 8) lbase[F.tid] = (int)__hip_atomic_fetch_add((unsigned*)(F.ctl + CW_CNT + 64 * F.tid), (unsigned)lcnt[F.tid], RLX_AGENT);
        __syncthreads();
        int* tk = (int*)(F.ws + WS_TOK);
        const int per = (M + NGW - 1) / NGW;
        for (int i = F.tid; i < NWAVES * per * 2; i += NWAVES * 64) { const int w = i / (per * 2), rr = (i % (per * 2)) >> 1, k = i & 1;
            const int mrow = F.vcu * NWAVES + w + rr * NGW; if (mrow >= M) continue;
            const LAS int* en = rtab + (w * 16 + rr) * 8 + 4 * k;
            const int t = en[0], e = en[1];
            tk[TOK_E + t * 2 + k] = e; tk[TOK_SLOT + t * 2 + k] = lbase[e] + en[2]; tk[TOK_W + t * 2 + k] = en[3]; }
    }
}

__device__ const unsigned char T5_BUCKET[128] = {0, 1, 2, 3, 4, 5, 6, 7, 8, 9, 10, 11, 12, 13, 14, 15, 16, 16, 16, 17, 17, 18, 18, 18, 19, 19, 19, 20, 20, 20, 20, 21, 21, 21, 21, 22, 22, 22, 22, 22, 23, 23, 23, 23, 23, 23, 24, 24, 24, 24, 24, 24, 25, 25, 25, 25, 25, 25, 25, 26, 26, 26, 26, 26, 26, 26, 26, 27, 27, 27, 27, 27, 27, 27, 27, 27, 27, 28, 28, 28, 28, 28, 28, 28, 28, 28, 28, 29, 29, 29, 29, 29, 29, 29, 29, 29, 29, 29, 29, 30, 30, 30, 30, 30, 30, 30, 30, 30, 30, 30, 30, 30, 30, 31, 31, 31, 31, 31, 31, 31, 31, 31, 31, 31, 31, 31, 31, 31};

__device__ __forceinline__ void mix_prep(Frame& F, int l) {
    const bf16* proj = (const bf16*)(F.ws + WS_PROJ); const float* side = (const float*)(F.ws + WS_SIDE);
    bf16* qkc = (bf16*)(F.ws + WS_QKC); float* la = (float*)(F.ws + WS_LA); bf16* kn = (bf16*)(F.ws + WS_KN);
    const int gw = F.vcu * NWAVES + F.wave, NGW = F.G * NWAVES, lane = F.lane;
    const float* wc = F.in[IN_WCONV] + l * 4 * 512; const float* bc = F.in[IN_BCONV] + l * 512;
    const float* wd = F.in[IN_WDEC] + l * 16 * 256; const float* bd = F.in[IN_BDEC] + l * 256; const float* gk = F.in[IN_GKN] + l * 64;
    for (int m = gw; m < M; m += NGW) {
        const int pos = m & (SEQ - 1);
        {
            float y[8]; const int ch = lane * 8;
            { const f32x4 b0 = *(const f32x4*)(bc + ch), b1 = *(const f32x4*)(bc + ch + 4); y[0] = b0.x; y[1] = b0.y; y[2] = b0.z; y[3] = b0.w; y[4] = b1.x; y[5] = b1.y; y[6] = b1.z; y[7] = b1.w; }
#pragma unroll
            for (int i = 0; i < 4; ++i) { if (pos - 3 + i >= 0) {
                const v4u xv = *(const v4u*)(proj + (size_t)(m - 3 + i) * PROJ_LD + ch);
                const f32x4 w0 = *(const f32x4*)(wc + i * 512 + ch), w1 = *(const f32x4*)(wc + i * 512 + ch + 4);
                y[0] += w0.x * bflo(xv.x); y[1] += w0.y * bfhi(xv.x); y[2] += w0.z * bflo(xv.y); y[3] += w0.w * bfhi(xv.y);
                y[4] += w1.x * bflo(xv.z); y[5] += w1.y * bfhi(xv.z); y[6] += w1.z * bflo(xv.w); y[7] += w1.w * bfhi(xv.w); } }
            const float sc = ch >= 256 ? 0.125f : 1.0f;
#pragma unroll
            for (int i = 0; i < 8; ++i) y[i] = siluf_(y[i]) * sc;
            v4u o; o.x = pk2(y[0], y[1]); o.y = pk2(y[2], y[3]); o.z = pk2(y[4], y[5]); o.w = pk2(y[6], y[7]);
            *(v4u*)(qkc + (size_t)m * 512 + ch) = o;
        }
        {
            const int c = lane * 4; f32x4 z = *(const f32x4*)(bd + c);
            const f32x4* gp = (const f32x4*)(side + (size_t)m * 32 + 8);
            const f32x4 g0 = gp[0], g1 = gp[1], g2 = gp[2], g3 = gp[3];
            const float ga[16] = {g0.x, g0.y, g0.z, g0.w, g1.x, g1.y, g1.z, g1.w, g2.x, g2.y, g2.z, g2.w, g3.x, g3.y, g3.z, g3.w};
#pragma unroll
            for (int r = 0; r < 16; ++r) { const f32x4 w = *(const f32x4*)(wd + r * 256 + c); z += w * ga[r]; }
            f32x4 o; o.x = logsigmoidf_(z.x) * 0.0625f; o.y = logsigmoidf_(z.y) * 0.0625f; o.z = logsigmoidf_(z.z) * 0.0625f; o.w = logsigmoidf_(z.w) * 0.0625f;
            *(f32x4*)(la + (size_t)m * 256 + c) = o;
        }
        {
            const unsigned kv = *(const unsigned*)(proj + (size_t)m * PROJ_LD + C_AK + 2 * lane);
            const float k0 = bflo(kv), k1 = bfhi(kv); float ss = k0 * k0 + k1 * k1;
#pragma unroll
            for (int o = 1; o < 32; o <<= 1) ss += __shfl_xor(ss, o);
            const float rstd = 1.0f / sqrtf(ss * (1.0f / 64.0f) + EPS);
            *(unsigned*)(kn + (size_t)m * 128 + 2 * lane) = pk2(k0 * rstd * gk[(2 * lane) & 63], k1 * rstd * gk[(2 * lane + 1) & 63]);
        }
    }
}

__device__ __forceinline__ void naive_mlstm(Frame& F, int l, int bh) {
    const int b = bh >> 2, h = bh & 3, tid = F.tid, v = tid >> 2, kq = tid & 3;
    const bf16* proj = (const bf16*)(F.ws + WS_PROJ); const float* side = (const float*)(F.ws + WS_SIDE); const bf16* qkc = (const bf16*)(F.ws + WS_QKC);
    bf16* Y = (bf16*)(F.ws + WS_Y);
    LAS float* red = (LAS float*)(F.lds + RING_OFF);
    const float bi = F.in[IN_BGATES][l * 8 + h], bfg = F.in[IN_BGATES][l * 8 + 4 + h];
    const float gout = F.in[IN_GOUTM][l * 512 + h * 128 + v];
    float C[16], n[16]; float mst = 0.f;
#pragma unroll
    for (int i = 0; i < 16; ++i) { C[i] = 0.f; n[i] = 0.f; }
    for (int t = 0; t < SEQ; ++t) {
        const size_t row = (size_t)b * SEQ + t;
        const v4u q0 = *(const v4u*)(qkc + row * 512 + h * 64 + kq * 16), q1 = *(const v4u*)(qkc + row * 512 + h * 64 + kq * 16 + 8);
        const v4u k0 = *(const v4u*)(qkc + row * 512 + 256 + h * 64 + kq * 16), k1 = *(const v4u*)(qkc + row * 512 + 256 + h * 64 + kq * 16 + 8);
        const float q[16] = {bflo(q0.x), bfhi(q0.x), bflo(q0.y), bfhi(q0.y), bflo(q0.z), bfhi(q0.z), bflo(q0.w), bfhi(q0.w), bflo(q1.x), bfhi(q1.x), bflo(q1.y), bfhi(q1.y), bflo(q1.z), bfhi(q1.z), bflo(q1.w), bfhi(q1.w)};
        const float k[16] = {bflo(k0.x), bfhi(k0.x), bflo(k0.y), bfhi(k0.y), bflo(k0.z), bfhi(k0.z), bflo(k0.w), bfhi(k0.w), bflo(k1.x), bfhi(k1.x), bflo(k1.y), bfhi(k1.y), bflo(k1.z), bfhi(k1.z), bflo(k1.w), bfhi(k1.w)};
        const float vv = bf1(proj[row * PROJ_LD + C_MV + h * 128 + v]);
        const float ip = side[row * 32 + h] + bi, lf = logsigmoidf_(side[row * 32 + 4 + h] + bfg);
        const float mn = fmaxf(lf + mst, ip), fd = expf(lf + mst - mn), iw = expf(ip - mn); mst = mn;
        float num = 0.f, den = 0.f;
#pragma unroll
        for (int i = 0; i < 16; ++i) { C[i] = fd * C[i] + (iw * vv) * k[i]; n[i] = fd * n[i] + iw * k[i]; num += C[i] * q[i]; den += n[i] * q[i]; }
        num += __shfl_xor(num, 1); num += __shfl_xor(num, 2); den += __shfl_xor(den, 1); den += __shfl_xor(den, 2);
        const float hv = num / fmaxf(fabsf(den), expf(-mst));
        const float s2 = wave_sum(kq == 0 ? hv * hv : 0.f);
        if (F.lane == 0) red[(t & 1) * 8 + F.wave] = s2;
        __syncthreads();
        float tot = 0.f;
#pragma unroll
        for (int w = 0; w < 8; ++w) tot += red[(t & 1) * 8 + w];
        const float rstd = 1.0f / sqrtf(tot * (1.0f / 128.0f) + EPS);
        if (kq == 0) { const float mo = bf1(proj[row * PROJ_LD + C_MO + h * 128 + v]);
            Y[row * DM + h * 128 + v] = (bf16)f2bf(hv * rstd * gout * sigmoidf_(mo)); }
    }
    __syncthreads();
}
__device__ __forceinline__ void naive_gla(Frame& F, int l, int bh) {
    const int b = bh >> 2, h = bh & 3, tid = F.tid, v = tid >> 2, kq = tid & 3;
    const bf16* proj = (const bf16*)(F.ws + WS_PROJ); const float* la = (const float*)(F.ws + WS_LA);
    bf16* Y = (bf16*)(F.ws + WS_Y);
    LAS float* red = (LAS float*)(F.lds + RING_OFF);
    const float gout = F.in[IN_GOUTG][l * 512 + h * 128 + v];
    float S[16];
#pragma unroll
    for (int i = 0; i < 16; ++i) S[i] = 0.f;
    for (int t = 0; t < SEQ; ++t) {
        const size_t row = (size_t)b * SEQ + t;
        const v4u q0 = *(const v4u*)(proj + row * PROJ_LD + C_GQ + h * 64 + kq * 16), q1 = *(const v4u*)(proj + row * PROJ_LD + C_GQ + h * 64 + kq * 16 + 8);
        const v4u k0 = *(const v4u*)(proj + row * PROJ_LD + C_GK + h * 64 + kq * 16), k1 = *(const v4u*)(proj + row * PROJ_LD + C_GK + h * 64 + kq * 16 + 8);
        const float q[16] = {bflo(q0.x), bfhi(q0.x), bflo(q0.y), bfhi(q0.y), bflo(q0.z), bfhi(q0.z), bflo(q0.w), bfhi(q0.w), bflo(q1.x), bfhi(q1.x), bflo(q1.y), bfhi(q1.y), bflo(q1.z), bfhi(q1.z), bflo(q1.w), bfhi(q1.w)};
        const float k[16] = {bflo(k0.x), bfhi(k0.x), bflo(k0.y), bfhi(k0.y), bflo(k0.z), bfhi(k0.z), bflo(k0.w), bfhi(k0.w), bflo(k1.x), bfhi(k1.x), bflo(k1.y), bfhi(k1.y), bflo(k1.z), bfhi(k1.z), bflo(k1.w), bfhi(k1.w)};
        const f32x4* lp = (const f32x4*)(la + row * 256 + h * 64 + kq * 16);
        const f32x4 a0 = lp[0], a1 = lp[1], a2 = lp[2], a3 = lp[3];
        const float a[16] = {a0.x, a0.y, a0.z, a0.w, a1.x, a1.y, a1.z, a1.w, a2.x, a2.y, a2.z, a2.w, a3.x, a3.y, a3.z, a3.w};
        const float vv = bf1(proj[row * PROJ_LD + C_GV + h * 128 + v]);
        float o = 0.f;
#pragma unroll
        for (int i = 0; i < 16; ++i) { S[i] = expf(a[i]) * S[i] + k[i] * vv; o += (q[i] * 0.125f) * S[i]; }
        o += __shfl_xor(o, 1); o += __shfl_xor(o, 2);
        const float s2 = wave_sum(kq == 0 ? o * o : 0.f);
        if (F.lane == 0) red[(t & 1) * 8 + F.wave] = s2;
        __syncthreads();
        float tot = 0.f;
#pragma unroll
        for (int w = 0; w < 8; ++w) tot += red[(t & 1) * 8 + w];
        const float rstd = 1.0f / sqrtf(tot * (1.0f / 128.0f) + EPS);
        if (kq == 0) { const float gg = bf1(proj[row * PROJ_LD + C_GG + h * 128 + v]);
            Y[row * DM + 512 + h * 128 + v] = (bf16)f2bf(o * rstd * gout * siluf_(gg)); }
    }
    __syncthreads();
}
__device__ __forceinline__ void naive_swa(Frame& F, int l, int blk) {
    const int tid = F.tid, hq = tid & 15, row = blk * 32 + (tid >> 4), kvh = hq >> 3, pos = row & (SEQ - 1);
    const bf16* proj = (const bf16*)(F.ws + WS_PROJ); const bf16* kn = (const bf16*)(F.ws + WS_KN); bf16* Y = (bf16*)(F.ws + WS_Y);
    const float* gq = F.in[IN_GQN] + l * 64; const float* relb = F.in[IN_RELB];
    float q[64], o[64];
    { float ss = 0.f;
#pragma unroll
      for (int c = 0; c < 8; ++c) { const v4u x = *(const v4u*)(proj + (size_t)row * PROJ_LD + C_AQ + hq * 64 + 8 * c);
          q[8 * c + 0] = bflo(x.x); q[8 * c + 1] = bfhi(x.x); q[8 * c + 2] = bflo(x.y); q[8 * c + 3] = bfhi(x.y); q[8 * c + 4] = bflo(x.z); q[8 * c + 5] = bfhi(x.z); q[8 * c + 6] = bflo(x.w); q[8 * c + 7] = bfhi(x.w); }
#pragma unroll
      for (int d = 0; d < 64; ++d) ss += q[d] * q[d];
      const float rstd = 1.0f / sqrtf(ss * (1.0f / 64.0f) + EPS);
#pragma unroll
      for (int d = 0; d < 64; ++d) { q[d] = q[d] * rstd * gq[d] * 0.125f; o[d] = 0.f; } }
    float mx = F.in[IN_SINKS][l * 16 + hq], den = 1.0f;
    const int s0 = pos - 127 < 0 ? 0 : pos - 127;
    for (int s = s0; s <= pos; ++s) {
        const size_t kr = (size_t)(row - pos + s);
        float dot = 0.f;
#pragma unroll
        for (int c = 0; c < 8; ++c) { const v4u x = *(const v4u*)(kn + kr * 128 + kvh * 64 + 8 * c);
            dot += q[8 * c + 0] * bflo(x.x) + q[8 * c + 1] * bfhi(x.x) + q[8 * c + 2] * bflo(x.y) + q[8 * c + 3] * bfhi(x.y) + q[8 * c + 4] * bflo(x.z) + q[8 * c + 5] * bfhi(x.z) + q[8 * c + 6] * bflo(x.w) + q[8 * c + 7] * bfhi(x.w); }
        const float sc = dot + relb[T5_BUCKET[pos - s] * 16 + hq];
        const float mn = fmaxf(mx, sc), corr = expf(mx - mn), p = expf(sc - mn); mx = mn; den = den * corr + p;
#pragma unroll
        for (int c = 0; c < 8; ++c) { const v4u x = *(const v4u*)(proj + kr * PROJ_LD + C_AV + kvh * 64 + 8 * c);
            o[8 * c + 0] = o[8 * c + 0] * corr + p * bflo(x.x); o[8 * c + 1] = o[8 * c + 1] * corr + p * bfhi(x.x); o[8 * c + 2] = o[8 * c + 2] * corr + p * bflo(x.y); o[8 * c + 3] = o[8 * c + 3] * corr + p * bfhi(x.y);
            o[8 * c + 4] = o[8 * c + 4] * corr + p * bflo(x.z); o[8 * c + 5] = o[8 * c + 5] * corr + p * bfhi(x.z); o[8 * c + 6] = o[8 * c + 6] * corr + p * bflo(x.w); o[8 * c + 7] = o[8 * c + 7] * corr + p * bfhi(x.w); }
    }
    const float inv = 1.0f / den;
#pragma unroll
    for (int c = 0; c < 8; ++c) { v4u w; w.x = pk2(o[8 * c] * inv, o[8 * c + 1] * inv); w.y = pk2(o[8 * c + 2] * inv, o[8 * c + 3] * inv); w.z = pk2(o[8 * c + 4] * inv, o[8 * c + 5] * inv); w.w = pk2(o[8 * c + 6] * inv, o[8 * c + 7] * inv);
        *(v4u*)(Y + (size_t)row * DM + 1024 + hq * 64 + 8 * c) = w; }
}
__device__ __forceinline__ void mix_naive(Frame& F, int l) {
    for (int u = F.vcu; u < 64 + 512; u += F.G) {
        if (u < 32) { if (!FAST_MLSTM) naive_mlstm(F, l, u); }
        else if (u < 64) { if (!FAST_GLA) naive_gla(F, l, u - 32); }
        else { if (!FAST_SWA) naive_swa(F, l, u - 64); }
    }
}

__device__ __forceinline__ int moe_tables(Frame& F) {
    LAS int* seg = (LAS int*)(F.lds + MISC_OFF + 1024); LAS int* tile_e = (LAS int*)(F.lds + MISC_OFF + 64);
    if (F.tid == 0) { int s = 0;
        for (int e = 0; e < 8; ++e) { seg[e] = s; const int c = (int)__hip_atomic_load(F.ctl + CW_CNT + 64 * e, RLX_AGENT); const int nt = (c + 255) >> 8; for (int i = 0; i < nt; ++i) tile_e[(s >> 8) + i] = e; s += nt << 8; }
        seg[8] = s; }
    __syncthreads();
    return seg[8] >> 8;
}
__device__ __forceinline__ void moe_gather(Frame& F) {
    (void)moe_tables(F);
    const LAS int* seg = (const LAS int*)(F.lds + MISC_OFF + 1024);
    const int gw = F.vcu * NWAVES + F.wave, NGW = F.G * NWAVES;
    int* tk = (int*)(F.ws + WS_TOK); const unsigned char* XN = (const unsigned char*)(F.ws + WS_XN); unsigned char* AS = (unsigned char*)(F.ws + WS_AS);
    for (int m = gw; m < M; m += NGW) {
        const v4u* src = (const v4u*)(XN + (size_t)m * DM) + F.lane; v4u r[2];
#pragma unroll
        for (int j = 0; j < 2; ++j) r[j] = src[64 * j];
#pragma unroll
        for (int k = 0; k < 2; ++k) { const int e = tk[TOK_E + m * 2 + k], dest = seg[e] + tk[TOK_SLOT + m * 2 + k];
            v4u* dst = (v4u*)(AS + (size_t)dest * DM) + F.lane;
#pragma unroll
            for (int j = 0; j < 2; ++j) dst[64 * j] = r[j];
            if (F.lane == 0) tk[TOK_POS + m * 2 + k] = dest; }
    }
    for (int e = 0; e < 8; ++e) { const int c = (int)__hip_atomic_load(F.ctl + CW_CNT + 64 * e, RLX_AGENT);
        for (int r = seg[e] + c + gw; r < seg[e + 1]; r += NGW) { v4u* dst = (v4u*)(AS + (size_t)r * DM) + F.lane;
#pragma unroll
            for (int j = 0; j < 2; ++j) dst[64 * j] = (v4u){0u, 0u, 0u, 0u}; } }
}
__device__ __forceinline__ void moe_combine(Frame& F, const float* gtf) {
    const int gw = F.vcu * NWAVES + F.wave, NGW = F.G * NWAVES;
    const int* tk = (const int*)(F.ws + WS_TOK); const float* xa = (const float*)(F.ws + WS_XA); const bf16* YS = (const bf16*)(F.ws + WS_AS);
    for (int m = gw; m < M; m += NGW) {
        const int b = m >> 11, p1 = tk[TOK_POS + 2 * m], p2 = tk[TOK_POS + 2 * m + 1];
        const float w1 = __builtin_bit_cast(float, tk[TOK_W + 2 * m]), w2 = __builtin_bit_cast(float, tk[TOK_W + 2 * m + 1]);
        const f32x4* xr = (const f32x4*)(xa + (size_t)m * DM) + F.lane; const f32x4* gp = (const f32x4*)(gtf + (size_t)b * 12288) + F.lane;
        const v2u* y1 = (const v2u*)(YS + (size_t)p1 * DM) + F.lane; const v2u* y2 = (const v2u*)(YS + (size_t)p2 * DM) + F.lane;
        f32x4* op = (f32x4*)(F.out + (size_t)m * DM) + F.lane;
#pragma unroll
        for (int j = 0; j < 8; ++j) { const f32x4 x = xr[64 * j], g = gp[64 * j]; const v2u a = y1[64 * j], c = y2[64 * j];
            f32x4 y; y.x = w1 * bflo(a.x) + w2 * bflo(c.x); y.y = w1 * bfhi(a.x) + w2 * bfhi(c.x); y.z = w1 * bflo(a.y) + w2 * bflo(c.y); y.w = w1 * bfhi(a.y) + w2 * bfhi(c.y);
            op[64 * j] = x + g * y; }
    }
}

typedef short v4i16_t __attribute__((ext_vector_type(4)));
#define MFMA16(a, b, c) __builtin_amdgcn_mfma_f32_16x16x32_bf16((a), (b), (c), 0, 0, 0)
__device__ __forceinline__ bf16x8 frag_row(const LAS unsigned char* base, int ldb, int r0, int k0, int lane) {
    return *(const LAS bf16x8*)(base + (r0 + (lane & 15)) * ldb + (k0 + 8 * (lane >> 4)) * 2);
}
__device__ __forceinline__ bf16x8 frag_tr2(const LAS unsigned char* base, int ldb, int ra, int rb, int c0, int lane) {
    const int g = lane >> 4, q = (lane & 15) >> 2, p = lane & 3;
    const LAS unsigned char* a0 = base + (ra + 4 * g + q) * ldb + (c0 + 4 * p) * 2;
    const LAS unsigned char* a1 = base + (rb + 4 * g + q) * ldb + (c0 + 4 * p) * 2;
    const v4i16_t lo = __builtin_amdgcn_ds_read_tr16_b64_v4i16((LAS v4i16_t*)a0), hi = __builtin_amdgcn_ds_read_tr16_b64_v4i16((LAS v4i16_t*)a1);
    bf16x8 r; r[0] = lo[0]; r[1] = lo[1]; r[2] = lo[2]; r[3] = lo[3]; r[4] = hi[0]; r[5] = hi[1]; r[6] = hi[2]; r[7] = hi[3]; return r;
}
__device__ __forceinline__ bf16x8 frag_tr(const LAS unsigned char* base, int ldb, int k0, int c0, int lane) {
    const int g = lane >> 4;
    return frag_tr2(base, ldb, k0 + 4 * g, k0 + 4 * g + 4, c0, lane);
}
__device__ __forceinline__ bf16x8 pack8(float a, float b, float c, float d, float e, float f, float g, float h) {
    v4u w; w.x = pk2(a, b); w.y = pk2(c, d); w.z = pk2(e, f); w.w = pk2(g, h); return __builtin_bit_cast(bf16x8, w);
}
__device__ __forceinline__ float scan_add(float v, int lane) {
#pragma unroll
    for (int d = 1; d < 64; d <<= 1) { const float t = __shfl_up(v, d); if (lane >= d) v += t; }
    return v;
}
__device__ __forceinline__ float scan_max(float v, int lane) {
#pragma unroll
    for (int d = 1; d < 64; d <<= 1) { const float t = __shfl_up(v, d); if (lane >= d) v = fmaxf(v, t); }
    return v;
}

__device__ __forceinline__ void swa_unit(Frame& F, int l, int unit) {
    const int b = unit >> 5, kvh = (unit >> 4) & 1, nb = unit & 15;
    const int tid = F.tid, lane = F.lane, w = F.wave, g = lane >> 4, n = lane & 15;
    const bf16* proj = (const bf16*)(F.ws + WS_PROJ); bf16* Y = (bf16*)(F.ws + WS_Y);
    LAS unsigned char* Kt = F.lds + RING_OFF; LAS unsigned char* Vt = Kt + 36864; LAS float* bias = (LAS float*)(Kt + 73728);
    constexpr int LDB = 144;
    const int hq = kvh * 8 + w;
    v4u qn[2][2];
    const bf16* qbase = proj + (size_t)(b * SEQ + nb * 128 + n) * PROJ_LD + C_AQ + hq * 64 + 8 * g;
#pragma unroll
    for (int jt = 0; jt < 2; ++jt) { qn[jt][0] = *(const v4u*)(qbase + (size_t)(jt * 16) * PROJ_LD); qn[jt][1] = *(const v4u*)(qbase + (size_t)(jt * 16) * PROJ_LD + 32); }
    __syncthreads();
    {
        const int r = tid >> 1, hf = tid & 1, pos = nb * 128 - 128 + r;
        v4u kx[4], vx[4];
        if (pos >= 0) { const bf16* kp = proj + (size_t)(b * SEQ + pos) * PROJ_LD + C_AK + kvh * 64 + hf * 32; const bf16* vp = proj + (size_t)(b * SEQ + pos) * PROJ_LD + C_AV + kvh * 64 + hf * 32;
#pragma unroll
            for (int j = 0; j < 4; ++j) { kx[j] = *(const v4u*)(kp + 8 * j); vx[j] = *(const v4u*)(vp + 8 * j); } }
        else {
#pragma unroll
            for (int j = 0; j < 4; ++j) { kx[j] = (v4u){0u, 0u, 0u, 0u}; vx[j] = (v4u){0u, 0u, 0u, 0u}; } }
        float kf[32]; float ss = 0.f;
#pragma unroll
        for (int j = 0; j < 4; ++j) { kf[8 * j + 0] = bflo(kx[j].x); kf[8 * j + 1] = bfhi(kx[j].x); kf[8 * j + 2] = bflo(kx[j].y); kf[8 * j + 3] = bfhi(kx[j].y); kf[8 * j + 4] = bflo(kx[j].z); kf[8 * j + 5] = bfhi(kx[j].z); kf[8 * j + 6] = bflo(kx[j].w); kf[8 * j + 7] = bfhi(kx[j].w); }
#pragma unroll
        for (int i = 0; i < 32; ++i) ss += kf[i] * kf[i];
        ss += __shfl_xor(ss, 1);
        const float rstd = 1.0f / sqrtf(ss * (1.0f / 64.0f) + EPS);
        const float* gk = F.in[IN_GKN] + l * 64 + hf * 32;
#pragma unroll
        for (int j = 0; j < 4; ++j) { const f32x4 g0 = *(const f32x4*)(gk + 8 * j), g1 = *(const f32x4*)(gk + 8 * j + 4);
            v4u o; o.x = pk2(kf[8 * j] * rstd * g0.x, kf[8 * j + 1] * rstd * g0.y); o.y = pk2(kf[8 * j + 2] * rstd * g0.z, kf[8 * j + 3] * rstd * g0.w);
            o.z = pk2(kf[8 * j + 4] * rstd * g1.x, kf[8 * j + 5] * rstd * g1.y); o.w = pk2(kf[8 * j + 6] * rstd * g1.z, kf[8 * j + 7] * rstd * g1.w);
            *(LAS v4u*)(Kt + r * LDB + hf * 64 + 16 * j) = o; *(LAS v4u*)(Vt + r * LDB + hf * 64 + 16 * j) = vx[j]; }
    }
    for (int i = tid; i < 1024; i += NWAVES * 64) bias[i] = F.in[IN_RELB][T5_BUCKET[i & 127] * 16 + kvh * 8 + (i >> 7)] * 1.4426950408889634f;
    __syncthreads();
    const float sink = F.in[IN_SINKS][l * 16 + hq] * 1.4426950408889634f;
    const float* gq = F.in[IN_GQN] + l * 64;
    const f32x4 gq0 = *(const f32x4*)(gq + 8 * g), gq1 = *(const f32x4*)(gq + 8 * g + 4), gq2 = *(const f32x4*)(gq + 32 + 8 * g), gq3 = *(const f32x4*)(gq + 32 + 8 * g + 4);
    const LAS float* bw = bias + w * 128;
    for (int qb = 0; qb < 4; ++qb) {
        const int j0 = qb * 32;
        bf16x8 qf[2][2];
        v4u qc[2][2];
#pragma unroll
        for (int jt = 0; jt < 2; ++jt) { qc[jt][0] = qn[jt][0]; qc[jt][1] = qn[jt][1]; }
        if (qb < 3) {
#pragma unroll
            for (int jt = 0; jt < 2; ++jt) { qn[jt][0] = *(const v4u*)(qbase + (size_t)(j0 + 32 + jt * 16) * PROJ_LD); qn[jt][1] = *(const v4u*)(qbase + (size_t)(j0 + 32 + jt * 16) * PROJ_LD + 32); } }
#pragma unroll
        for (int jt = 0; jt < 2; ++jt) {
            const v4u x0 = qc[jt][0], x1 = qc[jt][1];
            float f[16] = {bflo(x0.x), bfhi(x0.x), bflo(x0.y), bfhi(x0.y), bflo(x0.z), bfhi(x0.z), bflo(x0.w), bfhi(x0.w), bflo(x1.x), bfhi(x1.x), bflo(x1.y), bfhi(x1.y), bflo(x1.z), bfhi(x1.z), bflo(x1.w), bfhi(x1.w)};
            float ss = 0.f;
#pragma unroll
            for (int i = 0; i < 16; ++i) ss += f[i] * f[i];
            ss += __shfl_xor(ss, 16); ss += __shfl_xor(ss, 32);
            const float rs = (0.125f * 1.4426950408889634f) / sqrtf(ss * (1.0f / 64.0f) + EPS);
            qf[jt][0] = pack8(f[0] * rs * gq0.x, f[1] * rs * gq0.y, f[2] * rs * gq0.z, f[3] * rs * gq0.w, f[4] * rs * gq1.x, f[5] * rs * gq1.y, f[6] * rs * gq1.z, f[7] * rs * gq1.w);
            qf[jt][1] = pack8(f[8] * rs * gq2.x, f[9] * rs * gq2.y, f[10] * rs * gq2.z, f[11] * rs * gq2.w, f[12] * rs * gq3.x, f[13] * rs * gq3.y, f[14] * rs * gq3.z, f[15] * rs * gq3.w);
        }
        f32x4 sc[2][10];
#pragma unroll
        for (int i = 0; i < 10; ++i) { const int kt = 2 * qb + i;
            const bf16x8 k0 = frag_row(Kt, LDB, 16 * kt, 0, lane), k1 = frag_row(Kt, LDB, 16 * kt, 32, lane);
#pragma unroll
            for (int jt = 0; jt < 2; ++jt) { f32x4 a = (f32x4){0.f, 0.f, 0.f, 0.f};
                if (i - jt >= 0 && i - jt <= 8) { a = MFMA16(k0, qf[jt][0], a); a = MFMA16(k1, qf[jt][1], a); }
                sc[jt][i] = a; } }
        float inv[2];
#pragma unroll
        for (int jt = 0; jt < 2; ++jt) { const int j = j0 + 16 * jt + n; float mx = sink;
#pragma unroll
            for (int i = 0; i < 10; ++i) { const int d = i - jt;
                if (d < 0 || d > 8) continue;
                const bool tile_ok = (nb > 0) || (2 * qb + i >= 8);
#pragma unroll
                for (int r = 0; r < 4; ++r) { const int dist = 16 * jt + n + 128 - 16 * i - 4 * g - r;
                    const bool ok = tile_ok && (d == 0 ? (4 * g + r > n) : (d == 8 ? (4 * g + r <= n) : true));
                    const float v = ok ? sc[jt][i][r] + bw[dist & 127] : -INFINITY; sc[jt][i][r] = v; mx = fmaxf(mx, v); } }
            mx = fmaxf(mx, __shfl_xor(mx, 16)); mx = fmaxf(mx, __shfl_xor(mx, 32));
            float sum = 0.f;
#pragma unroll
            for (int i = 0; i < 10; ++i) { const int d = i - jt;
                if (d < 0 || d > 8) continue;
#pragma unroll
                for (int r = 0; r < 4; ++r) { const float pz = __builtin_amdgcn_exp2f(sc[jt][i][r] - mx); sc[jt][i][r] = pz; sum += pz; } }
            sum += __shfl_xor(sum, 16); sum += __shfl_xor(sum, 32);
            inv[jt] = 1.0f / (sum + __builtin_amdgcn_exp2f(sink - mx)); }
        f32x4 o[4][2];
#pragma unroll
        for (int dt = 0; dt < 4; ++dt) { o[dt][0] = (f32x4){0.f, 0.f, 0.f, 0.f}; o[dt][1] = (f32x4){0.f, 0.f, 0.f, 0.f}; }
#pragma unroll
        for (int kk = 0; kk < 5; ++kk) { bf16x8 pf[2];
#pragma unroll
            for (int jt = 0; jt < 2; ++jt) pf[jt] = pack8(sc[jt][2 * kk][0], sc[jt][2 * kk][1], sc[jt][2 * kk][2], sc[jt][2 * kk][3], sc[jt][2 * kk + 1][0], sc[jt][2 * kk + 1][1], sc[jt][2 * kk + 1][2], sc[jt][2 * kk + 1][3]);
            const int ra = 16 * (2 * qb + 2 * kk);
#pragma unroll
            for (int dt = 0; dt < 4; ++dt) { const bf16x8 a = frag_tr2(Vt, LDB, ra, ra + 16, 16 * dt, lane);
                o[dt][0] = MFMA16(a, pf[0], o[dt][0]); o[dt][1] = MFMA16(a, pf[1], o[dt][1]); } }
#pragma unroll
        for (int jt = 0; jt < 2; ++jt) { bf16* yp = Y + (size_t)(b * SEQ + nb * 128 + j0 + 16 * jt + n) * DM + 1024 + hq * 64 + 4 * g;
#pragma unroll
            for (int dt = 0; dt < 4; ++dt) { v2u wv; wv.x = pk2(o[dt][jt][0] * inv[jt], o[dt][jt][1] * inv[jt]); wv.y = pk2(o[dt][jt][2] * inv[jt], o[dt][jt][3] * inv[jt]); *(v2u*)(yp + 16 * dt) = wv; } }
    }
}

__device__ __forceinline__ void gla_u_unit(Frame& F, int l, int u) {
    const int b = u >> 7, h = (u >> 5) & 3, c = u & 31, t0 = b * SEQ + 64 * c;
    const int tid = F.tid, lane = F.lane, w = F.wave, g = lane >> 4, n = lane & 15;
    const bf16* proj = (const bf16*)(F.ws + WS_PROJ); const float* side = (const float*)(F.ws + WS_SIDE);
    bf16* QT = (bf16*)(F.ws + WS_GAUX); bf16* QP = QT + (size_t)M * 256; bf16* KT = QP + (size_t)M * 256; float* BL = (float*)(KT + (size_t)M * 256); float* UG = (float*)(F.ws + WS_UG);
    LAS float* LAm = (LAS float*)(F.lds + RING_OFF);
    LAS unsigned char* KP = F.lds + RING_OFF + 16640;
    LAS unsigned char* VT = F.lds + RING_OFF + 25856;
    __syncthreads();
    const int s = tid >> 3, kg = tid & 7;
    const v4u kx = *(const v4u*)(proj + (size_t)(t0 + s) * PROJ_LD + C_GK + h * 64 + 8 * kg), qx = *(const v4u*)(proj + (size_t)(t0 + s) * PROJ_LD + C_GQ + h * 64 + 8 * kg);
    {
        const float* wd = F.in[IN_WDEC] + l * 16 * 256 + h * 64 + 8 * kg; const float* bd = F.in[IN_BDEC] + l * 256 + h * 64 + 8 * kg;
        f32x4 z0 = *(const f32x4*)(bd), z1 = *(const f32x4*)(bd + 4);
        const f32x4* gp = (const f32x4*)(side + (size_t)(t0 + s) * 32 + 8);
        const f32x4 g0 = gp[0], g1 = gp[1], g2 = gp[2], g3 = gp[3];
        const float ga[16] = {g0.x, g0.y, g0.z, g0.w, g1.x, g1.y, g1.z, g1.w, g2.x, g2.y, g2.z, g2.w, g3.x, g3.y, g3.z, g3.w};
#pragma unroll
        for (int r = 0; r < 16; ++r) { z0 += *(const f32x4*)(wd + r * 256) * ga[r]; z1 += *(const f32x4*)(wd + r * 256 + 4) * ga[r]; }
        LAS float* lp = LAm + s * 65 + 8 * kg;
        lp[0] = logsigmoidf_(z0.x) * 0.0625f; lp[1] = logsigmoidf_(z0.y) * 0.0625f; lp[2] = logsigmoidf_(z0.z) * 0.0625f; lp[3] = logsigmoidf_(z0.w) * 0.0625f;
        lp[4] = logsigmoidf_(z1.x) * 0.0625f; lp[5] = logsigmoidf_(z1.y) * 0.0625f; lp[6] = logsigmoidf_(z1.z) * 0.0625f; lp[7] = logsigmoidf_(z1.w) * 0.0625f;
        const bf16* vp = proj + (size_t)(t0 + s) * PROJ_LD + C_GV + h * 128 + 16 * kg;
        *(LAS v4u*)(VT + s * 272 + 32 * kg) = *(const v4u*)(vp); *(LAS v4u*)(VT + s * 272 + 32 * kg + 16) = *(const v4u*)(vp + 8);
    }
    __syncthreads();
#pragma unroll
    for (int ci = 0; ci < 8; ++ci) { const int k = 8 * w + ci; const float v = scan_add(LAm[lane * 65 + k], lane); LAm[lane * 65 + k] = v; }
    __syncthreads();
    {
        const float kf[8] = {bflo(kx.x), bfhi(kx.x), bflo(kx.y), bfhi(kx.y), bflo(kx.z), bfhi(kx.z), bflo(kx.w), bfhi(kx.w)};
        const float qf[8] = {bflo(qx.x), bfhi(qx.x), bflo(qx.y), bfhi(qx.y), bflo(qx.z), bfhi(qx.z), bflo(qx.w), bfhi(qx.w)};
        float o1[8], o2[8], o3[8], o4[8];
#pragma unroll
        for (int i = 0; i < 8; ++i) { const float bb = LAm[s * 65 + 8 * kg + i], bl = LAm[63 * 65 + 8 * kg + i], br = LAm[31 * 65 + 8 * kg + i];
            o1[i] = kf[i] * __expf(bl - bb); o2[i] = qf[i] * 0.125f * __expf(bb - br); o3[i] = qf[i] * 0.125f * __expf(bb); o4[i] = kf[i] * __expf(br - bb);
            if (s == 63) BL[(size_t)u * 64 + 8 * kg + i] = bl; }
        v4u o; o.x = pk2(o1[0], o1[1]); o.y = pk2(o1[2], o1[3]); o.z = pk2(o1[4], o1[5]); o.w = pk2(o1[6], o1[7]); *(LAS v4u*)(KP + s * 144 + 16 * kg) = o;
        const size_t go = (size_t)(t0 + s) * 256 + h * 64 + 8 * kg;
        o.x = pk2(o2[0], o2[1]); o.y = pk2(o2[2], o2[3]); o.z = pk2(o2[4], o2[5]); o.w = pk2(o2[6], o2[7]); *(v4u*)(QT + go) = o;
        o.x = pk2(o3[0], o3[1]); o.y = pk2(o3[2], o3[3]); o.z = pk2(o3[4], o3[5]); o.w = pk2(o3[6], o3[7]); *(v4u*)(QP + go) = o;
        o.x = pk2(o4[0], o4[1]); o.y = pk2(o4[2], o4[3]); o.z = pk2(o4[4], o4[5]); o.w = pk2(o4[6], o4[7]); *(v4u*)(KT + go) = o;
    }
    __syncthreads();
    {
        f32x4 acc[4];
#pragma unroll
        for (int mt = 0; mt < 4; ++mt) acc[mt] = (f32x4){0.f, 0.f, 0.f, 0.f};
#pragma unroll
        for (int ks = 0; ks < 2; ++ks) { const bf16x8 bv = frag_tr(VT, 272, 32 * ks, 16 * w, lane);
#pragma unroll
            for (int mt = 0; mt < 4; ++mt) { const bf16x8 a = frag_tr(KP, 144, 32 * ks, 16 * mt, lane); acc[mt] = MFMA16(a, bv, acc[mt]); } }
        float* up = UG + (size_t)u * 64 * 128 + 16 * w + n;
#pragma unroll
        for (int mt = 0; mt < 4; ++mt)
#pragma unroll
            for (int r = 0; r < 4; ++r) up[(size_t)(16 * mt + 4 * g + r) * 128] = acc[mt][r];
    }
}
__device__ __forceinline__ void gla_out_group(Frame& F, int l, int ug) {
    const int bh = ug >> 3, jj = ug & 7, b = bh >> 2, h = bh & 3;
    const int tid = F.tid, lane = F.lane, w = F.wave, g = lane >> 4, n = lane & 15;
    const bf16* proj = (const bf16*)(F.ws + WS_PROJ); bf16* Y = (bf16*)(F.ws + WS_Y);
    const bf16* QT = (const bf16*)(F.ws + WS_GAUX); const bf16* QP = QT + (size_t)M * 256; const bf16* KT = QP + (size_t)M * 256; const float* BL = (const float*)(KT + (size_t)M * 256); const float* UG = (const float*)(F.ws + WS_UG);
    LAS unsigned char* LQT = F.lds + RING_OFF; LAS unsigned char* LQP = LQT + 9216; LAS unsigned char* LKT = LQT + 18432; LAS unsigned char* VT = LQT + 27648; LAS unsigned char* ST = LQT + 45056;
    LAS float* SS = (LAS float*)(LQT + 62464);
    float S[16];
#pragma unroll
    for (int i = 0; i < 16; ++i) S[i] = 0.f;
    const int sk = tid >> 3, sv = (tid & 7) * 16;
    int cdone = 0;
    const float* gout = F.in[IN_GOUTG] + l * 512 + h * 128;
#pragma clang loop unroll(disable)
    for (int oi = 0; oi < 4; ++oi) {
        asm volatile("" : "+s"(proj), "+s"(Y), "+s"(QT), "+s"(QP), "+s"(KT), "+s"(BL), "+s"(UG), "+s"(gout));
        const int c = oi == 0 ? jj : (oi == 1 ? 15 - jj : (oi == 2 ? 16 + jj : 31 - jj));
        while (cdone < c) {
            const int nbt = (c - cdone) < 4 ? (c - cdone) : 4; f32x4 xb[4][4]; float db[4];
#pragma unroll
            for (int i = 0; i < 4; ++i) if (i < nbt) { const int uu = bh * 32 + cdone + i; db[i] = BL[(size_t)uu * 64 + sk];
                const f32x4* up = (const f32x4*)(UG + (size_t)uu * 64 * 128 + sk * 128 + sv);
#pragma unroll
                for (int q = 0; q < 4; ++q) xb[i][q] = up[q]; }
#pragma unroll
            for (int i = 0; i < 4; ++i) if (i < nbt) { const float dec = __expf(db[i]);
#pragma unroll
                for (int q = 0; q < 4; ++q) { const f32x4 x = xb[i][q]; S[4 * q] = dec * S[4 * q] + x.x; S[4 * q + 1] = dec * S[4 * q + 1] + x.y; S[4 * q + 2] = dec * S[4 * q + 2] + x.z; S[4 * q + 3] = dec * S[4 * q + 3] + x.w; } }
            cdone += nbt; }
        const int t0 = b * SEQ + 64 * c;
        __syncthreads();
        {
            v4u o; o.x = pk2(S[0], S[1]); o.y = pk2(S[2], S[3]); o.z = pk2(S[4], S[5]); o.w = pk2(S[6], S[7]); *(LAS v4u*)(ST + sk * 272 + sv * 2) = o;
            o.x = pk2(S[8], S[9]); o.y = pk2(S[10], S[11]); o.z = pk2(S[12], S[13]); o.w = pk2(S[14], S[15]); *(LAS v4u*)(ST + sk * 272 + sv * 2 + 16) = o;
            const int s = tid >> 3, kg = tid & 7; const size_t go = (size_t)(t0 + s) * 256 + h * 64 + 8 * kg;
            *(LAS v4u*)(LQT + s * 144 + 16 * kg) = *(const v4u*)(QT + go); *(LAS v4u*)(LQP + s * 144 + 16 * kg) = *(const v4u*)(QP + go); *(LAS v4u*)(LKT + s * 144 + 16 * kg) = *(const v4u*)(KT + go);
            const bf16* vp = proj + (size_t)(t0 + s) * PROJ_LD + C_GV + h * 128 + 16 * kg;
            *(LAS v4u*)(VT + s * 272 + 32 * kg) = *(const v4u*)(vp); *(LAS v4u*)(VT + s * 272 + 32 * kg + 16) = *(const v4u*)(vp + 8);
        }
        __syncthreads();
        const int jt = w & 3, vh = w >> 2;
        const size_t row = (size_t)(t0 + 16 * jt + n);
        f32x4 go4[4]; v2u gx4[4];
#pragma unroll
        for (int mt = 0; mt < 4; ++mt) { const int v = 64 * vh + 16 * mt + 4 * g; go4[mt] = *(const f32x4*)(gout + v); gx4[mt] = *(const v2u*)(proj + row * PROJ_LD + C_GG + h * 128 + v); }
        bf16x8 qf[2], qpf[2];
#pragma unroll
        for (int ks = 0; ks < 2; ++ks) { qf[ks] = frag_row(LQT, 144, 16 * jt, 32 * ks, lane); qpf[ks] = frag_row(LQP, 144, 16 * jt, 32 * ks, lane); }
        f32x4 at[4];
#pragma unroll
        for (int st = 0; st < 4; ++st) { at[st] = (f32x4){0.f, 0.f, 0.f, 0.f};
            if (st <= jt) {
#pragma unroll
                for (int ks = 0; ks < 2; ++ks) at[st] = MFMA16(frag_row(LKT, 144, 16 * st, 32 * ks, lane), qf[ks], at[st]);
                if (st == jt) {
#pragma unroll
                    for (int r = 0; r < 4; ++r) if (4 * g + r > n) at[st][r] = 0.f; } } }
        f32x4 o[4];
#pragma unroll
        for (int mt = 0; mt < 4; ++mt) { o[mt] = (f32x4){0.f, 0.f, 0.f, 0.f};
#pragma unroll
            for (int ks = 0; ks < 2; ++ks) o[mt] = MFMA16(frag_tr(ST, 272, 32 * ks, 64 * vh + 16 * mt, lane), qpf[ks], o[mt]); }
#pragma unroll
        for (int kk = 0; kk < 2; ++kk) { if (2 * kk <= jt) {
            const bf16x8 pf = pack8(at[2 * kk][0], at[2 * kk][1], at[2 * kk][2], at[2 * kk][3], at[2 * kk + 1][0], at[2 * kk + 1][1], at[2 * kk + 1][2], at[2 * kk + 1][3]);
#pragma unroll
            for (int mt = 0; mt < 4; ++mt) o[mt] = MFMA16(frag_tr2(VT, 272, 32 * kk, 32 * kk + 16, 64 * vh + 16 * mt, lane), pf, o[mt]); } }
        float ss = 0.f;
#pragma unroll
        for (int mt = 0; mt < 4; ++mt)
#pragma unroll
            for (int r = 0; r < 4; ++r) ss += o[mt][r] * o[mt][r];
        ss += __shfl_xor(ss, 16); ss += __shfl_xor(ss, 32);
        if (g == 0) SS[w * 16 + n] = ss;
        __syncthreads();
        const float rstd = 1.0f / sqrtf((SS[w * 16 + n] + SS[(w ^ 4) * 16 + n]) * (1.0f / 128.0f) + EPS);
#pragma unroll
        for (int mt = 0; mt < 4; ++mt) { const int v = 64 * vh + 16 * mt + 4 * g;
            const f32x4 gq4 = go4[mt]; const v2u gx = gx4[mt];
            v2u wv; wv.x = pk2(o[mt][0] * rstd * gq4.x * siluf_(bflo(gx.x)), o[mt][1] * rstd * gq4.y * siluf_(bfhi(gx.x))); wv.y = pk2(o[mt][2] * rstd * gq4.z * siluf_(bflo(gx.y)), o[mt][3] * rstd * gq4.w * siluf_(bfhi(gx.y)));
            *(v2u*)(Y + row * DM + 512 + h * 128 + v) = wv; }
    }
}

__device__ __forceinline__ void mlstm_u_unit(Frame& F, int l, int u) {
    const int b = u >> 6, h = (u >> 4) & 3, c = u & 15, t0 = b * SEQ + 128 * c;
    const int tid = F.tid, lane = F.lane, w = F.wave, g = lane >> 4, n = lane & 15;
    const bf16* proj = (const bf16*)(F.ws + WS_PROJ); const float* side = (const float*)(F.ws + WS_SIDE); bf16* qkc = (bf16*)(F.ws + WS_QKC);
    float* UM = (float*)(F.ws + WS_UM); float* MS = UM + (size_t)512 * 136 * 64;
    LAS unsigned char* KP = F.lds + RING_OFF;
    LAS unsigned char* VT = F.lds + RING_OFF + 18432;
    LAS float* GF = (LAS float*)(F.lds + RING_OFF + 53248);
    __syncthreads();
    const int s = tid >> 2, qd = tid & 3;
    float kc[16];
    {
        const float* wc = F.in[IN_WCONV] + l * 4 * 512; const float* bc = F.in[IN_BCONV] + l * 512;
        const int pos = 128 * c + s;
#pragma unroll
        for (int part = 0; part < 2; ++part) { const int ch = part * 256 + h * 64 + 16 * qd; float y[16];
#pragma unroll
            for (int q4 = 0; q4 < 4; ++q4) { const f32x4 bb = *(const f32x4*)(bc + ch + 4 * q4); y[4 * q4] = bb.x; y[4 * q4 + 1] = bb.y; y[4 * q4 + 2] = bb.z; y[4 * q4 + 3] = bb.w; }
#pragma unroll
            for (int i = 0; i < 4; ++i) { if (pos - 3 + i >= 0) { const bf16* xp = proj + (size_t)(t0 + s - 3 + i) * PROJ_LD + ch; const v4u x0 = *(const v4u*)xp, x1 = *(const v4u*)(xp + 8);
                const float xf[16] = {bflo(x0.x), bfhi(x0.x), bflo(x0.y), bfhi(x0.y), bflo(x0.z), bfhi(x0.z), bflo(x0.w), bfhi(x0.w), bflo(x1.x), bfhi(x1.x), bflo(x1.y), bfhi(x1.y), bflo(x1.z), bfhi(x1.z), bflo(x1.w), bfhi(x1.w)};
#pragma unroll
                for (int q4 = 0; q4 < 4; ++q4) { const f32x4 ww = *(const f32x4*)(wc + i * 512 + ch + 4 * q4); y[4 * q4] += ww.x * xf[4 * q4]; y[4 * q4 + 1] += ww.y * xf[4 * q4 + 1]; y[4 * q4 + 2] += ww.z * xf[4 * q4 + 2]; y[4 * q4 + 3] += ww.w * xf[4 * q4 + 3]; } } }
            const float scl = part ? 0.125f : 1.0f;
#pragma unroll
            for (int i = 0; i < 16; ++i) y[i] = siluf_(y[i]) * scl;
            v4u o0, o1; o0.x = pk2(y[0], y[1]); o0.y = pk2(y[2], y[3]); o0.z = pk2(y[4], y[5]); o0.w = pk2(y[6], y[7]); o1.x = pk2(y[8], y[9]); o1.y = pk2(y[10], y[11]); o1.z = pk2(y[12], y[13]); o1.w = pk2(y[14], y[15]);
            *(v4u*)(qkc + (size_t)(t0 + s) * 512 + ch) = o0; *(v4u*)(qkc + (size_t)(t0 + s) * 512 + ch + 8) = o1;
            if (part) {
#pragma unroll
                for (int i = 0; i < 16; ++i) kc[i] = y[i]; } }
        const bf16* vp = proj + (size_t)(t0 + s) * PROJ_LD + C_MV + h * 128 + 32 * qd;
#pragma unroll
        for (int j = 0; j < 4; ++j) *(LAS v4u*)(VT + s * 272 + 64 * qd + 16 * j) = *(const v4u*)(vp + 8 * j);
        if (tid < 128) { GF[tid] = logsigmoidf_(side[(size_t)(t0 + tid) * 32 + 4 + h] + F.in[IN_BGATES][l * 8 + 4 + h]); GF[128 + tid] = side[(size_t)(t0 + tid) * 32 + h] + F.in[IN_BGATES][l * 8 + h]; }
    }
    __syncthreads();
    if (w == 0) {
        const float a0 = GF[2 * lane], a1 = GF[2 * lane + 1]; const float P = scan_add(a0 + a1, lane);
        const float blast = __shfl(P, 63);
        const float lw0 = blast - (P - a1) + GF[128 + 2 * lane], lw1 = blast - P + GF[128 + 2 * lane + 1];
        float mx = fmaxf(lw0, lw1);
#pragma unroll
        for (int o = 1; o < 64; o <<= 1) mx = fmaxf(mx, __shfl_xor(mx, o));
        GF[256 + 2 * lane] = expf(lw0 - mx); GF[256 + 2 * lane + 1] = expf(lw1 - mx);
        if (lane == 0) { MS[(size_t)u * 2] = blast; MS[(size_t)u * 2 + 1] = mx; }
    }
    __syncthreads();
    {   const float wg = GF[256 + s];
        v4u o0, o1; o0.x = pk2(kc[0] * wg, kc[1] * wg); o0.y = pk2(kc[2] * wg, kc[3] * wg); o0.z = pk2(kc[4] * wg, kc[5] * wg); o0.w = pk2(kc[6] * wg, kc[7] * wg);
        o1.x = pk2(kc[8] * wg, kc[9] * wg); o1.y = pk2(kc[10] * wg, kc[11] * wg); o1.z = pk2(kc[12] * wg, kc[13] * wg); o1.w = pk2(kc[14] * wg, kc[15] * wg);
        *(LAS v4u*)(KP + s * 144 + 32 * qd) = o0; *(LAS v4u*)(KP + s * 144 + 32 * qd + 16) = o1; }
    __syncthreads();
    {
        const int nt = w & 3, m0 = w >> 2;
        f32x4 acc[5];
#pragma unroll
        for (int i = 0; i < 5; ++i) acc[i] = (f32x4){0.f, 0.f, 0.f, 0.f};
        const bf16x8 ones = (n == 0) ? pack8(1.f, 1.f, 1.f, 1.f, 1.f, 1.f, 1.f, 1.f) : pack8(0.f, 0.f, 0.f, 0.f, 0.f, 0.f, 0.f, 0.f);
#pragma unroll
        for (int ks = 0; ks < 4; ++ks) { const bf16x8 bv = frag_tr(KP, 144, 32 * ks, 16 * nt, lane);
#pragma unroll
            for (int i = 0; i < 4; ++i) acc[i] = MFMA16(frag_tr(VT, 272, 32 * ks, 16 * (m0 + 2 * i), lane), bv, acc[i]);
            if (m0 == 0) acc[4] = MFMA16(ones, bv, acc[4]); }
        float* up = UM + (size_t)u * 136 * 64 + 16 * nt + n;
#pragma unroll
        for (int i = 0; i < 4; ++i)
#pragma unroll
            for (int r = 0; r < 4; ++r) up[(size_t)(16 * (m0 + 2 * i) + 4 * g + r) * 64] = acc[i][r];
        if (m0 == 0 && g == 0) up[(size_t)128 * 64] = acc[4][0];
    }
}
__device__ __forceinline__ void mlstm_out_group(Frame& F, int l, int ug) {
    const int bh = ug >> 3, jj = ug & 7, b = bh >> 2, h = bh & 3;
    const int tid = F.tid, lane = F.lane, w = F.wave, g = lane >> 4, n = lane & 15;
    const bf16* proj = (const bf16*)(F.ws + WS_PROJ); const float* side = (const float*)(F.ws + WS_SIDE); const bf16* qkc = (const bf16*)(F.ws + WS_QKC); bf16* Y = (bf16*)(F.ws + WS_Y);
    const float* UM = (const float*)(F.ws + WS_UM); const float* MS = UM + (size_t)512 * 136 * 64;
    LAS unsigned char* QC = F.lds + RING_OFF; LAS unsigned char* KC = QC + 18432; LAS unsigned char* VT = QC + 36864; LAS unsigned char* CS = QC + 71680;
    LAS float* GF = (LAS float*)(QC + 92416);
    float C[16], nn = 0.f, mst = 0.f;
#pragma unroll
    for (int i = 0; i < 16; ++i) C[i] = 0.f;
    const int cv = tid >> 2, ck = (tid & 3) * 16;
    int cdone = 0;
    const float* gout = F.in[IN_GOUTM] + l * 512 + h * 128;
#pragma clang loop unroll(disable)
    for (int oi = 0; oi < 2; ++oi) {
        asm volatile("" : "+s"(proj), "+s"(side), "+s"(qkc), "+s"(Y), "+s"(UM), "+s"(MS), "+s"(gout));
        const int c = oi == 0 ? jj : 15 - jj;
        while (cdone < c) {
            const int nbt = (c - cdone) < 4 ? (c - cdone) : 4; f32x4 xb[4][4]; float bb[4], mb[4], nb4[4];
#pragma unroll
            for (int i = 0; i < 4; ++i) if (i < nbt) { const int uu = bh * 16 + cdone + i; bb[i] = MS[(size_t)uu * 2]; mb[i] = MS[(size_t)uu * 2 + 1];
                const f32x4* up = (const f32x4*)(UM + (size_t)uu * 136 * 64 + cv * 64 + ck);
#pragma unroll
                for (int q = 0; q < 4; ++q) xb[i][q] = up[q];
                nb4[i] = UM[(size_t)uu * 136 * 64 + 128 * 64 + (tid & 63)]; }
#pragma unroll
            for (int i = 0; i < 4; ++i) if (i < nbt) { const float Bc = bb[i], ml = mb[i];
                const float mn = fmaxf(Bc + mst, ml), d1 = expf(Bc + mst - mn), d2 = expf(ml - mn); mst = mn;
#pragma unroll
                for (int q = 0; q < 4; ++q) { const f32x4 x = xb[i][q]; C[4 * q] = d1 * C[4 * q] + d2 * x.x; C[4 * q + 1] = d1 * C[4 * q + 1] + d2 * x.y; C[4 * q + 2] = d1 * C[4 * q + 2] + d2 * x.z; C[4 * q + 3] = d1 * C[4 * q + 3] + d2 * x.w; }
                nn = d1 * nn + d2 * nb4[i]; }
            cdone += nbt; }
        const int t0 = b * SEQ + 128 * c;
        __syncthreads();
        {
            v4u o; o.x = pk2(C[0], C[1]); o.y = pk2(C[2], C[3]); o.z = pk2(C[4], C[5]); o.w = pk2(C[6], C[7]); *(LAS v4u*)(CS + cv * 144 + ck * 2) = o;
            o.x = pk2(C[8], C[9]); o.y = pk2(C[10], C[11]); o.z = pk2(C[12], C[13]); o.w = pk2(C[14], C[15]); *(LAS v4u*)(CS + cv * 144 + ck * 2 + 16) = o;
            if (tid < 64) *(LAS bf16*)(CS + 128 * 144 + tid * 2) = (bf16)f2bf(nn);
            for (int i = tid; i < 15 * 72; i += NWAVES * 64) *(LAS bf16*)(CS + 129 * 144 + i * 2) = (bf16)0;
            const int s = tid >> 2, qd = tid & 3;
            const bf16* qp = qkc + (size_t)(t0 + s) * 512 + h * 64 + 16 * qd;
            *(LAS v4u*)(QC + s * 144 + 32 * qd) = *(const v4u*)qp; *(LAS v4u*)(QC + s * 144 + 32 * qd + 16) = *(const v4u*)(qp + 8);
            *(LAS v4u*)(KC + s * 144 + 32 * qd) = *(const v4u*)(qp + 256); *(LAS v4u*)(KC + s * 144 + 32 * qd + 16) = *(const v4u*)(qp + 256 + 8);
            const bf16* vp = proj + (size_t)(t0 + s) * PROJ_LD + C_MV + h * 128 + 32 * qd;
#pragma unroll
            for (int j = 0; j < 4; ++j) *(LAS v4u*)(VT + s * 272 + 64 * qd + 16 * j) = *(const v4u*)(vp + 8 * j);
            if (tid < 128) { GF[tid] = logsigmoidf_(side[(size_t)(t0 + tid) * 32 + 4 + h] + F.in[IN_BGATES][l * 8 + 4 + h]); GF[128 + tid] = side[(size_t)(t0 + tid) * 32 + h] + F.in[IN_BGATES][l * 8 + h]; }
        }
        __syncthreads();
        if (w == 0) {
            const float a0 = GF[2 * lane], a1 = GF[2 * lane + 1]; const float P = scan_add(a0 + a1, lane);
            const float b0 = P - a1, b1 = P; const float x0 = GF[128 + 2 * lane] - b0, x1 = GF[128 + 2 * lane + 1] - b1;
            const float cm = scan_max(fmaxf(x0, x1), lane);
            float prev = __shfl_up(cm, 1); if (lane == 0) prev = -INFINITY;
            const float M0 = fmaxf(mst, fmaxf(prev, x0)), M1 = fmaxf(mst, cm);
            GF[2 * lane] = x0; GF[2 * lane + 1] = x1; GF[128 + 2 * lane] = M0; GF[128 + 2 * lane + 1] = M1; GF[256 + 2 * lane] = b0; GF[256 + 2 * lane + 1] = b1;
        }
        __syncthreads();
        {
            const int j = 16 * w + n; const float Mj = GF[128 + j], bj = GF[256 + j];
            const size_t row = (size_t)(t0 + j);
            v2u mx8[8];
#pragma unroll
            for (int mt = 0; mt < 8; ++mt) { const int v = 16 * mt + 4 * g; mx8[mt] = *(const v2u*)(proj + row * PROJ_LD + C_MO + h * 128 + v); }
            bf16x8 qf[2];
#pragma unroll
            for (int ks = 0; ks < 2; ++ks) qf[ks] = frag_row(QC, 144, 16 * w, 32 * ks, lane);
            f32x4 p[8];
#pragma unroll
            for (int st = 0; st < 8; ++st) { p[st] = (f32x4){0.f, 0.f, 0.f, 0.f};
                if (st <= w) {
#pragma unroll
                    for (int ks = 0; ks < 2; ++ks) p[st] = MFMA16(frag_row(KC, 144, 16 * st, 32 * ks, lane), qf[ks], p[st]);
                    const f32x4 as = *(const LAS f32x4*)(GF + 16 * st + 4 * g);
#pragma unroll
                    for (int r = 0; r < 4; ++r) { const float e = __expf(as[r] - Mj); p[st][r] = (st < w || 4 * g + r <= n) ? p[st][r] * e : 0.f; } } }
            f32x4 o[9];
            const float wi = __expf(mst - Mj);
#pragma unroll
            for (int mt = 0; mt < 9; ++mt) { o[mt] = (f32x4){0.f, 0.f, 0.f, 0.f};
#pragma unroll
                for (int ks = 0; ks < 2; ++ks) o[mt] = MFMA16(frag_row(CS, 144, 16 * mt, 32 * ks, lane), qf[ks], o[mt]);
                o[mt] = o[mt] * wi; }
            const bf16x8 ones = (n == 0) ? pack8(1.f, 1.f, 1.f, 1.f, 1.f, 1.f, 1.f, 1.f) : pack8(0.f, 0.f, 0.f, 0.f, 0.f, 0.f, 0.f, 0.f);
#pragma unroll
            for (int kk = 0; kk < 4; ++kk) { if (2 * kk <= w) {
                const bf16x8 pf = pack8(p[2 * kk][0], p[2 * kk][1], p[2 * kk][2], p[2 * kk][3], p[2 * kk + 1][0], p[2 * kk + 1][1], p[2 * kk + 1][2], p[2 * kk + 1][3]);
#pragma unroll
                for (int mt = 0; mt < 8; ++mt) o[mt] = MFMA16(frag_tr2(VT, 272, 32 * kk, 32 * kk + 16, 16 * mt, lane), pf, o[mt]);
                o[8] = MFMA16(ones, pf, o[8]); } }
            const float den = __shfl(o[8][0], n);
            const float dn = 1.0f / fmaxf(fabsf(den), __expf(-(bj + Mj)));
            float ss = 0.f;
#pragma unroll
            for (int mt = 0; mt < 8; ++mt)
#pragma unroll
                for (int r = 0; r < 4; ++r) { o[mt][r] *= dn; ss += o[mt][r] * o[mt][r]; }
            ss += __shfl_xor(ss, 16); ss += __shfl_xor(ss, 32);
            const float rstd = 1.0f / sqrtf(ss * (1.0f / 128.0f) + EPS);
#pragma unroll
            for (int mt = 0; mt < 8; ++mt) { const int v = 16 * mt + 4 * g;
                const f32x4 go4 = *(const f32x4*)(gout + v); const v2u mx = mx8[mt];
                v2u wv; wv.x = pk2(o[mt][0] * rstd * go4.x * sigmoidf_(bflo(mx.x)), o[mt][1] * rstd * go4.y * sigmoidf_(bfhi(mx.x))); wv.y = pk2(o[mt][2] * rstd * go4.z * sigmoidf_(bflo(mx.y)), o[mt][3] * rstd * go4.w * sigmoidf_(bfhi(mx.y)));
                *(v2u*)(Y + row * DM + h * 128 + v) = wv; }
        }
    }
}

#define PROBE_SUBREP(id) (PROBE_REPEAT == (id) ? 5 : 1)
__device__ __forceinline__ void mix_a(Frame& F, int l) {
    if (!(FAST_GLA && FAST_MLSTM && FAST_SWA)) mix_prep(F, l);
    if (FAST_SWA) for (int rep = 0; rep < PROBE_SUBREP(201); ++rep) for (int u = F.vcu; u < 256; u += F.G) swa_unit(F, l, u);
    if (FAST_MLSTM) for (int rep = 0; rep < PROBE_SUBREP(202); ++rep) for (int u = F.vcu; u < 512; u += F.G) mlstm_u_unit(F, l, u);
    if (FAST_GLA) for (int rep = 0; rep < PROBE_SUBREP(203); ++rep) for (int u = F.vcu; u < 1024; u += F.G) gla_u_unit(F, l, u);
}
__device__ __forceinline__ void mix_b(Frame& F, int l) {
    if (!(FAST_GLA && FAST_MLSTM && FAST_SWA)) mix_naive(F, l);
    if (FAST_MLSTM) for (int rep = 0; rep < PROBE_SUBREP(204); ++rep) for (int ug = F.vcu; ug < 256; ug += F.G) mlstm_out_group(F, l, ug);
    if (FAST_GLA) for (int rep = 0; rep < PROBE_SUBREP(205); ++rep) for (int ug = F.vcu; ug < 256; ug += F.G) gla_out_group(F, l, ug);
}

#ifndef MK_ONE_LAUNCH
#define MK_ONE_LAUNCH 1
#endif
constexpr int NPH = 19;
struct Args { const float* in[26]; float* out; unsigned char* ws; int ph_lo, ph_hi; };
__global__ void __launch_bounds__(NWAVES * 64, 2) hybrid_fwd(Args args) {
    extern __shared__ __attribute__((aligned(16))) unsigned char lds[];
    Frame F;
    F.lds = (LAS unsigned char*)lds;
    F.tid = threadIdx.x; F.lane = F.tid & 63; F.wave = __builtin_amdgcn_readfirstlane(F.tid >> 6);
    F.G = gridDim.x; { const int bx = blockIdx.x; F.vcu = (F.G % 8 == 0) ? (bx % 8) * (F.G / 8) + bx / 8 : bx; }
    F.ws = args.ws; F.out = args.out; F.ctl = (gu32*)(args.ws + WS_CTL);
    F.in = (cfp_k*)__builtin_amdgcn_kernarg_segment_ptr();
    for (int u = F.tid; u < (LDS_BYTES - MISC_OFF) / 4; u += NWAVES * 64) ((LAS unsigned*)(F.lds + MISC_OFF))[u] = 0u;
    __syncthreads();
    const int lo = args.ph_lo, hi = args.ph_hi;
    XcdBarrier bar; bar.bar = (unsigned*)(F.ctl + CW_BAR); bar.x = 0; bar.st = nullptr;
    if (hi - lo > 1) bar = xcd_barrier_post((unsigned*)(F.ctl + CW_BAR), (volatile LAS unsigned*)(F.lds + MISC_OFF));
#define IN(k) (lo <= (k) && (k) < hi)
#define SEAM(k) do { if (IN(k) && IN((k) + 1)) { xcd_barrier(bar); if (PROBE_REPEAT == 100) xcd_barrier(bar); } } while (0)
    bf16* const XN = (bf16*)(F.ws + WS_XN); bf16* const Yb = (bf16*)(F.ws + WS_Y); float* const XA = (float*)(F.ws + WS_XA);
    bf16* const PROJ = (bf16*)(F.ws + WS_PROJ); float* const SIDE = (float*)(F.ws + WS_SIDE); bf16* const HID = (bf16*)(F.ws + WS_HID); bf16* const AS = (bf16*)(F.ws + WS_AS);
    const float* const MOD = (const float*)(F.ws + WS_MOD);

    if (IN(0)) { p0_prologue(F); if (PROBE_REPEAT == 0) p0_prologue(F); }
    SEAM(0);
#define LAYER_MIX(l) do { \
        const int pb = 1 + 8 * (l); \
        const float* modl = MOD + (size_t)(l) * 8 * 12288; \
        const float* xin = (l) == 0 ? F.in[IN_X] : (const float*)F.out; \
        if (IN(pb)) { norm_phase<false>(F, xin, F.in[IN_GMIX] + (l) * DM, modl, 0, 2048); if (PROBE_REPEAT == pb) norm_phase<false>(F, xin, F.in[IN_GMIX] + (l) * DM, modl, 0, 2048); } \
        SEAM(pb); \
        if (IN(pb + 1)) { \
            pg8::Gemm g{XN, (const bf16*)(F.ws + WS_WIN) + (size_t)(l) * NPROJ * DM, M, NPROJ, DM}; pg8::StaticOrder S; S.init(M, NPROJ, F.G, (int)blockIdx.x); \
            pg8::EpiProj E{PROJ, SIDE}; \
            pg8::gemm_phase<pg8::EpiProj, pg8::StaticOrder, true, true>(F.lds + RING_OFF, g, S, E); \
            if (PROBE_REPEAT == pb + 1) pg8::gemm_phase<pg8::EpiProj, pg8::StaticOrder, true, true>(F.lds + RING_OFF, g, S, E); \
            if (F.G == 256 && blockIdx.x >= 128) moe_convert(F, MOE_ITEMS - (2 - (l)) * MOE_TAILQ, MOE_ITEMS - (1 - (l)) * MOE_TAILQ, ((int)blockIdx.x - 128) * NWAVES + F.wave, 128 * NWAVES);     \
            else if (F.G != 256) moe_convert(F, MOE_ITEMS - (2 - (l)) * MOE_TAILQ, MOE_ITEMS - (1 - (l)) * MOE_TAILQ, F.vcu * NWAVES + F.wave, F.G * NWAVES); \
        } \
        SEAM(pb + 1); \
        if (IN(pb + 2)) { mix_a(F, (l)); if (PROBE_REPEAT == pb + 2) mix_a(F, (l)); } \
        SEAM(pb + 2); \
        if (IN(pb + 3)) { mix_b(F, (l)); if (PROBE_REPEAT == pb + 3) mix_b(F, (l)); } \
        SEAM(pb + 3); \
        if (IN(pb + 4)) { \
            pg8::Gemm g{Yb, (const bf16*)(F.ws + WS_WOUT) + (size_t)(l) * DM * DM, M, DM, DM}; pg8::StaticOrder S; S.init(M, DM, F.G, (int)blockIdx.x); \
            pg8::EpiResid E{xin, XA, modl + 4096}; \
            pg8::gemm_phase<pg8::EpiResid, pg8::StaticOrder, true, true>(F.lds + RING_OFF, g, S, E); \
            if (PROBE_REPEAT == pb + 4) pg8::gemm_phase<pg8::EpiResid, pg8::StaticOrder, true, true>(F.lds + RING_OFF, g, S, E); \
        } \
        SEAM(pb + 4); \
    } while (0)
    LAYER_MIX(0);
    {
        const float* modl = MOD;
        if (IN(6)) { norm_phase<false>(F, XA, F.in[IN_GFFN], modl, 6144, 8192); if (PROBE_REPEAT == 6) norm_phase<false>(F, XA, F.in[IN_GFFN], modl, 6144, 8192); }
        SEAM(6);
        if (IN(7)) {
            pg8::Gemm g{XN, (const bf16*)(F.ws + WS_WGU0), M, 2 * DFF, DM}; pg8::StaticOrder S; S.init(M, 2 * DFF, F.G, (int)blockIdx.x);
            pg8::EpiSwiglu E{HID, DFF, 44};
            pg8::gemm_phase<pg8::EpiSwiglu, pg8::StaticOrder, true, true>(F.lds + RING_OFF, g, S, E);
            if (PROBE_REPEAT == 7) pg8::gemm_phase<pg8::EpiSwiglu, pg8::StaticOrder, true, true>(F.lds + RING_OFF, g, S, E);
        }
        SEAM(7);
        if (IN(8)) {
            pg8::Gemm g{HID, (const bf16*)(F.ws + WS_WDN0), M, DM, DFF}; pg8::StaticOrder S; S.init(M, DM, F.G, (int)blockIdx.x);
            pg8::EpiResid E{XA, F.out, modl + 10240};
            pg8::gemm_phase<pg8::EpiResid, pg8::StaticOrder, true, true>(F.lds + RING_OFF, g, S, E);
            if (PROBE_REPEAT == 8) pg8::gemm_phase<pg8::EpiResid, pg8::StaticOrder, true, true>(F.lds + RING_OFF, g, S, E);
        }
        SEAM(8);
    }
    LAYER_MIX(1);
    const float* mod1 = MOD + (size_t)8 * 12288;
    if (IN(14)) norm_phase<true>(F, XA, F.in[IN_GFFN] + DM, mod1, 6144, 8192);
    SEAM(14);
    if (IN(15)) { moe_gather(F); if (PROBE_REPEAT == 15) moe_gather(F); }
    SEAM(15);
    if (IN(16)) {
        const int T = moe_tables(F);
        pg8::Gemm g{AS, (const bf16*)(F.ws + WS_WGU1), T * 256, 2 * DFFE, DM / 2}; pg8::GroupedOrder S; S.init(T, 56, F.G, (int)blockIdx.x, (const LAS int*)(F.lds + MISC_OFF + 64));
        pg8::EpiSwigluF8 E{(unsigned char*)HID, DFFE, 56};
        pg8::gemm_phase<pg8::EpiSwigluF8, pg8::GroupedOrder, true, true>(F.lds + RING_OFF, g, S, E);
        if (PROBE_REPEAT == 16) pg8::gemm_phase<pg8::EpiSwigluF8, pg8::GroupedOrder, true, true>(F.lds + RING_OFF, g, S, E);
    }
    SEAM(16);
    if (IN(17)) {
        const int T = moe_tables(F);
        pg8::Gemm g{HID, (const bf16*)(F.ws + WS_WDN1), T * 256, DM, DFFE / 2}; pg8::GroupedOrder S; S.init(T, 8, F.G, (int)blockIdx.x, (const LAS int*)(F.lds + MISC_OFF + 64));
        pg8::EpiPlainBf16F8 E{AS, DM, 8};
        pg8::gemm_phase<pg8::EpiPlainBf16F8, pg8::GroupedOrder, true, true>(F.lds + RING_OFF, g, S, E);
        if (PROBE_REPEAT == 17) pg8::gemm_phase<pg8::EpiPlainBf16F8, pg8::GroupedOrder, true, true>(F.lds + RING_OFF, g, S, E);
    }
    SEAM(17);
    if (IN(18)) { moe_combine(F, mod1 + 10240); if (PROBE_REPEAT == 18) moe_combine(F, mod1 + 10240); }
#undef IN
#undef SEAM
}

extern "C" void kernel_launch(void* const* d_in, const int* in_sizes, int n_in, void* d_out, int out_size, void* d_ws, size_t ws_size, hipStream_t stream) {
    static int grid = 0;
    if (grid == 0) {
        if (n_in != 26 || in_sizes[0] != M * DM || out_size != M * DM || ws_size < WS_END) { fprintf(stderr, "kernel_launch: unexpected shapes (n_in %d, in0 %d, out %d, ws %zu < %zu)\n", n_in, n_in > 0 ? in_sizes[0] : -1, out_size, ws_size, (size_t)WS_END); grid = -1; return; }
        int dev = 0, cus = 0, per_cu = 0;
        if (hipGetDevice(&dev) != hipSuccess || hipDeviceGetAttribute(&cus, hipDeviceAttributeMultiprocessorCount, dev) != hipSuccess) { grid = -1; return; }
        if (hipFuncSetAttribute((const void*)hybrid_fwd, hipFuncAttributeMaxDynamicSharedMemorySize, LDS_BYTES) != hipSuccess) { fprintf(stderr, "kernel_launch: hipFuncSetAttribute failed\n"); grid = -1; return; }
        if (hipOccupancyMaxActiveBlocksPerMultiprocessor(&per_cu, (const void*)hybrid_fwd, NWAVES * 64, LDS_BYTES) != hipSuccess || per_cu < 1) fprintf(stderr, "kernel_launch: occupancy query says %d\n", per_cu);
        (void)hipGetLastError();
        grid = cus < 256 ? cus : 256;
    }
    if (grid < 0) return;
    if (hipMemsetAsync((char*)d_ws + WS_CTL, 0, CTL_ZERO_BYTES, stream) != hipSuccess) return;
    Args a{};
    for (int i = 0; i < 26; ++i) a.in[i] = (const float*)d_in[i];
    a.out = (float*)d_out; a.ws = (unsigned char*)d_ws;
#if MK_ONE_LAUNCH
    a.ph_lo = 0; a.ph_hi = NPH;
    hipLaunchKernelGGL(hybrid_fwd, dim3(grid), dim3(NWAVES * 64), LDS_BYTES, stream, a);
#else
    for (int p = 0; p < NPH; ++p) { a.ph_lo = p; a.ph_hi = p + 1; hipLaunchKernelGGL(hybrid_fwd, dim3(grid), dim3(NWAVES * 64), LDS_BYTES, stream, a); }
#endif
}
```

```cpp
#include <hip/hip_runtime.h>
#include <cstdio>
#include <cstdint>
namespace pg8 {
#define PG8_LAS __attribute__((address_space(3)))
typedef unsigned short bf16_t;
typedef short bf16x8 __attribute__((ext_vector_type(8)));
typedef float f32x4 __attribute__((ext_vector_type(4)));
typedef unsigned u32x4 __attribute__((ext_vector_type(4)));
constexpr int BM = 256, BK = 64, HALF = 128, HTB = HALF * BK * 2  , STAGE_BYTES = 8 * HTB, NXCD = 8, WGM = 8;

__host__ __device__ __forceinline__ int lds_byte(int r, int c) { const int st = (r >> 4) * 2 + (c >> 5), rr = r & 15, cc = c & 31, ob = rr * 64 + cc * 2; return st * 1024 + (ob ^ (((ob >> 9) & 1) << 5)); }
__host__ __device__ __forceinline__ void stage_rc(int b, int& R, int& C) { const int st = b / 1024, sb = b % 1024, swz = sb ^ (((sb >> 9) & 1) << 5); R = (st >> 1) * 16 + swz / 64; C = (st & 1) * 32 + (swz % 64) / 2; }
__host__ __device__ __forceinline__ int perm32(int rho) { const int n = rho >> 4, i = rho & 15; return 8 * (i >> 2) + 4 * n + (i & 3); }

struct Unit { int pm, pn; };
struct Gemm { const bf16_t* A; const bf16_t* Bt; int M, N, K; };

struct StaticOrder {
    int nM, nN, nwg, G, c;
    __host__ __device__ void init(int M, int N, int G_, int c_) { nM = M / BM; nN = N / BM; nwg = nM * nN; G = G_; c = c_; }
    __host__ __device__ bool next(int i, Unit& u) const {
        const long L = (long)i * G + c; if (L >= nwg) return false;
        int wgid = (int)L; { const int q = nwg / NXCD, r = nwg % NXCD, xcd = wgid % NXCD, off = wgid / NXCD; wgid = (xcd < r ? xcd * (q + 1) : r * (q + 1) + (xcd - r) * q) + off; }
        const int nig = WGM * nN, gid = wgid / nig, fm = gid * WGM, gsz = (nM - fm) < WGM ? (nM - fm) : WGM;
        u.pm = fm + ((wgid % nig) % gsz); u.pn = (wgid % nig) / gsz; return true;
    }
    __device__ __forceinline__ void a_ready(const Unit&) const {}
    __device__ __forceinline__ void done(const Unit&) const {}
};
__device__ __forceinline__ unsigned cvt_pk_bf16(float lo, float hi) { unsigned r; asm volatile("v_cvt_pk_bf16_f32 %0, %1, %2" : "=v"(r) : "v"(lo), "v"(hi)); return r; }
typedef int i32x8 __attribute__((ext_vector_type(8)));
typedef int i32x4 __attribute__((ext_vector_type(4)));
__device__ __forceinline__ i32x8 cat8(bf16x8 lo, bf16x8 hi) { const i32x4 a = __builtin_bit_cast(i32x4, lo), b = __builtin_bit_cast(i32x4, hi); return __builtin_shufflevector(a, b, 0, 1, 2, 3, 4, 5, 6, 7); }
typedef unsigned u32x2 __attribute__((ext_vector_type(2)));
__device__ __forceinline__ float fast_silu(float g) { return g * __builtin_amdgcn_rcpf(1.0f + __expf(-g)); }
struct EpiProj {
    static constexpr bool PERM = true, AFTER_DRAIN = false, FP8 = false; static constexpr int SCALE_W = 127, SCALE_X = 127;
    bf16_t* O; float* side;
    __device__ __forceinline__ void operator()(const f32x4 (&acc)[2][2][4][2], const Unit& u, int wr, int wc, int fr, int fq) const {
        const int row0 = u.pm * BM + wr * 64 + fr;
        if (u.pn < 17) {
            const int col0 = u.pn * BM + wc * 32 + 8 * fq;
#pragma unroll
            for (int ai = 0; ai < 2; ++ai)
#pragma unroll
                for (int m = 0; m < 4; ++m) { bf16_t* rowp = O + (size_t)(row0 + ai * HALF + m * 16) * 4352 + col0;
#pragma unroll
                    for (int bj = 0; bj < 2; ++bj) { const f32x4 v0 = acc[ai][bj][m][0], v1 = acc[ai][bj][m][1];
                        u32x4 w; w.x = cvt_pk_bf16(v0[0], v0[1]); w.y = cvt_pk_bf16(v0[2], v0[3]); w.z = cvt_pk_bf16(v1[0], v1[1]); w.w = cvt_pk_bf16(v1[2], v1[3]);
                        *(u32x4*)(rowp + bj * HALF) = w; } }
        } else if (wc == 0) {
#pragma unroll
            for (int ai = 0; ai < 2; ++ai)
#pragma unroll
                for (int m = 0; m < 4; ++m) { float* rowp = side + (size_t)(row0 + ai * HALF + m * 16) * 32 + 8 * fq;
                    *(f32x4*)(rowp) = acc[ai][0][m][0]; *(f32x4*)(rowp + 4) = acc[ai][0][m][1]; }
        }
    }
};
struct EpiResid {
    static constexpr bool PERM = false, AFTER_DRAIN = false, FP8 = false; static constexpr int SCALE_W = 127, SCALE_X = 127;
    const float* base; float* out; const float* gate;
    __device__ __forceinline__ void operator()(const f32x4 (&acc)[2][2][4][2], const Unit& u, int wr, int wc, int fr, int fq) const {
        const int row0 = u.pm * BM + wr * 64 + fr, col0 = u.pn * BM + wc * 32 + 4 * fq;
        const float* __restrict__ gp = gate + (size_t)(u.pm >> 3) * 12288 + col0;
        const float* __restrict__ bp = base + (size_t)row0 * 2048 + col0; float* __restrict__ op = out + (size_t)row0 * 2048 + col0;
        f32x4 gv[2][2];
#pragma unroll
        for (int bj = 0; bj < 2; ++bj)
#pragma unroll
            for (int n = 0; n < 2; ++n) gv[bj][n] = *(const f32x4*)(gp + bj * HALF + n * 16);
        f32x4 cur[2][2], nxt[2][2];
#pragma unroll
        for (int bj = 0; bj < 2; ++bj)
#pragma unroll
            for (int n = 0; n < 2; ++n) cur[bj][n] = *(const f32x4*)(bp + bj * HALF + n * 16);
#pragma unroll
        for (int g = 0; g < 8; ++g) { const int ai = g >> 2, m = g & 3; const size_t off = (size_t)(ai * HALF + m * 16) * 2048;
            if (g < 7) { const int ai2 = (g + 1) >> 2, m2 = (g + 1) & 3; const size_t off2 = (size_t)(ai2 * HALF + m2 * 16) * 2048;
#pragma unroll
                for (int bj = 0; bj < 2; ++bj)
#pragma unroll
                    for (int n = 0; n < 2; ++n) nxt[bj][n] = *(const f32x4*)(bp + off2 + bj * HALF + n * 16); }
#pragma unroll
            for (int bj = 0; bj < 2; ++bj)
#pragma unroll
                for (int n = 0; n < 2; ++n) *(f32x4*)(op + off + bj * HALF + n * 16) = cur[bj][n] + gv[bj][n] * acc[ai][bj][m][n];
#pragma unroll
            for (int bj = 0; bj < 2; ++bj)
#pragma unroll
                for (int n = 0; n < 2; ++n) cur[bj][n] = nxt[bj][n];
            asm volatile("" ::: "memory"); }
    }
};
struct EpiSwiglu {
    static constexpr bool PERM = true, AFTER_DRAIN = false, FP8 = false; static constexpr int SCALE_W = 127, SCALE_X = 127;
    bf16_t* O; int ldc; int nN;
    __device__ __forceinline__ void operator()(const f32x4 (&acc)[2][2][4][2], const Unit& u, int wr, int wc, int fr, int fq) const {
        const int row0 = u.pm * BM + wr * 64 + fr, col0 = (u.pn % nN) * HALF + wc * 32 + 8 * fq;
#pragma unroll
        for (int ai = 0; ai < 2; ++ai)
#pragma unroll
            for (int m = 0; m < 4; ++m) { bf16_t* rowp = O + (size_t)(row0 + ai * HALF + m * 16) * ldc + col0;
                const f32x4 g0 = acc[ai][0][m][0], g1 = acc[ai][0][m][1], u0 = acc[ai][1][m][0], u1 = acc[ai][1][m][1];
                u32x4 w; w.x = cvt_pk_bf16(fast_silu(g0[0]) * u0[0], fast_silu(g0[1]) * u0[1]); w.y = cvt_pk_bf16(fast_silu(g0[2]) * u0[2], fast_silu(g0[3]) * u0[3]);
                w.z = cvt_pk_bf16(fast_silu(g1[0]) * u1[0], fast_silu(g1[1]) * u1[1]); w.w = cvt_pk_bf16(fast_silu(g1[2]) * u1[2], fast_silu(g1[3]) * u1[3]);
                *(u32x4*)(rowp) = w; }
    }
};
struct EpiPlainBf16 {
    static constexpr bool PERM = true, AFTER_DRAIN = false, FP8 = false; static constexpr int SCALE_W = 127, SCALE_X = 127;
    bf16_t* O; int ldc; int nN;
    __device__ __forceinline__ void operator()(const f32x4 (&acc)[2][2][4][2], const Unit& u, int wr, int wc, int fr, int fq) const {
        const int row0 = u.pm * BM + wr * 64 + fr, col0 = (u.pn % nN) * BM + wc * 32 + 8 * fq;
#pragma unroll
        for (int ai = 0; ai < 2; ++ai)
#pragma unroll
            for (int m = 0; m < 4; ++m) { bf16_t* rowp = O + (size_t)(row0 + ai * HALF + m * 16) * ldc + col0;
#pragma unroll
                for (int bj = 0; bj < 2; ++bj) { const f32x4 v0 = acc[ai][bj][m][0], v1 = acc[ai][bj][m][1];
                    u32x4 w; w.x = cvt_pk_bf16(v0[0], v0[1]); w.y = cvt_pk_bf16(v0[2], v0[3]); w.z = cvt_pk_bf16(v1[0], v1[1]); w.w = cvt_pk_bf16(v1[2], v1[3]);
                    *(u32x4*)(rowp + bj * HALF) = w; } }
    }
};
__device__ __forceinline__ float clamp448(float x) { return __builtin_amdgcn_fmed3f(x, -448.f, 448.f); }
__device__ __forceinline__ unsigned pk4_fp8(float a, float b, float c, float d) { int w = 0; w = __builtin_amdgcn_cvt_pk_fp8_f32(clamp448(a), clamp448(b), w, false); w = __builtin_amdgcn_cvt_pk_fp8_f32(clamp448(c), clamp448(d), w, true); return (unsigned)w; }
struct EpiSwigluF8 {
    static constexpr bool PERM = true, AFTER_DRAIN = false, FP8 = true; static constexpr int SCALE_W = 122, SCALE_X = 127;
    unsigned char* O; int ldc; int nN;
    __device__ __forceinline__ void operator()(const f32x4 (&acc)[2][2][4][2], const Unit& u, int wr, int wc, int fr, int fq) const {
        const int row0 = u.pm * BM + wr * 64 + fr, col0 = (u.pn % nN) * HALF + wc * 32 + 8 * fq;
#pragma unroll
        for (int ai = 0; ai < 2; ++ai)
#pragma unroll
            for (int m = 0; m < 4; ++m) { unsigned char* rowp = O + (size_t)(row0 + ai * HALF + m * 16) * ldc + col0;
                const f32x4 g0 = acc[ai][0][m][0], g1 = acc[ai][0][m][1], u0 = acc[ai][1][m][0], u1 = acc[ai][1][m][1];
                u32x2 w; w.x = pk4_fp8(fast_silu(g0[0]) * u0[0], fast_silu(g0[1]) * u0[1], fast_silu(g0[2]) * u0[2], fast_silu(g0[3]) * u0[3]);
                w.y = pk4_fp8(fast_silu(g1[0]) * u1[0], fast_silu(g1[1]) * u1[1], fast_silu(g1[2]) * u1[2], fast_silu(g1[3]) * u1[3]);
                *(u32x2*)(rowp) = w; }
    }
};
struct EpiPlainBf16F8 {
    static constexpr bool PERM = true, AFTER_DRAIN = false, FP8 = true; static constexpr int SCALE_W = 121, SCALE_X = 124;
    bf16_t* O; int ldc; int nN;
    __device__ __forceinline__ void operator()(const f32x4 (&acc)[2][2][4][2], const Unit& u, int wr, int wc, int fr, int fq) const {
        const int row0 = u.pm * BM + wr * 64 + fr, col0 = (u.pn % nN) * BM + wc * 32 + 8 * fq;
#pragma unroll
        for (int ai = 0; ai < 2; ++ai)
#pragma unroll
            for (int m = 0; m < 4; ++m) { bf16_t* rowp = O + (size_t)(row0 + ai * HALF + m * 16) * ldc + col0;
#pragma unroll
                for (int bj = 0; bj < 2; ++bj) { const f32x4 v0 = acc[ai][bj][m][0], v1 = acc[ai][bj][m][1];
                    u32x4 w; w.x = cvt_pk_bf16(v0[0], v0[1]); w.y = cvt_pk_bf16(v0[2], v0[3]); w.z = cvt_pk_bf16(v1[0], v1[1]); w.w = cvt_pk_bf16(v1[2], v1[3]);
                    *(u32x4*)(rowp + bj * HALF) = w; } }
    }
};
struct GroupedOrder {
    int nM, nN, nwg, G, c, Lbase, Lend; const PG8_LAS int* tile_e;
    __device__ __forceinline__ void init(int nM_, int nN_, int G_, int c_, const PG8_LAS int* te) { nM = nM_; nN = nN_; nwg = nM * nN; G = G_; c = c_; tile_e = te; Lbase = 0; Lend = nwg; }
    __device__ __forceinline__ int row_tile_of(int L) const {
        int wgid = L; { const int q = nwg / NXCD, r = nwg % NXCD, xcd = wgid % NXCD, off = wgid / NXCD; wgid = (xcd < r ? xcd * (q + 1) : r * (q + 1) + (xcd - r) * q) + off; }
        const int nig = WGM * nN, gid = wgid / nig, fm = gid * WGM, gsz = (nM - fm) < WGM ? (nM - fm) : WGM;
        return fm + ((wgid % nig) % gsz);
    }
    __device__ __forceinline__ bool next(int i, Unit& u) const {
        const long L = (long)Lbase + (long)i * G + c; if (L >= Lend) return false;
        int wgid = (int)L; { const int q = nwg / NXCD, r = nwg % NXCD, xcd = wgid % NXCD, off = wgid / NXCD; wgid = (xcd < r ? xcd * (q + 1) : r * (q + 1) + (xcd - r) * q) + off; }
        const int nig = WGM * nN, gid = wgid / nig, fm = gid * WGM, gsz = (nM - fm) < WGM ? (nM - fm) : WGM;
        u.pm = fm + ((wgid % nig) % gsz); u.pn = tile_e[u.pm] * nN + (wgid % nig) / gsz; return true;
    }
    __device__ __forceinline__ void a_ready(const Unit&) const {}
    __device__ __forceinline__ void done(const Unit&) const {}
};
template <class Epi, class Sched, bool ALIGN_EPI = false, bool SP2 = false>
__device__ __forceinline__ void gemm_phase(PG8_LAS unsigned char* lds, const Gemm g, const Sched& S, const Epi& E) {
    const int tid = threadIdx.x, wid = __builtin_amdgcn_readfirstlane(tid >> 6), lane = tid & 63, wr = wid >> 2, wc = wid & 3, fr = lane & 15, fq = lane >> 4;
    const int K = g.K, nt = K / BK;
    unsigned voffA[2], voffB[2];
#pragma unroll
    for (int i = 0; i < 2; ++i) { int R, C; stage_rc(tid * 16 + i * 8192, R, C); const int Rb = Epi::PERM ? ((R & ~31) + perm32(R & 31)) : R;
        voffA[i] = (unsigned)(R * K + C) * 2u; voffB[i] = (unsigned)(Rb * K + C) * 2u; }
    const size_t kstep = (size_t)(BK * 2);
    const size_t hstep = (size_t)HALF * K * 2;
    const size_t tstep = 2 * hstep;
    const unsigned ldsw = (unsigned)wid * 1024u;
    const int aoff = lds_byte(wr * 64 + fr, fq * 8), boff = lds_byte(wc * 32 + fr, fq * 8);
#define PG8_SA(b, h) (((b) * 2 + (h)) * HTB)
#define PG8_SB(b, h) ((4 + (b) * 2 + (h)) * HTB)
#define PG8_STAGE(bufoff, gbase, voff) do { _Pragma("unroll") for (int _i = 0; _i < 2; ++_i) \
        __builtin_amdgcn_global_load_lds((const unsigned*)((const char*)(gbase) + (voff)[_i]), (PG8_LAS unsigned*)(lds + (bufoff) + ldsw + _i * 8192), 16, 0, 0); } while (0)
#define PG8_LDA(dst, b, h) do { _Pragma("unroll") for (int m = 0; m < 4; ++m) _Pragma("unroll") for (int k = 0; k < 2; ++k) dst[m][k] = *(const PG8_LAS bf16x8*)(lds + PG8_SA(b, h) + aoff + m * 2048 + k * 1024); } while (0)
#define PG8_LDB(dst, b, h) do { _Pragma("unroll") for (int n = 0; n < 2; ++n) _Pragma("unroll") for (int k = 0; k < 2; ++k) dst[n][k] = *(const PG8_LAS bf16x8*)(lds + PG8_SB(b, h) + boff + n * 2048 + k * 1024); } while (0)
#define PG8_MMA(ai, bj, At, Bt) do { __builtin_amdgcn_s_setprio(1); _Pragma("unroll") for (int m = 0; m < 4; ++m) _Pragma("unroll") for (int n = 0; n < 2; ++n) { \
        if constexpr (Epi::FP8) { asm volatile("v_mfma_scale_f32_16x16x128_f8f6f4 %0, %1, %2, %0, %3, %4 op_sel_hi:[0,0,0]" : "+v"(acc[ai][bj][m][n]) : "v"(cat8(Bt[n][0], Bt[n][1])), "v"(cat8(At[m][0], At[m][1])), "v"(f8_sw), "v"(f8_sx)); } \
        else { _Pragma("unroll") for (int k = 0; k < 2; ++k) acc[ai][bj][m][n] = __builtin_amdgcn_mfma_f32_16x16x32_bf16(Bt[n][k], At[m][k], acc[ai][bj][m][n], 0, 0, 0); } } __builtin_amdgcn_s_setprio(0); } while (0)
#define PG8_WAIT_V(n) asm volatile("s_waitcnt vmcnt(" #n ")" ::: "memory")
#define PG8_WAIT_L(n) asm volatile("s_waitcnt lgkmcnt(" #n ")" ::: "memory")
#define PG8_BAR __builtin_amdgcn_s_barrier()
#define PG8_SCHED __builtin_amdgcn_sched_barrier(0)
    Unit cur, nxt; int ui = 0;
    if (!S.next(0, cur)) return;
    int f8_sw = Epi::SCALE_W, f8_sx = Epi::SCALE_X;
    if constexpr (Epi::FP8) asm volatile("" : "+v"(f8_sw), "+v"(f8_sx));
    f32x4 acc[2][2][4][2];
#pragma unroll
    for (int a = 0; a < 2; ++a)
#pragma unroll
        for (int b = 0; b < 2; ++b)
#pragma unroll
            for (int m = 0; m < 4; ++m)
#pragma unroll
                for (int n = 0; n < 2; ++n) acc[a][b][m][n] = (f32x4){0.f, 0.f, 0.f, 0.f};
    bf16x8 At[4][2], B0[2][2], B1[2][2];
    const char* cA = (const char*)g.A + (size_t)cur.pm * tstep; const char* cB = (const char*)g.Bt + (size_t)cur.pn * tstep;
    S.a_ready(cur);
    if constexpr (SP2) {
        PG8_STAGE(PG8_SB(0, 0), cB, voffB); PG8_STAGE(PG8_SB(0, 1), cB + hstep, voffB); PG8_STAGE(PG8_SA(0, 0), cA, voffA); PG8_STAGE(PG8_SA(0, 1), cA + hstep, voffA);
        if (wr == 1) PG8_BAR;
        PG8_WAIT_V(2); PG8_BAR;
        PG8_STAGE(PG8_SB(1, 0), cB + kstep, voffB); PG8_STAGE(PG8_SA(1, 0), cA + kstep, voffA); PG8_STAGE(PG8_SB(1, 1), cB + hstep + kstep, voffB);
        PG8_WAIT_V(6); PG8_BAR;
    } else {
        PG8_STAGE(PG8_SB(0, 0), cB, voffB); PG8_STAGE(PG8_SA(0, 0), cA, voffA); PG8_STAGE(PG8_SB(0, 1), cB + hstep, voffB); PG8_STAGE(PG8_SA(0, 1), cA + hstep, voffA);
        if (wr == 1) PG8_BAR;
        PG8_WAIT_V(4); PG8_BAR;
        PG8_STAGE(PG8_SB(1, 0), cB + kstep, voffB); PG8_STAGE(PG8_SA(1, 0), cA + kstep, voffA); PG8_STAGE(PG8_SB(1, 1), cB + hstep + kstep, voffB);
        PG8_WAIT_V(6); PG8_BAR;
    }
    for (;;) {
        const bool has_next = S.next(ui + 1, nxt);
        const char* nA = has_next ? (const char*)g.A + (size_t)nxt.pm * tstep : cA; const char* nB = has_next ? (const char*)g.Bt + (size_t)nxt.pn * tstep : cB;
        for (int t = 0; t < nt; t += 2) {
            const bool last = (t == nt - 2);
            const char* a1 = cA + (size_t)(t + 1) * kstep;
            const char* a2 = last ? nA : cA + (size_t)(t + 2) * kstep; const char* b2 = last ? nB : cB + (size_t)(t + 2) * kstep;
            const char* a3 = a2 + kstep; const char* b3 = b2 + kstep;
            if (last && has_next) S.a_ready(nxt);
            if constexpr (SP2) {
            PG8_LDB(B0, 0, 0); PG8_LDB(B1, 0, 1); PG8_SCHED; PG8_LDA(At, 0, 0); PG8_STAGE(PG8_SA(1, 1), a1 + hstep, voffA);
            PG8_WAIT_V(8); PG8_WAIT_L(0); PG8_BAR; PG8_MMA(0, 0, At, B0); PG8_MMA(0, 1, At, B1); PG8_BAR; PG8_SCHED;
            PG8_LDA(At, 0, 1); PG8_STAGE(PG8_SB(0, 0), b2, voffB); PG8_STAGE(PG8_SB(0, 1), b2 + hstep, voffB); PG8_STAGE(PG8_SA(0, 0), a2, voffA);
            PG8_WAIT_V(8); PG8_WAIT_L(0); PG8_BAR; PG8_MMA(1, 0, At, B0); PG8_MMA(1, 1, At, B1); PG8_BAR; PG8_SCHED;
            PG8_LDB(B0, 1, 0); PG8_LDB(B1, 1, 1); PG8_SCHED; PG8_LDA(At, 1, 0); PG8_STAGE(PG8_SA(0, 1), a2 + hstep, voffA);
            PG8_WAIT_V(8); PG8_WAIT_L(0); PG8_BAR; PG8_MMA(0, 0, At, B0); PG8_MMA(0, 1, At, B1); PG8_BAR; PG8_SCHED;
            PG8_LDA(At, 1, 1); PG8_STAGE(PG8_SB(1, 0), b3, voffB); PG8_STAGE(PG8_SB(1, 1), b3 + hstep, voffB); PG8_STAGE(PG8_SA(1, 0), a3, voffA);
            PG8_WAIT_V(8); PG8_WAIT_L(0); PG8_BAR; PG8_MMA(1, 0, At, B0); PG8_MMA(1, 1, At, B1); PG8_BAR; PG8_SCHED;
            } else {
            PG8_LDB(B0, 0, 0); PG8_SCHED; PG8_LDA(At, 0, 0); PG8_STAGE(PG8_SA(1, 1), a1 + hstep, voffA);
            PG8_WAIT_L(8); PG8_BAR; PG8_WAIT_L(0); PG8_MMA(0, 0, At, B0); PG8_BAR; PG8_SCHED;
            PG8_LDB(B1, 0, 1); PG8_STAGE(PG8_SB(0, 0), b2, voffB);
            PG8_BAR; PG8_WAIT_L(0); PG8_MMA(0, 1, At, B1); PG8_BAR;
            PG8_LDA(At, 0, 1); PG8_STAGE(PG8_SA(0, 0), a2, voffA);
            PG8_BAR; PG8_WAIT_L(0); PG8_MMA(1, 0, At, B0); PG8_BAR; PG8_SCHED;
            PG8_STAGE(PG8_SB(0, 1), b2 + hstep, voffB);
            PG8_WAIT_V(6); PG8_BAR; PG8_MMA(1, 1, At, B1); PG8_BAR;
            PG8_LDB(B0, 1, 0); PG8_SCHED; PG8_LDA(At, 1, 0); PG8_STAGE(PG8_SA(0, 1), a2 + hstep, voffA);
            PG8_WAIT_L(8); PG8_BAR; PG8_WAIT_L(0); PG8_MMA(0, 0, At, B0); PG8_BAR; PG8_SCHED;
            PG8_LDB(B1, 1, 1); PG8_STAGE(PG8_SB(1, 0), b3, voffB);
            PG8_BAR; PG8_WAIT_L(0); PG8_MMA(0, 1, At, B1); PG8_BAR;
            PG8_LDA(At, 1, 1); PG8_STAGE(PG8_SA(1, 0), a3, voffA);
            PG8_BAR; PG8_WAIT_L(0); PG8_MMA(1, 0, At, B0); PG8_BAR; PG8_SCHED;
            PG8_STAGE(PG8_SB(1, 1), b3 + hstep, voffB);
            PG8_WAIT_V(6); PG8_BAR; PG8_MMA(1, 1, At, B1); PG8_BAR;
            }
        }
        if constexpr (ALIGN_EPI) { if (wr == 0) PG8_BAR; }
        if constexpr (!Epi::AFTER_DRAIN) { E(acc, cur, wr, wc, fr, fq); S.done(cur); }
        if (!has_next) break;
#pragma unroll
        for (int a = 0; a < 2; ++a)
#pragma unroll
            for (int b = 0; b < 2; ++b)
#pragma unroll
                for (int m = 0; m < 4; ++m)
#pragma unroll
                    for (int n = 0; n < 2; ++n) acc[a][b][m][n] = (f32x4){0.f, 0.f, 0.f, 0.f};
        cur = nxt; cA = nA; cB = nB; ++ui;
        if constexpr (ALIGN_EPI) { if (wr == 1) PG8_BAR; }
    }
    PG8_WAIT_V(0);
    if constexpr (!ALIGN_EPI) { if (wr == 0) PG8_BAR; }
    PG8_BAR;
    if constexpr (Epi::AFTER_DRAIN) { E.fused(acc, cur, wr, wc, fr, fq, lds, wid, lane); S.done(cur); }
#undef PG8_SA
#undef PG8_SB
#undef PG8_STAGE
#undef PG8_LDA
#undef PG8_LDB
#undef PG8_MMA
#undef PG8_WAIT_V
#undef PG8_WAIT_L
#undef PG8_BAR
#undef PG8_SCHED
}
}

constexpr int NWAVES = 8;
constexpr int BATCH = 8, SEQ = 2048, DM = 2048, M = BATCH * SEQ;
constexpr int NPROJ = 4608, PROJ_LD = 4352;
constexpr int DFF = 5632, DFFE = 7168, NE = 8;
constexpr int C_MQ = 0, C_MK = 256, C_MV = 512, C_MO = 1024, C_GQ = 1536, C_GK = 1792, C_GV = 2048, C_GG = 2560, C_AQ = 3072, C_AK = 4096, C_AV = 4224;
constexpr float EPS = 1e-6f;
constexpr int MAXROWS_S = M * 2 + NE * 256;

constexpr size_t MiB = 1u << 20;
constexpr size_t WS_CTL = 0, CTL_ZERO_BYTES = 65536;
constexpr size_t WS_MOD = 1 * MiB;
constexpr size_t WS_WIN = 2 * MiB;
constexpr size_t WS_WOUT = 38 * MiB;
constexpr size_t WS_WGU0 = 54 * MiB;
constexpr size_t WS_WDN0 = 98 * MiB;
constexpr size_t WS_WGU1 = 120 * MiB;
constexpr size_t WS_WDN1 = 568 * MiB;
constexpr size_t WS_XA = 792 * MiB;
constexpr size_t WS_XN = 920 * MiB;
constexpr size_t WS_Y = 984 * MiB;
constexpr size_t WS_SIDE = 1048 * MiB;
constexpr size_t WS_TOK = 1050 * MiB;
constexpr size_t WS_BIG = 1052 * MiB;
constexpr size_t WS_HID = WS_BIG;
constexpr size_t WS_AS = WS_BIG + 476 * MiB;
constexpr size_t WS_PROJ = WS_BIG;
constexpr size_t WS_QKC = WS_BIG + 144 * MiB;
constexpr size_t WS_LA = WS_BIG + 160 * MiB;
constexpr size_t WS_KN = WS_BIG + 176 * MiB;
constexpr size_t WS_UM = WS_BIG + 192 * MiB;
constexpr size_t WS_UG = WS_BIG + 212 * MiB;
constexpr size_t WS_GAUX = WS_BIG + 244 * MiB;
constexpr size_t WS_END = WS_BIG + 612 * MiB;
constexpr int TOK_E = 0, TOK_SLOT = 32768, TOK_W = 65536, TOK_POS = 98304;

constexpr int CW_TMO = 0, CW_CODE = 1, CW_BAR = 4096, CW_CNT = 8192;

constexpr int RING_OFF = 0, RING_BYTES = 131072;
constexpr int MISC_OFF = RING_BYTES;
constexpr int LDS_BYTES = 147456;

#define GAS __attribute__((address_space(1)))
#define LAS __attribute__((address_space(3)))
typedef unsigned short bf16;
typedef unsigned v4u __attribute__((ext_vector_type(4)));
typedef unsigned v2u __attribute__((ext_vector_type(2)));
typedef float f32x4 __attribute__((ext_vector_type(4)));
typedef short bf16x8 __attribute__((ext_vector_type(8)));
typedef GAS unsigned gu32;
#define RLX_AGENT __ATOMIC_RELAXED, __HIP_MEMORY_SCOPE_AGENT
#define LDS_WAIT() asm volatile("s_waitcnt lgkmcnt(0)" ::: "memory")
#define VM_WAIT() asm volatile("s_waitcnt vmcnt(0)" ::: "memory")
typedef float f32x2_t __attribute__((ext_vector_type(2)));
typedef __bf16 bf16x2_t __attribute__((ext_vector_type(2)));
__device__ __forceinline__ unsigned pk2(float lo, float hi) { const f32x2_t v = {lo, hi}; return __builtin_bit_cast(unsigned, __builtin_convertvector(v, bf16x2_t)); }
__device__ __forceinline__ unsigned f2bf(float f) { return pk2(f, 0.f) & 0xffffu; }
__device__ __forceinline__ float bflo(unsigned w) { return __builtin_bit_cast(float, w << 16); }
__device__ __forceinline__ float bfhi(unsigned w) { return __builtin_bit_cast(float, w & 0xffff0000u); }
__device__ __forceinline__ float bf1(bf16 b) { return __builtin_bit_cast(float, ((unsigned)b) << 16); }
__device__ __forceinline__ float wave_sum(float v) {
#pragma unroll
    for (int o = 1; o < 64; o <<= 1) v += __shfl_xor(v, o);
    return v;
}
__device__ __forceinline__ float sigmoidf_(float x) { return 1.0f / (1.0f + __expf(-x)); }
__device__ __forceinline__ float siluf_(float x) { return x / (1.0f + __expf(-x)); }
__device__ __forceinline__ float logsigmoidf_(float z) { return fminf(z, 0.f) - __logf(1.0f + __expf(-fabsf(z))); }

#ifndef FAST_SWA
#define FAST_SWA 1
#endif
#ifndef FAST_GLA
#define FAST_GLA 1
#endif
#ifndef FAST_MLSTM
#define FAST_MLSTM 1
#endif
#ifndef PROBE_REPEAT
#define PROBE_REPEAT -1
#endif
#define XB_TMO      128
#define XB_XCNT(j)  (256  + 64 * (j))
#define XB_XSUB(j)  (1280 + 64 * (j))
#define XB_XGEN(j)  (2304 + 64 * (j))
#define XB_TOP      3328
#define XB_TOPGEN   3392
#define XCD_BAR_WORDS 3456
#define XB_SPIN_CAP (1u << 18)

__device__ __forceinline__ unsigned xb_ld(unsigned* p)              { return __hip_atomic_load(p, __ATOMIC_RELAXED, __HIP_MEMORY_SCOPE_AGENT); }
__device__ __forceinline__ unsigned xb_add(unsigned* p, unsigned v) { return __hip_atomic_fetch_add(p, v, __ATOMIC_RELAXED, __HIP_MEMORY_SCOPE_AGENT); }
__device__ __forceinline__ unsigned xb_xcc_id() { return (unsigned)__builtin_amdgcn_s_getreg((3 << 11) | 20) & 0xFu; }
#define XB_SPIN(cond, bar) do { unsigned _sp = 0; while (cond) { __builtin_amdgcn_s_sleep(1); \
    if ((++_sp & 255u) == 0u) { if (xb_ld(&(bar)[XB_TMO])) break; if (_sp > XB_SPIN_CAP) { atomicAdd(&(bar)[XB_TMO], 1u); break; } } } } while (0)

struct XcdBarrier {
    unsigned* bar; unsigned x;
    volatile LAS unsigned* st;
};

__device__ __forceinline__ XcdBarrier xcd_barrier_post(unsigned* bar, volatile LAS unsigned* st) {
    XcdBarrier b; b.bar = bar; b.x = xb_xcc_id(); b.st = st;
    if (threadIdx.x == 0) (void)xb_add(&bar[XB_XCNT(b.x)], 1u);
    return b;
}
__device__ __forceinline__ void xcd_barrier_complete(unsigned* bar, unsigned x, unsigned& nloc, unsigned& nx) {
    const unsigned G = gridDim.x * gridDim.y * gridDim.z;
    unsigned sum, cnt, mine, sp = 0u;
    for (;;) {
        sum = 0u; cnt = 0u; mine = 0u;
#pragma unroll
        for (unsigned j = 0; j < 16; ++j) { const unsigned c = xb_ld(&bar[XB_XCNT(j)]); sum += c; cnt += (c > 0u) ? 1u : 0u; mine = (j == x) ? c : mine; }
        if (sum == G) break;
        __builtin_amdgcn_s_sleep(1);
        if ((++sp & 255u) == 0u) { if (xb_ld(&bar[XB_TMO])) break; if (sp > XB_SPIN_CAP) { atomicAdd(&bar[XB_TMO], 1u); break; } }
    }
    nloc = mine > 0u ? mine : 1u; nx = cnt > 0u ? cnt : 1u;
}

__device__ __forceinline__ void xcd_barrier(const XcdBarrier& b) {
    asm volatile("s_waitcnt vmcnt(0)" ::: "memory");
    __syncthreads();
    if (threadIdx.x == 0) {
        unsigned* bar = b.bar;
        __builtin_amdgcn_s_waitcnt(0);
        unsigned nloc = b.st[0], nx = b.st[1];
        if (nloc == 0u) { xcd_barrier_complete(bar, b.x, nloc, nx); b.st[0] = nloc; b.st[1] = nx; }
        const unsigned old = xb_add(&bar[XB_XSUB(b.x)], 1u);
        const unsigned gen = old / nloc;
        if (old + 1u == (gen + 1u) * nloc) {
            __builtin_amdgcn_fence(__ATOMIC_RELEASE, "agent");
            asm volatile("s_waitcnt vmcnt(0)" ::: "memory");
            const unsigned og = xb_add(&bar[XB_TOP], 1u);
            const unsigned tg = og / nx;
            if (og + 1u == (tg + 1u) * nx) xb_add(&bar[XB_TOPGEN], 1u);
            else XB_SPIN(xb_ld(&bar[XB_TOPGEN]) == tg, bar);
            __builtin_amdgcn_fence(__ATOMIC_ACQUIRE, "agent");
            xb_add(&bar[XB_XGEN(b.x)], 1u);
            asm volatile("s_waitcnt vmcnt(0)" ::: "memory");
        } else {
            XB_SPIN(xb_ld(&bar[XB_XGEN(b.x)]) == gen, bar);
            __builtin_amdgcn_fence(__ATOMIC_ACQUIRE, "agent");
            asm volatile("s_waitcnt vmcnt(0)" ::: "memory");
        }
    }
    __syncthreads();
}

typedef const float* cfp;
typedef __attribute__((address_space(4))) cfp cfp_k;
struct Frame {
    LAS unsigned char* lds;
    gu32* ctl;
    int tid, lane, wave, vcu, G;
    cfp_k* in;
    float* out; unsigned char* ws;
};
#define IN_X 0
#define IN_C 1
#define IN_WADA 2
#define IN_BADA 3
#define IN_GMIX 4
#define IN_GFFN 5
#define IN_WIN 6
#define IN_BGATES 7
#define IN_WCONV 8
#define IN_BCONV 9
#define IN_GOUTM 10
#define IN_WDEC 11
#define IN_BDEC 12
#define IN_GOUTG 13
#define IN_GQN 14
#define IN_GKN 15
#define IN_SINKS 16
#define IN_RELB 17
#define IN_WOUT 18
#define IN_WFG 19
#define IN_WFU 20
#define IN_WFD 21
#define IN_WROUTER 22
#define IN_WMG 23
#define IN_WMU 24
#define IN_WMD 25

__device__ __forceinline__ int rowmap(int kind, int off, int n) {
    if (kind == 0) return off + n;
    if (kind == 1) return off + ((n >> 7) << 8) + (n & 127);
    if (n < 1536) return n; if (n < 1544) return 4352 + (n - 1536); if (n < 3080) return n - 8; if (n < 3096) return 4360 + (n - 3080); return n - 24;
}
__device__ __forceinline__ void transpose_item(const float* W, int N, bf16* WT, int ldt, int kind, int off, int item, int lane) {
    const int nblk = (N + 63) >> 6, kb = item / nblk, nb = item - kb * nblk, k0 = 64 * kb + 8 * (lane & 7), n = 64 * nb + 4 * (lane >> 3);
    const f32x4* src = (const f32x4*)(W + (size_t)k0 * N + n);
    f32x4 v[2][8];
#pragma unroll
    for (int hh = 0; hh < 2; ++hh) { if (n + 32 * hh < N) {
#pragma unroll
        for (int j = 0; j < 8; ++j) v[hh][j] = __builtin_nontemporal_load(src + (size_t)j * (N >> 2) + 8 * hh); } }
#pragma unroll
    for (int hh = 0; hh < 2; ++hh) { if (n + 32 * hh < N) {
#pragma unroll
        for (int i = 0; i < 4; ++i) { v4u o; o.x = pk2(v[hh][0][i], v[hh][1][i]); o.y = pk2(v[hh][2][i], v[hh][3][i]); o.z = pk2(v[hh][4][i], v[hh][5][i]); o.w = pk2(v[hh][6][i], v[hh][7][i]);
            *(v4u*)(WT + (size_t)rowmap(kind, off, n + 32 * hh + i) * ldt + k0) = o; } } }
}
__device__ __forceinline__ void transpose_item_f8(const float* W, int N, unsigned char* WT, int ldt, int kind, int off, int item, int lane, float scale) {
    const int nblk = (N + 63) >> 6, kb = item / nblk, nb = item - kb * nblk, k0 = 128 * kb + 16 * (lane & 3), n = 64 * nb + 4 * (lane >> 2);
    if (n >= N) return;
    const f32x4* src = (const f32x4*)(W + (size_t)k0 * N + n);
    f32x4 v[2][16];
#pragma unroll
    for (int hh = 0; hh < 2; ++hh)
#pragma unroll
        for (int j = 0; j < 16; ++j) v[hh][j] = __builtin_nontemporal_load(src + (size_t)(64 * hh + j) * (N >> 2));
#pragma unroll
    for (int hh = 0; hh < 2; ++hh)
#pragma unroll
        for (int i = 0; i < 4; ++i) { v4u o; o.x = pg8::pk4_fp8(v[hh][0][i] * scale, v[hh][1][i] * scale, v[hh][2][i] * scale, v[hh][3][i] * scale); o.y = pg8::pk4_fp8(v[hh][4][i] * scale, v[hh][5][i] * scale, v[hh][6][i] * scale, v[hh][7][i] * scale);
            o.z = pg8::pk4_fp8(v[hh][8][i] * scale, v[hh][9][i] * scale, v[hh][10][i] * scale, v[hh][11][i] * scale); o.w = pg8::pk4_fp8(v[hh][12][i] * scale, v[hh][13][i] * scale, v[hh][14][i] * scale, v[hh][15][i] * scale);
            __builtin_nontemporal_store(o, (v4u*)(WT + (size_t)rowmap(kind, off, n + i) * ldt + k0 + 64 * hh)); }
}
constexpr int MOE_ITEMS = 3 * 14336, MOE_TAILQ = 0;
__device__ __forceinline__ void moe_convert(Frame& F, int lo, int hi, int rank, int nrank) {
    for (int it = lo + rank; it < hi; it += nrank) {
        int r = it; const float* W; unsigned char* WT; int N, ldt, kind, off; float f8s;
        if (r < 14336) { const int e = r / 1792; r -= e * 1792; W = F.in[IN_WMG] + (size_t)e * 2048 * DFFE; N = DFFE; WT = F.ws + WS_WGU1 + (size_t)e * 14336 * 2048; ldt = 2048; kind = 1; off = 0; f8s = 32.f; }
        else if ((r -= 14336) < 14336) { const int e = r / 1792; r -= e * 1792; W = F.in[IN_WMU] + (size_t)e * 2048 * DFFE; N = DFFE; WT = F.ws + WS_WGU1 + (size_t)e * 14336 * 2048; ldt = 2048; kind = 1; off = 128; f8s = 256.f; }
        else { r -= 14336; const int e = r / 1792; r -= e * 1792; W = F.in[IN_WMD] + (size_t)e * DFFE * 2048; N = 2048; WT = F.ws + WS_WDN1 + (size_t)e * 2048 * DFFE; ldt = DFFE; kind = 0; off = 0; f8s = 64.f; }
        transpose_item_f8(W, N, WT, ldt, kind, off, r, F.lane, f8s);
    }
}
__device__ __forceinline__ void p0_prologue(Frame& F) {
    __syncthreads();
    {
        LAS float* cond = (LAS float*)(F.lds + RING_OFF);
        LAS float* red = (LAS float*)(F.lds + RING_OFF + 65536);
        float* mod = (float*)(F.ws + WS_MOD);
        bool have = false;
        for (int it = F.vcu; it < 192; it += F.G) {
            if (!have) { for (int i = F.tid; i < 8 * 2048; i += NWAVES * 64) { const float cv = F.in[IN_C][i]; cond[i] = cv / (1.0f + expf(-cv)); } have = true; }
            __syncthreads();
            const int l = it / 96, cg = it % 96, c4 = F.tid & 31, dp = F.tid >> 5;
            f32x4 acc[8];
#pragma unroll
            for (int b = 0; b < 8; ++b) acc[b] = (f32x4){0.f, 0.f, 0.f, 0.f};
            const f32x4* wp = (const f32x4*)(F.in[IN_WADA] + (size_t)l * 2048 * 12288 + (size_t)(dp * 128) * 12288 + cg * 128 + 4 * c4);
            const LAS float* cp = cond + dp * 128;
#pragma unroll 8
            for (int d = 0; d < 128; ++d) { const f32x4 w = __builtin_nontemporal_load(wp + (size_t)d * 3072);
#pragma unroll
                for (int b = 0; b < 8; ++b) acc[b] += w * cp[b * 2048 + d]; }
#pragma unroll
            for (int b = 0; b < 8; ++b) *(LAS f32x4*)(red + (dp * 8 + b) * 128 + 4 * c4) = acc[b];
            __syncthreads();
            for (int i = F.tid; i < 8 * 128; i += NWAVES * 64) { const int b = i >> 7, cc = i & 127; float s = 0.f;
#pragma unroll
                for (int q = 0; q < 16; ++q) s += red[(q * 8 + b) * 128 + cc];
                mod[(size_t)(l * 8 + b) * 12288 + cg * 128 + cc] = s + F.in[IN_BADA][l * 12288 + cg * 128 + cc]; }
        }
        __syncthreads();
    }
    const int gw = F.vcu * NWAVES + F.wave, NGW = F.G * NWAVES;
    constexpr int NITEMS = 4416 + 2048 + 3 * 2816;
    for (int it = gw; it < NITEMS; it += NGW) {
        int r = it; const float* W; bf16* WT; int N, ldt, kind, off;
        if (r < 4416) { const int l = r / 2208; r -= l * 2208; W = F.in[IN_WIN] + (size_t)l * 2048 * 4376; N = 4376; WT = (bf16*)(F.ws + WS_WIN) + (size_t)l * NPROJ * 2048; ldt = 2048; kind = 2; off = 0; }
        else if ((r -= 4416) < 2048) { const int l = r / 1024; r -= l * 1024; W = F.in[IN_WOUT] + (size_t)l * 2048 * 2048; N = 2048; WT = (bf16*)(F.ws + WS_WOUT) + (size_t)l * 2048 * 2048; ldt = 2048; kind = 0; off = 0; }
        else if ((r -= 2048) < 2816) { W = F.in[IN_WFG]; N = DFF; WT = (bf16*)(F.ws + WS_WGU0); ldt = 2048; kind = 1; off = 0; }
        else if ((r -= 2816) < 2816) { W = F.in[IN_WFU]; N = DFF; WT = (bf16*)(F.ws + WS_WGU0); ldt = 2048; kind = 1; off = 128; }
        else { r -= 2816; W = F.in[IN_WFD]; N = 2048; WT = (bf16*)(F.ws + WS_WDN0); ldt = DFF; kind = 0; off = 0; }
        transpose_item(W, N, WT, ldt, kind, off, r, F.lane);
    }
    moe_convert(F, 0, MOE_ITEMS - 2 * MOE_TAILQ, gw, NGW);
    for (int i = gw; i < 2 * 232; i += NGW) { const int l = i / 232, rr = 4376 + i % 232; v4u* p = (v4u*)((bf16*)(F.ws + WS_WIN) + ((size_t)l * NPROJ + rr) * 2048);
#pragma unroll
        for (int j = 0; j < 4; ++j) p[F.lane + 64 * j] = (v4u){0u, 0u, 0u, 0u}; }
}

template <bool ROUTER>
__device__ __forceinline__ void norm_phase(Frame& F, const float* xin, const float* g, const float* modl, int sh_off, int sc_off) {
    bf16* XN = (bf16*)(F.ws + WS_XN);
    const int gw = F.vcu * NWAVES + F.wave, NGW = F.G * NWAVES;
    LAS float* wrT = (LAS float*)(F.lds + RING_OFF);
    LAS int* lcnt = (LAS int*)(F.lds + MISC_OFF + 1152);
    LAS int* lbase = (LAS int*)(F.lds + MISC_OFF + 1216);
    LAS int* rtab = (LAS int*)(F.lds + MISC_OFF + 2048);
    int nrow = 0;
    if (ROUTER) {
        for (int i = F.tid; i < 2048 * 8; i += NWAVES * 64) wrT[(i & 7) * 2048 + (i >> 3)] = F.in[IN_WROUTER][i];
        if (F.tid < 8) lcnt[F.tid] = 0;
        __syncthreads();
    }
    for (int m = gw; m < M; m += NGW, ++nrow) {
        const int b = m >> 11;
        const f32x4* xr = (const f32x4*)(xin + (size_t)m * DM) + F.lane;
        f32x4 v[8]; float ss = 0.f;
#pragma unroll
        for (int j = 0; j < 8; ++j) { v[j] = xr[64 * j]; ss += (v[j].x * v[j].x + v[j].y * v[j].y) + (v[j].z * v[j].z + v[j].w * v[j].w); }
        const float rstd = 1.0f / sqrtf(wave_sum(ss) * (1.0f / DM) + EPS);
        const f32x4* gp = (const f32x4*)g + F.lane; const f32x4* scp = (const f32x4*)(modl + (size_t)b * 12288 + sc_off) + F.lane; const f32x4* shp = (const f32x4*)(modl + (size_t)b * 12288 + sh_off) + F.lane;
        v2u* o8 = (v2u*)(XN + (size_t)m * DM) + F.lane;
#pragma unroll
        for (int j = 0; j < 8; ++j) { const f32x4 gg = gp[64 * j], sc = scp[64 * j], sh = shp[64 * j];
            v[j] = v[j] * rstd * gg * (sc + 1.0f) + sh;
            if (ROUTER) ((unsigned*)((unsigned char*)XN + (size_t)m * DM))[F.lane + 64 * j] = pg8::pk4_fp8(v[j].x, v[j].y, v[j].z, v[j].w);
            else { v2u w; w.x = pk2(v[j].x, v[j].y); w.y = pk2(v[j].z, v[j].w); o8[64 * j] = w; } }
        if (ROUTER) {
            float lg[8];
#pragma unroll
            for (int e = 0; e < 8; ++e) { float p = 0.f; const LAS f32x4* wp = (const LAS f32x4*)(wrT + e * 2048) + F.lane;
#pragma unroll
                for (int j = 0; j < 8; ++j) { const f32x4 w = wp[64 * j]; p += (v[j].x * w.x + v[j].y * w.y) + (v[j].z * w.z + v[j].w * w.w); }
                lg[e] = wave_sum(p); }
            int e1 = 0; float v1 = lg[0];
#pragma unroll
            for (int e = 1; e < 8; ++e) if (lg[e] > v1) { v1 = lg[e]; e1 = e; }
            int e2 = -1; float v2 = -3.0e38f;
#pragma unroll
            for (int e = 0; e < 8; ++e) if (e != e1 && lg[e] > v2) { v2 = lg[e]; e2 = e; }
            const float w1 = 1.0f / (1.0f + expf(v2 - v1)), w2 = 1.0f - w1;
            if (F.lane == 0) {
                const int r1 = atomicAdd((int*)(lcnt + e1), 1), r2 = atomicAdd((int*)(lcnt + e2), 1);
                LAS int* en = rtab + (F.wave * 16 + nrow) * 8;
                en[0] = m; en[1] = e1; en[2] = r1; en[3] = __builtin_bit_cast(int, w1); en[4] = m; en[5] = e2; en[6] = r2; en[7] = __builtin_bit_cast(int, w2);
            }
        }
    }
    if (ROUTER) {
        __syncthreads();
        if (F.tid < 8) lbase[F.tid] = (int)__hip_atomic_fetch_add((unsigned*)(F.ctl + CW_CNT + 64 * F.tid), (unsigned)lcnt[F.tid], RLX_AGENT);
        __syncthreads();
        int* tk = (int*)(F.ws + WS_TOK);
        const int per = (M + NGW - 1) / NGW;
        for (int i = F.tid; i < NWAVES * per * 2; i += NWAVES * 64) { const int w = i / (per * 2), rr = (i % (per * 2)) >> 1, k = i & 1;
            const int mrow = F.vcu * NWAVES + w + rr * NGW; if (mrow >= M) continue;
            const LAS int* en = rtab + (w * 16 + rr) * 8 + 4 * k;
            const int t = en[0], e = en[1];
            tk[TOK_E + t * 2 + k] = e; tk[TOK_SLOT + t * 2 + k] = lbase[e] + en[2]; tk[TOK_W + t * 2 + k] = en[3]; }
    }
}

__device__ const unsigned char T5_BUCKET[128] = {0, 1, 2, 3, 4, 5, 6, 7, 8, 9, 10, 11, 12, 13, 14, 15, 16, 16, 16, 17, 17, 18, 18, 18, 19, 19, 19, 20, 20, 20, 20, 21, 21, 21, 21, 22, 22, 22, 22, 22, 23, 23, 23, 23, 23, 23, 24, 24, 24, 24, 24, 24, 25, 25, 25, 25, 25, 25, 25, 26, 26, 26, 26, 26, 26, 26, 26, 27, 27, 27, 27, 27, 27, 27, 27, 27, 27, 28, 28, 28, 28, 28, 28, 28, 28, 28, 28, 29, 29, 29, 29, 29, 29, 29, 29, 29, 29, 29, 29, 30, 30, 30, 30, 30, 30, 30, 30, 30, 30, 30, 30, 30, 30, 31, 31, 31, 31, 31, 31, 31, 31, 31, 31, 31, 31, 31, 31, 31};

__device__ __forceinline__ void mix_prep(Frame& F, int l) {
    const bf16* proj = (const bf16*)(F.ws + WS_PROJ); const float* side = (const float*)(F.ws + WS_SIDE);
    bf16* qkc = (bf16*)(F.ws + WS_QKC); float* la = (float*)(F.ws + WS_LA); bf16* kn = (bf16*)(F.ws + WS_KN);
    const int gw = F.vcu * NWAVES + F.wave, NGW = F.G * NWAVES, lane = F.lane;
    const float* wc = F.in[IN_WCONV] + l * 4 * 512; const float* bc = F.in[IN_BCONV] + l * 512;
    const float* wd = F.in[IN_WDEC] + l * 16 * 256; const float* bd = F.in[IN_BDEC] + l * 256; const float* gk = F.in[IN_GKN] + l * 64;
    for (int m = gw; m < M; m += NGW) {
        const int pos = m & (SEQ - 1);
        {
            float y[8]; const int ch = lane * 8;
            { const f32x4 b0 = *(const f32x4*)(bc + ch), b1 = *(const f32x4*)(bc + ch + 4); y[0] = b0.x; y[1] = b0.y; y[2] = b0.z; y[3] = b0.w; y[4] = b1.x; y[5] = b1.y; y[6] = b1.z; y[7] = b1.w; }
#pragma unroll
            for (int i = 0; i < 4; ++i) { if (pos - 3 + i >= 0) {
                const v4u xv = *(const v4u*)(proj + (size_t)(m - 3 + i) * PROJ_LD + ch);
                const f32x4 w0 = *(const f32x4*)(wc + i * 512 + ch), w1 = *(const f32x4*)(wc + i * 512 + ch + 4);
                y[0] += w0.x * bflo(xv.x); y[1] += w0.y * bfhi(xv.x); y[2] += w0.z * bflo(xv.y); y[3] += w0.w * bfhi(xv.y);
                y[4] += w1.x * bflo(xv.z); y[5] += w1.y * bfhi(xv.z); y[6] += w1.z * bflo(xv.w); y[7] += w1.w * bfhi(xv.w); } }
            const float sc = ch >= 256 ? 0.125f : 1.0f;
#pragma unroll
            for (int i = 0; i < 8; ++i) y[i] = siluf_(y[i]) * sc;
            v4u o; o.x = pk2(y[0], y[1]); o.y = pk2(y[2], y[3]); o.z = pk2(y[4], y[5]); o.w = pk2(y[6], y[7]);
            *(v4u*)(qkc + (size_t)m * 512 + ch) = o;
        }
        {
            const int c = lane * 4; f32x4 z = *(const f32x4*)(bd + c);
            const f32x4* gp = (const f32x4*)(side + (size_t)m * 32 + 8);
            const f32x4 g0 = gp[0], g1 = gp[1], g2 = gp[2], g3 = gp[3];
            const float ga[16] = {g0.x, g0.y, g0.z, g0.w, g1.x, g1.y, g1.z, g1.w, g2.x, g2.y, g2.z, g2.w, g3.x, g3.y, g3.z, g3.w};
#pragma unroll
            for (int r = 0; r < 16; ++r) { const f32x4 w = *(const f32x4*)(wd + r * 256 + c); z += w * ga[r]; }
            f32x4 o; o.x = logsigmoidf_(z.x) * 0.0625f; o.y = logsigmoidf_(z.y) * 0.0625f; o.z = logsigmoidf_(z.z) * 0.0625f; o.w = logsigmoidf_(z.w) * 0.0625f;
            *(f32x4*)(la + (size_t)m * 256 + c) = o;
        }
        {
            const unsigned kv = *(const unsigned*)(proj + (size_t)m * PROJ_LD + C_AK + 2 * lane);
            const float k0 = bflo(kv), k1 = bfhi(kv); float ss = k0 * k0 + k1 * k1;
#pragma unroll
            for (int o = 1; o < 32; o <<= 1) ss += __shfl_xor(ss, o);
            const float rstd = 1.0f / sqrtf(ss * (1.0f / 64.0f) + EPS);
            *(unsigned*)(kn + (size_t)m * 128 + 2 * lane) = pk2(k0 * rstd * gk[(2 * lane) & 63], k1 * rstd * gk[(2 * lane + 1) & 63]);
        }
    }
}

__device__ __forceinline__ void naive_mlstm(Frame& F, int l, int bh) {
    const int b = bh >> 2, h = bh & 3, tid = F.tid, v = tid >> 2, kq = tid & 3;
    const bf16* proj = (const bf16*)(F.ws + WS_PROJ); const float* side = (const float*)(F.ws + WS_SIDE); const bf16* qkc = (const bf16*)(F.ws + WS_QKC);
    bf16* Y = (bf16*)(F.ws + WS_Y);
    LAS float* red = (LAS float*)(F.lds + RING_OFF);
    const float bi = F.in[IN_BGATES][l * 8 + h], bfg = F.in[IN_BGATES][l * 8 + 4 + h];
    const float gout = F.in[IN_GOUTM][l * 512 + h * 128 + v];
    float C[16], n[16]; float mst = 0.f;
#pragma unroll
    for (int i = 0; i < 16; ++i) { C[i] = 0.f; n[i] = 0.f; }
    for (int t = 0; t < SEQ; ++t) {
        const size_t row = (size_t)b * SEQ + t;
        const v4u q0 = *(const v4u*)(qkc + row * 512 + h * 64 + kq * 16), q1 = *(const v4u*)(qkc + row * 512 + h * 64 + kq * 16 + 8);
        const v4u k0 = *(const v4u*)(qkc + row * 512 + 256 + h * 64 + kq * 16), k1 = *(const v4u*)(qkc + row * 512 + 256 + h * 64 + kq * 16 + 8);
        const float q[16] = {bflo(q0.x), bfhi(q0.x), bflo(q0.y), bfhi(q0.y), bflo(q0.z), bfhi(q0.z), bflo(q0.w), bfhi(q0.w), bflo(q1.x), bfhi(q1.x), bflo(q1.y), bfhi(q1.y), bflo(q1.z), bfhi(q1.z), bflo(q1.w), bfhi(q1.w)};
        const float k[16] = {bflo(k0.x), bfhi(k0.x), bflo(k0.y), bfhi(k0.y), bflo(k0.z), bfhi(k0.z), bflo(k0.w), bfhi(k0.w), bflo(k1.x), bfhi(k1.x), bflo(k1.y), bfhi(k1.y), bflo(k1.z), bfhi(k1.z), bflo(k1.w), bfhi(k1.w)};
        const float vv = bf1(proj[row * PROJ_LD + C_MV + h * 128 + v]);
        const float ip = side[row * 32 + h] + bi, lf = logsigmoidf_(side[row * 32 + 4 + h] + bfg);
        const float mn = fmaxf(lf + mst, ip), fd = expf(lf + mst - mn), iw = expf(ip - mn); mst = mn;
        float num = 0.f, den = 0.f;
#pragma unroll
        for (int i = 0; i < 16; ++i) { C[i] = fd * C[i] + (iw * vv) * k[i]; n[i] = fd * n[i] + iw * k[i]; num += C[i] * q[i]; den += n[i] * q[i]; }
        num += __shfl_xor(num, 1); num += __shfl_xor(num, 2); den += __shfl_xor(den, 1); den += __shfl_xor(den, 2);
        const float hv = num / fmaxf(fabsf(den), expf(-mst));
        const float s2 = wave_sum(kq == 0 ? hv * hv : 0.f);
        if (F.lane == 0) red[(t & 1) * 8 + F.wave] = s2;
        __syncthreads();
        float tot = 0.f;
#pragma unroll
        for (int w = 0; w < 8; ++w) tot += red[(t & 1) * 8 + w];
        const float rstd = 1.0f / sqrtf(tot * (1.0f / 128.0f) + EPS);
        if (kq == 0) { const float mo = bf1(proj[row * PROJ_LD + C_MO + h * 128 + v]);
            Y[row * DM + h * 128 + v] = (bf16)f2bf(hv * rstd * gout * sigmoidf_(mo)); }
    }
    __syncthreads();
}
__device__ __forceinline__ void naive_gla(Frame& F, int l, int bh) {
    const int b = bh >> 2, h = bh & 3, tid = F.tid, v = tid >> 2, kq = tid & 3;
    const bf16* proj = (const bf16*)(F.ws + WS_PROJ); const float* la = (const float*)(F.ws + WS_LA);
    bf16* Y = (bf16*)(F.ws + WS_Y);
    LAS float* red = (LAS float*)(F.lds + RING_OFF);
    const float gout = F.in[IN_GOUTG][l * 512 + h * 128 + v];
    float S[16];
#pragma unroll
    for (int i = 0; i < 16; ++i) S[i] = 0.f;
    for (int t = 0; t < SEQ; ++t) {
        const size_t row = (size_t)b * SEQ + t;
        const v4u q0 = *(const v4u*)(proj + row * PROJ_LD + C_GQ + h * 64 + kq * 16), q1 = *(const v4u*)(proj + row * PROJ_LD + C_GQ + h * 64 + kq * 16 + 8);
        const v4u k0 = *(const v4u*)(proj + row * PROJ_LD + C_GK + h * 64 + kq * 16), k1 = *(const v4u*)(proj + row * PROJ_LD + C_GK + h * 64 + kq * 16 + 8);
        const float q[16] = {bflo(q0.x), bfhi(q0.x), bflo(q0.y), bfhi(q0.y), bflo(q0.z), bfhi(q0.z), bflo(q0.w), bfhi(q0.w), bflo(q1.x), bfhi(q1.x), bflo(q1.y), bfhi(q1.y), bflo(q1.z), bfhi(q1.z), bflo(q1.w), bfhi(q1.w)};
        const float k[16] = {bflo(k0.x), bfhi(k0.x), bflo(k0.y), bfhi(k0.y), bflo(k0.z), bfhi(k0.z), bflo(k0.w), bfhi(k0.w), bflo(k1.x), bfhi(k1.x), bflo(k1.y), bfhi(k1.y), bflo(k1.z), bfhi(k1.z), bflo(k1.w), bfhi(k1.w)};
        const f32x4* lp = (const f32x4*)(la + row * 256 + h * 64 + kq * 16);
        const f32x4 a0 = lp[0], a1 = lp[1], a2 = lp[2], a3 = lp[3];
        const float a[16] = {a0.x, a0.y, a0.z, a0.w, a1.x, a1.y, a1.z, a1.w, a2.x, a2.y, a2.z, a2.w, a3.x, a3.y, a3.z, a3.w};
        const float vv = bf1(proj[row * PROJ_LD + C_GV + h * 128 + v]);
        float o = 0.f;
#pragma unroll
        for (int i = 0; i < 16; ++i) { S[i] = expf(a[i]) * S[i] + k[i] * vv; o += (q[i] * 0.125f) * S[i]; }
        o += __shfl_xor(o, 1); o += __shfl_xor(o, 2);
        const float s2 = wave_sum(kq == 0 ? o * o : 0.f);
        if (F.lane == 0) red[(t & 1) * 8 + F.wave] = s2;
        __syncthreads();
        float tot = 0.f;
#pragma unroll
        for (int w = 0; w < 8; ++w) tot += red[(t & 1) * 8 + w];
        const float rstd = 1.0f / sqrtf(tot * (1.0f / 128.0f) + EPS);
        if (kq == 0) { const float gg = bf1(proj[row * PROJ_LD + C_GG + h * 128 + v]);
            Y[row * DM + 512 + h * 128 + v] = (bf16)f2bf(o * rstd * gout * siluf_(gg)); }
    }
    __syncthreads();
}
__device__ __forceinline__ void naive_swa(Frame& F, int l, int blk) {
    const int tid = F.tid, hq = tid & 15, row = blk * 32 + (tid >> 4), kvh = hq >> 3, pos = row & (SEQ - 1);
    const bf16* proj = (const bf16*)(F.ws + WS_PROJ); const bf16* kn = (const bf16*)(F.ws + WS_KN); bf16* Y = (bf16*)(F.ws + WS_Y);
    const float* gq = F.in[IN_GQN] + l * 64; const float* relb = F.in[IN_RELB];
    float q[64], o[64];
    { float ss = 0.f;
#pragma unroll
      for (int c = 0; c < 8; ++c) { const v4u x = *(const v4u*)(proj + (size_t)row * PROJ_LD + C_AQ + hq * 64 + 8 * c);
          q[8 * c + 0] = bflo(x.x); q[8 * c + 1] = bfhi(x.x); q[8 * c + 2] = bflo(x.y); q[8 * c + 3] = bfhi(x.y); q[8 * c + 4] = bflo(x.z); q[8 * c + 5] = bfhi(x.z); q[8 * c + 6] = bflo(x.w); q[8 * c + 7] = bfhi(x.w); }
#pragma unroll
      for (int d = 0; d < 64; ++d) ss += q[d] * q[d];
      const float rstd = 1.0f / sqrtf(ss * (1.0f / 64.0f) + EPS);
#pragma unroll
      for (int d = 0; d < 64; ++d) { q[d] = q[d] * rstd * gq[d] * 0.125f; o[d] = 0.f; } }
    float mx = F.in[IN_SINKS][l * 16 + hq], den = 1.0f;
    const int s0 = pos - 127 < 0 ? 0 : pos - 127;
    for (int s = s0; s <= pos; ++s) {
        const size_t kr = (size_t)(row - pos + s);
        float dot = 0.f;
#pragma unroll
        for (int c = 0; c < 8; ++c) { const v4u x = *(const v4u*)(kn + kr * 128 + kvh * 64 + 8 * c);
            dot += q[8 * c + 0] * bflo(x.x) + q[8 * c + 1] * bfhi(x.x) + q[8 * c + 2] * bflo(x.y) + q[8 * c + 3] * bfhi(x.y) + q[8 * c + 4] * bflo(x.z) + q[8 * c + 5] * bfhi(x.z) + q[8 * c + 6] * bflo(x.w) + q[8 * c + 7] * bfhi(x.w); }
        const float sc = dot + relb[T5_BUCKET[pos - s] * 16 + hq];
        const float mn = fmaxf(mx, sc), corr = expf(mx - mn), p = expf(sc - mn); mx = mn; den = den * corr + p;
#pragma unroll
        for (int c = 0; c < 8; ++c) { const v4u x = *(const v4u*)(proj + kr * PROJ_LD + C_AV + kvh * 64 + 8 * c);
            o[8 * c + 0] = o[8 * c + 0] * corr + p * bflo(x.x); o[8 * c + 1] = o[8 * c + 1] * corr + p * bfhi(x.x); o[8 * c + 2] = o[8 * c + 2] * corr + p * bflo(x.y); o[8 * c + 3] = o[8 * c + 3] * corr + p * bfhi(x.y);
            o[8 * c + 4] = o[8 * c + 4] * corr + p * bflo(x.z); o[8 * c + 5] = o[8 * c + 5] * corr + p * bfhi(x.z); o[8 * c + 6] = o[8 * c + 6] * corr + p * bflo(x.w); o[8 * c + 7] = o[8 * c + 7] * corr + p * bfhi(x.w); }
    }
    const float inv = 1.0f / den;
#pragma unroll
    for (int c = 0; c < 8; ++c) { v4u w; w.x = pk2(o[8 * c] * inv, o[8 * c + 1] * inv); w.y = pk2(o[8 * c + 2] * inv, o[8 * c + 3] * inv); w.z = pk2(o[8 * c + 4] * inv, o[8 * c + 5] * inv); w.w = pk2(o[8 * c + 6] * inv, o[8 * c + 7] * inv);
        *(v4u*)(Y + (size_t)row * DM + 1024 + hq * 64 + 8 * c) = w; }
}
__device__ __forceinline__ void mix_naive(Frame& F, int l) {
    for (int u = F.vcu; u < 64 + 512; u += F.G) {
        if (u < 32) { if (!FAST_MLSTM) naive_mlstm(F, l, u); }
        else if (u < 64) { if (!FAST_GLA) naive_gla(F, l, u - 32); }
        else { if (!FAST_SWA) naive_swa(F, l, u - 64); }
    }
}

__device__ __forceinline__ int moe_tables(Frame& F) {
    LAS int* seg = (LAS int*)(F.lds + MISC_OFF + 1024); LAS int* tile_e = (LAS int*)(F.lds + MISC_OFF + 64);
    if (F.tid == 0) { int s = 0;
        for (int e = 0; e < 8; ++e) { seg[e] = s; const int c = (int)__hip_atomic_load(F.ctl + CW_CNT + 64 * e, RLX_AGENT); const int nt = (c + 255) >> 8; for (int i = 0; i < nt; ++i) tile_e[(s >> 8) + i] = e; s += nt << 8; }
        seg[8] = s; }
    __syncthreads();
    return seg[8] >> 8;
}
__device__ __forceinline__ void moe_gather(Frame& F) {
    (void)moe_tables(F);
    const LAS int* seg = (const LAS int*)(F.lds + MISC_OFF + 1024);
    const int gw = F.vcu * NWAVES + F.wave, NGW = F.G * NWAVES;
    int* tk = (int*)(F.ws + WS_TOK); const unsigned char* XN = (const unsigned char*)(F.ws + WS_XN); unsigned char* AS = (unsigned char*)(F.ws + WS_AS);
    for (int m = gw; m < M; m += NGW) {
        const v4u* src = (const v4u*)(XN + (size_t)m * DM) + F.lane; v4u r[2];
#pragma unroll
        for (int j = 0; j < 2; ++j) r[j] = src[64 * j];
#pragma unroll
        for (int k = 0; k < 2; ++k) { const int e = tk[TOK_E + m * 2 + k], dest = seg[e] + tk[TOK_SLOT + m * 2 + k];
            v4u* dst = (v4u*)(AS + (size_t)dest * DM) + F.lane;
#pragma unroll
            for (int j = 0; j < 2; ++j) dst[64 * j] = r[j];
            if (F.lane == 0) tk[TOK_POS + m * 2 + k] = dest; }
    }
    for (int e = 0; e < 8; ++e) { const int c = (int)__hip_atomic_load(F.ctl + CW_CNT + 64 * e, RLX_AGENT);
        for (int r = seg[e] + c + gw; r < seg[e + 1]; r += NGW) { v4u* dst = (v4u*)(AS + (size_t)r * DM) + F.lane;
#pragma unroll
            for (int j = 0; j < 2; ++j) dst[64 * j] = (v4u){0u, 0u, 0u, 0u}; } }
}
template <int MODE>
__device__ __forceinline__ void moe_combine(Frame& F, const float* gtf, int rank, int nrank, const LAS int* late) {
    const int gw = rank, NGW = nrank;
    const int* tk = (const int*)(F.ws + WS_TOK); const float* xa = (const float*)(F.ws + WS_XA); const bf16* YS = (const bf16*)(F.ws + WS_AS);
    for (int m = gw; m < M; m += NGW) {
        const int b = m >> 11, p1 = tk[TOK_POS + 2 * m], p2 = tk[TOK_POS + 2 * m + 1];
        if (MODE != 0) { const bool is_late = (late[p1 >> 8] | late[p2 >> 8]) != 0; if ((MODE == 1) == is_late) continue; }
        const float w1 = __builtin_bit_cast(float, tk[TOK_W + 2 * m]), w2 = __builtin_bit_cast(float, tk[TOK_W + 2 * m + 1]);
        const f32x4* xr = (const f32x4*)(xa + (size_t)m * DM) + F.lane; const f32x4* gp = (const f32x4*)(gtf + (size_t)b * 12288) + F.lane;
        const v2u* y1 = (const v2u*)(YS + (size_t)p1 * DM) + F.lane; const v2u* y2 = (const v2u*)(YS + (size_t)p2 * DM) + F.lane;
        f32x4* op = (f32x4*)(F.out + (size_t)m * DM) + F.lane;
#pragma unroll
        for (int j = 0; j < 8; ++j) { const f32x4 x = xr[64 * j], g = gp[64 * j]; const v2u a = y1[64 * j], c = y2[64 * j];
            f32x4 y; y.x = w1 * bflo(a.x) + w2 * bflo(c.x); y.y = w1 * bfhi(a.x) + w2 * bfhi(c.x); y.z = w1 * bflo(a.y) + w2 * bflo(c.y); y.w = w1 * bfhi(a.y) + w2 * bfhi(c.y);
            op[64 * j] = x + g * y; }
    }
}

typedef short v4i16_t __attribute__((ext_vector_type(4)));
#define MFMA16(a, b, c) __builtin_amdgcn_mfma_f32_16x16x32_bf16((a), (b), (c), 0, 0, 0)
__device__ __forceinline__ bf16x8 frag_row(const LAS unsigned char* base, int ldb, int r0, int k0, int lane) {
    return *(const LAS bf16x8*)(base + (r0 + (lane & 15)) * ldb + (k0 + 8 * (lane >> 4)) * 2);
}
__device__ __forceinline__ bf16x8 frag_tr2(const LAS unsigned char* base, int ldb, int ra, int rb, int c0, int lane) {
    const int g = lane >> 4, q = (lane & 15) >> 2, p = lane & 3;
    const LAS unsigned char* a0 = base + (ra + 4 * g + q) * ldb + (c0 + 4 * p) * 2;
    const LAS unsigned char* a1 = base + (rb + 4 * g + q) * ldb + (c0 + 4 * p) * 2;
    const v4i16_t lo = __builtin_amdgcn_ds_read_tr16_b64_v4i16((LAS v4i16_t*)a0), hi = __builtin_amdgcn_ds_read_tr16_b64_v4i16((LAS v4i16_t*)a1);
    bf16x8 r; r[0] = lo[0]; r[1] = lo[1]; r[2] = lo[2]; r[3] = lo[3]; r[4] = hi[0]; r[5] = hi[1]; r[6] = hi[2]; r[7] = hi[3]; return r;
}
__device__ __forceinline__ bf16x8 frag_tr(const LAS unsigned char* base, int ldb, int k0, int c0, int lane) {
    const int g = lane >> 4;
    return frag_tr2(base, ldb, k0 + 4 * g, k0 + 4 * g + 4, c0, lane);
}
__device__ __forceinline__ bf16x8 pack8(float a, float b, float c, float d, float e, float f, float g, float h) {
    v4u w; w.x = pk2(a, b); w.y = pk2(c, d); w.z = pk2(e, f); w.w = pk2(g, h); return __builtin_bit_cast(bf16x8, w);
}
__device__ __forceinline__ float scan_add(float v, int lane) {
#pragma unroll
    for (int d = 1; d < 64; d <<= 1) { const float t = __shfl_up(v, d); if (lane >= d) v += t; }
    return v;
}
__device__ __forceinline__ float scan_max(float v, int lane) {
#pragma unroll
    for (int d = 1; d < 64; d <<= 1) { const float t = __shfl_up(v, d); if (lane >= d) v = fmaxf(v, t); }
    return v;
}

__device__ __forceinline__ void swa_unit(Frame& F, int l, int unit) {
    const int b = unit >> 5, kvh = (unit >> 4) & 1, nb = unit & 15;
    const int tid = F.tid, lane = F.lane, w = F.wave, g = lane >> 4, n = lane & 15;
    const bf16* proj = (const bf16*)(F.ws + WS_PROJ); bf16* Y = (bf16*)(F.ws + WS_Y);
    LAS unsigned char* Kt = F.lds + RING_OFF; LAS unsigned char* Vt = Kt + 36864; LAS float* bias = (LAS float*)(Kt + 73728);
    constexpr int LDB = 144;
    const int hq = kvh * 8 + w;
    v4u qn[2][2];
    const bf16* qbase = proj + (size_t)(b * SEQ + nb * 128 + n) * PROJ_LD + C_AQ + hq * 64 + 8 * g;
#pragma unroll
    for (int jt = 0; jt < 2; ++jt) { qn[jt][0] = *(const v4u*)(qbase + (size_t)(jt * 16) * PROJ_LD); qn[jt][1] = *(const v4u*)(qbase + (size_t)(jt * 16) * PROJ_LD + 32); }
    __syncthreads();
    {
        const int r = tid >> 1, hf = tid & 1, pos = nb * 128 - 128 + r;
        v4u kx[4], vx[4];
        if (pos >= 0) { const bf16* kp = proj + (size_t)(b * SEQ + pos) * PROJ_LD + C_AK + kvh * 64 + hf * 32; const bf16* vp = proj + (size_t)(b * SEQ + pos) * PROJ_LD + C_AV + kvh * 64 + hf * 32;
#pragma unroll
            for (int j = 0; j < 4; ++j) { kx[j] = *(const v4u*)(kp + 8 * j); vx[j] = *(const v4u*)(vp + 8 * j); } }
        else {
#pragma unroll
            for (int j = 0; j < 4; ++j) { kx[j] = (v4u){0u, 0u, 0u, 0u}; vx[j] = (v4u){0u, 0u, 0u, 0u}; } }
        float kf[32]; float ss = 0.f;
#pragma unroll
        for (int j = 0; j < 4; ++j) { kf[8 * j + 0] = bflo(kx[j].x); kf[8 * j + 1] = bfhi(kx[j].x); kf[8 * j + 2] = bflo(kx[j].y); kf[8 * j + 3] = bfhi(kx[j].y); kf[8 * j + 4] = bflo(kx[j].z); kf[8 * j + 5] = bfhi(kx[j].z); kf[8 * j + 6] = bflo(kx[j].w); kf[8 * j + 7] = bfhi(kx[j].w); }
#pragma unroll
        for (int i = 0; i < 32; ++i) ss += kf[i] * kf[i];
        ss += __shfl_xor(ss, 1);
        const float rstd = 1.0f / sqrtf(ss * (1.0f / 64.0f) + EPS);
        const float* gk = F.in[IN_GKN] + l * 64 + hf * 32;
#pragma unroll
        for (int j = 0; j < 4; ++j) { const f32x4 g0 = *(const f32x4*)(gk + 8 * j), g1 = *(const f32x4*)(gk + 8 * j + 4);
            v4u o; o.x = pk2(kf[8 * j] * rstd * g0.x, kf[8 * j + 1] * rstd * g0.y); o.y = pk2(kf[8 * j + 2] * rstd * g0.z, kf[8 * j + 3] * rstd * g0.w);
            o.z = pk2(kf[8 * j + 4] * rstd * g1.x, kf[8 * j + 5] * rstd * g1.y); o.w = pk2(kf[8 * j + 6] * rstd * g1.z, kf[8 * j + 7] * rstd * g1.w);
            *(LAS v4u*)(Kt + r * LDB + hf * 64 + 16 * j) = o; *(LAS v4u*)(Vt + r * LDB + hf * 64 + 16 * j) = vx[j]; }
    }
    for (int i = tid; i < 1024; i += NWAVES * 64) bias[i] = F.in[IN_RELB][T5_BUCKET[i & 127] * 16 + kvh * 8 + (i >> 7)] * 1.4426950408889634f;
    __syncthreads();
    const float sink = F.in[IN_SINKS][l * 16 + hq] * 1.4426950408889634f;
    const float* gq = F.in[IN_GQN] + l * 64;
    const f32x4 gq0 = *(const f32x4*)(gq + 8 * g), gq1 = *(const f32x4*)(gq + 8 * g + 4), gq2 = *(const f32x4*)(gq + 32 + 8 * g), gq3 = *(const f32x4*)(gq + 32 + 8 * g + 4);
    const LAS float* bw = bias + w * 128;
    for (int qb = 0; qb < 4; ++qb) {
        const int j0 = qb * 32;
        bf16x8 qf[2][2];
        v4u qc[2][2];
#pragma unroll
        for (int jt = 0; jt < 2; ++jt) { qc[jt][0] = qn[jt][0]; qc[jt][1] = qn[jt][1]; }
        if (qb < 3) {
#pragma unroll
            for (int jt = 0; jt < 2; ++jt) { qn[jt][0] = *(const v4u*)(qbase + (size_t)(j0 + 32 + jt * 16) * PROJ_LD); qn[jt][1] = *(const v4u*)(qbase + (size_t)(j0 + 32 + jt * 16) * PROJ_LD + 32); } }
#pragma unroll
        for (int jt = 0; jt < 2; ++jt) {
            const v4u x0 = qc[jt][0], x1 = qc[jt][1];
            float f[16] = {bflo(x0.x), bfhi(x0.x), bflo(x0.y), bfhi(x0.y), bflo(x0.z), bfhi(x0.z), bflo(x0.w), bfhi(x0.w), bflo(x1.x), bfhi(x1.x), bflo(x1.y), bfhi(x1.y), bflo(x1.z), bfhi(x1.z), bflo(x1.w), bfhi(x1.w)};
            float ss = 0.f;
#pragma unroll
            for (int i = 0; i < 16; ++i) ss += f[i] * f[i];
            ss += __shfl_xor(ss, 16); ss += __shfl_xor(ss, 32);
            const float rs = (0.125f * 1.4426950408889634f) / sqrtf(ss * (1.0f / 64.0f) + EPS);
            qf[jt][0] = pack8(f[0] * rs * gq0.x, f[1] * rs * gq0.y, f[2] * rs * gq0.z, f[3] * rs * gq0.w, f[4] * rs * gq1.x, f[5] * rs * gq1.y, f[6] * rs * gq1.z, f[7] * rs * gq1.w);
            qf[jt][1] = pack8(f[8] * rs * gq2.x, f[9] * rs * gq2.y, f[10] * rs * gq2.z, f[11] * rs * gq2.w, f[12] * rs * gq3.x, f[13] * rs * gq3.y, f[14] * rs * gq3.z, f[15] * rs * gq3.w);
        }
        f32x4 sc[2][10];
#pragma unroll
        for (int i = 0; i < 10; ++i) { const int kt = 2 * qb + i;
            const bf16x8 k0 = frag_row(Kt, LDB, 16 * kt, 0, lane), k1 = frag_row(Kt, LDB, 16 * kt, 32, lane);
#pragma unroll
            for (int jt = 0; jt < 2; ++jt) { f32x4 a = (f32x4){0.f, 0.f, 0.f, 0.f};
                if (i - jt >= 0 && i - jt <= 8) { a = MFMA16(k0, qf[jt][0], a); a = MFMA16(k1, qf[jt][1], a); }
                sc[jt][i] = a; } }
        float inv[2];
#pragma unroll
        for (int jt = 0; jt < 2; ++jt) { const int j = j0 + 16 * jt + n; float mx = sink;
#pragma unroll
            for (int i = 0; i < 10; ++i) { const int d = i - jt;
                if (d < 0 || d > 8) continue;
                const bool tile_ok = (nb > 0) || (2 * qb + i >= 8);
#pragma unroll
                for (int r = 0; r < 4; ++r) { const int dist = 16 * jt + n + 128 - 16 * i - 4 * g - r;
                    const bool ok = tile_ok && (d == 0 ? (4 * g + r > n) : (d == 8 ? (4 * g + r <= n) : true));
                    const float v = ok ? sc[jt][i][r] + bw[dist & 127] : -INFINITY; sc[jt][i][r] = v; mx = fmaxf(mx, v); } }
            mx = fmaxf(mx, __shfl_xor(mx, 16)); mx = fmaxf(mx, __shfl_xor(mx, 32));
            float sum = 0.f;
#pragma unroll
            for (int i = 0; i < 10; ++i) { const int d = i - jt;
                if (d < 0 || d > 8) continue;
#pragma unroll
                for (int r = 0; r < 4; ++r) { const float pz = __builtin_amdgcn_exp2f(sc[jt][i][r] - mx); sc[jt][i][r] = pz; sum += pz; } }
            sum += __shfl_xor(sum, 16); sum += __shfl_xor(sum, 32);
            inv[jt] = 1.0f / (sum + __builtin_amdgcn_exp2f(sink - mx)); }
        f32x4 o[4][2];
#pragma unroll
        for (int dt = 0; dt < 4; ++dt) { o[dt][0] = (f32x4){0.f, 0.f, 0.f, 0.f}; o[dt][1] = (f32x4){0.f, 0.f, 0.f, 0.f}; }
#pragma unroll
        for (int kk = 0; kk < 5; ++kk) { bf16x8 pf[2];
#pragma unroll
            for (int jt = 0; jt < 2; ++jt) pf[jt] = pack8(sc[jt][2 * kk][0], sc[jt][2 * kk][1], sc[jt][2 * kk][2], sc[jt][2 * kk][3], sc[jt][2 * kk + 1][0], sc[jt][2 * kk + 1][1], sc[jt][2 * kk + 1][2], sc[jt][2 * kk + 1][3]);
            const int ra = 16 * (2 * qb + 2 * kk);
#pragma unroll
            for (int dt = 0; dt < 4; ++dt) { const bf16x8 a = frag_tr2(Vt, LDB, ra, ra + 16, 16 * dt, lane);
                o[dt][0] = MFMA16(a, pf[0], o[dt][0]); o[dt][1] = MFMA16(a, pf[1], o[dt][1]); } }
#pragma unroll
        for (int jt = 0; jt < 2; ++jt) { bf16* yp = Y + (size_t)(b * SEQ + nb * 128 + j0 + 16 * jt + n) * DM + 1024 + hq * 64 + 4 * g;
#pragma unroll
            for (int dt = 0; dt < 4; ++dt) { v2u wv; wv.x = pk2(o[dt][jt][0] * inv[jt], o[dt][jt][1] * inv[jt]); wv.y = pk2(o[dt][jt][2] * inv[jt], o[dt][jt][3] * inv[jt]); *(v2u*)(yp + 16 * dt) = wv; } }
    }
}

__device__ __forceinline__ void gla_u_unit(Frame& F, int l, int u) {
    const int b = u >> 7, h = (u >> 5) & 3, c = u & 31, t0 = b * SEQ + 64 * c;
    const int tid = F.tid, lane = F.lane, w = F.wave, g = lane >> 4, n = lane & 15;
    const bf16* proj = (const bf16*)(F.ws + WS_PROJ); const float* side = (const float*)(F.ws + WS_SIDE);
    bf16* QT = (bf16*)(F.ws + WS_GAUX); bf16* QP = QT + (size_t)M * 256; bf16* KT = QP + (size_t)M * 256; float* BL = (float*)(KT + (size_t)M * 256); float* UG = (float*)(F.ws + WS_UG);
    LAS float* LAm = (LAS float*)(F.lds + RING_OFF);
    LAS unsigned char* KP = F.lds + RING_OFF + 16640;
    LAS unsigned char* VT = F.lds + RING_OFF + 25856;
    __syncthreads();
    const int s = tid >> 3, kg = tid & 7;
    const v4u kx = *(const v4u*)(proj + (size_t)(t0 + s) * PROJ_LD + C_GK + h * 64 + 8 * kg), qx = *(const v4u*)(proj + (size_t)(t0 + s) * PROJ_LD + C_GQ + h * 64 + 8 * kg);
    {
        const float* wd = F.in[IN_WDEC] + l * 16 * 256 + h * 64 + 8 * kg; const float* bd = F.in[IN_BDEC] + l * 256 + h * 64 + 8 * kg;
        f32x4 z0 = *(const f32x4*)(bd), z1 = *(const f32x4*)(bd + 4);
        const f32x4* gp = (const f32x4*)(side + (size_t)(t0 + s) * 32 + 8);
        const f32x4 g0 = gp[0], g1 = gp[1], g2 = gp[2], g3 = gp[3];
        const float ga[16] = {g0.x, g0.y, g0.z, g0.w, g1.x, g1.y, g1.z, g1.w, g2.x, g2.y, g2.z, g2.w, g3.x, g3.y, g3.z, g3.w};
#pragma unroll
        for (int r = 0; r < 16; ++r) { z0 += *(const f32x4*)(wd + r * 256) * ga[r]; z1 += *(const f32x4*)(wd + r * 256 + 4) * ga[r]; }
        LAS float* lp = LAm + s * 65 + 8 * kg;
        lp[0] = logsigmoidf_(z0.x) * 0.0625f; lp[1] = logsigmoidf_(z0.y) * 0.0625f; lp[2] = logsigmoidf_(z0.z) * 0.0625f; lp[3] = logsigmoidf_(z0.w) * 0.0625f;
        lp[4] = logsigmoidf_(z1.x) * 0.0625f; lp[5] = logsigmoidf_(z1.y) * 0.0625f; lp[6] = logsigmoidf_(z1.z) * 0.0625f; lp[7] = logsigmoidf_(z1.w) * 0.0625f;
        const bf16* vp = proj + (size_t)(t0 + s) * PROJ_LD + C_GV + h * 128 + 16 * kg;
        *(LAS v4u*)(VT + s * 272 + 32 * kg) = *(const v4u*)(vp); *(LAS v4u*)(VT + s * 272 + 32 * kg + 16) = *(const v4u*)(vp + 8);
    }
    __syncthreads();
#pragma unroll
    for (int ci = 0; ci < 8; ++ci) { const int k = 8 * w + ci; const float v = scan_add(LAm[lane * 65 + k], lane); LAm[lane * 65 + k] = v; }
    __syncthreads();
    {
        const float kf[8] = {bflo(kx.x), bfhi(kx.x), bflo(kx.y), bfhi(kx.y), bflo(kx.z), bfhi(kx.z), bflo(kx.w), bfhi(kx.w)};
        const float qf[8] = {bflo(qx.x), bfhi(qx.x), bflo(qx.y), bfhi(qx.y), bflo(qx.z), bfhi(qx.z), bflo(qx.w), bfhi(qx.w)};
        float o1[8], o2[8], o3[8], o4[8];
#pragma unroll
        for (int i = 0; i < 8; ++i) { const float bb = LAm[s * 65 + 8 * kg + i], bl = LAm[63 * 65 + 8 * kg + i], br = LAm[31 * 65 + 8 * kg + i];
            o1[i] = kf[i] * __expf(bl - bb); o2[i] = qf[i] * 0.125f * __expf(bb - br); o3[i] = qf[i] * 0.125f * __expf(bb); o4[i] = kf[i] * __expf(br - bb);
            if (s == 63) BL[(size_t)u * 64 + 8 * kg + i] = bl; }
        v4u o; o.x = pk2(o1[0], o1[1]); o.y = pk2(o1[2], o1[3]); o.z = pk2(o1[4], o1[5]); o.w = pk2(o1[6], o1[7]); *(LAS v4u*)(KP + s * 144 + 16 * kg) = o;
        const size_t go = (size_t)(t0 + s) * 256 + h * 64 + 8 * kg;
        o.x = pk2(o2[0], o2[1]); o.y = pk2(o2[2], o2[3]); o.z = pk2(o2[4], o2[5]); o.w = pk2(o2[6], o2[7]); *(v4u*)(QT + go) = o;
        o.x = pk2(o3[0], o3[1]); o.y = pk2(o3[2], o3[3]); o.z = pk2(o3[4], o3[5]); o.w = pk2(o3[6], o3[7]); *(v4u*)(QP + go) = o;
        o.x = pk2(o4[0], o4[1]); o.y = pk2(o4[2], o4[3]); o.z = pk2(o4[4], o4[5]); o.w = pk2(o4[6], o4[7]); *(v4u*)(KT + go) = o;
    }
    __syncthreads();
    {
        f32x4 acc[4];
#pragma unroll
        for (int mt = 0; mt < 4; ++mt) acc[mt] = (f32x4){0.f, 0.f, 0.f, 0.f};
#pragma unroll
        for (int ks = 0; ks < 2; ++ks) { const bf16x8 bv = frag_tr(VT, 272, 32 * ks, 16 * w, lane);
#pragma unroll
            for (int mt = 0; mt < 4; ++mt) { const bf16x8 a = frag_tr(KP, 144, 32 * ks, 16 * mt, lane); acc[mt] = MFMA16(a, bv, acc[mt]); } }
        float* up = UG + (size_t)u * 64 * 128 + 16 * w + n;
#pragma unroll
        for (int mt = 0; mt < 4; ++mt)
#pragma unroll
            for (int r = 0; r < 4; ++r) up[(size_t)(16 * mt + 4 * g + r) * 128] = acc[mt][r];
    }
}
__device__ __forceinline__ void gla_out_group(Frame& F, int l, int ug) {
    const int bh = ug >> 3, jj = ug & 7, b = bh >> 2, h = bh & 3;
    const int tid = F.tid, lane = F.lane, w = F.wave, g = lane >> 4, n = lane & 15;
    const bf16* proj = (const bf16*)(F.ws + WS_PROJ); bf16* Y = (bf16*)(F.ws + WS_Y);
    const bf16* QT = (const bf16*)(F.ws + WS_GAUX); const bf16* QP = QT + (size_t)M * 256; const bf16* KT = QP + (size_t)M * 256; const float* BL = (const float*)(KT + (size_t)M * 256); const float* UG = (const float*)(F.ws + WS_UG);
    LAS unsigned char* LQT = F.lds + RING_OFF; LAS unsigned char* LQP = LQT + 9216; LAS unsigned char* LKT = LQT + 18432; LAS unsigned char* VT = LQT + 27648; LAS unsigned char* ST = LQT + 45056;
    LAS float* SS = (LAS float*)(LQT + 62464);
    float S[16];
#pragma unroll
    for (int i = 0; i < 16; ++i) S[i] = 0.f;
    const int sk = tid >> 3, sv = (tid & 7) * 16;
    int cdone = 0;
    const float* gout = F.in[IN_GOUTG] + l * 512 + h * 128;
#pragma clang loop unroll(disable)
    for (int oi = 0; oi < 4; ++oi) {
        asm volatile("" : "+s"(proj), "+s"(Y), "+s"(QT), "+s"(QP), "+s"(KT), "+s"(BL), "+s"(UG), "+s"(gout));
        const int c = oi == 0 ? jj : (oi == 1 ? 15 - jj : (oi == 2 ? 16 + jj : 31 - jj));
        while (cdone < c) {
            const int nbt = (c - cdone) < 4 ? (c - cdone) : 4; f32x4 xb[4][4]; float db[4];
#pragma unroll
            for (int i = 0; i < 4; ++i) if (i < nbt) { const int uu = bh * 32 + cdone + i; db[i] = BL[(size_t)uu * 64 + sk];
                const f32x4* up = (const f32x4*)(UG + (size_t)uu * 64 * 128 + sk * 128 + sv);
#pragma unroll
                for (int q = 0; q < 4; ++q) xb[i][q] = up[q]; }
#pragma unroll
            for (int i = 0; i < 4; ++i) if (i < nbt) { const float dec = __expf(db[i]);
#pragma unroll
                for (int q = 0; q < 4; ++q) { const f32x4 x = xb[i][q]; S[4 * q] = dec * S[4 * q] + x.x; S[4 * q + 1] = dec * S[4 * q + 1] + x.y; S[4 * q + 2] = dec * S[4 * q + 2] + x.z; S[4 * q + 3] = dec * S[4 * q + 3] + x.w; } }
            cdone += nbt; }
        const int t0 = b * SEQ + 64 * c;
        __syncthreads();
        {
            v4u o; o.x = pk2(S[0], S[1]); o.y = pk2(S[2], S[3]); o.z = pk2(S[4], S[5]); o.w = pk2(S[6], S[7]); *(LAS v4u*)(ST + sk * 272 + sv * 2) = o;
            o.x = pk2(S[8], S[9]); o.y = pk2(S[10], S[11]); o.z = pk2(S[12], S[13]); o.w = pk2(S[14], S[15]); *(LAS v4u*)(ST + sk * 272 + sv * 2 + 16) = o;
            const int s = tid >> 3, kg = tid & 7; const size_t go = (size_t)(t0 + s) * 256 + h * 64 + 8 * kg;
            *(LAS v4u*)(LQT + s * 144 + 16 * kg) = *(const v4u*)(QT + go); *(LAS v4u*)(LQP + s * 144 + 16 * kg) = *(const v4u*)(QP + go); *(LAS v4u*)(LKT + s * 144 + 16 * kg) = *(const v4u*)(KT + go);
            const bf16* vp = proj + (size_t)(t0 + s) * PROJ_LD + C_GV + h * 128 + 16 * kg;
            *(LAS v4u*)(VT + s * 272 + 32 * kg) = *(const v4u*)(vp); *(LAS v4u*)(VT + s * 272 + 32 * kg + 16) = *(const v4u*)(vp + 8);
        }
        __syncthreads();
        const int jt = w & 3, vh = w >> 2;
        const size_t row = (size_t)(t0 + 16 * jt + n);
        f32x4 go4[4]; v2u gx4[4];
#pragma unroll
        for (int mt = 0; mt < 4; ++mt) { const int v = 64 * vh + 16 * mt + 4 * g; go4[mt] = *(const f32x4*)(gout + v); gx4[mt] = *(const v2u*)(proj + row * PROJ_LD + C_GG + h * 128 + v); }
        bf16x8 qf[2], qpf[2];
#pragma unroll
        for (int ks = 0; ks < 2; ++ks) { qf[ks] = frag_row(LQT, 144, 16 * jt, 32 * ks, lane); qpf[ks] = frag_row(LQP, 144, 16 * jt, 32 * ks, lane); }
        f32x4 at[4];
#pragma unroll
        for (int st = 0; st < 4; ++st) { at[st] = (f32x4){0.f, 0.f, 0.f, 0.f};
            if (st <= jt) {
#pragma unroll
                for (int ks = 0; ks < 2; ++ks) at[st] = MFMA16(frag_row(LKT, 144, 16 * st, 32 * ks, lane), qf[ks], at[st]);
                if (st == jt) {
#pragma unroll
                    for (int r = 0; r < 4; ++r) if (4 * g + r > n) at[st][r] = 0.f; } } }
        f32x4 o[4];
#pragma unroll
        for (int mt = 0; mt < 4; ++mt) { o[mt] = (f32x4){0.f, 0.f, 0.f, 0.f};
#pragma unroll
            for (int ks = 0; ks < 2; ++ks) o[mt] = MFMA16(frag_tr(ST, 272, 32 * ks, 64 * vh + 16 * mt, lane), qpf[ks], o[mt]); }
#pragma unroll
        for (int kk = 0; kk < 2; ++kk) { if (2 * kk <= jt) {
            const bf16x8 pf = pack8(at[2 * kk][0], at[2 * kk][1], at[2 * kk][2], at[2 * kk][3], at[2 * kk + 1][0], at[2 * kk + 1][1], at[2 * kk + 1][2], at[2 * kk + 1][3]);
#pragma unroll
            for (int mt = 0; mt < 4; ++mt) o[mt] = MFMA16(frag_tr2(VT, 272, 32 * kk, 32 * kk + 16, 64 * vh + 16 * mt, lane), pf, o[mt]); } }
        float ss = 0.f;
#pragma unroll
        for (int mt = 0; mt < 4; ++mt)
#pragma unroll
            for (int r = 0; r < 4; ++r) ss += o[mt][r] * o[mt][r];
        ss += __shfl_xor(ss, 16); ss += __shfl_xor(ss, 32);
        if (g == 0) SS[w * 16 + n] = ss;
        __syncthreads();
        const float rstd = 1.0f / sqrtf((SS[w * 16 + n] + SS[(w ^ 4) * 16 + n]) * (1.0f / 128.0f) + EPS);
#pragma unroll
        for (int mt = 0; mt < 4; ++mt) { const int v = 64 * vh + 16 * mt + 4 * g;
            const f32x4 gq4 = go4[mt]; const v2u gx = gx4[mt];
            v2u wv; wv.x = pk2(o[mt][0] * rstd * gq4.x * siluf_(bflo(gx.x)), o[mt][1] * rstd * gq4.y * siluf_(bfhi(gx.x))); wv.y = pk2(o[mt][2] * rstd * gq4.z * siluf_(bflo(gx.y)), o[mt][3] * rstd * gq4.w * siluf_(bfhi(gx.y)));
            *(v2u*)(Y + row * DM + 512 + h * 128 + v) = wv; }
    }
}

__device__ __forceinline__ void mlstm_u_unit(Frame& F, int l, int u) {
    const int b = u >> 6, h = (u >> 4) & 3, c = u & 15, t0 = b * SEQ + 128 * c;
    const int tid = F.tid, lane = F.lane, w = F.wave, g = lane >> 4, n = lane & 15;
    const bf16* proj = (const bf16*)(F.ws + WS_PROJ); const float* side = (const float*)(F.ws + WS_SIDE); bf16* qkc = (bf16*)(F.ws + WS_QKC);
    float* UM = (float*)(F.ws + WS_UM); float* MS = UM + (size_t)512 * 136 * 64;
    LAS unsigned char* KP = F.lds + RING_OFF;
    LAS unsigned char* VT = F.lds + RING_OFF + 18432;
    LAS float* GF = (LAS float*)(F.lds + RING_OFF + 53248);
    __syncthreads();
    const int s = tid >> 2, qd = tid & 3;
    float kc[16];
    {
        const float* wc = F.in[IN_WCONV] + l * 4 * 512; const float* bc = F.in[IN_BCONV] + l * 512;
        const int pos = 128 * c + s;
#pragma unroll
        for (int part = 0; part < 2; ++part) { const int ch = part * 256 + h * 64 + 16 * qd; float y[16];
#pragma unroll
            for (int q4 = 0; q4 < 4; ++q4) { const f32x4 bb = *(const f32x4*)(bc + ch + 4 * q4); y[4 * q4] = bb.x; y[4 * q4 + 1] = bb.y; y[4 * q4 + 2] = bb.z; y[4 * q4 + 3] = bb.w; }
#pragma unroll
            for (int i = 0; i < 4; ++i) { if (pos - 3 + i >= 0) { const bf16* xp = proj + (size_t)(t0 + s - 3 + i) * PROJ_LD + ch; const v4u x0 = *(const v4u*)xp, x1 = *(const v4u*)(xp + 8);
                const float xf[16] = {bflo(x0.x), bfhi(x0.x), bflo(x0.y), bfhi(x0.y), bflo(x0.z), bfhi(x0.z), bflo(x0.w), bfhi(x0.w), bflo(x1.x), bfhi(x1.x), bflo(x1.y), bfhi(x1.y), bflo(x1.z), bfhi(x1.z), bflo(x1.w), bfhi(x1.w)};
#pragma unroll
                for (int q4 = 0; q4 < 4; ++q4) { const f32x4 ww = *(const f32x4*)(wc + i * 512 + ch + 4 * q4); y[4 * q4] += ww.x * xf[4 * q4]; y[4 * q4 + 1] += ww.y * xf[4 * q4 + 1]; y[4 * q4 + 2] += ww.z * xf[4 * q4 + 2]; y[4 * q4 + 3] += ww.w * xf[4 * q4 + 3]; } } }
            const float scl = part ? 0.125f : 1.0f;
#pragma unroll
            for (int i = 0; i < 16; ++i) y[i] = siluf_(y[i]) * scl;
            v4u o0, o1; o0.x = pk2(y[0], y[1]); o0.y = pk2(y[2], y[3]); o0.z = pk2(y[4], y[5]); o0.w = pk2(y[6], y[7]); o1.x = pk2(y[8], y[9]); o1.y = pk2(y[10], y[11]); o1.z = pk2(y[12], y[13]); o1.w = pk2(y[14], y[15]);
            *(v4u*)(qkc + (size_t)(t0 + s) * 512 + ch) = o0; *(v4u*)(qkc + (size_t)(t0 + s) * 512 + ch + 8) = o1;
            if (part) {
#pragma unroll
                for (int i = 0; i < 16; ++i) kc[i] = y[i]; } }
        const bf16* vp = proj + (size_t)(t0 + s) * PROJ_LD + C_MV + h * 128 + 32 * qd;
#pragma unroll
        for (int j = 0; j < 4; ++j) *(LAS v4u*)(VT + s * 272 + 64 * qd + 16 * j) = *(const v4u*)(vp + 8 * j);
        if (tid < 128) { GF[tid] = logsigmoidf_(side[(size_t)(t0 + tid) * 32 + 4 + h] + F.in[IN_BGATES][l * 8 + 4 + h]); GF[128 + tid] = side[(size_t)(t0 + tid) * 32 + h] + F.in[IN_BGATES][l * 8 + h]; }
    }
    __syncthreads();
    if (w == 0) {
        const float a0 = GF[2 * lane], a1 = GF[2 * lane + 1]; const float P = scan_add(a0 + a1, lane);
        const float blast = __shfl(P, 63);
        const float lw0 = blast - (P - a1) + GF[128 + 2 * lane], lw1 = blast - P + GF[128 + 2 * lane + 1];
        float mx = fmaxf(lw0, lw1);
#pragma unroll
        for (int o = 1; o < 64; o <<= 1) mx = fmaxf(mx, __shfl_xor(mx, o));
        GF[256 + 2 * lane] = expf(lw0 - mx); GF[256 + 2 * lane + 1] = expf(lw1 - mx);
        if (lane == 0) { MS[(size_t)u * 2] = blast; MS[(size_t)u * 2 + 1] = mx; }
    }
    __syncthreads();
    {   const float wg = GF[256 + s];
        v4u o0, o1; o0.x = pk2(kc[0] * wg, kc[1] * wg); o0.y = pk2(kc[2] * wg, kc[3] * wg); o0.z = pk2(kc[4] * wg, kc[5] * wg); o0.w = pk2(kc[6] * wg, kc[7] * wg);
        o1.x = pk2(kc[8] * wg, kc[9] * wg); o1.y = pk2(kc[10] * wg, kc[11] * wg); o1.z = pk2(kc[12] * wg, kc[13] * wg); o1.w = pk2(kc[14] * wg, kc[15] * wg);
        *(LAS v4u*)(KP + s * 144 + 32 * qd) = o0; *(LAS v4u*)(KP + s * 144 + 32 * qd + 16) = o1; }
    __syncthreads();
    {
        const int nt = w & 3, m0 = w >> 2;
        f32x4 acc[5];
#pragma unroll
        for (int i = 0; i < 5; ++i) acc[i] = (f32x4){0.f, 0.f, 0.f, 0.f};
        const bf16x8 ones = (n == 0) ? pack8(1.f, 1.f, 1.f, 1.f, 1.f, 1.f, 1.f, 1.f) : pack8(0.f, 0.f, 0.f, 0.f, 0.f, 0.f, 0.f, 0.f);
#pragma unroll
        for (int ks = 0; ks < 4; ++ks) { const bf16x8 bv = frag_tr(KP, 144, 32 * ks, 16 * nt, lane);
#pragma unroll
            for (int i = 0; i < 4; ++i) acc[i] = MFMA16(frag_tr(VT, 272, 32 * ks, 16 * (m0 + 2 * i), lane), bv, acc[i]);
            if (m0 == 0) acc[4] = MFMA16(ones, bv, acc[4]); }
        float* up = UM + (size_t)u * 136 * 64 + 16 * nt + n;
#pragma unroll
        for (int i = 0; i < 4; ++i)
#pragma unroll
            for (int r = 0; r < 4; ++r) up[(size_t)(16 * (m0 + 2 * i) + 4 * g + r) * 64] = acc[i][r];
        if (m0 == 0 && g == 0) up[(size_t)128 * 64] = acc[4][0];
    }
}
__device__ __forceinline__ void mlstm_out_group(Frame& F, int l, int ug) {
    const int bh = ug >> 3, jj = ug & 7, b = bh >> 2, h = bh & 3;
    const int tid = F.tid, lane = F.lane, w = F.wave, g = lane >> 4, n = lane & 15;
    const bf16* proj = (const bf16*)(F.ws + WS_PROJ); const float* side = (const float*)(F.ws + WS_SIDE); const bf16* qkc = (const bf16*)(F.ws + WS_QKC); bf16* Y = (bf16*)(F.ws + WS_Y);
    const float* UM = (const float*)(F.ws + WS_UM); const float* MS = UM + (size_t)512 * 136 * 64;
    LAS unsigned char* QC = F.lds + RING_OFF; LAS unsigned char* KC = QC + 18432; LAS unsigned char* VT = QC + 36864; LAS unsigned char* CS = QC + 71680;
    LAS float* GF = (LAS float*)(QC + 92416);
    float C[16], nn = 0.f, mst = 0.f;
#pragma unroll
    for (int i = 0; i < 16; ++i) C[i] = 0.f;
    const int cv = tid >> 2, ck = (tid & 3) * 16;
    int cdone = 0;
    const float* gout = F.in[IN_GOUTM] + l * 512 + h * 128;
#pragma clang loop unroll(disable)
    for (int oi = 0; oi < 2; ++oi) {
        asm volatile("" : "+s"(proj), "+s"(side), "+s"(qkc), "+s"(Y), "+s"(UM), "+s"(MS), "+s"(gout));
        const int c = oi == 0 ? jj : 15 - jj;
        while (cdone < c) {
            const int nbt = (c - cdone) < 4 ? (c - cdone) : 4; f32x4 xb[4][4]; float bb[4], mb[4], nb4[4];
#pragma unroll
            for (int i = 0; i < 4; ++i) if (i < nbt) { const int uu = bh * 16 + cdone + i; bb[i] = MS[(size_t)uu * 2]; mb[i] = MS[(size_t)uu * 2 + 1];
                const f32x4* up = (const f32x4*)(UM + (size_t)uu * 136 * 64 + cv * 64 + ck);
#pragma unroll
                for (int q = 0; q < 4; ++q) xb[i][q] = up[q];
                nb4[i] = UM[(size_t)uu * 136 * 64 + 128 * 64 + (tid & 63)]; }
#pragma unroll
            for (int i = 0; i < 4; ++i) if (i < nbt) { const float Bc = bb[i], ml = mb[i];
                const float mn = fmaxf(Bc + mst, ml), d1 = expf(Bc + mst - mn), d2 = expf(ml - mn); mst = mn;
#pragma unroll
                for (int q = 0; q < 4; ++q) { const f32x4 x = xb[i][q]; C[4 * q] = d1 * C[4 * q] + d2 * x.x; C[4 * q + 1] = d1 * C[4 * q + 1] + d2 * x.y; C[4 * q + 2] = d1 * C[4 * q + 2] + d2 * x.z; C[4 * q + 3] = d1 * C[4 * q + 3] + d2 * x.w; }
                nn = d1 * nn + d2 * nb4[i]; }
            cdone += nbt; }
        const int t0 = b * SEQ + 128 * c;
        __syncthreads();
        {
            v4u o; o.x = pk2(C[0], C[1]); o.y = pk2(C[2], C[3]); o.z = pk2(C[4], C[5]); o.w = pk2(C[6], C[7]); *(LAS v4u*)(CS + cv * 144 + ck * 2) = o;
            o.x = pk2(C[8], C[9]); o.y = pk2(C[10], C[11]); o.z = pk2(C[12], C[13]); o.w = pk2(C[14], C[15]); *(LAS v4u*)(CS + cv * 144 + ck * 2 + 16) = o;
            if (tid < 64) *(LAS bf16*)(CS + 128 * 144 + tid * 2) = (bf16)f2bf(nn);
            for (int i = tid; i < 15 * 72; i += NWAVES * 64) *(LAS bf16*)(CS + 129 * 144 + i * 2) = (bf16)0;
            const int s = tid >> 2, qd = tid & 3;
            const bf16* qp = qkc + (size_t)(t0 + s) * 512 + h * 64 + 16 * qd;
            *(LAS v4u*)(QC + s * 144 + 32 * qd) = *(const v4u*)qp; *(LAS v4u*)(QC + s * 144 + 32 * qd + 16) = *(const v4u*)(qp + 8);
            *(LAS v4u*)(KC + s * 144 + 32 * qd) = *(const v4u*)(qp + 256); *(LAS v4u*)(KC + s * 144 + 32 * qd + 16) = *(const v4u*)(qp + 256 + 8);
            const bf16* vp = proj + (size_t)(t0 + s) * PROJ_LD + C_MV + h * 128 + 32 * qd;
#pragma unroll
            for (int j = 0; j < 4; ++j) *(LAS v4u*)(VT + s * 272 + 64 * qd + 16 * j) = *(const v4u*)(vp + 8 * j);
            if (tid < 128) { GF[tid] = logsigmoidf_(side[(size_t)(t0 + tid) * 32 + 4 + h] + F.in[IN_BGATES][l * 8 + 4 + h]); GF[128 + tid] = side[(size_t)(t0 + tid) * 32 + h] + F.in[IN_BGATES][l * 8 + h]; }
        }
        __syncthreads();
        if (w == 0) {
            const float a0 = GF[2 * lane], a1 = GF[2 * lane + 1]; const float P = scan_add(a0 + a1, lane);
            const float b0 = P - a1, b1 = P; const float x0 = GF[128 + 2 * lane] - b0, x1 = GF[128 + 2 * lane + 1] - b1;
            const float cm = scan_max(fmaxf(x0, x1), lane);
            float prev = __shfl_up(cm, 1); if (lane == 0) prev = -INFINITY;
            const float M0 = fmaxf(mst, fmaxf(prev, x0)), M1 = fmaxf(mst, cm);
            GF[2 * lane] = x0; GF[2 * lane + 1] = x1; GF[128 + 2 * lane] = M0; GF[128 + 2 * lane + 1] = M1; GF[256 + 2 * lane] = b0; GF[256 + 2 * lane + 1] = b1;
        }
        __syncthreads();
        {
            const int j = 16 * w + n; const float Mj = GF[128 + j], bj = GF[256 + j];
            const size_t row = (size_t)(t0 + j);
            v2u mx8[8];
#pragma unroll
            for (int mt = 0; mt < 8; ++mt) { const int v = 16 * mt + 4 * g; mx8[mt] = *(const v2u*)(proj + row * PROJ_LD + C_MO + h * 128 + v); }
            bf16x8 qf[2];
#pragma unroll
            for (int ks = 0; ks < 2; ++ks) qf[ks] = frag_row(QC, 144, 16 * w, 32 * ks, lane);
            f32x4 p[8];
#pragma unroll
            for (int st = 0; st < 8; ++st) { p[st] = (f32x4){0.f, 0.f, 0.f, 0.f};
                if (st <= w) {
#pragma unroll
                    for (int ks = 0; ks < 2; ++ks) p[st] = MFMA16(frag_row(KC, 144, 16 * st, 32 * ks, lane), qf[ks], p[st]);
                    const f32x4 as = *(const LAS f32x4*)(GF + 16 * st + 4 * g);
#pragma unroll
                    for (int r = 0; r < 4; ++r) { const float e = __expf(as[r] - Mj); p[st][r] = (st < w || 4 * g + r <= n) ? p[st][r] * e : 0.f; } } }
            f32x4 o[9];
            const float wi = __expf(mst - Mj);
#pragma unroll
            for (int mt = 0; mt < 9; ++mt) { o[mt] = (f32x4){0.f, 0.f, 0.f, 0.f};
#pragma unroll
                for (int ks = 0; ks < 2; ++ks) o[mt] = MFMA16(frag_row(CS, 144, 16 * mt, 32 * ks, lane), qf[ks], o[mt]);
                o[mt] = o[mt] * wi; }
            const bf16x8 ones = (n == 0) ? pack8(1.f, 1.f, 1.f, 1.f, 1.f, 1.f, 1.f, 1.f) : pack8(0.f, 0.f, 0.f, 0.f, 0.f, 0.f, 0.f, 0.f);
#pragma unroll
            for (int kk = 0; kk < 4; ++kk) { if (2 * kk <= w) {
                const bf16x8 pf = pack8(p[2 * kk][0], p[2 * kk][1], p[2 * kk][2], p[2 * kk][3], p[2 * kk + 1][0], p[2 * kk + 1][1], p[2 * kk + 1][2], p[2 * kk + 1][3]);
#pragma unroll
                for (int mt = 0; mt < 8; ++mt) o[mt] = MFMA16(frag_tr2(VT, 272, 32 * kk, 32 * kk + 16, 16 * mt, lane), pf, o[mt]);
                o[8] = MFMA16(ones, pf, o[8]); } }
            const float den = __shfl(o[8][0], n);
            const float dn = 1.0f / fmaxf(fabsf(den), __expf(-(bj + Mj)));
            float ss = 0.f;
#pragma unroll
            for (int mt = 0; mt < 8; ++mt)
#pragma unroll
                for (int r = 0; r < 4; ++r) { o[mt][r] *= dn; ss += o[mt][r] * o[mt][r]; }
            ss += __shfl_xor(ss, 16); ss += __shfl_xor(ss, 32);
            const float rstd = 1.0f / sqrtf(ss * (1.0f / 128.0f) + EPS);
#pragma unroll
            for (int mt = 0; mt < 8; ++mt) { const int v = 16 * mt + 4 * g;
                const f32x4 go4 = *(const f32x4*)(gout + v); const v2u mx = mx8[mt];
                v2u wv; wv.x = pk2(o[mt][0] * rstd * go4.x * sigmoidf_(bflo(mx.x)), o[mt][1] * rstd * go4.y * sigmoidf_(bfhi(mx.x))); wv.y = pk2(o[mt][2] * rstd * go4.z * sigmoidf_(bflo(mx.y)), o[mt][3] * rstd * go4.w * sigmoidf_(bfhi(mx.y)));
                *(v2u*)(Y + row * DM + h * 128 + v) = wv; }
        }
    }
}

#define PROBE_SUBREP(id) (PROBE_REPEAT == (id) ? 5 : 1)
__device__ __forceinline__ void mix_a(Frame& F, int l) {
    if (!(FAST_GLA && FAST_MLSTM && FAST_SWA)) mix_prep(F, l);
    if (FAST_SWA) for (int rep = 0; rep < PROBE_SUBREP(201); ++rep) for (int u = F.vcu; u < 256; u += F.G) swa_unit(F, l, u);
    if (FAST_MLSTM) for (int rep = 0; rep < PROBE_SUBREP(202); ++rep) for (int u = F.vcu; u < 512; u += F.G) mlstm_u_unit(F, l, u);
    if (FAST_GLA) for (int rep = 0; rep < PROBE_SUBREP(203); ++rep) for (int u = F.vcu; u < 1024; u += F.G) gla_u_unit(F, l, u);
}
__device__ __forceinline__ void mix_b(Frame& F, int l) {
    if (!(FAST_GLA && FAST_MLSTM && FAST_SWA)) mix_naive(F, l);
    if (FAST_MLSTM) for (int rep = 0; rep < PROBE_SUBREP(204); ++rep) for (int ug = F.vcu; ug < 256; ug += F.G) mlstm_out_group(F, l, ug);
    if (FAST_GLA) for (int rep = 0; rep < PROBE_SUBREP(205); ++rep) for (int ug = F.vcu; ug < 256; ug += F.G) gla_out_group(F, l, ug);
}

#ifndef MK_ONE_LAUNCH
#define MK_ONE_LAUNCH 1
#endif
constexpr int NPH = 19;
struct Args { const float* in[26]; float* out; unsigned char* ws; int ph_lo, ph_hi; };
__global__ void __launch_bounds__(NWAVES * 64, 2) hybrid_fwd(Args args) {
    extern __shared__ __attribute__((aligned(16))) unsigned char lds[];
    Frame F;
    F.lds = (LAS unsigned char*)lds;
    F.tid = threadIdx.x; F.lane = F.tid & 63; F.wave = __builtin_amdgcn_readfirstlane(F.tid >> 6);
    F.G = gridDim.x; { const int bx = blockIdx.x; F.vcu = (F.G % 8 == 0) ? (bx % 8) * (F.G / 8) + bx / 8 : bx; }
    F.ws = args.ws; F.out = args.out; F.ctl = (gu32*)(args.ws + WS_CTL);
    F.in = (cfp_k*)__builtin_amdgcn_kernarg_segment_ptr();
    for (int u = F.tid; u < (LDS_BYTES - MISC_OFF) / 4; u += NWAVES * 64) ((LAS unsigned*)(F.lds + MISC_OFF))[u] = 0u;
    __syncthreads();
    const int lo = args.ph_lo, hi = args.ph_hi;
    XcdBarrier bar; bar.bar = (unsigned*)(F.ctl + CW_BAR); bar.x = 0; bar.st = nullptr;
    if (hi - lo > 1) bar = xcd_barrier_post((unsigned*)(F.ctl + CW_BAR), (volatile LAS unsigned*)(F.lds + MISC_OFF));
#define IN(k) (lo <= (k) && (k) < hi)
#define SEAM(k) do { if (IN(k) && IN((k) + 1)) { xcd_barrier(bar); if (PROBE_REPEAT == 100) xcd_barrier(bar); } } while (0)
    bf16* const XN = (bf16*)(F.ws + WS_XN); bf16* const Yb = (bf16*)(F.ws + WS_Y); float* const XA = (float*)(F.ws + WS_XA);
    bf16* const PROJ = (bf16*)(F.ws + WS_PROJ); float* const SIDE = (float*)(F.ws + WS_SIDE); bf16* const HID = (bf16*)(F.ws + WS_HID); bf16* const AS = (bf16*)(F.ws + WS_AS);
    const float* const MOD = (const float*)(F.ws + WS_MOD);

    if (IN(0)) { p0_prologue(F); if (PROBE_REPEAT == 0) p0_prologue(F); }
    SEAM(0);
#define LAYER_MIX(l) do { \
        const int pb = 1 + 8 * (l); \
        const float* modl = MOD + (size_t)(l) * 8 * 12288; \
        const float* xin = (l) == 0 ? F.in[IN_X] : (const float*)F.out; \
        if (IN(pb)) { norm_phase<false>(F, xin, F.in[IN_GMIX] + (l) * DM, modl, 0, 2048); if (PROBE_REPEAT == pb) norm_phase<false>(F, xin, F.in[IN_GMIX] + (l) * DM, modl, 0, 2048); } \
        SEAM(pb); \
        if (IN(pb + 1)) { \
            pg8::Gemm g{XN, (const bf16*)(F.ws + WS_WIN) + (size_t)(l) * NPROJ * DM, M, NPROJ, DM}; pg8::StaticOrder S; S.init(M, NPROJ, F.G, (int)blockIdx.x); \
            pg8::EpiProj E{PROJ, SIDE}; \
            pg8::gemm_phase<pg8::EpiProj, pg8::StaticOrder, true, true>(F.lds + RING_OFF, g, S, E); \
            if (PROBE_REPEAT == pb + 1) pg8::gemm_phase<pg8::EpiProj, pg8::StaticOrder, true, true>(F.lds + RING_OFF, g, S, E); \
            if (F.G == 256 && blockIdx.x >= 128) moe_convert(F, MOE_ITEMS - (2 - (l)) * MOE_TAILQ, MOE_ITEMS - (1 - (l)) * MOE_TAILQ, ((int)blockIdx.x - 128) * NWAVES + F.wave, 128 * NWAVES);     \
            else if (F.G != 256) moe_convert(F, MOE_ITEMS - (2 - (l)) * MOE_TAILQ, MOE_ITEMS - (1 - (l)) * MOE_TAILQ, F.vcu * NWAVES + F.wave, F.G * NWAVES); \
        } \
        SEAM(pb + 1); \
        if (IN(pb + 2)) { mix_a(F, (l)); if (PROBE_REPEAT == pb + 2) mix_a(F, (l)); } \
        SEAM(pb + 2); \
        if (IN(pb + 3)) { mix_b(F, (l)); if (PROBE_REPEAT == pb + 3) mix_b(F, (l)); } \
        SEAM(pb + 3); \
        if (IN(pb + 4)) { \
            pg8::Gemm g{Yb, (const bf16*)(F.ws + WS_WOUT) + (size_t)(l) * DM * DM, M, DM, DM}; pg8::StaticOrder S; S.init(M, DM, F.G, (int)blockIdx.x); \
            pg8::EpiResid E{xin, XA, modl + 4096}; \
            pg8::gemm_phase<pg8::EpiResid, pg8::StaticOrder, true, true>(F.lds + RING_OFF, g, S, E); \
            if (PROBE_REPEAT == pb + 4) pg8::gemm_phase<pg8::EpiResid, pg8::StaticOrder, true, true>(F.lds + RING_OFF, g, S, E); \
        } \
        SEAM(pb + 4); \
    } while (0)
    LAYER_MIX(0);
    {
        const float* modl = MOD;
        if (IN(6)) { norm_phase<false>(F, XA, F.in[IN_GFFN], modl, 6144, 8192); if (PROBE_REPEAT == 6) norm_phase<false>(F, XA, F.in[IN_GFFN], modl, 6144, 8192); }
        SEAM(6);
        if (IN(7)) {
            pg8::Gemm g{XN, (const bf16*)(F.ws + WS_WGU0), M, 2 * DFF, DM}; pg8::StaticOrder S; S.init(M, 2 * DFF, F.G, (int)blockIdx.x);
            pg8::EpiSwiglu E{HID, DFF, 44};
            pg8::gemm_phase<pg8::EpiSwiglu, pg8::StaticOrder, true, true>(F.lds + RING_OFF, g, S, E);
            if (PROBE_REPEAT == 7) pg8::gemm_phase<pg8::EpiSwiglu, pg8::StaticOrder, true, true>(F.lds + RING_OFF, g, S, E);
        }
        SEAM(7);
        if (IN(8)) {
            pg8::Gemm g{HID, (const bf16*)(F.ws + WS_WDN0), M, DM, DFF}; pg8::StaticOrder S; S.init(M, DM, F.G, (int)blockIdx.x);
            pg8::EpiResid E{XA, F.out, modl + 10240};
            pg8::gemm_phase<pg8::EpiResid, pg8::StaticOrder, true, true>(F.lds + RING_OFF, g, S, E);
            if (PROBE_REPEAT == 8) pg8::gemm_phase<pg8::EpiResid, pg8::StaticOrder, true, true>(F.lds + RING_OFF, g, S, E);
        }
        SEAM(8);
    }
    LAYER_MIX(1);
    const float* mod1 = MOD + (size_t)8 * 12288;
    if (IN(14)) norm_phase<true>(F, XA, F.in[IN_GFFN] + DM, mod1, 6144, 8192);
    SEAM(14);
    if (IN(15)) { moe_gather(F); if (PROBE_REPEAT == 15) moe_gather(F); }
    SEAM(15);
    if (IN(16)) {
        const int T = moe_tables(F);
        pg8::Gemm g{AS, (const bf16*)(F.ws + WS_WGU1), T * 256, 2 * DFFE, DM / 2}; pg8::GroupedOrder S; S.init(T, 56, F.G, (int)blockIdx.x, (const LAS int*)(F.lds + MISC_OFF + 64));
        pg8::EpiSwigluF8 E{(unsigned char*)HID, DFFE, 56};
        pg8::gemm_phase<pg8::EpiSwigluF8, pg8::GroupedOrder, true, true>(F.lds + RING_OFF, g, S, E);
        if (PROBE_REPEAT == 16) pg8::gemm_phase<pg8::EpiSwigluF8, pg8::GroupedOrder, true, true>(F.lds + RING_OFF, g, S, E);
    }
    SEAM(16);
    if (IN(17)) {
        const int T = moe_tables(F);
        pg8::Gemm g{HID, (const bf16*)(F.ws + WS_WDN1), T * 256, DM, DFFE / 2}; pg8::GroupedOrder S; S.init(T, 8, F.G, (int)blockIdx.x, (const LAS int*)(F.lds + MISC_OFF + 64));
        const int full = (S.nwg / F.G) * F.G, rem = S.nwg - full;
        pg8::EpiPlainBf16F8 E{AS, DM, 8};
        S.Lbase = 0; S.Lend = full;
        pg8::gemm_phase<pg8::EpiPlainBf16F8, pg8::GroupedOrder, true, true>(F.lds + RING_OFF, g, S, E);
        if (PROBE_REPEAT == 17) pg8::gemm_phase<pg8::EpiPlainBf16F8, pg8::GroupedOrder, true, true>(F.lds + RING_OFF, g, S, E);
        xcd_barrier(bar);
        LAS int* late = (LAS int*)(F.lds + MISC_OFF + 4096);
        for (int i = F.tid; i < 192; i += NWAVES * 64) late[i] = 0;
        __syncthreads();
        for (int i = F.tid; i < rem; i += NWAVES * 64) late[S.row_tile_of(full + i)] = 1;
        __syncthreads();
        if ((int)blockIdx.x < rem) { S.Lbase = full; S.Lend = S.nwg;
            pg8::gemm_phase<pg8::EpiPlainBf16F8, pg8::GroupedOrder, true, true>(F.lds + RING_OFF, g, S, E); }
        else moe_combine<1>(F, mod1 + 10240, ((int)blockIdx.x - rem) * NWAVES + F.wave, (F.G - rem) * NWAVES, late);
    }
    SEAM(17);
    if (IN(18)) { moe_combine<2>(F, mod1 + 10240, F.vcu * NWAVES + F.wave, F.G * NWAVES, (const LAS int*)(F.lds + MISC_OFF + 4096)); }
#undef IN
#undef SEAM
}

extern "C" void kernel_launch(void* const* d_in, const int* in_sizes, int n_in, void* d_out, int out_size, void* d_ws, size_t ws_size, hipStream_t stream) {
    static int grid = 0;
    if (grid == 0) {
        if (n_in != 26 || in_sizes[0] != M * DM || out_size != M * DM || ws_size < WS_END) { fprintf(stderr, "kernel_launch: unexpected shapes (n_in %d, in0 %d, out %d, ws %zu < %zu)\n", n_in, n_in > 0 ? in_sizes[0] : -1, out_size, ws_size, (size_t)WS_END); grid = -1; return; }
        int dev = 0, cus = 0, per_cu = 0;
        if (hipGetDevice(&dev) != hipSuccess || hipDeviceGetAttribute(&cus, hipDeviceAttributeMultiprocessorCount, dev) != hipSuccess) { grid = -1; return; }
        if (hipFuncSetAttribute((const void*)hybrid_fwd, hipFuncAttributeMaxDynamicSharedMemorySize, LDS_BYTES) != hipSuccess) { fprintf(stderr, "kernel_launch: hipFuncSetAttribute failed\n"); grid = -1; return; }
        if (hipOccupancyMaxActiveBlocksPerMultiprocessor(&per_cu, (const void*)hybrid_fwd, NWAVES * 64, LDS_BYTES) != hipSuccess || per_cu < 1) fprintf(stderr, "kernel_launch: occupancy query says %d\n", per_cu);
        (void)hipGetLastError();
        grid = cus < 256 ? cus : 256;
    }
    if (grid < 0) return;
    if (hipMemsetAsync((char*)d_ws + WS_CTL, 0, CTL_ZERO_BYTES, stream) != hipSuccess) return;
    Args a{};
    for (int i = 0; i < 26; ++i) a.in[i] = (const float*)d_in[i];
    a.out = (float*)d_out; a.ws = (unsigned char*)d_ws;
#if MK_ONE_LAUNCH
    a.ph_lo = 0; a.ph_hi = NPH;
    hipLaunchKernelGGL(hybrid_fwd, dim3(grid), dim3(NWAVES * 64), LDS_BYTES, stream, a);
#else
    for (int p = 0; p < NPH; ++p) { a.ph_lo = p; a.ph_hi = p + 1; hipLaunchKernelGGL(hybrid_fwd, dim3(grid), dim3(NWAVES * 64), LDS_BYTES, stream, a); }
#endif
}
```
